# Optimizing an MI355X kernel written in HIP

```python
import jax, jax.numpy as jnp
from jax import lax
import numpy as np

D_MODEL = 1024
BATCH = 8
SEQ = 4096
DEPTH = 2
DEC_BATCH = 4
DEC_SEQ = 4096
PAST_LEN = 128

GRID_W = 64
D_MIX = D_MODEL
D_RWKV = D_MIX // 2
D_NAT = D_MIX - D_RWKV
HEAD_DIM = 64
H_RWKV = D_RWKV // HEAD_DIM
H_NAT = D_NAT // HEAD_DIM
N_DIR = 2
DECAY_LORA = 64
AAA_LORA = 64
GATE_LORA = 128
MV_LORA = 32
WIN_ROWS = 8
WIN_COLS = 16
D_FF = 2816
RMS_EPS = 1e-6
LNX_EPS = 64e-5
RW_COLS = 3 * D_RWKV + N_DIR * DECAY_LORA + N_DIR * AAA_LORA + GATE_LORA
IN_COLS = RW_COLS + 3 * D_NAT

kernel_name = 'hybrid_rwkv7_natten2d_encoder'


def rms_norm(x, g):
    xf = x.astype(jnp.float32)
    y = xf * lax.rsqrt(jnp.mean(xf * xf, axis=-1, keepdims=True) + RMS_EPS)
    return (y * g.astype(jnp.float32)).astype(x.dtype)


def shift_prev(x):
    return jnp.pad(x, ((0, 0), (1, 0), (0, 0)))[:, :-1]


def shift_next(x):
    return jnp.pad(x, ((0, 0), (0, 1), (0, 0)))[:, 1:]


def to_scan_layout(x):
    xt = jnp.transpose(x, (1, 2, 0, 3, 4))
    return jnp.stack([xt[:, 0], jnp.flip(xt[:, 1], axis=0)], axis=1)


def rwkv7_scan(r, w, k, v, kk, a):
    _, nd, b, h, n = r.shape

    def step(S, inp):
        r_t, w_t, k_t, v_t, kk_t, a_t = inp
        s_kk = jnp.einsum('dbhij,dbhj->dbhi', S, -kk_t)
        S = (S * w_t[..., None, :]
             + s_kk[..., :, None] * (kk_t * a_t)[..., None, :]
             + v_t[..., :, None] * k_t[..., None, :])
        return S, jnp.einsum('dbhij,dbhj->dbhi', S, r_t)

    S0 = jnp.zeros((nd, b, h, n, n), jnp.float32)
    _, ys = lax.scan(step, S0, (r, w, k, v, kk, a))
    return ys[:, 0] + jnp.flip(ys[:, 1], axis=0)


def rwkv7_time_mix(p, v_first, li, prm):
    f32 = jnp.float32
    B, L, _ = p.shape
    H, N = H_RWKV, HEAD_DIM
    o1 = 3 * D_RWKV
    o2 = o1 + N_DIR * DECAY_LORA
    o3 = o2 + N_DIR * AAA_LORA
    r = p[..., :D_RWKV].astype(f32)
    k = p[..., D_RWKV:2 * D_RWKV].astype(f32)
    v = p[..., 2 * D_RWKV:o1].astype(f32)
    wd = p[..., o1:o2].reshape(B, L, N_DIR, DECAY_LORA)
    ad = p[..., o2:o3].reshape(B, L, N_DIR, AAA_LORA)
    gd = p[..., o3:]
    w_raw = prm['decay_w0'][li] + jnp.einsum('bldr,drc->bldc', jnp.tanh(wd), prm['decay_up'][li])
    decay = jnp.exp(-jnp.exp(-jax.nn.softplus(-w_raw.astype(f32)) - 0.5))
    a = jax.nn.sigmoid((prm['aaa_a0'][li] + jnp.einsum('bldr,drc->bldc', ad, prm['aaa_up'][li])).astype(f32))
    g = (jax.nn.sigmoid(gd) @ prm['gate_up'][li]).astype(f32)
    if v_first is None:
        v_first = v
    else:
        j = li - 1
        mix = jax.nn.sigmoid((prm['vres_v0'][j] + (v @ prm['vres_down'][j]) @ prm['vres_up'][j]).astype(f32))
        v = v + (v_first - v) * mix
    kk = (k * prm['k_k'][li]).reshape(B, L, H, N)
    kk = kk * lax.rsqrt(jnp.maximum(jnp.sum(kk * kk, axis=-1, keepdims=True), 1e-12))
    kd = k[:, :, None, :] * (1.0 + (a - 1.0) * prm['k_a'][li])
    rh = r.reshape(B, L, H, N)
    vh = v.reshape(B, L, H, N)

    def heads(t):
        return t.reshape(B, L, N_DIR, H, N)

    def both(t):
        return jnp.broadcast_to(t[:, :, None], (B, L, N_DIR, H, N))

    y = rwkv7_scan(to_scan_layout(both(rh)), to_scan_layout(heads(decay)), to_scan_layout(heads(kd)),
                   to_scan_layout(both(vh)), to_scan_layout(both(kk)), to_scan_layout(heads(a)))
    y = jnp.transpose(y, (1, 0, 2, 3))
    mu = jnp.mean(y, axis=-1, keepdims=True)
    var = jnp.mean(jnp.square(y - mu), axis=-1, keepdims=True)
    y = ((y - mu) * lax.rsqrt(var + LNX_EPS)).reshape(B, L, D_RWKV) * prm['lnx_g'][li] + prm['lnx_b'][li]
    bonus = jnp.sum(rh * jnp.sum(heads(kd), axis=2) * prm['r_k'][li], axis=-1, keepdims=True) * vh
    out = (y + bonus.reshape(B, L, D_RWKV)) * g
    return out.astype(p.dtype), v_first


def neighbourhood_attention(q, k, v, li, prm):
    B, L, _ = q.shape
    rows = L // GRID_W
    kh = min(WIN_ROWS, rows)
    kw = WIN_COLS
    q = rms_norm(q.reshape(B, L, H_NAT, HEAD_DIM), prm['qn_g'][li]) * (HEAD_DIM ** -0.5)
    k = rms_norm(k.reshape(B, L, H_NAT, HEAD_DIM), prm['kn_g'][li])
    q_grid = q.reshape(B, rows, GRID_W, H_NAT, HEAD_DIM)
    k_grid = k.reshape(B, rows, GRID_W, H_NAT, HEAD_DIM)
    v_grid = v.reshape(B, rows, GRID_W, H_NAT, HEAD_DIM)
    cols = np.arange(GRID_W)
    col_start = np.clip(cols - kw // 2, 0, GRID_W - kw)
    col_idx = col_start[:, None] + np.arange(kw)[None, :]
    col_bias_idx = col_idx - cols[:, None] + (WIN_COLS - 1)
    rpb_cols = prm['rpb'][li][:, :, col_bias_idx].astype(jnp.float32)

    def row_block(r):
        rs = jnp.clip(r - kh // 2, 0, rows - kh)
        k_rows = lax.dynamic_slice_in_dim(k_grid, rs, kh, axis=1)
        v_rows = lax.dynamic_slice_in_dim(v_grid, rs, kh, axis=1)
        k_g = k_rows[:, :, col_idx]
        v_g = v_rows[:, :, col_idx]
        q_r = lax.dynamic_index_in_dim(q_grid, r, axis=1, keepdims=False)
        s = jnp.einsum('bchd,bicjhd->bhcij', q_r, k_g, preferred_element_type=jnp.float32)
        row_bias_idx = rs + jnp.arange(kh) - r + (WIN_ROWS - 1)
        bias = jnp.take(rpb_cols, row_bias_idx, axis=1)
        s = s + jnp.transpose(bias, (0, 2, 1, 3))[None]
        pr = jax.nn.softmax(s.reshape(B, H_NAT, GRID_W, kh * kw), axis=-1)
        pr = pr.reshape(B, H_NAT, GRID_W, kh, kw).astype(v_g.dtype)
        return jnp.einsum('bhcij,bicjhd->bchd', pr, v_g)

    out = lax.map(row_block, jnp.arange(rows))
    return jnp.transpose(out, (1, 0, 2, 3, 4)).reshape(B, L, D_NAT)


def conv_ffn(x, li, prm):
    h = rms_norm(x, prm['norm2_g'][li])
    u = h @ prm['w_up'][li]
    cw = prm['conv_w'][li]
    u = cw[0] * shift_prev(u) + cw[1] * u + cw[2] * shift_next(u) + prm['conv_b'][li]
    gate, val = u[..., :D_FF], u[..., D_FF:]
    return (jax.nn.silu(gate) * val) @ prm['w_down'][li]


def encoder_trunk(x, prm):
    v_first = None
    for li in range(DEPTH):
        h = rms_norm(x, prm['norm1_g'][li])
        proj = h @ prm['w_in'][li]
        p_rw = proj[..., :RW_COLS]
        p_na = proj[..., RW_COLS:]
        mu = prm['shift_mu'][li]
        p_rw = p_rw + mu[0] * (shift_prev(p_rw) - p_rw) + mu[1] * (shift_next(p_rw) - p_rw)
        rw_out, v_first = rwkv7_time_mix(p_rw, v_first, li, prm)
        na_out = neighbourhood_attention(p_na[..., :D_NAT], p_na[..., D_NAT:2 * D_NAT],
                                         p_na[..., 2 * D_NAT:], li, prm)
        x = x + jnp.concatenate([rw_out, na_out], axis=-1) @ prm['w_out'][li]
        x = x + conv_ffn(x, li, prm)
    return x


def setup_inputs(seed: int = 0) -> dict:
    key = jax.random.key(seed)
    ks = jax.random.split(key, 28)
    f32 = jnp.float32

    def nrm(k, shape, s):
        return s * jax.random.normal(k, shape, f32)

    def unif(k, shape, lo, hi):
        return jax.random.uniform(k, shape, f32, lo, hi)

    return {
        'x_prompt': nrm(ks[0], (BATCH, SEQ, D_MODEL), 1.0),
        'x_sample': nrm(ks[1], (DEC_BATCH, DEC_SEQ, D_MODEL), 1.0),
        'norm1_g': 1.0 + nrm(ks[2], (DEPTH, D_MODEL), 0.02),
        'w_in': nrm(ks[3], (DEPTH, D_MODEL, IN_COLS), D_MODEL ** -0.5),
        'shift_mu': unif(ks[4], (DEPTH, 2, RW_COLS), 0.0, 0.6),
        'decay_w0': unif(ks[5], (DEPTH, N_DIR, D_RWKV), -5.0, 0.5),
        'decay_up': nrm(ks[6], (DEPTH, N_DIR, DECAY_LORA, D_RWKV), 0.5 * DECAY_LORA ** -0.5),
        'aaa_a0': nrm(ks[7], (DEPTH, N_DIR, D_RWKV), 0.1),
        'aaa_up': nrm(ks[8], (DEPTH, N_DIR, AAA_LORA, D_RWKV), 0.5 * AAA_LORA ** -0.5),
        'gate_up': nrm(ks[9], (DEPTH, GATE_LORA, D_RWKV), GATE_LORA ** -0.5),
        'vres_v0': 0.5 + nrm(ks[10], (DEPTH - 1, D_RWKV), 0.1),
        'vres_down': nrm(ks[11], (DEPTH - 1, D_RWKV, MV_LORA), D_RWKV ** -0.5),
        'vres_up': nrm(ks[12], (DEPTH - 1, MV_LORA, D_RWKV), 0.5 * MV_LORA ** -0.5),
        'k_k': 0.85 + nrm(ks[13], (DEPTH, D_RWKV), 0.02),
        'k_a': 1.0 + nrm(ks[14], (DEPTH, D_RWKV), 0.02),
        'r_k': nrm(ks[15], (DEPTH, H_RWKV, HEAD_DIM), 0.1),
        'lnx_g': 1.0 + nrm(ks[16], (DEPTH, D_RWKV), 0.02),
        'lnx_b': nrm(ks[17], (DEPTH, D_RWKV), 0.02),
        'qn_g': 1.0 + nrm(ks[18], (DEPTH, HEAD_DIM), 0.02),
        'kn_g': 1.0 + nrm(ks[19], (DEPTH, HEAD_DIM), 0.02),
        'rpb': nrm(ks[20], (DEPTH, H_NAT, 2 * WIN_ROWS - 1, 2 * WIN_COLS - 1), 0.02),
        'w_out': nrm(ks[21], (DEPTH, D_MIX, D_MODEL), D_MIX ** -0.5),
        'norm2_g': 1.0 + nrm(ks[22], (DEPTH, D_MODEL), 0.02),
        'w_up': nrm(ks[23], (DEPTH, D_MODEL, 2 * D_FF), D_MODEL ** -0.5),
        'conv_w': nrm(ks[24], (DEPTH, 3, 2 * D_FF), 3 ** -0.5),
        'conv_b': nrm(ks[25], (DEPTH, 2 * D_FF), 0.02),
        'w_down': nrm(ks[26], (DEPTH, D_FF, D_MODEL), D_FF ** -0.5),
    }


def reference(x_prompt, x_sample, norm1_g, w_in, shift_mu, decay_w0, decay_up, aaa_a0, aaa_up,
              gate_up, vres_v0, vres_down, vres_up, k_k, k_a, r_k, lnx_g, lnx_b, qn_g, kn_g,
              rpb, w_out, norm2_g, w_up, conv_w, conv_b, w_down):
    prm = {
        'norm1_g': norm1_g, 'w_in': w_in, 'shift_mu': shift_mu,
        'decay_w0': decay_w0, 'decay_up': decay_up, 'aaa_a0': aaa_a0, 'aaa_up': aaa_up,
        'gate_up': gate_up, 'vres_v0': vres_v0, 'vres_down': vres_down, 'vres_up': vres_up,
        'k_k': k_k, 'k_a': k_a, 'r_k': r_k, 'lnx_g': lnx_g, 'lnx_b': lnx_b,
        'qn_g': qn_g, 'kn_g': kn_g, 'rpb': rpb, 'w_out': w_out,
        'norm2_g': norm2_g, 'w_up': w_up, 'conv_w': conv_w, 'conv_b': conv_b, 'w_down': w_down,
    }
    y_prompt = encoder_trunk(x_prompt, prm)
    y_sample = encoder_trunk(x_sample, prm)
    return (y_prompt, y_sample)
```

```cpp
#include <hip/hip_runtime.h>
#include <cstdio>
#include <cstdint>
namespace pg8 {
#define PG8_LAS __attribute__((address_space(3)))
typedef unsigned short bf16_t;
typedef short bf16x8 __attribute__((ext_vector_type(8)));
typedef float f32x4 __attribute__((ext_vector_type(4)));
typedef unsigned u32x4 __attribute__((ext_vector_type(4)));
constexpr int BM = 256, BK = 64, HALF = 128, HTB = HALF * BK * 2  , STAGE_BYTES = 8 * HTB, NXCD = 8, WGM = 8;

__host__ __device__ __forceinline__ int lds_byte(int r, int c) { const int st = (r >> 4) * 2 + (c >> 5), rr = r & 15, cc = c & 31, ob = rr * 64 + cc * 2; return st * 1024 + (ob ^ (((ob >> 9) & 1) << 5)); }
__host__ __device__ __forceinline__ void stage_rc(int b, int& R, int& C) { const int st = b / 1024, sb = b % 1024, swz = sb ^ (((sb >> 9) & 1) << 5); R = (st >> 1) * 16 + swz / 64; C = (st & 1) * 32 + (swz % 64) / 2; }
__host__ __device__ __forceinline__ int perm32(int rho) { const int n = rho >> 4, i = rho & 15; return 8 * (i >> 2) + 4 * n + (i & 3); }

struct Unit { int pm, pn; };
struct Gemm { const bf16_t* A; const bf16_t* Bt; int M, N, K, pad; };

struct StaticOrder {
    int nM, nN, nwg, G, c;
    __host__ __device__ void init(int M, int N, int G_, int c_) { nM = M / BM; nN = N / BM; nwg = nM * nN; G = G_; c = c_; }
    __host__ __device__ bool next(int i, Unit& u) const {
        const long L = (long)i * G + c; if (L >= nwg) return false;
        int wgid = (int)L; { const int q = nwg / NXCD, r = nwg % NXCD, xcd = wgid % NXCD, off = wgid / NXCD; wgid = (xcd < r ? xcd * (q + 1) : r * (q + 1) + (xcd - r) * q) + off; }
        const int nig = WGM * nN, gid = wgid / nig, fm = gid * WGM, gsz = (nM - fm) < WGM ? (nM - fm) : WGM;
        u.pm = fm + ((wgid % nig) % gsz); u.pn = (wgid % nig) / gsz; return true;
    }
    __device__ __forceinline__ void a_ready(const Unit&) const {}
    __device__ __forceinline__ void done(const Unit&) const {}
};

__device__ __forceinline__ unsigned cvt_pk_bf16(float lo, float hi) { unsigned r; asm volatile("v_cvt_pk_bf16_f32 %0, %1, %2" : "=v"(r) : "v"(lo), "v"(hi)); return r; }
typedef float f32x2 __attribute__((ext_vector_type(2)));
template <class Epi, class Sched, bool ALIGN_EPI = false, bool SP2 = false>
__device__ __forceinline__ void gemm_phase(PG8_LAS unsigned char* lds, const Gemm g, const Sched& S, const Epi& E) {
    const int tid = threadIdx.x, wid = __builtin_amdgcn_readfirstlane(tid >> 6), lane = tid & 63, wr = wid >> 2, wc = wid & 3, fr = lane & 15, fq = lane >> 4;
    const int K = g.K, nt = K / BK;
    unsigned voffA[2], voffB[2];
#pragma unroll
    for (int i = 0; i < 2; ++i) { int R, C; stage_rc(tid * 16 + i * 8192, R, C); const int Rb = Epi::PERM ? ((R & ~31) + perm32(R & 31)) : R;
        voffA[i] = (unsigned)(R * K + C) * 2u; voffB[i] = (unsigned)(Rb * K + C) * 2u; }
    const size_t kstep = (size_t)(BK * 2);
    const size_t hstep = (size_t)HALF * K * 2;
    const size_t tstep = 2 * hstep;
    const unsigned ldsw = (unsigned)wid * 1024u;
    const int aoff = lds_byte(wr * 64 + fr, fq * 8), boff = lds_byte(wc * 32 + fr, fq * 8);
#define PG8_SA(b, h) (((b) * 2 + (h)) * HTB)
#define PG8_SB(b, h) ((4 + (b) * 2 + (h)) * HTB)
#define PG8_STAGE(bufoff, gbase, voff) do { _Pragma("unroll") for (int _i = 0; _i < 2; ++_i) \
        __builtin_amdgcn_global_load_lds((const unsigned*)((const char*)(gbase) + (voff)[_i]), (PG8_LAS unsigned*)(lds + (bufoff) + ldsw + _i * 8192), 16, 0, 0); } while (0)
#define PG8_LDA(dst, b, h) do { _Pragma("unroll") for (int m = 0; m < 4; ++m) _Pragma("unroll") for (int k = 0; k < 2; ++k) dst[m][k] = *(const PG8_LAS bf16x8*)(lds + PG8_SA(b, h) + aoff + m * 2048 + k * 1024); } while (0)
#define PG8_LDB(dst, b, h) do { _Pragma("unroll") for (int n = 0; n < 2; ++n) _Pragma("unroll") for (int k = 0; k < 2; ++k) dst[n][k] = *(const PG8_LAS bf16x8*)(lds + PG8_SB(b, h) + boff + n * 2048 + k * 1024); } while (0)
#define PG8_MMA(ai, bj, At, Bt) do { __builtin_amdgcn_s_setprio(1); _Pragma("unroll") for (int m = 0; m < 4; ++m) _Pragma("unroll") for (int n = 0; n < 2; ++n) _Pragma("unroll") for (int k = 0; k < 2; ++k) \
        acc[ai][bj][m][n] = __builtin_amdgcn_mfma_f32_16x16x32_bf16(Bt[n][k], At[m][k], acc[ai][bj][m][n], 0, 0, 0); __builtin_amdgcn_s_setprio(0); } while (0)
#define PG8_WAIT_V(n) asm volatile("s_waitcnt vmcnt(" #n ")" ::: "memory")
#define PG8_WAIT_L(n) asm volatile("s_waitcnt lgkmcnt(" #n ")" ::: "memory")
#define PG8_BAR __builtin_amdgcn_s_barrier()
#define PG8_SCHED __builtin_amdgcn_sched_barrier(0)
    Unit cur, nxt; int ui = 0;
    if (!S.next(0, cur)) return;
    f32x4 acc[2][2][4][2];
#pragma unroll
    for (int a = 0; a < 2; ++a)
#pragma unroll
        for (int b = 0; b < 2; ++b)
#pragma unroll
            for (int m = 0; m < 4; ++m)
#pragma unroll
                for (int n = 0; n < 2; ++n) acc[a][b][m][n] = (f32x4){0.f, 0.f, 0.f, 0.f};
    bf16x8 At[4][2], B0[2][2], B1[2][2];
    const char* cA = (const char*)g.A + (size_t)cur.pm * tstep; const char* cB = (const char*)g.Bt + (size_t)cur.pn * tstep;
    S.a_ready(cur);
    if constexpr (SP2) {
        PG8_STAGE(PG8_SB(0, 0), cB, voffB); PG8_STAGE(PG8_SB(0, 1), cB + hstep, voffB); PG8_STAGE(PG8_SA(0, 0), cA, voffA); PG8_STAGE(PG8_SA(0, 1), cA + hstep, voffA);
        if (wr == 1) PG8_BAR;
        PG8_WAIT_V(2); PG8_BAR;
        PG8_STAGE(PG8_SB(1, 0), cB + kstep, voffB); PG8_STAGE(PG8_SA(1, 0), cA + kstep, voffA); PG8_STAGE(PG8_SB(1, 1), cB + hstep + kstep, voffB);
        PG8_WAIT_V(6); PG8_BAR;
    } else {
        PG8_STAGE(PG8_SB(0, 0), cB, voffB); PG8_STAGE(PG8_SA(0, 0), cA, voffA); PG8_STAGE(PG8_SB(0, 1), cB + hstep, voffB); PG8_STAGE(PG8_SA(0, 1), cA + hstep, voffA);
        if (wr == 1) PG8_BAR;
        PG8_WAIT_V(4); PG8_BAR;
        PG8_STAGE(PG8_SB(1, 0), cB + kstep, voffB); PG8_STAGE(PG8_SA(1, 0), cA + kstep, voffA); PG8_STAGE(PG8_SB(1, 1), cB + hstep + kstep, voffB);
        PG8_WAIT_V(6); PG8_BAR;
    }
    for (;;) {
        const bool has_next = S.next(ui + 1, nxt);
        const char* nA = has_next ? (const char*)g.A + (size_t)nxt.pm * tstep : cA; const char* nB = has_next ? (const char*)g.Bt + (size_t)nxt.pn * tstep : cB;
        for (int t = 0; t < nt; t += 2) {
            const bool last = (t == nt - 2);
            const char* a1 = cA + (size_t)(t + 1) * kstep;
            const char* a2 = last ? nA : cA + (size_t)(t + 2) * kstep; const char* b2 = last ? nB : cB + (size_t)(t + 2) * kstep;
            const char* a3 = a2 + kstep; const char* b3 = b2 + kstep;
            if (last && has_next) S.a_ready(nxt);
            if constexpr (SP2) {
            PG8_LDB(B0, 0, 0); PG8_LDB(B1, 0, 1); PG8_SCHED; PG8_LDA(At, 0, 0); PG8_STAGE(PG8_SA(1, 1), a1 + hstep, voffA);
            PG8_WAIT_V(8); PG8_WAIT_L(0); PG8_BAR; PG8_MMA(0, 0, At, B0); PG8_MMA(0, 1, At, B1); PG8_BAR; PG8_SCHED;
            PG8_LDA(At, 0, 1); PG8_STAGE(PG8_SB(0, 0), b2, voffB); PG8_STAGE(PG8_SB(0, 1), b2 + hstep, voffB); PG8_STAGE(PG8_SA(0, 0), a2, voffA);
            PG8_WAIT_V(8); PG8_WAIT_L(0); PG8_BAR; PG8_MMA(1, 0, At, B0); PG8_MMA(1, 1, At, B1); PG8_BAR; PG8_SCHED;
            PG8_LDB(B0, 1, 0); PG8_LDB(B1, 1, 1); PG8_SCHED; PG8_LDA(At, 1, 0); PG8_STAGE(PG8_SA(0, 1), a2 + hstep, voffA);
            PG8_WAIT_V(8); PG8_WAIT_L(0); PG8_BAR; PG8_MMA(0, 0, At, B0); PG8_MMA(0, 1, At, B1); PG8_BAR; PG8_SCHED;
            PG8_LDA(At, 1, 1); PG8_STAGE(PG8_SB(1, 0), b3, voffB); PG8_STAGE(PG8_SB(1, 1), b3 + hstep, voffB); PG8_STAGE(PG8_SA(1, 0), a3, voffA);
            PG8_WAIT_V(8); PG8_WAIT_L(0); PG8_BAR; PG8_MMA(1, 0, At, B0); PG8_MMA(1, 1, At, B1); PG8_BAR; PG8_SCHED;
            } else {
            PG8_LDB(B0, 0, 0); PG8_SCHED; PG8_LDA(At, 0, 0); PG8_STAGE(PG8_SA(1, 1), a1 + hstep, voffA);
            PG8_WAIT_L(8); PG8_BAR; PG8_WAIT_L(0); PG8_MMA(0, 0, At, B0); PG8_BAR; PG8_SCHED;
            PG8_LDB(B1, 0, 1); PG8_STAGE(PG8_SB(0, 0), b2, voffB);
            PG8_BAR; PG8_WAIT_L(0); PG8_MMA(0, 1, At, B1); PG8_BAR;
            PG8_LDA(At, 0, 1); PG8_STAGE(PG8_SA(0, 0), a2, voffA);
            PG8_BAR; PG8_WAIT_L(0); PG8_MMA(1, 0, At, B0); PG8_BAR; PG8_SCHED;
            PG8_STAGE(PG8_SB(0, 1), b2 + hstep, voffB);
            PG8_WAIT_V(6); PG8_BAR; PG8_MMA(1, 1, At, B1); PG8_BAR;
            PG8_LDB(B0, 1, 0); PG8_SCHED; PG8_LDA(At, 1, 0); PG8_STAGE(PG8_SA(0, 1), a2 + hstep, voffA);
            PG8_WAIT_L(8); PG8_BAR; PG8_WAIT_L(0); PG8_MMA(0, 0, At, B0); PG8_BAR; PG8_SCHED;
            PG8_LDB(B1, 1, 1); PG8_STAGE(PG8_SB(1, 0), b3, voffB);
            PG8_BAR; PG8_WAIT_L(0); PG8_MMA(0, 1, At, B1); PG8_BAR;
            PG8_LDA(At, 1, 1); PG8_STAGE(PG8_SA(1, 0), a3, voffA);
            PG8_BAR; PG8_WAIT_L(0); PG8_MMA(1, 0, At, B0); PG8_BAR; PG8_SCHED;
            PG8_STAGE(PG8_SB(1, 1), b3 + hstep, voffB);
            PG8_WAIT_V(6); PG8_BAR; PG8_MMA(1, 1, At, B1); PG8_BAR;
            }
        }
        if constexpr (ALIGN_EPI) { if (wr == 0) PG8_BAR; }
        if constexpr (!Epi::AFTER_DRAIN) { E(acc, cur, wr, wc, fr, fq); S.done(cur); }
        if (!has_next) break;
#pragma unroll
        for (int a = 0; a < 2; ++a)
#pragma unroll
            for (int b = 0; b < 2; ++b)
#pragma unroll
                for (int m = 0; m < 4; ++m)
#pragma unroll
                    for (int n = 0; n < 2; ++n) acc[a][b][m][n] = (f32x4){0.f, 0.f, 0.f, 0.f};
        cur = nxt; cA = nA; cB = nB; ++ui;
        if constexpr (ALIGN_EPI) { if (wr == 1) PG8_BAR; }
    }
    PG8_WAIT_V(0);
    if constexpr (!ALIGN_EPI) { if (wr == 0) PG8_BAR; }
    PG8_BAR;
    if constexpr (Epi::AFTER_DRAIN) { E.fused(acc, cur, wr, wc, fr, fq, lds, wid, lane); S.done(cur); }
#undef PG8_SA
#undef PG8_SB
#undef PG8_STAGE
#undef PG8_LDA
#undef PG8_LDB
#undef PG8_MMA
#undef PG8_WAIT_V
#undef PG8_WAIT_L
#undef PG8_BAR
#undef PG8_SCHED
}
}

typedef unsigned short bf16_t;
typedef float f32x4 __attribute__((ext_vector_type(4)));

constexpr int D = 1024, NSEQ = 12, SEQ = 4096, NTOK = NSEQ * SEQ, DEPTH = 2;
constexpr int DR = 512, NH = 8, RWC = 1920, PC = 3584, NATOFF = 2048, DFF = 2816, UPC = 5632;
constexpr int O_WD = 1536, O_AD = 1664, O_GD = 1792;

__device__ __forceinline__ unsigned short f2bf(float f) { unsigned u = __float_as_uint(f); u += 0x7fffu + ((u >> 16) & 1u); return (unsigned short)(u >> 16); }
__device__ __forceinline__ float wave_sum(float v) {
#pragma unroll
    for (int o = 1; o < 64; o <<= 1) v += __shfl_xor(v, o);
    return v;
}
__device__ __forceinline__ float sigmoidf_(float x) { return 1.f / (1.f + expf(-x)); }

__global__ void k_prep_w(const float* __restrict__ W, int K, int Nsrc, const float* __restrict__ scale, bf16_t* __restrict__ out, int Nout, int mode) {
    __shared__ float tile[32][33];
    const int n0 = blockIdx.x * 32, k0 = blockIdx.y * 32, tx = threadIdx.x, ty = threadIdx.y;
    for (int i = ty; i < 32; i += 8) {
        const int n = n0 + tx, k = k0 + i; int ns = n; bool valid = true;
        if (mode == 1) { if (n < 1920) ns = n; else if (n < 2048) valid = false; else ns = n - 128; }
        float v = 0.f;
        if (valid) v = W[(size_t)k * Nsrc + ns] * (scale ? scale[k] : 1.f);
        tile[i][tx] = v;
    }
    __syncthreads();
    for (int i = ty; i < 32; i += 8) { const int n = n0 + i, k = k0 + tx; out[(size_t)n * K + k] = f2bf(tile[tx][i]); }
}

__global__ void k_rms(const float* __restrict__ xin, float* __restrict__ xcopy, bf16_t* __restrict__ xb, float* __restrict__ rstd, int rows) {
    const int row = blockIdx.x * 4 + (threadIdx.x >> 6), lane = threadIdx.x & 63;
    if (row >= rows) return;
    const f32x4* xr = (const f32x4*)(xin + (size_t)row * D);
    f32x4 v[4]; float s = 0.f;
#pragma unroll
    for (int j = 0; j < 4; ++j) { v[j] = xr[lane + 64 * j]; s += v[j].x * v[j].x + v[j].y * v[j].y + v[j].z * v[j].z + v[j].w * v[j].w; }
    s = wave_sum(s);
    if (lane == 0) rstd[row] = rsqrtf(s * (1.f / D) + 1e-6f);
#pragma unroll
    for (int j = 0; j < 4; ++j) {
        const int c = (lane + 64 * j) * 4;
        bf16_t* o = xb + (size_t)row * D + c;
        o[0] = f2bf(v[j].x); o[1] = f2bf(v[j].y); o[2] = f2bf(v[j].z); o[3] = f2bf(v[j].w);
        if (xcopy) *(f32x4*)(xcopy + (size_t)row * D + c) = v[j];
    }
}

struct EpiRow {
    static constexpr bool PERM = false, AFTER_DRAIN = false;
    float* C; const float* rowscale; const float* resid; int ldc; int pad;
    __device__ __forceinline__ void operator()(const pg8::f32x4 (&acc)[2][2][4][2], const pg8::Unit& u, int wr, int wc, int fr, int fq) const {
        const int row0 = u.pm * 256 + wr * 64 + fr, col0 = u.pn * 256 + wc * 32 + 4 * fq;
#pragma unroll
        for (int ai = 0; ai < 2; ++ai)
#pragma unroll
            for (int m = 0; m < 4; ++m) {
                const int row = row0 + ai * 128 + m * 16; const float s = rowscale ? rowscale[row] : 1.f;
#pragma unroll
                for (int bj = 0; bj < 2; ++bj)
#pragma unroll
                    for (int n = 0; n < 2; ++n) {
                        const size_t off = (size_t)row * ldc + col0 + bj * 128 + n * 16;
                        pg8::f32x4 v = acc[ai][bj][m][n] * s;
                        if (resid) v += *(const pg8::f32x4*)(resid + off);
                        *(pg8::f32x4*)(C + off) = v;
                    }
            }
    }
};
template <class Epi> __global__ __launch_bounds__(512, 2) void k_gemm(pg8::Gemm g, Epi E) {
    extern __shared__ __attribute__((aligned(16))) unsigned char shm[];
    pg8::StaticOrder S; S.init(g.M, g.N, (int)gridDim.x, (int)blockIdx.x);
    pg8::gemm_phase<Epi, pg8::StaticOrder, true, true>((PG8_LAS unsigned char*)shm, g, S, E);
}

struct PreArgs {
    const float *P, *mu, *w0, *wup, *a0, *aup, *gup, *v0, *vdown, *vup, *kk_, *ka, *rk;
    float *R, *KK, *V, *W, *KD, *B, *G, *BON, *vfirst; int layer; int pad;
};
__global__ __launch_bounds__(512) void k_rwkv_pre(PreArgs a) {
    __shared__ float p[RWC]; __shared__ float tw[128]; __shared__ float sg[128]; __shared__ float hid[32]; __shared__ float hpart[16][32]; __shared__ float vsh[512];
    const int t = blockIdx.x, c = threadIdx.x, h = c >> 6, lane = c & 63;
    const float* Pc = a.P + (size_t)t * PC;
    for (int i = c; i < RWC; i += 512) {
        const float cur = Pc[i], pv = t > 0 ? Pc[i - PC] : 0.f, nx = t < SEQ - 1 ? Pc[i + PC] : 0.f;
        p[i] = cur + a.mu[i] * (pv - cur) + a.mu[RWC + i] * (nx - cur);
    }
    __syncthreads();
    if (c < 128) { tw[c] = tanhf(p[O_WD + c]); sg[c] = sigmoidf_(p[O_GD + c]); }
    const float r = p[c], k = p[512 + c]; float v = p[1024 + c];
    vsh[c] = v;
    __syncthreads();
    if (a.layer > 0) {
        { const int j = c & 31, part = c >> 5; float s = 0.f; for (int q = 0; q < 32; ++q) { const int cc = part * 32 + q; s += vsh[cc] * a.vdown[cc * 32 + j]; } hpart[part][j] = s; }
        __syncthreads();
        if (c < 32) { float s = 0.f; for (int q = 0; q < 16; ++q) s += hpart[q][c]; hid[c] = s; }
        __syncthreads();
        float m = a.v0[c]; for (int j = 0; j < 32; ++j) m += hid[j] * a.vup[j * 512 + c];
        m = sigmoidf_(m);
        const float vf = a.vfirst[(size_t)t * 512 + c];
        v = v + (vf - v) * m;
    } else a.vfirst[(size_t)t * 512 + c] = v;
    float dec[2], aa[2];
    for (int d = 0; d < 2; ++d) {
        float wr = a.w0[d * 512 + c], ar = a.a0[d * 512 + c];
        for (int j = 0; j < 64; ++j) { wr += tw[d * 64 + j] * a.wup[(d * 64 + j) * 512 + c]; ar += p[O_AD + d * 64 + j] * a.aup[(d * 64 + j) * 512 + c]; }
        const float xx = -wr, sp = fmaxf(xx, 0.f) + log1pf(expf(-fabsf(xx)));
        dec[d] = expf(-expf(-sp - 0.5f));
        aa[d] = sigmoidf_(ar);
    }
    float g = 0.f; for (int j = 0; j < 128; ++j) g += sg[j] * a.gup[j * 512 + c];
    const float kkr = k * a.kk_[c]; const float ss = wave_sum(kkr * kkr);
    const float kk = kkr * rsqrtf(fmaxf(ss, 1e-12f));
    const float kd0 = k * (1.f + (aa[0] - 1.f) * a.ka[c]), kd1 = k * (1.f + (aa[1] - 1.f) * a.ka[c]);
    const float bon = wave_sum(r * (kd0 + kd1) * a.rk[c]);
    const size_t o1 = (size_t)t * 512 + c, o2 = (size_t)t * 1024 + c;
    a.R[o1] = r; a.KK[o1] = kk; a.V[o1] = v; a.G[o1] = g;
    a.W[o2] = dec[0]; a.W[o2 + 512] = dec[1]; a.KD[o2] = kd0; a.KD[o2 + 512] = kd1; a.B[o2] = kk * aa[0]; a.B[o2 + 512] = kk * aa[1];
    if (lane == 0) a.BON[t * 8 + h] = bon;
}

__global__ __launch_bounds__(512) void k_scan(const float* __restrict__ R, const float* __restrict__ KK, const float* __restrict__ V, const float* __restrict__ W,
                                              const float* __restrict__ KD, const float* __restrict__ B, float* __restrict__ Y) {
    const int chain = blockIdx.x, dir = chain >> 3, h = chain & 7, tid = threadIdx.x, i = tid >> 3, q = tid & 7;
    float S[8];
#pragma unroll
    for (int j = 0; j < 8; ++j) S[j] = 0.f;
    for (int s = 0; s < SEQ; ++s) {
        const int t = dir ? SEQ - 1 - s : s;
        const size_t o1 = (size_t)t * 512 + h * 64 + q * 8, o2 = ((size_t)t * 2 + dir) * 512 + h * 64 + q * 8;
        float kk[8], r[8], w[8], kd[8], b[8];
        *(f32x4*)&kk[0] = *(const f32x4*)(KK + o1); *(f32x4*)&kk[4] = *(const f32x4*)(KK + o1 + 4);
        *(f32x4*)&r[0] = *(const f32x4*)(R + o1);   *(f32x4*)&r[4] = *(const f32x4*)(R + o1 + 4);
        *(f32x4*)&w[0] = *(const f32x4*)(W + o2);   *(f32x4*)&w[4] = *(const f32x4*)(W + o2 + 4);
        *(f32x4*)&kd[0] = *(const f32x4*)(KD + o2); *(f32x4*)&kd[4] = *(const f32x4*)(KD + o2 + 4);
        *(f32x4*)&b[0] = *(const f32x4*)(B + o2);   *(f32x4*)&b[4] = *(const f32x4*)(B + o2 + 4);
        const float v = V[(size_t)t * 512 + h * 64 + i];
        float sk = 0.f;
#pragma unroll
        for (int j = 0; j < 8; ++j) sk += S[j] * kk[j];
        sk += __shfl_xor(sk, 1); sk += __shfl_xor(sk, 2); sk += __shfl_xor(sk, 4);
        float y = 0.f;
#pragma unroll
        for (int j = 0; j < 8; ++j) { S[j] = S[j] * w[j] - sk * b[j] + v * kd[j]; y += S[j] * r[j]; }
        y += __shfl_xor(y, 1); y += __shfl_xor(y, 2); y += __shfl_xor(y, 4);
        if (q == 0) Y[((size_t)dir * SEQ + t) * 512 + h * 64 + i] = y;
    }
}

__global__ __launch_bounds__(512) void k_post(const float* __restrict__ Y, const float* __restrict__ V, const float* __restrict__ G, const float* __restrict__ BON,
                                              const float* __restrict__ lg, const float* __restrict__ lb, bf16_t* __restrict__ mix) {
    const int t = blockIdx.x, c = threadIdx.x, h = c >> 6;
    const float y = Y[(size_t)t * 512 + c] + Y[((size_t)SEQ + t) * 512 + c];
    const float mu = wave_sum(y) * (1.f / 64.f); const float dv = y - mu; const float var = wave_sum(dv * dv) * (1.f / 64.f);
    const float yn = dv * rsqrtf(var + 64e-5f) * lg[c] + lb[c];
    const float o = (yn + BON[t * 8 + h] * V[(size_t)t * 512 + c]) * G[(size_t)t * 512 + c];
    mix[(size_t)t * 1024 + c] = f2bf(o);
}

__global__ __launch_bounds__(512) void k_qknorm(float* __restrict__ P, const float* __restrict__ qg, const float* __restrict__ kg) {
    const int t = blockIdx.x, c = threadIdx.x;
    float* row = P + (size_t)t * PC + NATOFF;
    const float q = row[c], k = row[512 + c];
    const float sq = wave_sum(q * q), sk = wave_sum(k * k);
    row[c] = q * rsqrtf(sq * (1.f / 64.f) + 1e-6f) * qg[c & 63] * 0.125f;
    row[512 + c] = k * rsqrtf(sk * (1.f / 64.f) + 1e-6f) * kg[c & 63];
}
__global__ __launch_bounds__(256) void k_natten(const float* __restrict__ P, const float* __restrict__ rpb  , bf16_t* __restrict__ mix) {
    const int idx = blockIdx.x * 256 + threadIdx.x, h = idx >> 12, t = idx & 4095, r = t >> 6, c = t & 63;
    const int rs = min(max(r - 4, 0), 56), cs = min(max(c - 8, 0), 48);
    float q[64], acc[64];
    const float* qp = P + (size_t)t * PC + NATOFF + h * 64;
#pragma unroll
    for (int d = 0; d < 64; d += 4) { const f32x4 v = *(const f32x4*)(qp + d); q[d] = v.x; q[d + 1] = v.y; q[d + 2] = v.z; q[d + 3] = v.w; acc[d] = acc[d + 1] = acc[d + 2] = acc[d + 3] = 0.f; }
    float m = -1e30f, l = 0.f;
    for (int i = 0; i < 8; ++i)
        for (int j = 0; j < 16; ++j) {
            const int kt = (rs + i) * 64 + cs + j;
            const float* kp = P + (size_t)kt * PC + NATOFF + 512 + h * 64; const float* vp = kp + 512;
            float s = 0.f;
#pragma unroll
            for (int d = 0; d < 64; d += 4) { const f32x4 kv = *(const f32x4*)(kp + d); s += q[d] * kv.x + q[d + 1] * kv.y + q[d + 2] * kv.z + q[d + 3] * kv.w; }
            s += rpb[(h * 15 + (rs + i - r + 7)) * 31 + (cs + j - c + 15)];
            const float mn = fmaxf(m, s), sc = expf(m - mn), pe = expf(s - mn);
            l = l * sc + pe; m = mn;
#pragma unroll
            for (int d = 0; d < 64; d += 4) { const f32x4 vv = *(const f32x4*)(vp + d); acc[d] = acc[d] * sc + pe * vv.x; acc[d + 1] = acc[d + 1] * sc + pe * vv.y; acc[d + 2] = acc[d + 2] * sc + pe * vv.z; acc[d + 3] = acc[d + 3] * sc + pe * vv.w; }
        }
    const float inv = 1.f / l;
    bf16_t* o = mix + (size_t)t * 1024 + 512 + h * 64;
#pragma unroll
    for (int d = 0; d < 64; ++d) o[d] = f2bf(acc[d] * inv);
}

__global__ __launch_bounds__(256) void k_convact(const float* __restrict__ U, const float* __restrict__ cw, const float* __restrict__ cb, bf16_t* __restrict__ act) {
    const int t = blockIdx.x;
    const float* u = U + (size_t)t * UPC;
    for (int c = threadIdx.x; c < DFF; c += 256) {
        float g = cw[UPC + c] * u[c] + cb[c], v = cw[UPC + DFF + c] * u[DFF + c] + cb[DFF + c];
        if (t > 0) { g += cw[c] * u[c - UPC]; v += cw[DFF + c] * u[DFF + c - UPC]; }
        if (t < SEQ - 1) { g += cw[2 * UPC + c] * u[c + UPC]; v += cw[2 * UPC + DFF + c] * u[DFF + c + UPC]; }
        act[(size_t)t * DFF + c] = f2bf(g * sigmoidf_(g) * v);
    }
}

extern "C" void kernel_launch(void* const* d_in, const int* in_sizes, int n_in, void* d_out, int out_size, void* d_ws, size_t ws_size, hipStream_t stream) {
    static bool attr_done = false;
    if (!attr_done) {
        hipFuncSetAttribute((const void*)k_gemm<EpiRow>, hipFuncAttributeMaxDynamicSharedMemorySize, 131072);
        attr_done = true;
    }
    const float* in[27]; for (int i = 0; i < 27; ++i) in[i] = (const float*)d_in[i];
    float* X = (float*)d_out;
    unsigned char* ws = (unsigned char*)d_ws; size_t off = 0;
    auto alloc = [&](size_t bytes) { void* p = ws + off; off += (bytes + 255) & ~(size_t)255; return p; };
    bf16_t* WinT = (bf16_t*)alloc((size_t)DEPTH * PC * D * 2);
    bf16_t* WoutT = (bf16_t*)alloc((size_t)DEPTH * D * D * 2);
    bf16_t* WupT = (bf16_t*)alloc((size_t)DEPTH * UPC * D * 2);
    bf16_t* WdnT = (bf16_t*)alloc((size_t)DEPTH * D * DFF * 2);
    bf16_t* xb = (bf16_t*)alloc((size_t)NTOK * D * 2);
    float* rstd = (float*)alloc((size_t)NTOK * 4);
    float* vfirst = (float*)alloc((size_t)NTOK * 512 * 4);
    float* P = (float*)alloc((size_t)SEQ * PC * 4);
    float* sR = (float*)alloc((size_t)SEQ * 512 * 4);
    float* sKK = (float*)alloc((size_t)SEQ * 512 * 4);
    float* sV = (float*)alloc((size_t)SEQ * 512 * 4);
    float* sW = (float*)alloc((size_t)SEQ * 1024 * 4);
    float* sKD = (float*)alloc((size_t)SEQ * 1024 * 4);
    float* sB = (float*)alloc((size_t)SEQ * 1024 * 4);
    float* sG = (float*)alloc((size_t)SEQ * 512 * 4);
    float* sBON = (float*)alloc((size_t)SEQ * 8 * 4);
    float* sY = (float*)alloc((size_t)2 * SEQ * 512 * 4);
    float* U = P;
    bf16_t* mix = (bf16_t*)alloc((size_t)SEQ * 1024 * 2);
    bf16_t* act = (bf16_t*)alloc((size_t)SEQ * DFF * 2);
    if (off > ws_size) { fprintf(stderr, "ws too small: need %zu have %zu\n", off, ws_size); return; }

    for (int l = 0; l < DEPTH; ++l) {
        k_prep_w<<<dim3(PC / 32, D / 32), dim3(32, 8), 0, stream>>>(in[3] + (size_t)l * D * 3456, D, 3456, in[2] + l * D, WinT + (size_t)l * PC * D, PC, 1);
        k_prep_w<<<dim3(D / 32, D / 32), dim3(32, 8), 0, stream>>>(in[21] + (size_t)l * D * D, D, D, nullptr, WoutT + (size_t)l * D * D, D, 0);
        k_prep_w<<<dim3(UPC / 32, D / 32), dim3(32, 8), 0, stream>>>(in[23] + (size_t)l * D * UPC, D, UPC, in[22] + l * D, WupT + (size_t)l * UPC * D, UPC, 0);
        k_prep_w<<<dim3(D / 32, DFF / 32), dim3(32, 8), 0, stream>>>(in[26] + (size_t)l * DFF * D, DFF, D, nullptr, WdnT + (size_t)l * D * DFF, D, 0);
    }
    k_rms<<<8 * SEQ / 4, 256, 0, stream>>>(in[0], X, xb, rstd, 8 * SEQ);
    k_rms<<<4 * SEQ / 4, 256, 0, stream>>>(in[1], X + (size_t)8 * SEQ * D, xb + (size_t)8 * SEQ * D, rstd + 8 * SEQ, 4 * SEQ);

    for (int l = 0; l < DEPTH; ++l) {
        for (int s = 0; s < NSEQ; ++s) {
            const size_t r0 = (size_t)s * SEQ;
            { pg8::Gemm g{xb + r0 * D, WinT + (size_t)l * PC * D, SEQ, PC, D, 0}; EpiRow e{P, rstd + r0, nullptr, PC, 0};
              k_gemm<EpiRow><<<256, 512, 131072, stream>>>(g, e); }
            PreArgs a{};
            a.P = P; a.mu = in[4] + (size_t)l * 2 * RWC; a.w0 = in[5] + l * 1024; a.wup = in[6] + (size_t)l * 2 * 64 * 512; a.a0 = in[7] + l * 1024; a.aup = in[8] + (size_t)l * 2 * 64 * 512;
            a.gup = in[9] + (size_t)l * 128 * 512; a.v0 = in[10]; a.vdown = in[11]; a.vup = in[12]; a.kk_ = in[13] + l * 512; a.ka = in[14] + l * 512; a.rk = in[15] + l * 512;
            a.R = sR; a.KK = sKK; a.V = sV; a.W = sW; a.KD = sKD; a.B = sB; a.G = sG; a.BON = sBON; a.vfirst = vfirst + r0 * 512; a.layer = l; a.pad = 0;
            k_rwkv_pre<<<SEQ, 512, 0, stream>>>(a);
            k_scan<<<16, 512, 0, stream>>>(sR, sKK, sV, sW, sKD, sB, sY);
            k_post<<<SEQ, 512, 0, stream>>>(sY, sV, sG, sBON, in[16] + l * 512, in[17] + l * 512, mix);
            k_qknorm<<<SEQ, 512, 0, stream>>>(P, in[18] + l * 64, in[19] + l * 64);
            k_natten<<<SEQ * 8 / 256, 256, 0, stream>>>(P, in[20] + (size_t)l * 8 * 15 * 31, mix);
            { pg8::Gemm g{mix, WoutT + (size_t)l * D * D, SEQ, D, D, 0}; EpiRow e{X + r0 * D, nullptr, X + r0 * D, D, 0};
              k_gemm<EpiRow><<<256, 512, 131072, stream>>>(g, e); }
            k_rms<<<SEQ / 4, 256, 0, stream>>>(X + r0 * D, nullptr, xb + r0 * D, rstd + r0, SEQ);
            { pg8::Gemm g{xb + r0 * D, WupT + (size_t)l * UPC * D, SEQ, UPC, D, 0}; EpiRow e{U, rstd + r0, nullptr, UPC, 0};
              k_gemm<EpiRow><<<256, 512, 131072, stream>>>(g, e); }
            k_convact<<<SEQ, 256, 0, stream>>>(U, in[24] + (size_t)l * 3 * UPC, in[25] + (size_t)l * UPC, act);
            { pg8::Gemm g{act, WdnT + (size_t)l * D * DFF, SEQ, D, DFF, 0}; EpiRow e{X + r0 * D, nullptr, X + r0 * D, D, 0};
              k_gemm<EpiRow><<<256, 512, 131072, stream>>>(g, e); }
            k_rms<<<SEQ / 4, 256, 0, stream>>>(X + r0 * D, nullptr, xb + r0 * D, rstd + r0, SEQ);
        }
    }
}
```

```cpp
#include <hip/hip_runtime.h>
#include <cstdio>
#include <cstdint>
namespace pg8 {
#define PG8_LAS __attribute__((address_space(3)))
typedef unsigned short bf16_t;
typedef short bf16x8 __attribute__((ext_vector_type(8)));
typedef float f32x4 __attribute__((ext_vector_type(4)));
typedef unsigned u32x4 __attribute__((ext_vector_type(4)));
constexpr int BM = 256, BK = 64, HALF = 128, HTB = HALF * BK * 2  , STAGE_BYTES = 8 * HTB, NXCD = 8, WGM = 8;

__host__ __device__ __forceinline__ int lds_byte(int r, int c) { const int st = (r >> 4) * 2 + (c >> 5), rr = r & 15, cc = c & 31, ob = rr * 64 + cc * 2; return st * 1024 + (ob ^ (((ob >> 9) & 1) << 5)); }
__host__ __device__ __forceinline__ void stage_rc(int b, int& R, int& C) { const int st = b / 1024, sb = b % 1024, swz = sb ^ (((sb >> 9) & 1) << 5); R = (st >> 1) * 16 + swz / 64; C = (st & 1) * 32 + (swz % 64) / 2; }
__host__ __device__ __forceinline__ int perm32(int rho) { const int n = rho >> 4, i = rho & 15; return 8 * (i >> 2) + 4 * n + (i & 3); }

struct Unit { int pm, pn; };
struct Gemm { const bf16_t* A; const bf16_t* Bt; int M, N, K, pad; };

struct StaticOrder {
    int nM, nN, nwg, G, c;
    __host__ __device__ void init(int M, int N, int G_, int c_) { nM = M / BM; nN = N / BM; nwg = nM * nN; G = G_; c = c_; }
    __host__ __device__ bool next(int i, Unit& u) const {
        const int L = i * G + c; if (L >= nwg) return false;
        int wgid = L; { const int q = nwg / NXCD, r = nwg % NXCD, xcd = wgid % NXCD, off = wgid / NXCD; wgid = (xcd < r ? xcd * (q + 1) : r * (q + 1) + (xcd - r) * q) + off; }
        const int nig = WGM * nN, gid = wgid / nig, fm = gid * WGM, gsz = (nM - fm) < WGM ? (nM - fm) : WGM;
        u.pm = fm + ((wgid % nig) % gsz); u.pn = (wgid % nig) / gsz; return true;
    }
    __device__ __forceinline__ void a_ready(const Unit&) const {}
    __device__ __forceinline__ void done(const Unit&) const {}
};

__device__ __forceinline__ unsigned cvt_pk_bf16(float lo, float hi) { unsigned r; asm volatile("v_cvt_pk_bf16_f32 %0, %1, %2" : "=v"(r) : "v"(lo), "v"(hi)); return r; }
typedef float f32x2 __attribute__((ext_vector_type(2)));
template <class Epi, class Sched, bool ALIGN_EPI = false, bool SP2 = false>
__device__ __forceinline__ void gemm_phase(PG8_LAS unsigned char* lds, const Gemm g, const Sched& S, const Epi& E, const int tid_in) {
    const int tid = tid_in, wid = __builtin_amdgcn_readfirstlane(tid >> 6), lane = tid & 63, wr = wid >> 2, wc = wid & 3, fr = lane & 15, fq = lane >> 4;
    const int K = g.K, nt = K / BK;
    unsigned voffA[2], voffB[2];
#pragma unroll
    for (int i = 0; i < 2; ++i) { int R, C; stage_rc(tid * 16 + i * 8192, R, C); const int Rb = Epi::PERM ? ((R & ~31) + perm32(R & 31)) : R;
        const int Ra = Epi::APERM ? ((R & ~63) + 4 * (R & 15) + ((R >> 4) & 3)) : R;
        voffA[i] = (unsigned)(Ra * K + C) * 2u; voffB[i] = (unsigned)(Rb * K + C) * 2u; }
    const size_t kstep = (size_t)(BK * 2);
    const size_t hstep = (size_t)HALF * K * 2;
    const size_t tstep = 2 * hstep;
    const unsigned ldsw = (unsigned)wid * 1024u;
    const int aoff = lds_byte(wr * 64 + fr, fq * 8), boff = lds_byte(wc * 32 + fr, fq * 8);
#define PG8_SA(b, h) (((b) * 2 + (h)) * HTB)
#define PG8_SB(b, h) ((4 + (b) * 2 + (h)) * HTB)
#define PG8_STAGE(bufoff, gbase, voff) do { _Pragma("unroll") for (int _i = 0; _i < 2; ++_i) \
        __builtin_amdgcn_global_load_lds((const unsigned*)((const char*)(gbase) + (voff)[_i]), (PG8_LAS unsigned*)(lds + (bufoff) + ldsw + _i * 8192), 16, 0, 0); } while (0)
#define PG8_LDA(dst, b, h) do { _Pragma("unroll") for (int m = 0; m < 4; ++m) _Pragma("unroll") for (int k = 0; k < 2; ++k) dst[m][k] = *(const PG8_LAS bf16x8*)(lds + PG8_SA(b, h) + aoff + m * 2048 + k * 1024); } while (0)
#define PG8_LDB(dst, b, h) do { _Pragma("unroll") for (int n = 0; n < 2; ++n) _Pragma("unroll") for (int k = 0; k < 2; ++k) dst[n][k] = *(const PG8_LAS bf16x8*)(lds + PG8_SB(b, h) + boff + n * 2048 + k * 1024); } while (0)
#define PG8_MMA(ai, bj, At, Bt) do { __builtin_amdgcn_s_setprio(1); _Pragma("unroll") for (int m = 0; m < 4; ++m) _Pragma("unroll") for (int n = 0; n < 2; ++n) _Pragma("unroll") for (int k = 0; k < 2; ++k) \
        acc[ai][bj][m][n] = __builtin_amdgcn_mfma_f32_16x16x32_bf16(Bt[n][k], At[m][k], acc[ai][bj][m][n], 0, 0, 0); __builtin_amdgcn_s_setprio(0); } while (0)
#define PG8_WAIT_V(n) asm volatile("s_waitcnt vmcnt(" #n ")" ::: "memory")
#define PG8_WAIT_L(n) asm volatile("s_waitcnt lgkmcnt(" #n ")" ::: "memory")
#define PG8_BAR __builtin_amdgcn_s_barrier()
#define PG8_SCHED __builtin_amdgcn_sched_barrier(0)
    Unit cur, nxt; int ui = 0;
    if (!S.next(0, cur)) return;
    f32x4 acc[2][2][4][2];
#pragma unroll
    for (int a = 0; a < 2; ++a)
#pragma unroll
        for (int b = 0; b < 2; ++b)
#pragma unroll
            for (int m = 0; m < 4; ++m)
#pragma unroll
                for (int n = 0; n < 2; ++n) acc[a][b][m][n] = (f32x4){0.f, 0.f, 0.f, 0.f};
    bf16x8 At[4][2], B0[2][2], B1[2][2];
    const char* cA = (const char*)g.A + (size_t)cur.pm * tstep; const char* cB = (const char*)g.Bt + (size_t)cur.pn * tstep;
    S.a_ready(cur);
    if constexpr (SP2) {
        PG8_STAGE(PG8_SB(0, 0), cB, voffB); PG8_STAGE(PG8_SB(0, 1), cB + hstep, voffB); PG8_STAGE(PG8_SA(0, 0), cA, voffA); PG8_STAGE(PG8_SA(0, 1), cA + hstep, voffA);
        if (wr == 1) PG8_BAR;
        PG8_WAIT_V(2); PG8_BAR;
        PG8_STAGE(PG8_SB(1, 0), cB + kstep, voffB); PG8_STAGE(PG8_SA(1, 0), cA + kstep, voffA); PG8_STAGE(PG8_SB(1, 1), cB + hstep + kstep, voffB);
        PG8_WAIT_V(6); PG8_BAR;
    } else {
        PG8_STAGE(PG8_SB(0, 0), cB, voffB); PG8_STAGE(PG8_SA(0, 0), cA, voffA); PG8_STAGE(PG8_SB(0, 1), cB + hstep, voffB); PG8_STAGE(PG8_SA(0, 1), cA + hstep, voffA);
        if (wr == 1) PG8_BAR;
        PG8_WAIT_V(4); PG8_BAR;
        PG8_STAGE(PG8_SB(1, 0), cB + kstep, voffB); PG8_STAGE(PG8_SA(1, 0), cA + kstep, voffA); PG8_STAGE(PG8_SB(1, 1), cB + hstep + kstep, voffB);
        PG8_WAIT_V(6); PG8_BAR;
    }
    for (;;) {
        const bool has_next = S.next(ui + 1, nxt);
        const char* nA = has_next ? (const char*)g.A + (size_t)nxt.pm * tstep : cA; const char* nB = has_next ? (const char*)g.Bt + (size_t)nxt.pn * tstep : cB;
        for (int t = 0; t < nt; t += 2) {
            const bool last = (t == nt - 2);
            const char* a1 = cA + (size_t)(t + 1) * kstep;
            const char* a2 = last ? nA : cA + (size_t)(t + 2) * kstep; const char* b2 = last ? nB : cB + (size_t)(t + 2) * kstep;
            const char* a3 = a2 + kstep; const char* b3 = b2 + kstep;
            if (last && has_next) S.a_ready(nxt);
            if constexpr (SP2) {
            PG8_LDB(B0, 0, 0); PG8_LDB(B1, 0, 1); PG8_SCHED; PG8_LDA(At, 0, 0); PG8_STAGE(PG8_SA(1, 1), a1 + hstep, voffA);
            PG8_WAIT_V(8); PG8_WAIT_L(0); PG8_BAR; PG8_MMA(0, 0, At, B0); PG8_MMA(0, 1, At, B1); PG8_BAR; PG8_SCHED;
            PG8_LDA(At, 0, 1); PG8_STAGE(PG8_SB(0, 0), b2, voffB); PG8_STAGE(PG8_SB(0, 1), b2 + hstep, voffB); PG8_STAGE(PG8_SA(0, 0), a2, voffA);
            PG8_WAIT_V(8); PG8_WAIT_L(0); PG8_BAR; PG8_MMA(1, 0, At, B0); PG8_MMA(1, 1, At, B1); PG8_BAR; PG8_SCHED;
            PG8_LDB(B0, 1, 0); PG8_LDB(B1, 1, 1); PG8_SCHED; PG8_LDA(At, 1, 0); PG8_STAGE(PG8_SA(0, 1), a2 + hstep, voffA);
            PG8_WAIT_V(8); PG8_WAIT_L(0); PG8_BAR; PG8_MMA(0, 0, At, B0); PG8_MMA(0, 1, At, B1); PG8_BAR; PG8_SCHED;
            PG8_LDA(At, 1, 1); PG8_STAGE(PG8_SB(1, 0), b3, voffB); PG8_STAGE(PG8_SB(1, 1), b3 + hstep, voffB); PG8_STAGE(PG8_SA(1, 0), a3, voffA);
            PG8_WAIT_V(8); PG8_WAIT_L(0); PG8_BAR; PG8_MMA(1, 0, At, B0); PG8_MMA(1, 1, At, B1); PG8_BAR; PG8_SCHED;
            } else {
            PG8_LDB(B0, 0, 0); PG8_SCHED; PG8_LDA(At, 0, 0); PG8_STAGE(PG8_SA(1, 1), a1 + hstep, voffA);
            PG8_WAIT_L(8); PG8_BAR; PG8_WAIT_L(0); PG8_MMA(0, 0, At, B0); PG8_BAR; PG8_SCHED;
            PG8_LDB(B1, 0, 1); PG8_STAGE(PG8_SB(0, 0), b2, voffB);
            PG8_BAR; PG8_WAIT_L(0); PG8_MMA(0, 1, At, B1); PG8_BAR;
            PG8_LDA(At, 0, 1); PG8_STAGE(PG8_SA(0, 0), a2, voffA);
            PG8_BAR; PG8_WAIT_L(0); PG8_MMA(1, 0, At, B0); PG8_BAR; PG8_SCHED;
            PG8_STAGE(PG8_SB(0, 1), b2 + hstep, voffB);
            PG8_WAIT_V(6); PG8_BAR; PG8_MMA(1, 1, At, B1); PG8_BAR;
            PG8_LDB(B0, 1, 0); PG8_SCHED; PG8_LDA(At, 1, 0); PG8_STAGE(PG8_SA(0, 1), a2 + hstep, voffA);
            PG8_WAIT_L(8); PG8_BAR; PG8_WAIT_L(0); PG8_MMA(0, 0, At, B0); PG8_BAR; PG8_SCHED;
            PG8_LDB(B1, 1, 1); PG8_STAGE(PG8_SB(1, 0), b3, voffB);
            PG8_BAR; PG8_WAIT_L(0); PG8_MMA(0, 1, At, B1); PG8_BAR;
            PG8_LDA(At, 1, 1); PG8_STAGE(PG8_SA(1, 0), a3, voffA);
            PG8_BAR; PG8_WAIT_L(0); PG8_MMA(1, 0, At, B0); PG8_BAR; PG8_SCHED;
            PG8_STAGE(PG8_SB(1, 1), b3 + hstep, voffB);
            PG8_WAIT_V(6); PG8_BAR; PG8_MMA(1, 1, At, B1); PG8_BAR;
            }
        }
        if constexpr (ALIGN_EPI) { if (wr == 0) PG8_BAR; }
        if constexpr (!Epi::AFTER_DRAIN) { E(acc, cur, wr, wc, fr, fq); S.done(cur); }
        if (!has_next) break;
#pragma unroll
        for (int a = 0; a < 2; ++a)
#pragma unroll
            for (int b = 0; b < 2; ++b)
#pragma unroll
                for (int m = 0; m < 4; ++m)
#pragma unroll
                    for (int n = 0; n < 2; ++n) acc[a][b][m][n] = (f32x4){0.f, 0.f, 0.f, 0.f};
        cur = nxt; cA = nA; cB = nB; ++ui;
        if constexpr (ALIGN_EPI) { if (wr == 1) PG8_BAR; }
    }
    PG8_WAIT_V(0);
    if constexpr (!ALIGN_EPI) { if (wr == 0) PG8_BAR; }
    PG8_BAR;
    if constexpr (Epi::AFTER_DRAIN) { E.fused(acc, cur, wr, wc, fr, fq, lds, wid, lane); S.done(cur); }
#undef PG8_SA
#undef PG8_SB
#undef PG8_STAGE
#undef PG8_LDA
#undef PG8_LDB
#undef PG8_MMA
#undef PG8_WAIT_V
#undef PG8_WAIT_L
#undef PG8_BAR
#undef PG8_SCHED
}
}
#define XB_TMO      128
#define XB_XCNT(j)  (256  + 64 * (j))
#define XB_XSUB(j)  (1280 + 64 * (j))
#define XB_XGEN(j)  (2304 + 64 * (j))
#define XB_TOP      3328
#define XB_TOPGEN   3392
#define XCD_BAR_WORDS 3456
#define XB_SPIN_CAP (1u << 22)
#define LAS __attribute__((address_space(3)))

__device__ __forceinline__ unsigned xb_ld(unsigned* p)              { return __hip_atomic_load(p, __ATOMIC_RELAXED, __HIP_MEMORY_SCOPE_AGENT); }
__device__ __forceinline__ unsigned xb_add(unsigned* p, unsigned v) { return __hip_atomic_fetch_add(p, v, __ATOMIC_RELAXED, __HIP_MEMORY_SCOPE_AGENT); }
__device__ __forceinline__ unsigned xb_xcc_id() { return (unsigned)__builtin_amdgcn_s_getreg((3 << 11) | 20) & 0xFu; }
#define XB_SPIN(cond, bar) do { unsigned _sp = 0; while (cond) { __builtin_amdgcn_s_sleep(1); \
    if ((++_sp & 255u) == 0u) { if (xb_ld(&(bar)[XB_TMO])) break; if (_sp > XB_SPIN_CAP) { atomicAdd(&(bar)[XB_TMO], 1u); break; } } } } while (0)

struct XcdBarrier {
    unsigned* bar; unsigned x;
    volatile LAS unsigned* st;
};

__device__ __forceinline__ XcdBarrier xcd_barrier_post(unsigned* bar, volatile LAS unsigned* st, const bool lead) {
    XcdBarrier b; b.bar = bar; b.x = xb_xcc_id(); b.st = st;
    if (lead) (void)xb_add(&bar[XB_XCNT(b.x)], 1u);
    return b;
}
__device__ __forceinline__ void xcd_barrier_complete(unsigned* bar, unsigned x, unsigned& nloc, unsigned& nx) {
    const unsigned G = gridDim.x * gridDim.y * gridDim.z;
    unsigned sum, cnt, mine, sp = 0u;
    for (;;) {
        sum = 0u; cnt = 0u; mine = 0u;
#pragma unroll
        for (unsigned j = 0; j < 16; ++j) { const unsigned c = xb_ld(&bar[XB_XCNT(j)]); sum += c; cnt += (c > 0u) ? 1u : 0u; mine = (j == x) ? c : mine; }
        if (sum == G) break;
        __builtin_amdgcn_s_sleep(1);
        if ((++sp & 255u) == 0u) { if (xb_ld(&bar[XB_TMO])) break; if (sp > XB_SPIN_CAP) { atomicAdd(&bar[XB_TMO], 1u); break; } }
    }
    nloc = mine > 0u ? mine : 1u; nx = cnt > 0u ? cnt : 1u;
}

__device__ __forceinline__ void xcd_barrier(const XcdBarrier& b, const bool lead) {
    asm volatile("s_waitcnt vmcnt(0)" ::: "memory");
    __syncthreads();
    if (lead) {
        unsigned* bar = b.bar;
        __builtin_amdgcn_s_waitcnt(0);
        unsigned nloc = b.st[0], nx = b.st[1];
        if (nloc == 0u) { xcd_barrier_complete(bar, b.x, nloc, nx); b.st[0] = nloc; b.st[1] = nx; }
        const unsigned old = xb_add(&bar[XB_XSUB(b.x)], 1u);
        const unsigned gen = old / nloc;
        if (old + 1u == (gen + 1u) * nloc) {
            __builtin_amdgcn_fence(__ATOMIC_RELEASE, "agent");
            asm volatile("s_waitcnt vmcnt(0)" ::: "memory");
            const unsigned og = xb_add(&bar[XB_TOP], 1u);
            const unsigned tg = og / nx;
            if (og + 1u == (tg + 1u) * nx) xb_add(&bar[XB_TOPGEN], 1u);
            else XB_SPIN(xb_ld(&bar[XB_TOPGEN]) == tg, bar);
            __builtin_amdgcn_fence(__ATOMIC_ACQUIRE, "agent");
            xb_add(&bar[XB_XGEN(b.x)], 1u);
            asm volatile("s_waitcnt vmcnt(0)" ::: "memory");
        } else {
            XB_SPIN(xb_ld(&bar[XB_XGEN(b.x)]) == gen, bar);
            __builtin_amdgcn_fence(__ATOMIC_ACQUIRE, "agent");
            asm volatile("s_waitcnt vmcnt(0)" ::: "memory");
        }
    }
    __syncthreads();
}

typedef unsigned short bf16_t;
typedef float f32x4 __attribute__((ext_vector_type(4)));
typedef short bf16x8 __attribute__((ext_vector_type(8)));
typedef unsigned u32x4 __attribute__((ext_vector_type(4)));
typedef unsigned u32x2 __attribute__((ext_vector_type(2)));

constexpr int D = 1024, NSEQ = 12, SEQ = 4096, NTOK = NSEQ * SEQ, DEPTH = 2;
constexpr int RWC = 1920, INC = 3456, PCW = 3072, QOFF = 2048, KOFF = 2560, DFF = 2816, UPC = 5632;
constexpr int O_WD = 1536, O_AD = 1664, O_GD = 1792;
constexpr int NT = 512, NWG = 256;
constexpr int LDS_MISC = 161792, LDS_BYTES = LDS_MISC + 1024;
constexpr size_t WS_CTL_BYTES = 65536;
constexpr int GSEQ = 4, GR = GSEQ * SEQ, NGRP = NSEQ / GSEQ;

typedef __bf16 bf16v2_t __attribute__((ext_vector_type(2)));
typedef float f32v2_t __attribute__((ext_vector_type(2)));
__device__ __forceinline__ unsigned cvtpk(float lo, float hi) { f32v2_t f = {lo, hi}; bf16v2_t b = __builtin_convertvector(f, bf16v2_t); return __builtin_bit_cast(unsigned, b); }
__device__ __forceinline__ unsigned short f2bf(float f) { return __builtin_bit_cast(unsigned short, (__bf16)f); }
__device__ __forceinline__ float bf2f(unsigned short b) { return __uint_as_float(((unsigned)b) << 16); }
__device__ __forceinline__ unsigned pk2bf(float lo, float hi) { return cvtpk(lo, hi); }
__device__ __forceinline__ float shx(float v, int m, int lane) { return __int_as_float(__builtin_amdgcn_ds_bpermute((lane ^ m) << 2, __float_as_int(v))); }
__device__ __forceinline__ float shl_(float v, int src) { return __int_as_float(__builtin_amdgcn_ds_bpermute(src << 2, __float_as_int(v))); }
__device__ __forceinline__ float wave_sum(float v, int lane) {
#pragma unroll
    for (int o = 1; o < 64; o <<= 1) v += shx(v, o, lane);
    return v;
}
__device__ __forceinline__ int olane() { unsigned z = 0u; asm volatile("" : "+s"(z)); int l = (int)__builtin_amdgcn_mbcnt_hi(~0u, __builtin_amdgcn_mbcnt_lo(~0u, z)); asm volatile("" : "+v"(l)); return l; }
__device__ __forceinline__ int otid() { return (__builtin_amdgcn_readfirstlane((int)threadIdx.x >> 6) << 6) | olane(); }
__device__ __forceinline__ float sigmoidf_(float x) { return 1.f / (1.f + expf(-x)); }

__device__ __forceinline__ void ph_prep_w(LAS unsigned char* lds, const float* __restrict__ W, int K, int Nsrc, const float* __restrict__ scale, bf16_t* __restrict__ out, int Nout, int mode, float mul) {
    const int tid0 = otid(); const int half = tid0 >> 8, t8 = tid0 & 255, tx = t8 & 31, ty = t8 >> 5;
    LAS float* tile = (LAS float*)(lds + half * 4352);
    const int ntn = Nout / 32, ntiles = ntn * (K / 32);
    for (int vb = blockIdx.x; 2 * vb < ntiles; vb += NWG) {
        const int ti = 2 * vb + half; const bool on = ti < ntiles;
        const int n0 = (ti % ntn) * 32, k0 = (ti / ntn) * 32;
        if (on) for (int i = ty; i < 32; i += 8) {
            const int n = n0 + tx, k = k0 + i; int ns = n; bool valid = true;
            if (mode == 1) { if (n < 1920) ns = n; else if (n < 2048) valid = false; else ns = n - 128; }
            if (mode == 2) ns = n + 2944;
            if (mode == 3) ns = ((n >> 7) & 1) * DFF + (n >> 8) * 128 + (n & 127);
            float v = 0.f;
            if (valid) v = W[(size_t)k * Nsrc + ns] * (scale ? scale[k] : 1.f) * mul;
            if (mode == 1) { if (n >= O_WD && n < O_WD + 128) v *= 2.88539008f; else if (n >= O_GD && n < O_GD + 128) v *= -1.44269504f; }
            tile[i * 33 + tx] = v;
        }
        __syncthreads();
        if (on) for (int i = ty; i < 32; i += 8) { const int n = n0 + i, k = k0 + tx; out[(size_t)n * K + k] = f2bf(tile[tx * 33 + i]); }
        __syncthreads();
    }
}

__device__ __forceinline__ void ph_rms_in(const float* __restrict__ xin, bf16_t* __restrict__ xb, float* __restrict__ rstd, int rows) {
    const int tid0 = otid(); const int lane = tid0 & 63;
    for (int row = blockIdx.x * 8 + (tid0 >> 6); row < rows; row += NWG * 8) {
        const f32x4* xr = (const f32x4*)(xin + (size_t)row * D);
        f32x4 v[4]; float s = 0.f;
#pragma unroll
        for (int j = 0; j < 4; ++j) { v[j] = xr[lane + 64 * j]; s += v[j].x * v[j].x + v[j].y * v[j].y + v[j].z * v[j].z + v[j].w * v[j].w; }
        s = wave_sum(s, lane);
        if (lane == 0) rstd[row] = rsqrtf(s * (1.f / D) + 1e-6f);
#pragma unroll
        for (int j = 0; j < 4; ++j) {
            const int c = (lane + 64 * j) * 4;
            u32x2 w; w.x = pk2bf(v[j].x, v[j].y); w.y = pk2bf(v[j].z, v[j].w);
            *(u32x2*)(xb + (size_t)row * D + c) = w;
        }
    }
}
__device__ __forceinline__ void ph_rstd(const bf16_t* __restrict__ xb, float* __restrict__ rstd, int rows) {
    const int tid0 = otid(); const int lane = tid0 & 63;
#pragma unroll 4
    for (int row = blockIdx.x * 8 + (tid0 >> 6); row < rows; row += NWG * 8) {
        const u32x4* xr = (const u32x4*)(xb + (size_t)row * D);
        float s = 0.f;
#pragma unroll
        for (int j = 0; j < 2; ++j) {
            const u32x4 q = xr[lane + 64 * j];
            const unsigned w[4] = {q.x, q.y, q.z, q.w};
#pragma unroll
            for (int k = 0; k < 4; ++k) { const float a = __uint_as_float(w[k] << 16), c = __uint_as_float(w[k] & 0xffff0000u); s += a * a + c * c; }
        }
        s = wave_sum(s, lane);
        if (lane == 0) rstd[row] = rsqrtf(s * (1.f / D) + 1e-6f);
    }
}

struct EpiRow {
    static constexpr bool PERM = true, AFTER_DRAIN = false, APERM = false;
    bf16_t* X; float* outf; int pad0; int pad;
    __device__ __forceinline__ void operator()(const pg8::f32x4 (&acc)[2][2][4][2], const pg8::Unit& u, int wr, int wc, int fr, int fq) const {
        const int row0 = u.pm * 256 + wr * 64 + fr, col0 = u.pn * 256 + wc * 32 + 8 * fq;
        const unsigned off0 = (unsigned)row0 * (unsigned)D + (unsigned)col0;
        pg8::u32x4 r[2][4][2];
#pragma unroll
        for (int ai = 0; ai < 2; ++ai)
#pragma unroll
            for (int m = 0; m < 4; ++m)
#pragma unroll
                for (int bj = 0; bj < 2; ++bj) r[ai][m][bj] = *(const pg8::u32x4*)(X + off0 + (unsigned)((ai * 128 + m * 16) * D + bj * 128));
#pragma unroll
        for (int ai = 0; ai < 2; ++ai)
#pragma unroll
            for (int m = 0; m < 4; ++m) {
                const unsigned off = off0 + (unsigned)((ai * 128 + m * 16) * D);
#pragma unroll
                for (int bj = 0; bj < 2; ++bj) {
                    const pg8::u32x4 rr = r[ai][m][bj];
                    pg8::f32x4 v0 = acc[ai][bj][m][0], v1 = acc[ai][bj][m][1];
                    v0[0] += __uint_as_float(rr.x << 16); v0[1] += __uint_as_float(rr.x & 0xffff0000u); v0[2] += __uint_as_float(rr.y << 16); v0[3] += __uint_as_float(rr.y & 0xffff0000u);
                    v1[0] += __uint_as_float(rr.z << 16); v1[1] += __uint_as_float(rr.z & 0xffff0000u); v1[2] += __uint_as_float(rr.w << 16); v1[3] += __uint_as_float(rr.w & 0xffff0000u);
                    if (outf) { *(pg8::f32x4*)(outf + off + bj * 128) = v0; *(pg8::f32x4*)(outf + off + bj * 128 + 4) = v1; }
                    else {
                        pg8::u32x4 w; w.x = pg8::cvt_pk_bf16(v0[0], v0[1]); w.y = pg8::cvt_pk_bf16(v0[2], v0[3]); w.z = pg8::cvt_pk_bf16(v1[0], v1[1]); w.w = pg8::cvt_pk_bf16(v1[2], v1[3]);
                        *(pg8::u32x4*)(X + off + bj * 128) = w;
                    }
                }
            }
    }
};
struct EpiBf {
    static constexpr bool PERM = true, AFTER_DRAIN = false, APERM = false;
    bf16_t* O; const float* rowscale; const float* colscale; int ldc; int pad;
    __device__ __forceinline__ void operator()(const pg8::f32x4 (&acc)[2][2][4][2], const pg8::Unit& u, int wr, int wc, int fr, int fq) const {
        const int row0 = u.pm * 256 + wr * 64 + fr, col0 = u.pn * 256 + wc * 32 + 8 * fq;
        pg8::f32x4 cs[2][2];
#pragma unroll
        for (int bj = 0; bj < 2; ++bj)
#pragma unroll
            for (int n = 0; n < 2; ++n) cs[bj][n] = colscale ? *(const pg8::f32x4*)(colscale + col0 + bj * 128 + 4 * n) : (pg8::f32x4){1.f, 1.f, 1.f, 1.f};
        float rsc[2][4];
#pragma unroll
        for (int ai = 0; ai < 2; ++ai)
#pragma unroll
            for (int m = 0; m < 4; ++m) rsc[ai][m] = rowscale ? rowscale[row0 + ai * 128 + m * 16] : 1.f;
#pragma unroll
        for (int ai = 0; ai < 2; ++ai)
#pragma unroll
            for (int m = 0; m < 4; ++m) {
                const int row = row0 + ai * 128 + m * 16; const float s = rsc[ai][m];
                bf16_t* rowp = (ldc < 0) ? O + (size_t)(col0 >> 3) * 4096 + row * 8 : O + (size_t)row * ldc + col0;
#pragma unroll
                for (int bj = 0; bj < 2; ++bj) {
                    const pg8::f32x4 v0 = acc[ai][bj][m][0] * s * cs[bj][0], v1 = acc[ai][bj][m][1] * s * cs[bj][1];
                    pg8::u32x4 w; w.x = pg8::cvt_pk_bf16(v0[0], v0[1]); w.y = pg8::cvt_pk_bf16(v0[2], v0[3]); w.z = pg8::cvt_pk_bf16(v1[0], v1[1]); w.w = pg8::cvt_pk_bf16(v1[2], v1[3]);
                    *(pg8::u32x4*)(rowp + (ldc < 0 ? bj * 16 * 4096 : bj * 128)) = w;
                }
            }
    }
};
__device__ __forceinline__ void ph_gemm(LAS unsigned char* lds, const bf16_t* A, const bf16_t* Bt, int M, int N, int K, bf16_t* X, float* outf) {
    pg8::Gemm g{A, Bt, M, N, K, 0}; EpiRow e{X, outf, 0, 0};
    pg8::StaticOrder S; S.init(M, N, NWG, (int)blockIdx.x);
    pg8::gemm_phase<EpiRow, pg8::StaticOrder, true, true>(lds, g, S, e, otid());
}
__device__ __forceinline__ void ph_gemm_bf(LAS unsigned char* lds, const bf16_t* A, const bf16_t* Bt, int M, int N, int K, bf16_t* O, const float* rowscale, const float* colscale, int ldc) {
    pg8::Gemm g{A, Bt, M, N, K, 0}; EpiBf e{O, rowscale, colscale, ldc, 0};
    pg8::StaticOrder S; S.init(M, N, NWG, (int)blockIdx.x);
    pg8::gemm_phase<EpiBf, pg8::StaticOrder, true, true>(lds, g, S, e, otid());
}

__device__ __forceinline__ void ph_qknorm(bf16_t* __restrict__ P, const float* __restrict__ qg, const float* __restrict__ kg, int rows) {
    const int tid0 = otid(); const int lane = tid0 & 63;
    const float* gp = (lane < 32 ? qg : kg) + 16 * (lane & 3); const float gs = lane < 32 ? 0.125f * 1.44269504f : 1.f;
    float gv[16];
#pragma unroll
    for (int j = 0; j < 16; ++j) gv[j] = gp[j] * gs;
#pragma unroll 2
    for (int row = blockIdx.x * 8 + (tid0 >> 6); row < rows; row += NWG * 8) {
        bf16_t* p = P + (size_t)row * PCW + QOFF + 16 * lane;
        const u32x4 a = *(const u32x4*)p, c = *(const u32x4*)(p + 8);
        const unsigned w[8] = {a.x, a.y, a.z, a.w, c.x, c.y, c.z, c.w};
        float f[16]; float ss = 0.f;
#pragma unroll
        for (int j = 0; j < 8; ++j) { f[2 * j] = __uint_as_float(w[j] << 16); f[2 * j + 1] = __uint_as_float(w[j] & 0xffff0000u); ss += f[2 * j] * f[2 * j] + f[2 * j + 1] * f[2 * j + 1]; }
        ss += __int_as_float(__builtin_amdgcn_update_dpp(0, __float_as_int(ss), 0xB1, 0xf, 0xf, false));
        ss += __int_as_float(__builtin_amdgcn_update_dpp(0, __float_as_int(ss), 0x4E, 0xf, 0xf, false));
        const float sc = rsqrtf(ss * (1.f / 64.f) + 1e-6f);
        u32x4 o0, o1;
        o0.x = pk2bf(f[0] * sc * gv[0], f[1] * sc * gv[1]); o0.y = pk2bf(f[2] * sc * gv[2], f[3] * sc * gv[3]); o0.z = pk2bf(f[4] * sc * gv[4], f[5] * sc * gv[5]); o0.w = pk2bf(f[6] * sc * gv[6], f[7] * sc * gv[7]);
        o1.x = pk2bf(f[8] * sc * gv[8], f[9] * sc * gv[9]); o1.y = pk2bf(f[10] * sc * gv[10], f[11] * sc * gv[11]); o1.z = pk2bf(f[12] * sc * gv[12], f[13] * sc * gv[13]); o1.w = pk2bf(f[14] * sc * gv[14], f[15] * sc * gv[15]);
        *(u32x4*)p = o0; *(u32x4*)(p + 8) = o1;
    }
}
__device__ __forceinline__ void natten_item(const bf16_t* __restrict__ P, const bf16_t* __restrict__ VT, int gr, const LAS float* rpbl, bf16_t* __restrict__ mixb, int item, int lane) {
    const int g = item & 3, r = (item >> 2) & 63, h = (item >> 8) & 7, b = item >> 11;
    const int rs = min(max(r - 4, 0), 56);
    const int kc0 = (g == 0) ? 0 : (g == 1) ? 8 : (g == 2) ? 24 : 32;
    const int n = lane & 15, kq = lane >> 4;
    const int tok0 = b * SEQ;
    const char* qb = (const char*)(P + (size_t)(tok0 + r * 64 + 16 * g) * PCW + QOFF + h * 64);
    const unsigned qofs = (unsigned)(n * PCW + 8 * kq) * 2u;
    const u32x4 q0 = *(const u32x4*)(qb + qofs), q1 = *(const u32x4*)(qb + qofs + 64);
    u32x4 ka[16], kc[16];
    const unsigned kofs = (unsigned)((8 * (n >> 2) + (n & 3)) * PCW + 8 * kq) * 2u;
#pragma unroll
    for (int bi = 0; bi < 16; ++bi) {
        const char* kb = (const char*)(P + (size_t)(tok0 + (rs + (bi >> 1)) * 64 + kc0 + 4 * (bi & 1)) * PCW + KOFF + h * 64);
        ka[bi] = *(const u32x4*)(kb + kofs); kc[bi] = *(const u32x4*)(kb + kofs + 64);
    }
    f32x4 sc_[16];
    const int cq = 16 * g + n, cs = min(max(cq - 8, 0), 48);
#pragma unroll
    for (int bi = 0; bi < 16; ++bi) {
        const int i = bi >> 1, nb = bi & 1;
        f32x4 acc = (f32x4){0.f, 0.f, 0.f, 0.f};
        acc = __builtin_amdgcn_mfma_f32_16x16x32_bf16(__builtin_bit_cast(bf16x8, ka[bi]), __builtin_bit_cast(bf16x8, q0), acc, 0, 0, 0);
        acc = __builtin_amdgcn_mfma_f32_16x16x32_bf16(__builtin_bit_cast(bf16x8, kc[bi]), __builtin_bit_cast(bf16x8, q1), acc, 0, 0, 0);
        const LAS float* brow = rpbl + (rs + i - r + 7) * 32;
#pragma unroll
        for (int e = 0; e < 4; ++e) {
            const int kcn = kc0 + 8 * kq + 4 * nb + e;
            const bool valid = (kcn >= cs) && (kcn < cs + 16);
            const int ci = valid ? min(max(kcn - cq + 15, 0), 30) : 31;
            float bv = brow[ci]; asm volatile("" : "+v"(bv));
            acc[e] += bv;
        }
        sc_[bi] = acc;
    }
    u32x4 vv[8][4];
    {
        const unsigned vofs = (unsigned)(kq * 4096 + n * 8) * 2u;
#pragma unroll
        for (int i = 0; i < 8; ++i)
#pragma unroll
            for (int d = 0; d < 4; ++d) vv[i][d] = *(const u32x4*)((const char*)(VT + (size_t)((tok0 + (rs + i) * 64 + kc0) >> 3) * 4096 + (h * 64 + 16 * d) * 8) + vofs);
    }
    float mx = -1e30f;
#pragma unroll
    for (int q = 0; q < 16; ++q) mx = fmaxf(fmaxf(fmaxf(mx, sc_[q][0]), fmaxf(sc_[q][1], sc_[q][2])), sc_[q][3]);
    mx = fmaxf(mx, shx(mx, 16, lane)); mx = fmaxf(mx, shx(mx, 32, lane));
    float l = 0.f;
#pragma unroll
    for (int q = 0; q < 16; ++q)
#pragma unroll
        for (int e = 0; e < 4; ++e) { const float pe = __builtin_amdgcn_exp2f(sc_[q][e] - mx); sc_[q][e] = pe; l += pe; }
    l += shx(l, 16, lane); l += shx(l, 32, lane);
    f32x4 o[4];
#pragma unroll
    for (int d = 0; d < 4; ++d) o[d] = (f32x4){0.f, 0.f, 0.f, 0.f};
#pragma unroll
    for (int i = 0; i < 8; ++i) {
        u32x4 pa; pa.x = pk2bf(sc_[2 * i][0], sc_[2 * i][1]); pa.y = pk2bf(sc_[2 * i][2], sc_[2 * i][3]); pa.z = pk2bf(sc_[2 * i + 1][0], sc_[2 * i + 1][1]); pa.w = pk2bf(sc_[2 * i + 1][2], sc_[2 * i + 1][3]);
        const bf16x8 pf = __builtin_bit_cast(bf16x8, pa);
#pragma unroll
        for (int d = 0; d < 4; ++d) o[d] = __builtin_amdgcn_mfma_f32_16x16x32_bf16(__builtin_bit_cast(bf16x8, vv[i][d]), pf, o[d], 0, 0, 0);
    }
    const float li = 1.f / l;
    char* ob = (char*)(mixb + (size_t)(tok0 + r * 64 + 16 * g) * 1024 + 512 + h * 64);
    const unsigned oo = (unsigned)(n * 1024 + 4 * kq) * 2u;
#pragma unroll
    for (int d = 0; d < 4; ++d) *(u32x2*)(ob + oo + 32 * d) = (u32x2){pk2bf(o[d][0] * li, o[d][1] * li), pk2bf(o[d][2] * li, o[d][3] * li)};
}
constexpr int L_RPB = 32768;
__device__ __forceinline__ void ph_natten(LAS unsigned char* lds, const bf16_t* P, const bf16_t* VT, int gr, int nseq, const float* rpb, bf16_t* mixb, int wg, int nwg) {
    const int tid0 = otid(); const int lane = tid0 & 63, wave = __builtin_amdgcn_readfirstlane(tid0 >> 6);
    const int h = wg & 7, r = 2 * (wg >> 3) + (wave >> 2), g = wave & 3;
    __syncthreads();
    for (int i = tid0; i < 15 * 32; i += NT) { const int rr = i >> 5, cc = i & 31; ((LAS float*)(lds + L_RPB))[i] = (cc < 31) ? 1.44269504f * rpb[h * 15 * 31 + rr * 31 + cc] : -1e30f; }
    __syncthreads();
    for (int b = 0; b < nseq; ++b) natten_item(P, VT, gr, (const LAS float*)(lds + L_RPB), mixb, (b << 11) | (h << 8) | (r << 2) | g, lane);
}
template <int CTRL> __device__ __forceinline__ float dppf(float x) { return __int_as_float(__builtin_amdgcn_update_dpp(0, __float_as_int(x), CTRL, 0xf, 0xf, true)); }
constexpr int EPI_W = 135168, EPI_R = EPI_W + 4096;
struct EpiFfn {
    static constexpr bool PERM = true, AFTER_DRAIN = false, APERM = true;
    LAS unsigned char* lds;
    bf16_t* act; float* edge; const float* rstd; const float* cw; const float* cb;
    typedef float f32x2v __attribute__((ext_vector_type(2)));
    static __device__ __forceinline__ f32x2v ld2(const float* base, unsigned byteoff) { return *(const f32x2v*)((const char*)base + byteoff); }
    __device__ __forceinline__ void operator()(const pg8::f32x4 (&acc)[2][2][4][2], const pg8::Unit& u, int wr, int wc, int fr_in, int fq_in) const {
        const int lane_ = olane();
        const int fr = lane_ & 15, fq = lane_ >> 4; (void)fr_in; (void)fq_in;
        const unsigned g0 = (unsigned)(u.pn * 128 + wc * 32 + 8 * fq);
        {
            const int tid_ = (wr * 4 + wc) * 64 + lane_;
            LAS float* Wl = (LAS float*)(lds + EPI_W), * Rl = (LAS float*)(lds + EPI_R);
#pragma unroll
            for (int q = 0; q < 2; ++q) {
                const int idx = tid_ + 512 * q, k = idx >> 7, j = idx & 127;
                const float* src = ((k & 3) < 3 ? cw + (k & 3) * UPC : cb) + (k >> 2) * DFF + u.pn * 128 + j;
                Wl[idx] = *src;
            }
            if (tid_ < 256) Rl[tid_] = rstd[u.pm * 256 + tid_];
            __syncthreads();
        }
#pragma unroll
        for (int n = 0; n < 2; ++n) {
#pragma unroll
            for (int ai = 0; ai < 2; ++ai) {
                const int lane2 = olane();
                const int fr = lane2 & 15, fq = lane2 >> 4;
                const unsigned g0 = (unsigned)(u.pn * 128 + wc * 32 + 8 * fq);
                const LAS float* Wl = (const LAS float*)(lds + EPI_W) + (wc * 32 + 8 * fq);
                const bool isedge = (fr == 0) || (fr == 15);
                const unsigned rowbase = (unsigned)(u.pm * 256 + ai * 128 + wr * 64);
                const f32x4 rs = *(const LAS f32x4*)((const LAS float*)(lds + EPI_R) + (wr * 64 + ai * 128 + 4 * fr));
                const unsigned eoff = (((rowbase >> 6) * 4 + (unsigned)(fr == 0 ? 0 : 2)) * UPC + g0 + 4 * n) * 4u;
                unsigned outp[4][2];
                const f32x4 wg0 = *(const LAS f32x4*)(Wl + 0 * 128 + 4 * n), wg1 = *(const LAS f32x4*)(Wl + 1 * 128 + 4 * n), wg2 = *(const LAS f32x4*)(Wl + 2 * 128 + 4 * n), bg4 = *(const LAS f32x4*)(Wl + 3 * 128 + 4 * n);
                const f32x4 wv0 = *(const LAS f32x4*)(Wl + 4 * 128 + 4 * n), wv1 = *(const LAS f32x4*)(Wl + 5 * 128 + 4 * n), wv2 = *(const LAS f32x4*)(Wl + 6 * 128 + 4 * n), bv4 = *(const LAS f32x4*)(Wl + 7 * 128 + 4 * n);
#pragma unroll
                for (int e = 0; e < 4; ++e) {
                    float cg[4], cv[4];
                    const float wg0e = wg0[e], wg1e = wg1[e], wg2e = wg2[e], bge = bg4[e], wv0e = wv0[e], wv1e = wv1[e], wv2e = wv2[e], bve = bv4[e];
                    {
                        float x[4];
#pragma unroll
                        for (int m = 0; m < 4; ++m) x[m] = acc[ai][0][m][n][e] * rs[m];
                        if (isedge) { *(float*)((char*)edge + eoff + 4u * e) = (fr == 0) ? x[0] : x[2]; *(float*)((char*)edge + eoff + UPC * 4u + 4u * e) = (fr == 0) ? x[1] : x[3]; }
                        const float up = dppf<0x111>(x[3]), dn = dppf<0x101>(x[0]);
                        cg[0] = fmaf(wg0e, up, fmaf(wg1e, x[0], fmaf(wg2e, x[1], bge))); cg[1] = fmaf(wg0e, x[0], fmaf(wg1e, x[1], fmaf(wg2e, x[2], bge)));
                        cg[2] = fmaf(wg0e, x[1], fmaf(wg1e, x[2], fmaf(wg2e, x[3], bge))); cg[3] = fmaf(wg0e, x[2], fmaf(wg1e, x[3], fmaf(wg2e, dn, bge)));
                    }
                    {
                        float x[4];
#pragma unroll
                        for (int m = 0; m < 4; ++m) x[m] = acc[ai][1][m][n][e] * rs[m];
                        if (isedge) { *(float*)((char*)edge + eoff + DFF * 4u + 4u * e) = (fr == 0) ? x[0] : x[2]; *(float*)((char*)edge + eoff + (UPC + DFF) * 4u + 4u * e) = (fr == 0) ? x[1] : x[3]; }
                        const float up = dppf<0x111>(x[3]), dn = dppf<0x101>(x[0]);
                        cv[0] = fmaf(wv0e, up, fmaf(wv1e, x[0], fmaf(wv2e, x[1], bve))); cv[1] = fmaf(wv0e, x[0], fmaf(wv1e, x[1], fmaf(wv2e, x[2], bve)));
                        cv[2] = fmaf(wv0e, x[1], fmaf(wv1e, x[2], fmaf(wv2e, x[3], bve))); cv[3] = fmaf(wv0e, x[2], fmaf(wv1e, x[3], fmaf(wv2e, dn, bve)));
                    }
#pragma unroll
                    for (int m = 0; m < 4; ++m) {
                        const float o = (cg[m] * cv[m]) * __builtin_amdgcn_rcpf(1.f + __builtin_amdgcn_exp2f(-1.44269504f * cg[m]));
                        outp[m][e >> 1] = (e & 1) ? cvtpk(__uint_as_float(outp[m][e >> 1]), o) : __float_as_uint(o);
                    }
                    __builtin_amdgcn_sched_barrier(0);
                }
#pragma unroll
                for (int m = 0; m < 4; ++m) {
                    const unsigned rib = 4 * (unsigned)fr + m;
                    if (rib != 0 && rib != 63) *(u32x2*)((char*)act + ((rowbase + rib) * DFF + g0 + 4 * n) * 2u) = (u32x2){outp[m][0], outp[m][1]};
                }
                asm volatile("" ::: "memory");
            }
        }
    }
};
__device__ __forceinline__ void ph_gemm_ffn(LAS unsigned char* lds, const bf16_t* A, const bf16_t* Bt, int M, bf16_t* act, float* edge, const float* rstd, const float* cw, const float* cb) {
    pg8::Gemm g{A, Bt, M, UPC, D, 0}; EpiFfn e{lds, act, edge, rstd, cw, cb};
    pg8::StaticOrder S; S.init(M, UPC, NWG, (int)blockIdx.x);
    pg8::gemm_phase<EpiFfn, pg8::StaticOrder, true, true>(lds, g, S, e, otid());
}
__device__ __forceinline__ void ph_ffn_fix(const float* __restrict__ edge, const float* __restrict__ cw, const float* __restrict__ cb, bf16_t* __restrict__ act, int rows) {
    typedef float f2 __attribute__((ext_vector_type(2)));
    const int tid0 = otid(); const int nb = rows / 64;
    constexpr int CP = DFF / 2;
    const int total = 2 * nb * CP;
#pragma unroll 3
    for (int p = blockIdx.x * NT + tid0; p < total; p += NWG * NT) {
        const int it = p / CP, c = 2 * (p - it * CP);
        const int blk = it >> 1, last = it & 1;
        const int row = blk * 64 + (last ? 63 : 0), t = row & (SEQ - 1);
        const float* cur = edge + ((size_t)blk * 4 + (last ? 3 : 0)) * UPC;
        const bool hp = last ? true : (t > 0), hn = last ? (t < SEQ - 1) : true;
        const float* prv = last ? edge + ((size_t)blk * 4 + 2) * UPC : edge + ((size_t)(hp ? blk - 1 : blk) * 4 + 3) * UPC;
        const float* nxt = last ? edge + ((size_t)(hn ? blk + 1 : blk) * 4 + 0) * UPC : edge + ((size_t)blk * 4 + 1) * UPC;
        const f2 w0g = *(const f2*)(cw + c), w1g = *(const f2*)(cw + UPC + c), w2g = *(const f2*)(cw + 2 * UPC + c), bg = *(const f2*)(cb + c);
        const f2 w0v = *(const f2*)(cw + DFF + c), w1v = *(const f2*)(cw + UPC + DFF + c), w2v = *(const f2*)(cw + 2 * UPC + DFF + c), bv = *(const f2*)(cb + DFF + c);
        const f2 cg = *(const f2*)(cur + c), cv = *(const f2*)(cur + DFF + c);
        f2 pg = *(const f2*)(prv + c), pv = *(const f2*)(prv + DFF + c), ng = *(const f2*)(nxt + c), nv = *(const f2*)(nxt + DFF + c);
        if (!hp) { pg = (f2){0.f, 0.f}; pv = pg; }
        if (!hn) { ng = (f2){0.f, 0.f}; nv = ng; }
        const f2 g = w1g * cg + bg + w0g * pg + w2g * ng, v = w1v * cv + bv + w0v * pv + w2v * nv;
        const float o0 = g[0] * sigmoidf_(g[0]) * v[0], o1 = g[1] * sigmoidf_(g[1]) * v[1];
        *(unsigned*)(act + (size_t)row * DFF + c) = cvtpk(o0, o1);
    }
}

constexpr int NSEG = 4, SEGTOK = SEQ / NSEG;
constexpr int OP_AP = 0, OP_RP = 2048, OP_MX2 = 4096, OP_MD = 5120, OP_MY = 6144, OP_GP = 7168, OP_VT = 11264, OP_GC = 13312, OP_SIZE = 13568;
constexpr int LS_OPS = 0, LS_LABT = 8 * OP_SIZE, LS_MU = LS_LABT + 8 * 1024, LS_CST = LS_MU + 3 * 7 * 64 * 4, LS_WL = LS_CST + 6 * 64 * 4, LS_EOF = LS_WL + 36 * 1024, LS_END = LS_EOF + 1024;
constexpr int WL_DEC = 0, WL_AAA = 8 * 1024, WL_VU = 16 * 1024, WL_G = 20 * 1024;
static_assert(LS_END <= LDS_MISC, "scan unit LDS map");

template <int CTRL> __device__ __forceinline__ float dpp_mov(float x) { return __int_as_float(__builtin_amdgcn_update_dpp(0, __float_as_int(x), CTRL, 0xf, 0xf, false)); }
template <int CTRL> __device__ __forceinline__ unsigned dpp_keep(unsigned old, unsigned src) { return (unsigned)__builtin_amdgcn_update_dpp((int)old, (int)src, CTRL, 0xf, 0xf, false); }
__device__ __forceinline__ float fsig(float z) { return __builtin_amdgcn_rcpf(1.f + __builtin_amdgcn_exp2f(z)); }
__device__ __forceinline__ float ftanh(float z) { return 1.f - 2.f * __builtin_amdgcn_rcpf(1.f + __builtin_amdgcn_exp2f(z)); }
__device__ __forceinline__ f32v2_t bfpair(unsigned u) { return (f32v2_t){__uint_as_float(u << 16), __uint_as_float(u & 0xffff0000u)}; }
__device__ __forceinline__ u32x4 pack8(const float* v) { u32x4 r; r.x = cvtpk(v[0], v[1]); r.y = cvtpk(v[2], v[3]); r.z = cvtpk(v[4], v[5]); r.w = cvtpk(v[6], v[7]); return r; }

struct ScanW {
    const float *mu, *w0, *a0, *v0, *kk_, *ka, *rk;
    const bf16_t *WdecT, *WaaaT, *WgT, *WvuT;
};

template <int NKS> __device__ __forceinline__ void lora_mm(const LAS unsigned char* wl, const u32x4 (&xf)[NKS], float (&out)[16]) {
#pragma unroll
    for (int nb = 0; nb < 4; ++nb) {
        f32x4 acc = (f32x4){0.f, 0.f, 0.f, 0.f};
#pragma unroll
        for (int ks = 0; ks < NKS; ++ks)
            acc = __builtin_amdgcn_mfma_f32_16x16x32_bf16(*(const LAS bf16x8*)(wl + (nb * NKS + ks) * 1024), __builtin_bit_cast(bf16x8, xf[ks]), acc, 0, 0, 0);
        out[4 * nb + 0] = acc[0]; out[4 * nb + 1] = acc[1]; out[4 * nb + 2] = acc[2]; out[4 * nb + 3] = acc[3];
    }
}

template <int V> struct IC { static constexpr int value = V; };
template <int N> __device__ __forceinline__ unsigned edge_lo(unsigned v) { if constexpr (N == 0) return v; else return (unsigned)__builtin_amdgcn_update_dpp(0, (int)v, 0x100 + N, 0xf, 0xf, true); }
template <int N> __device__ __forceinline__ unsigned edge_hi(unsigned v) { if constexpr (N == 0) return v; else return (unsigned)__builtin_amdgcn_update_dpp(0, (int)v, 0x110 + N, 0xf, 0xf, true); }
__device__ __forceinline__ void scan_unit(LAS unsigned char* lds, int unit, int layer, const bf16_t* __restrict__ P, const ScanW& w,
                                          bf16_t* __restrict__ ybuf, bf16_t* __restrict__ gbuf, bf16_t* __restrict__ mixb, bf16_t* __restrict__ vfirst, float* __restrict__ sbon,
                                          bf16_t* __restrict__ yaug, float* __restrict__ segst) {
    const int tid = otid(), lane = tid & 63, wave = __builtin_amdgcn_readfirstlane(tid >> 6);
    const int seg = unit & (NSEG - 1), chain = unit / NSEG;
    const int h = chain & 7, dir = (chain >> 3) & 1, b = chain >> 4;
    const int tokbase = b * SEQ;
    const int t = lane & 15, kq = lane >> 4;
    auto segcol = [&](int s_) { return s_ < 3 ? s_ * 512 + h * 64 : s_ == 3 ? O_WD + dir * 64 : s_ == 4 ? O_AD + dir * 64 : O_GD + (s_ - 5) * 64; };
    for (int i = tid; i < 3 * 7 * 64; i += NT) {
        const int m = i / 448, r = i % 448, sg = r >> 6, c = r & 63; const int col = segcol(sg) + c;
        ((LAS float*)(lds + LS_MU))[i] = (m < 2) ? w.mu[(m ^ dir) * RWC + col] : 1.f - w.mu[col] - w.mu[RWC + col];
    }
    if (tid < 384) {
        const int which = tid >> 6, ch = h * 64 + (tid & 63);
        const float v = (which == 0) ? w.kk_[ch] : (which == 1) ? w.ka[ch] : (which == 2) ? w.rk[ch] : (which == 3) ? w.w0[dir * 512 + ch] : (which == 4) ? w.a0[dir * 512 + ch] : ((layer > 0) ? w.v0[ch] : 0.f);
        ((LAS float*)(lds + LS_CST))[tid] = (which >= 3) ? -1.44269504f * v : v;
    }
    for (int i = tid; i < 36 * 64; i += NT) {
        const int f = i >> 6, n = i & 15, q = (i >> 4) & 3;
        const bf16_t* src; int Kw, nb, ks;
        if (f < 8)       { src = w.WdecT + (size_t)dir * 512 * 64; Kw = 64; nb = f >> 1; ks = f & 1; }
        else if (f < 16) { src = w.WaaaT + (size_t)dir * 512 * 64; Kw = 64; nb = (f - 8) >> 1; ks = f & 1; }
        else if (f < 20) { src = w.WvuT; Kw = 32; nb = f - 16; ks = 0; }
        else             { src = w.WgT; Kw = 128; nb = (f - 20) >> 2; ks = (f - 20) & 3; }
        const bf16_t* p = src + (h * 64 + 16 * nb + n) * Kw + 32 * ks + 4 * q;
        const u32x2 lo = *(const u32x2*)p, hi = *(const u32x2*)(p + 16);
        *(LAS u32x4*)(lds + LS_WL + i * 16) = (u32x4){lo.x, lo.y, hi.x, hi.y};
    }
    __syncthreads();

    f32x4 St[4];
    const bool augw = wave >= 4; const int colw = 16 * (wave & 3) + t;
#pragma unroll
    for (int jb = 0; jb < 4; ++jb)
#pragma unroll
        for (int e = 0; e < 4; ++e) St[jb][e] = (augw && (16 * jb + 4 * kq + e) == colw) ? 1.f : 0.f;

    const char* Pc = (const char*)P;
    u32x2 rc[7][4], fz[3][2], EL[2], EH[2];
    const int colLo = dir ? 1984 : 1952, colHi = dir ? 1952 : 1984;
    auto piece_col = [&](int p, int foldcol) { const int sg = p >> 2, g = p & 3; return (p < 28 ? segcol(sg) + 16 * g : foldcol + 16 * (p & 1)) * 2 + 8 * kq; };
    if (tid < 64) *(LAS u32x4*)(lds + LS_EOF + tid * 16) = (u32x4){(unsigned)piece_col(t, colLo), (unsigned)piece_col((t + 16) & 31, colLo), (unsigned)piece_col(15 - t, colHi), (unsigned)piece_col(31 - t, colHi)};
    auto issue_loads = [&](int it_) {
        const int gb = seg * (SEGTOK / 16) + it_ * 8 + wave;
        const int st = 16 * gb + t;
        const int tok = dir ? (SEQ - 1 - st) : st;
        const unsigned ro = (unsigned)(tokbase + tok) * (unsigned)(PCW * 2) + 8u * kq;
        const int sL = 16 * gb - 1, sH = 16 * gb + 16;
        const bool vL_ = gb > 0, vH_ = gb < SEQ / 16 - 1;
        const int tL = vL_ ? (dir ? (SEQ - 1 - sL) : sL) : 0, tH = vH_ ? (dir ? (SEQ - 1 - sH) : sH) : 0;
        const unsigned rl = (unsigned)(tokbase + tL) * (unsigned)(PCW * 2), rh = (unsigned)(tokbase + tH) * (unsigned)(PCW * 2);
#pragma unroll
        for (int sg = 0; sg < 7; ++sg) {
            if (sg >= 5 && (it_ & 1)) continue;
            const int col = segcol(sg);
#pragma unroll
            for (int g = 0; g < 4; ++g) rc[sg][g] = *(const u32x2*)(Pc + ro + col * 2 + 32 * g);
        }
        const u32x4 eo4 = *(const LAS u32x4*)(lds + LS_EOF + lane * 16);
        const unsigned zo_ = 2016u * 2u + 8u * (unsigned)(lane & 3);
        EL[0] = *(const u32x2*)(Pc + (rl + (vL_ ? eo4.x : zo_))); EL[1] = *(const u32x2*)(Pc + (rl + (vL_ ? eo4.y : zo_)));
        EH[0] = *(const u32x2*)(Pc + (rh + (vH_ ? eo4.z : zo_))); EH[1] = *(const u32x2*)(Pc + (rh + (vH_ ? eo4.w : zo_)));
        if (layer > 0) {
#pragma unroll
            for (int g = 0; g < 2; ++g) { fz[0][g] = *(const u32x2*)(Pc + ro + 1920 * 2 + 32 * g); fz[1][g] = *(const u32x2*)(Pc + ro + colLo * 2 + 32 * g); fz[2][g] = *(const u32x2*)(Pc + ro + colHi * 2 + 32 * g); }
        }
    };
#pragma unroll
    for (int sg = 0; sg < 7; ++sg)
#pragma unroll
        for (int g = 0; g < 4; ++g) rc[sg][g] = (u32x2){0u, 0u};
#pragma unroll
    for (int g = 0; g < 2; ++g) { fz[0][g] = fz[1][g] = fz[2][g] = (u32x2){0u, 0u}; }
    __syncthreads();
    issue_loads(0);
    for (int it = 0; it < SEGTOK / 128; ++it) {
        {
            if (wave >= 4) __builtin_amdgcn_s_sleep(3);
            int lane_o = lane; asm volatile("" : "+v"(lane_o));
            const int t = lane_o & 15, kq = lane_o >> 4;
            const LAS unsigned char* WL = lds + LS_WL + lane_o * 16;
            const LAS float* MU = (const LAS float*)(lds + LS_MU) + 4 * kq;
            const LAS float* CST = (const LAS float*)(lds + LS_CST) + 4 * kq;
            LAS unsigned char* myop = lds + LS_OPS + wave * OP_SIZE;
            LAS float* labt = (LAS float*)(lds + LS_LABT + wave * 1024);
            const int lane = lane_o;
            const int gb = seg * (SEGTOK / 16) + it * 8 + wave;
            const int st = 16 * gb + t;
            const int tok = dir ? (SEQ - 1 - st) : st;
            const unsigned grow = (unsigned)(tokbase + tok);
            u32x2 vf[4];
#pragma unroll
            for (int g = 0; g < 4; ++g) vf[g] = (u32x2){0u, 0u};
            if (layer > 0) {
#pragma unroll
                for (int g = 0; g < 4; ++g) vf[g] = *(const u32x2*)((const char*)vfirst + (grow * 1024u + (unsigned)((h * 64 + 16 * g + 4 * kq) * 2)));
            }
            auto seg_mix = [&](auto sgc, float (&out)[16]) {
                constexpr int sg = decltype(sgc)::value;
                auto grp = [&](auto gc) {
                    constexpr int g = decltype(gc)::value, p = 4 * sg + g, n = p & 15, j = p >> 4;
                    const u32x2 c = rc[sg][g];
                    const unsigned elx = edge_lo<n>(EL[j].x), ely = edge_lo<n>(EL[j].y), ehx = edge_hi<n>(EH[j].x), ehy = edge_hi<n>(EH[j].y);
                    const f32x4 ml = *(const LAS f32x4*)(MU + sg * 64 + 16 * g), mh = *(const LAS f32x4*)(MU + 448 + sg * 64 + 16 * g), m0 = *(const LAS f32x4*)(MU + 896 + sg * 64 + 16 * g);
                    {
                        const f32v2_t cc = bfpair(c.x), lo = bfpair(dpp_keep<0x111>(elx, c.x)), hi = bfpair(dpp_keep<0x101>(ehx, c.x));
                        const f32v2_t v = (f32v2_t){m0[0], m0[1]} * cc + (f32v2_t){ml[0], ml[1]} * lo + (f32v2_t){mh[0], mh[1]} * hi;
                        out[4 * g + 0] = v[0]; out[4 * g + 1] = v[1];
                    }
                    {
                        const f32v2_t cc = bfpair(c.y), lo = bfpair(dpp_keep<0x111>(ely, c.y)), hi = bfpair(dpp_keep<0x101>(ehy, c.y));
                        const f32v2_t v = (f32v2_t){m0[2], m0[3]} * cc + (f32v2_t){ml[2], ml[3]} * lo + (f32v2_t){mh[2], mh[3]} * hi;
                        out[4 * g + 2] = v[0]; out[4 * g + 3] = v[1];
                    }
                };
                grp(IC<0>{}); grp(IC<1>{}); grp(IC<2>{}); grp(IC<3>{});
            };
            auto cst16 = [&](int which, float (&out)[16]) {
#pragma unroll
                for (int g = 0; g < 4; ++g) { const f32x4 v = *(const LAS f32x4*)(CST + which * 64 + 16 * g); out[4 * g] = v[0]; out[4 * g + 1] = v[1]; out[4 * g + 2] = v[2]; out[4 * g + 3] = v[3]; }
            };
            u32x4 selE, selO;
            {
                const unsigned wv = (kq == (t >> 2)) ? (0x3F80u << (16 * (t & 1))) : 0u;
                const unsigned w0_ = (t & 2) ? 0u : wv, w1_ = (t & 2) ? wv : 0u;
                selE = (u32x4){w0_, w1_, 0u, 0u}; selO = (u32x4){0u, 0u, w0_, w1_};
            }
            if ((it & 1) == 0) {
                float g0[16], g1[16]; seg_mix(IC<5>{}, g0); seg_mix(IC<6>{}, g1);
#pragma unroll
                for (int i = 0; i < 16; ++i) { g0[i] = fsig(g0[i]); g1[i] = fsig(g1[i]); }
                u32x4 xf[4]; xf[0] = pack8(g0); xf[1] = pack8(g0 + 8); xf[2] = pack8(g1); xf[3] = pack8(g1 + 8);
                float go[16]; lora_mm<4>(WL + WL_G, xf, go);
#pragma unroll
                for (int g = 0; g < 4; ++g) *(u32x2*)((char*)gbuf + (grow * 1024u + (unsigned)((h * 64 + 16 * g + 4 * kq) * 2))) = (u32x2){cvtpk(go[4 * g], go[4 * g + 1]), cvtpk(go[4 * g + 2], go[4 * g + 3])};
            }
            float kv[16], kk[16];
            seg_mix(IC<1>{}, kv);
            {
                float c_[16]; cst16(0, c_);
                float ss = 0.f;
#pragma unroll
                for (int i = 0; i < 16; ++i) { kk[i] = kv[i] * c_[i]; ss += kk[i] * kk[i]; }
                ss += shx(ss, 16, lane); ss += shx(ss, 32, lane);
                const float rn = __builtin_amdgcn_rsqf(fmaxf(ss, 1e-12f));
#pragma unroll
                for (int i = 0; i < 16; ++i) kk[i] *= rn;
            }
            float kd[16], bb[16];
            {
                float ain[16]; seg_mix(IC<4>{}, ain);
                u32x4 xf[2]; xf[0] = pack8(ain); xf[1] = pack8(ain + 8);
                float xa[16]; lora_mm<2>(WL + WL_AAA, xf, xa);
                float a0c[16], kac[16]; cst16(4, a0c); cst16(1, kac);
#pragma unroll
                for (int i = 0; i < 16; ++i) { const float a = fsig(xa[i] + a0c[i]); kd[i] = kv[i] * (1.f + (a - 1.f) * kac[i]); bb[i] = kk[i] * a; }
            }
            float rv[16];
            seg_mix(IC<0>{}, rv);
            {
                float rkc[16]; cst16(2, rkc);
                float bon = 0.f;
#pragma unroll
                for (int i = 0; i < 16; ++i) bon += rv[i] * kd[i] * rkc[i];
                bon += shx(bon, 16, lane); bon += shx(bon, 32, lane);
                if (kq == 0) *(float*)((char*)sbon + (grow * 64u + (unsigned)((dir * 8 + h) * 4))) = bon;
            }
            {
                float vv[16]; seg_mix(IC<2>{}, vv);
                if (layer > 0) {
                    float hid[8];
                    {
                        const u32x2 z0 = fz[0][0], cl = fz[1][0], ch_ = fz[2][0];
                        const f32v2_t s0 = bfpair(z0.x) + bfpair(dpp_keep<0x111>(edge_lo<12>(EL[1].x), cl.x)) + bfpair(dpp_keep<0x101>(edge_hi<12>(EH[1].x), ch_.x));
                        const f32v2_t s1 = bfpair(z0.y) + bfpair(dpp_keep<0x111>(edge_lo<12>(EL[1].y), cl.y)) + bfpair(dpp_keep<0x101>(edge_hi<12>(EH[1].y), ch_.y));
                        hid[0] = s0[0]; hid[1] = s0[1]; hid[2] = s1[0]; hid[3] = s1[1];
                    }
                    {
                        const u32x2 z0 = fz[0][1], cl = fz[1][1], ch_ = fz[2][1];
                        const f32v2_t s0 = bfpair(z0.x) + bfpair(dpp_keep<0x111>(edge_lo<13>(EL[1].x), cl.x)) + bfpair(dpp_keep<0x101>(edge_hi<13>(EH[1].x), ch_.x));
                        const f32v2_t s1 = bfpair(z0.y) + bfpair(dpp_keep<0x111>(edge_lo<13>(EL[1].y), cl.y)) + bfpair(dpp_keep<0x101>(edge_hi<13>(EH[1].y), ch_.y));
                        hid[4] = s0[0]; hid[5] = s0[1]; hid[6] = s1[0]; hid[7] = s1[1];
                    }
                    u32x4 xf[1]; xf[0] = pack8(hid);
                    float xm[16]; lora_mm<1>(WL + WL_VU, xf, xm);
                    float v0c[16]; cst16(5, v0c);
#pragma unroll
                    for (int g = 0; g < 4; ++g) {
                        const f32v2_t f0 = bfpair(vf[g].x), f1 = bfpair(vf[g].y);
                        vv[4 * g + 0] += (f0[0] - vv[4 * g + 0]) * fsig(xm[4 * g + 0] + v0c[4 * g + 0]); vv[4 * g + 1] += (f0[1] - vv[4 * g + 1]) * fsig(xm[4 * g + 1] + v0c[4 * g + 1]);
                        vv[4 * g + 2] += (f1[0] - vv[4 * g + 2]) * fsig(xm[4 * g + 2] + v0c[4 * g + 2]); vv[4 * g + 3] += (f1[1] - vv[4 * g + 3]) * fsig(xm[4 * g + 3] + v0c[4 * g + 3]);
                    }
                }
                u32x4 vp[2]; vp[0] = pack8(vv); vp[1] = pack8(vv + 8);
                if (dir == 1) {
                    const unsigned pv[8] = {vp[0].x, vp[0].y, vp[0].z, vp[0].w, vp[1].x, vp[1].y, vp[1].z, vp[1].w};
#pragma unroll
                    for (int g = 0; g < 4; ++g) {
                        const u32x2 q = (u32x2){pv[2 * g], pv[2 * g + 1]};
                        *(u32x2*)((char*)mixb + (grow * 2048u + (unsigned)((h * 64 + 16 * g + 4 * kq) * 2))) = q;
                        if (layer == 0) *(u32x2*)((char*)vfirst + (grow * 1024u + (unsigned)((h * 64 + 16 * g + 4 * kq) * 2))) = q;
                    }
                }
#pragma unroll
                for (int ib = 0; ib < 4; ++ib) {
                    const f32x4 z = (f32x4){0.f, 0.f, 0.f, 0.f};
                    const f32x4 d = __builtin_amdgcn_mfma_f32_16x16x32_bf16(__builtin_bit_cast(bf16x8, vp[ib >> 1]), __builtin_bit_cast(bf16x8, (ib & 1) ? selO : selE), z, 0, 0, 0);
                    *(LAS u32x2*)(myop + OP_VT + (ib * 64 + lane) * 8) = (u32x2){cvtpk(d[0], d[1]), cvtpk(d[2], d[3])};
                }
            }
            u32x4 apf[2], rpf[2], btf[2], ktf[2], bgf[2], kgf[2];
            {
                float lw[16];
                {
                    float win[16]; seg_mix(IC<3>{}, win);
#pragma unroll
                    for (int i = 0; i < 16; ++i) win[i] = ftanh(win[i]);
                    u32x4 xf[2]; xf[0] = pack8(win); xf[1] = pack8(win + 8);
                    float xw[16]; lora_mm<2>(WL + WL_DEC, xf, xw);
                    float w0c[16]; cst16(3, w0c);
#pragma unroll
                    for (int i = 0; i < 16; ++i) lw[i] = -0.87503878f * fsig(xw[i] + w0c[i]);
                }
                float at[16], rt[16], bt[16], kt[16], bg[16], kg[16], gC[16];
#pragma unroll
                for (int i = 0; i < 16; ++i) {
                    float lam = lw[i];
                    lam += dpp_mov<0x111>(lam); lam += dpp_mov<0x112>(lam); lam += dpp_mov<0x114>(lam); lam += dpp_mov<0x118>(lam);
                    const float e3 = __builtin_amdgcn_exp2f(lam), e2 = __builtin_amdgcn_exp2f(-lam);
                    const float g = shl_(e3, (lane & 48) | 15);
                    const float e1 = __int_as_float(__builtin_amdgcn_update_dpp(0x3f800000, __float_as_int(e3), 0x111, 0xf, 0xf, false));
                    const float ge = g * e2;
                    gC[i] = g; at[i] = kk[i] * e1; rt[i] = rv[i] * e3; bt[i] = bb[i] * e2; kt[i] = kd[i] * e2; bg[i] = -bb[i] * ge; kg[i] = kd[i] * ge;
                }
                apf[0] = pack8(at); apf[1] = pack8(at + 8); rpf[0] = pack8(rt); rpf[1] = pack8(rt + 8); btf[0] = pack8(bt); btf[1] = pack8(bt + 8);
                ktf[0] = pack8(kt); ktf[1] = pack8(kt + 8); bgf[0] = pack8(bg); bgf[1] = pack8(bg + 8); kgf[0] = pack8(kg); kgf[1] = pack8(kg + 8);
                if (t == 0) {
#pragma unroll
                    for (int g = 0; g < 4; ++g) *(LAS f32x4*)(myop + OP_GC + (kq * 16 + 4 * g) * 4) = (f32x4){gC[4 * g], gC[4 * g + 1], gC[4 * g + 2], gC[4 * g + 3]};
                }
            }
            *(LAS u32x4*)(myop + OP_AP + lane * 16) = apf[0]; *(LAS u32x4*)(myop + OP_AP + 1024 + lane * 16) = apf[1];
            *(LAS u32x4*)(myop + OP_RP + lane * 16) = rpf[0]; *(LAS u32x4*)(myop + OP_RP + 1024 + lane * 16) = rpf[1];
            {
                f32x4 lab = (f32x4){0.f, 0.f, 0.f, 0.f}, lak = lab, lrb = lab, lrk = lab;
#pragma unroll
                for (int ks = 0; ks < 2; ++ks) {
                    lab = __builtin_amdgcn_mfma_f32_16x16x32_bf16(__builtin_bit_cast(bf16x8, btf[ks]), __builtin_bit_cast(bf16x8, apf[ks]), lab, 0, 0, 0);
                    lak = __builtin_amdgcn_mfma_f32_16x16x32_bf16(__builtin_bit_cast(bf16x8, ktf[ks]), __builtin_bit_cast(bf16x8, apf[ks]), lak, 0, 0, 0);
                    lrb = __builtin_amdgcn_mfma_f32_16x16x32_bf16(__builtin_bit_cast(bf16x8, btf[ks]), __builtin_bit_cast(bf16x8, rpf[ks]), lrb, 0, 0, 0);
                    lrk = __builtin_amdgcn_mfma_f32_16x16x32_bf16(__builtin_bit_cast(bf16x8, ktf[ks]), __builtin_bit_cast(bf16x8, rpf[ks]), lrk, 0, 0, 0);
                }
#pragma unroll
                for (int e = 0; e < 4; ++e) {
                    const int s = 4 * kq + e;
                    const bool lo = s < t, le = s <= t;
                    lab[e] = lo ? lab[e] : 0.f; lak[e] = lo ? lak[e] : 0.f; lrb[e] = le ? -lrb[e] : 0.f; lrk[e] = le ? lrk[e] : 0.f;
                    labt[s * 16 + t] = lab[e];
                }
                u32x4 mx; mx.x = 0u; mx.y = 0u; mx.z = cvtpk(lak[0], lak[1]); mx.w = cvtpk(lak[2], lak[3]);
                u32x4 my; my.x = cvtpk(lrb[0], lrb[1]); my.y = cvtpk(lrb[2], lrb[3]); my.z = cvtpk(lrk[0], lrk[1]); my.w = cvtpk(lrk[2], lrk[3]);
                *(LAS u32x4*)(myop + OP_MX2 + lane * 16) = mx; *(LAS u32x4*)(myop + OP_MY + lane * 16) = my;
            }
#pragma unroll
            for (int jb = 0; jb < 4; ++jb) {
                const f32x4 z = (f32x4){0.f, 0.f, 0.f, 0.f};
                const bf16x8 sel = __builtin_bit_cast(bf16x8, (jb & 1) ? selO : selE);
                const f32x4 d0 = __builtin_amdgcn_mfma_f32_16x16x32_bf16(__builtin_bit_cast(bf16x8, bgf[jb >> 1]), sel, z, 0, 0, 0);
                const f32x4 d1 = __builtin_amdgcn_mfma_f32_16x16x32_bf16(__builtin_bit_cast(bf16x8, kgf[jb >> 1]), sel, z, 0, 0, 0);
                u32x4 gp; gp.x = cvtpk(d0[0], d0[1]); gp.y = cvtpk(d0[2], d0[3]); gp.z = cvtpk(d1[0], d1[1]); gp.w = cvtpk(d1[2], d1[3]);
                *(LAS u32x4*)(myop + OP_GP + (jb * 64 + lane) * 16) = gp;
            }
            {
                const int s = t;
                float x[16];
#pragma unroll
                for (int q = 0; q < 16; ++q) x[q] = (q == s) ? 1.f : 0.f;
#pragma unroll
                for (int q = 0; q < 15; ++q) {
                    const f32x4 l0 = *(const LAS f32x4*)(labt + q * 16), l1 = *(const LAS f32x4*)(labt + q * 16 + 4), l2 = *(const LAS f32x4*)(labt + q * 16 + 8), l3 = *(const LAS f32x4*)(labt + q * 16 + 12);
                    const float lq[16] = {l0[0], l0[1], l0[2], l0[3], l1[0], l1[1], l1[2], l1[3], l2[0], l2[1], l2[2], l2[3], l3[0], l3[1], l3[2], l3[3]};
#pragma unroll
                    for (int r = q + 1; r < 16; ++r) x[r] -= lq[r] * x[q];
                }
                LAS bf16_t* md = (LAS bf16_t*)(myop + OP_MD) + (16 * (s >> 2)) * 8 + (s & 3);
#pragma unroll
                for (int j = 0; j < 4; ++j) {
                    const float xv = (kq == 0) ? x[j] : (kq == 1) ? x[4 + j] : (kq == 2) ? x[8 + j] : x[12 + j];
                    md[(4 * kq + j) * 8] = f2bf(xv);
                }
                { unsigned z_ = 0u; asm volatile("" : "+v"(z_)); *(LAS u32x2*)(myop + OP_MD + lane * 16 + 8) = (u32x2){z_, z_}; }
            }
        }
        __syncthreads();
        if (it + 1 < SEGTOK / 128) issue_loads(it + 1);
        int lane_c = lane; asm volatile("" : "+v"(lane_c));
#pragma unroll 1
        for (int c = 0; c < 8; ++c) {
            const int lane = lane_c, kq = lane_c >> 4, colc = 16 * (wave & 3) + (lane_c & 15);
            const LAS unsigned char* op = lds + LS_OPS + c * OP_SIZE;
            u32x2 vt = *(const LAS u32x2*)(op + OP_VT + ((wave & 3) * 64 + lane) * 8);
            if (augw) vt = (u32x2){0u, 0u};
            u32x4 sb0, sb1;
            sb0.x = cvtpk(St[0][0], St[0][1]); sb0.y = cvtpk(St[0][2], St[0][3]); sb0.z = cvtpk(St[1][0], St[1][1]); sb0.w = cvtpk(St[1][2], St[1][3]);
            sb1.x = cvtpk(St[2][0], St[2][1]); sb1.y = cvtpk(St[2][2], St[2][3]); sb1.z = cvtpk(St[3][0], St[3][1]); sb1.w = cvtpk(St[3][2], St[3][3]);
            const bf16x8 ap0 = *(const LAS bf16x8*)(op + OP_AP + lane * 16), ap1 = *(const LAS bf16x8*)(op + OP_AP + 1024 + lane * 16);
            const bf16x8 rp0 = *(const LAS bf16x8*)(op + OP_RP + lane * 16), rp1 = *(const LAS bf16x8*)(op + OP_RP + 1024 + lane * 16);
            const bf16x8 mx2 = *(const LAS bf16x8*)(op + OP_MX2 + lane * 16), mdm = *(const LAS bf16x8*)(op + OP_MD + lane * 16), mym = *(const LAS bf16x8*)(op + OP_MY + lane * 16);
            u32x4 b0v; b0v.x = 0u; b0v.y = 0u; b0v.z = vt.x; b0v.w = vt.y;
            f32x4 ax = (f32x4){0.f, 0.f, 0.f, 0.f};
            ax = __builtin_amdgcn_mfma_f32_16x16x32_bf16(mx2, __builtin_bit_cast(bf16x8, b0v), ax, 0, 0, 0);
            ax = __builtin_amdgcn_mfma_f32_16x16x32_bf16(ap0, __builtin_bit_cast(bf16x8, sb0), ax, 0, 0, 0);
            ax = __builtin_amdgcn_mfma_f32_16x16x32_bf16(ap1, __builtin_bit_cast(bf16x8, sb1), ax, 0, 0, 0);
            f32x4 ay = (f32x4){0.f, 0.f, 0.f, 0.f};
            ay = __builtin_amdgcn_mfma_f32_16x16x32_bf16(rp0, __builtin_bit_cast(bf16x8, sb0), ay, 0, 0, 0);
            ay = __builtin_amdgcn_mfma_f32_16x16x32_bf16(rp1, __builtin_bit_cast(bf16x8, sb1), ay, 0, 0, 0);
            u32x4 bx; bx.x = cvtpk(ax[0], ax[1]); bx.y = cvtpk(ax[2], ax[3]); bx.z = 0u; bx.w = 0u;
            f32x4 ad = (f32x4){0.f, 0.f, 0.f, 0.f};
            ad = __builtin_amdgcn_mfma_f32_16x16x32_bf16(mdm, __builtin_bit_cast(bf16x8, bx), ad, 0, 0, 0);
            u32x4 dv; dv.x = cvtpk(ad[0], ad[1]); dv.y = cvtpk(ad[2], ad[3]); dv.z = vt.x; dv.w = vt.y;
            ay = __builtin_amdgcn_mfma_f32_16x16x32_bf16(mym, __builtin_bit_cast(bf16x8, dv), ay, 0, 0, 0);
#pragma unroll
            for (int jb = 0; jb < 4; ++jb) {
                const f32x4 gc = *(const LAS f32x4*)(op + OP_GC + (kq * 16 + 4 * jb) * 4);
                const bf16x8 gp = *(const LAS bf16x8*)(op + OP_GP + (jb * 64 + lane) * 16);
                St[jb] = __builtin_amdgcn_mfma_f32_16x16x32_bf16(gp, __builtin_bit_cast(bf16x8, dv), St[jb] * gc, 0, 0, 0);
            }
            if (!augw || seg > 0) {
                bf16_t* yb = augw ? yaug : ybuf;
                const int sg0 = 16 * (seg * (SEGTOK / 16) + it * 8 + c) + 4 * kq;
#pragma unroll
                for (int e = 0; e < 4; ++e) { const int tk = dir ? (SEQ - 1 - (sg0 + e)) : (sg0 + e); *(bf16_t*)((char*)yb + ((unsigned)((tokbase + tk) * 2 + dir) * 1024u + (unsigned)((h * 64 + colc) * 2))) = f2bf(ay[e]); }
            }
        }
        __syncthreads();
    }
    if (seg + 1 < NSEG) {
        int lane_f = lane; asm volatile("" : "+v"(lane_f));
        const int kq = lane_f >> 4, colw = 16 * (wave & 3) + (lane_f & 15);
        float* dst = segst + ((size_t)unit * 2 + (augw ? 1 : 0)) * 4096;
#pragma unroll
        for (int jb = 0; jb < 4; ++jb)
#pragma unroll
            for (int e = 0; e < 4; ++e) dst[(16 * jb + 4 * kq + e) * 64 + colw] = St[jb][e];
    }
}

__device__ __forceinline__ void ph_segfix(LAS unsigned char* lds, const float* __restrict__ segst, bf16_t* __restrict__ SS, int nchain) {
    const int tid = otid(), j = tid >> 3, ig = tid & 7;
    LAS float* Sp = (LAS float*)lds;
    for (int chain = blockIdx.x; chain < nchain; chain += NWG) {
        float acc[8];
        for (int k = 1; k < NSEG; ++k) {
            const float* Cp = segst + ((size_t)(chain * NSEG + k - 1) * 2 + 0) * 4096 + j * 64 + 8 * ig;
            const float* Ap = segst + ((size_t)(chain * NSEG + k - 1) * 2 + 1) * 4096 + j * 64;
#pragma unroll
            for (int e = 0; e < 8; ++e) acc[e] = Cp[e];
            if (k > 1) {
                f32x4 ar[16];
#pragma unroll
                for (int q4 = 0; q4 < 16; ++q4) ar[q4] = *(const f32x4*)(Ap + 4 * q4);
#pragma unroll
                for (int q = 0; q < 64; ++q) {
                    const float a = ar[q >> 2][q & 3];
                    const f32x4 s0 = *(const LAS f32x4*)(Sp + q * 64 + 8 * ig), s1 = *(const LAS f32x4*)(Sp + q * 64 + 8 * ig + 4);
                    acc[0] += a * s0[0]; acc[1] += a * s0[1]; acc[2] += a * s0[2]; acc[3] += a * s0[3]; acc[4] += a * s1[0]; acc[5] += a * s1[1]; acc[6] += a * s1[2]; acc[7] += a * s1[3];
                }
            }
            __syncthreads();
#pragma unroll
            for (int e = 0; e < 8; ++e) { Sp[j * 64 + 8 * ig + e] = acc[e]; SS[((size_t)(chain * NSEG + k) * 64 + 8 * ig + e) * 64 + j] = f2bf(acc[e]); }
            __syncthreads();
        }
    }
}
__device__ __forceinline__ void ph_ycorr(const bf16_t* __restrict__ yaug, const bf16_t* __restrict__ SS, bf16_t* __restrict__ ybuf, int nchain) {
    const int tid = otid(), lane = tid & 63, wave = tid >> 6, il = lane & 15, kq = lane >> 4;
    constexpr int TPS = SEGTOK / 16, IPC = (NSEG - 1) * TPS;
    for (int it = blockIdx.x * 8 + wave; it < nchain * IPC; it += NWG * 8) {
        const int chain = it / IPC, r = it % IPC, seg = 1 + r / TPS, tile = r % TPS;
        const int h = chain & 7, dir = (chain >> 3) & 1, b = chain >> 4;
        const int st0 = seg * SEGTOK + 16 * tile, t0 = dir ? (SEQ - 16 - st0) : st0;
        const size_t rowbase = ((size_t)(b * SEQ + t0) * 2 + dir) * 512 + h * 64;
        const bf16x8 a0 = *(const bf16x8*)(yaug + rowbase + (size_t)il * 1024 + 8 * kq), a1 = *(const bf16x8*)(yaug + rowbase + (size_t)il * 1024 + 32 + 8 * kq);
        const bf16_t* ssp = SS + (size_t)(chain * NSEG + seg) * 4096;
#pragma unroll
        for (int nb = 0; nb < 4; ++nb) {
            const bf16x8 b0 = *(const bf16x8*)(ssp + (16 * nb + il) * 64 + 8 * kq), b1 = *(const bf16x8*)(ssp + (16 * nb + il) * 64 + 32 + 8 * kq);
            f32x4 acc = (f32x4){0.f, 0.f, 0.f, 0.f};
            acc = __builtin_amdgcn_mfma_f32_16x16x32_bf16(a0, b0, acc, 0, 0, 0);
            acc = __builtin_amdgcn_mfma_f32_16x16x32_bf16(a1, b1, acc, 0, 0, 0);
#pragma unroll
            for (int e = 0; e < 4; ++e) { bf16_t* yp = ybuf + rowbase + (size_t)(4 * kq + e) * 1024 + 16 * nb + il; *yp = f2bf(bf2f(*yp) + acc[e]); }
        }
    }
}

__device__ __forceinline__ void ph_post2(const bf16_t* __restrict__ ybuf, const bf16_t* __restrict__ gbuf, const float* __restrict__ sbon, const float* __restrict__ lg, const float* __restrict__ lb,
                                         bf16_t* __restrict__ mixb, int rows) {
    const int c = otid(), h = c >> 6, lane = c & 63;
    const float lgc = lg[c], lbc = lb[c];
    for (int t = blockIdx.x; t < rows; t += NWG) {
        const float y = bf2f(ybuf[(size_t)t * 1024 + c]) + bf2f(ybuf[(size_t)t * 1024 + 512 + c]);
        const float mu = wave_sum(y, lane) * (1.f / 64.f); const float dv = y - mu; const float var = wave_sum(dv * dv, lane) * (1.f / 64.f);
        const float yn = dv * rsqrtf(var + 64e-5f) * lgc + lbc;
        const float bon = sbon[(size_t)t * 16 + h] + sbon[(size_t)t * 16 + 8 + h];
        const float o = (yn + bon * bf2f(mixb[(size_t)t * 1024 + c])) * bf2f(gbuf[(size_t)t * 512 + c]);
        mixb[(size_t)t * 1024 + c] = f2bf(o);
    }
}

__device__ __forceinline__ void ph_fold(const float* __restrict__ win1, const float* __restrict__ g1, const float* __restrict__ mu1, const float* __restrict__ vdown, bf16_t* __restrict__ WinT1) {
    const int tid0 = otid();
    for (int idx = blockIdx.x * NT + tid0; idx < 96 * D; idx += NWG * NT) {
        const int jj = idx / D, k = idx % D, which = jj >> 5, j = jj & 31;
        const float* wr = win1 + (size_t)k * INC + 1024;
        float s = 0.f;
        for (int c = 0; c < 512; ++c) {
            const float m0 = mu1[1024 + c], m1 = mu1[RWC + 1024 + c];
            const float cf = (which == 0) ? (1.f - m0 - m1) : (which == 1) ? m0 : m1;
            s += wr[c] * cf * vdown[c * 32 + j];
        }
        WinT1[(size_t)(1920 + jj) * D + k] = f2bf(s * g1[k]);
    }
}


__device__ __forceinline__ void ph_post3(const bf16_t* __restrict__ ybuf, const bf16_t* __restrict__ yaug, const bf16_t* __restrict__ SS, const bf16_t* __restrict__ gbuf, const float* __restrict__ sbon,
                                         const float* __restrict__ lg, const float* __restrict__ lb, bf16_t* __restrict__ mixb, int nseq) {
    const int tid = otid(), lane = tid & 63, wave = tid >> 6, il = lane & 15, kq = lane >> 4;
    const int nitems = nseq * 8 * (SEQ / 16);
    for (int it = blockIdx.x * 8 + wave; it < nitems; it += NWG * 8) {
        const int tb = it % (SEQ / 16), h = (it / (SEQ / 16)) & 7, b = it / (8 * (SEQ / 16));
        const int t0 = 16 * tb;
        const size_t tokrow = (size_t)(b * SEQ + t0 + il);
        u32x2 vq_[4], gq_[4]; f32x4 g4_[4], b4_[4];
#pragma unroll
        for (int mb = 0; mb < 4; ++mb) {
            const int ch = h * 64 + 16 * mb + 4 * kq;
            g4_[mb] = *(const f32x4*)(lg + ch); b4_[mb] = *(const f32x4*)(lb + ch);
            vq_[mb] = *(const u32x2*)(mixb + tokrow * 1024 + ch); gq_[mb] = *(const u32x2*)(gbuf + tokrow * 512 + ch);
        }
        const float bon = sbon[tokrow * 16 + h] + sbon[tokrow * 16 + 8 + h];
        float y[4][4];
#pragma unroll
        for (int mb = 0; mb < 4; ++mb)
#pragma unroll
            for (int e = 0; e < 4; ++e) y[mb][e] = 0.f;
#pragma unroll
        for (int dir = 0; dir < 2; ++dir) {
            const size_t ro = (tokrow * 2 + dir) * 512 + h * 64;
#pragma unroll
            for (int mb = 0; mb < 4; ++mb) {
                const u32x2 q = *(const u32x2*)(ybuf + ro + 16 * mb + 4 * kq);
                y[mb][0] += __uint_as_float(q.x << 16); y[mb][1] += __uint_as_float(q.x & 0xffff0000u); y[mb][2] += __uint_as_float(q.y << 16); y[mb][3] += __uint_as_float(q.y & 0xffff0000u);
            }
            const int st0 = dir ? (SEQ - 16 - t0) : t0, seg = st0 / SEGTOK;
            if (seg > 0) {
                const int chain = (b * 2 + dir) * 8 + h;
                const bf16x8 y0 = *(const bf16x8*)(yaug + ro + 8 * kq), y1 = *(const bf16x8*)(yaug + ro + 32 + 8 * kq);
                const bf16_t* ssp = SS + (size_t)(chain * NSEG + seg) * 4096;
#pragma unroll
                for (int mb = 0; mb < 4; ++mb) {
                    const bf16x8 a0 = *(const bf16x8*)(ssp + (16 * mb + il) * 64 + 8 * kq), a1 = *(const bf16x8*)(ssp + (16 * mb + il) * 64 + 32 + 8 * kq);
                    f32x4 acc = (f32x4){y[mb][0], y[mb][1], y[mb][2], y[mb][3]};
                    acc = __builtin_amdgcn_mfma_f32_16x16x32_bf16(a0, y0, acc, 0, 0, 0);
                    acc = __builtin_amdgcn_mfma_f32_16x16x32_bf16(a1, y1, acc, 0, 0, 0);
                    y[mb][0] = acc[0]; y[mb][1] = acc[1]; y[mb][2] = acc[2]; y[mb][3] = acc[3];
                }
            }
        }
        float s = 0.f;
#pragma unroll
        for (int mb = 0; mb < 4; ++mb) s += (y[mb][0] + y[mb][1]) + (y[mb][2] + y[mb][3]);
        s += shx(s, 16, lane); s += shx(s, 32, lane);
        const float mu = s * (1.f / 64.f); float q2 = 0.f;
#pragma unroll
        for (int mb = 0; mb < 4; ++mb)
#pragma unroll
            for (int e = 0; e < 4; ++e) { y[mb][e] -= mu; q2 += y[mb][e] * y[mb][e]; }
        q2 += shx(q2, 16, lane); q2 += shx(q2, 32, lane);
        const float rs = rsqrtf(q2 * (1.f / 64.f) + 64e-5f);
#pragma unroll
        for (int mb = 0; mb < 4; ++mb) {
            const int ch = h * 64 + 16 * mb + 4 * kq;
            const f32x4 g4 = g4_[mb], b4 = b4_[mb];
            const u32x2 vq = vq_[mb], gq = gq_[mb];
            const float v0 = __uint_as_float(vq.x << 16), v1 = __uint_as_float(vq.x & 0xffff0000u), v2 = __uint_as_float(vq.y << 16), v3 = __uint_as_float(vq.y & 0xffff0000u);
            const float g0 = __uint_as_float(gq.x << 16), g1 = __uint_as_float(gq.x & 0xffff0000u), g2 = __uint_as_float(gq.y << 16), g3 = __uint_as_float(gq.y & 0xffff0000u);
            const float o0 = (y[mb][0] * rs * g4[0] + b4[0] + bon * v0) * g0, o1 = (y[mb][1] * rs * g4[1] + b4[1] + bon * v1) * g1;
            const float o2 = (y[mb][2] * rs * g4[2] + b4[2] + bon * v2) * g2, o3 = (y[mb][3] * rs * g4[3] + b4[3] + bon * v3) * g3;
            u32x2 o; o.x = cvtpk(o0, o1); o.y = cvtpk(o2, o3);
            *(u32x2*)(mixb + tokrow * 1024 + ch) = o;
        }
    }
}
struct Args { const float* in[27]; float* out; unsigned char* ws; };
struct WsMap { size_t ctl, WinT, WvT, WoutT, WupT, WdnT, WdecT, WaaaT, WgT, WvuT, xb, rstd, vfirst, mixb, act, P, VT, ybuf, gbuf, sbon, yaug, segst, SS, U, end; };
__host__ __device__ constexpr size_t al256(size_t x) { return (x + 255) & ~(size_t)255; }
__host__ __device__ constexpr WsMap make_map() {
    WsMap m{}; size_t off = 0;
    m.ctl = off; off += al256(WS_CTL_BYTES);
    m.WinT = off; off += al256((size_t)DEPTH * PCW * D * 2); m.WvT = off; off += al256((size_t)DEPTH * 512 * D * 2); m.WoutT = off; off += al256((size_t)DEPTH * D * D * 2);
    m.WupT = off; off += al256((size_t)DEPTH * UPC * D * 2); m.WdnT = off; off += al256((size_t)DEPTH * D * DFF * 2);
    m.WdecT = off; off += al256((size_t)DEPTH * 2 * 512 * 64 * 2); m.WaaaT = off; off += al256((size_t)DEPTH * 2 * 512 * 64 * 2); m.WgT = off; off += al256((size_t)DEPTH * 512 * 128 * 2); m.WvuT = off; off += al256((size_t)512 * 32 * 2);
    m.xb = off; off += al256((size_t)GR * D * 2); m.rstd = off; off += al256((size_t)GR * 4); m.vfirst = off; off += al256((size_t)GR * 512 * 2);
    m.mixb = off; off += al256((size_t)GR * 1024 * 2); m.act = off; off += al256((size_t)GR * DFF * 2);
    m.U = off;
    m.P = off; off += al256((size_t)GR * PCW * 2); m.VT = off; off += al256((size_t)512 * GR * 2);
    m.ybuf = off; off += al256((size_t)GR * 1024 * 2); m.gbuf = off; off += al256((size_t)GR * 512 * 2); m.sbon = off; off += al256((size_t)GR * 16 * 4);
    m.yaug = off; off += al256((size_t)GR * 1024 * 2); m.segst = off; off += al256((size_t)GSEQ * 16 * NSEG * 2 * 4096 * 4); m.SS = off; off += al256((size_t)GSEQ * 16 * NSEG * 4096 * 2);
    if (off < m.U + (size_t)GR * UPC * 2) off = m.U + (size_t)GR * UPC * 2;
    m.end = off; return m;
}
constexpr WsMap WSM = make_map();

__global__ void __launch_bounds__(NT, 2) mega(Args args) {
    extern __shared__ __attribute__((aligned(16))) unsigned char lds_raw[];
    LAS unsigned char* lds = (LAS unsigned char*)lds_raw;
    asm volatile("v_mov_b32 v1, 0\n\tv_mov_b32 v2, 0\n\tv_mov_b32 v3, 0\n\tv_mov_b32 v4, 0\n\tv_mov_b32 v5, 0\n\tv_mov_b32 v6, 0\n\tv_mov_b32 v7, 0\n\tv_mov_b32 v8, 0\n\tv_mov_b32 v9, 0\n\tv_mov_b32 v10, 0\n\tv_mov_b32 v11, 0\n\tv_mov_b32 v12, 0\n\tv_mov_b32 v13, 0\n\tv_mov_b32 v14, 0\n\tv_mov_b32 v15, 0\n\tv_mov_b32 v16, 0\n\tv_mov_b32 v17, 0\n\tv_mov_b32 v18, 0\n\tv_mov_b32 v19, 0\n\tv_mov_b32 v20, 0\n\tv_mov_b32 v21, 0\n\tv_mov_b32 v22, 0\n\tv_mov_b32 v23, 0\n\tv_mov_b32 v24, 0\n\tv_mov_b32 v25, 0\n\tv_mov_b32 v26, 0\n\tv_mov_b32 v27, 0\n\tv_mov_b32 v28, 0\n\tv_mov_b32 v29, 0\n\tv_mov_b32 v30, 0\n\tv_mov_b32 v31, 0\n\tv_mov_b32 v32, 0\n\tv_mov_b32 v33, 0\n\tv_mov_b32 v34, 0\n\tv_mov_b32 v35, 0\n\tv_mov_b32 v36, 0\n\tv_mov_b32 v37, 0\n\tv_mov_b32 v38, 0\n\tv_mov_b32 v39, 0\n\tv_mov_b32 v40, 0\n\tv_mov_b32 v41, 0\n\tv_mov_b32 v42, 0\n\tv_mov_b32 v43, 0\n\tv_mov_b32 v44, 0\n\tv_mov_b32 v45, 0\n\tv_mov_b32 v46, 0\n\tv_mov_b32 v47, 0\n\tv_mov_b32 v48, 0\n\tv_mov_b32 v49, 0\n\tv_mov_b32 v50, 0\n\tv_mov_b32 v51, 0\n\tv_mov_b32 v52, 0\n\tv_mov_b32 v53, 0\n\tv_mov_b32 v54, 0\n\tv_mov_b32 v55, 0\n\tv_mov_b32 v56, 0\n\tv_mov_b32 v57, 0\n\tv_mov_b32 v58, 0\n\tv_mov_b32 v59, 0\n\tv_mov_b32 v60, 0\n\tv_mov_b32 v61, 0\n\tv_mov_b32 v62, 0\n\tv_mov_b32 v63, 0\n\tv_mov_b32 v64, 0\n\tv_mov_b32 v65, 0\n\tv_mov_b32 v66, 0\n\tv_mov_b32 v67, 0\n\tv_mov_b32 v68, 0\n\tv_mov_b32 v69, 0\n\tv_mov_b32 v70, 0\n\tv_mov_b32 v71, 0\n\tv_mov_b32 v72, 0\n\tv_mov_b32 v73, 0\n\tv_mov_b32 v74, 0\n\tv_mov_b32 v75, 0\n\tv_mov_b32 v76, 0\n\tv_mov_b32 v77, 0\n\tv_mov_b32 v78, 0\n\tv_mov_b32 v79, 0\n\tv_mov_b32 v80, 0\n\tv_mov_b32 v81, 0\n\tv_mov_b32 v82, 0\n\tv_mov_b32 v83, 0\n\tv_mov_b32 v84, 0\n\tv_mov_b32 v85, 0\n\tv_mov_b32 v86, 0\n\tv_mov_b32 v87, 0\n\tv_mov_b32 v88, 0\n\tv_mov_b32 v89, 0\n\tv_mov_b32 v90, 0\n\tv_mov_b32 v91, 0\n\tv_mov_b32 v92, 0\n\tv_mov_b32 v93, 0\n\tv_mov_b32 v94, 0\n\tv_mov_b32 v95, 0\n\tv_mov_b32 v96, 0\n\tv_mov_b32 v97, 0\n\tv_mov_b32 v98, 0\n\tv_mov_b32 v99, 0\n\tv_mov_b32 v100, 0\n\tv_mov_b32 v101, 0\n\tv_mov_b32 v102, 0\n\tv_mov_b32 v103, 0\n\tv_mov_b32 v104, 0\n\tv_mov_b32 v105, 0\n\tv_mov_b32 v106, 0\n\tv_mov_b32 v107, 0\n\tv_mov_b32 v108, 0\n\tv_mov_b32 v109, 0\n\tv_mov_b32 v110, 0\n\tv_mov_b32 v111, 0\n\tv_mov_b32 v112, 0\n\tv_mov_b32 v113, 0\n\tv_mov_b32 v114, 0\n\tv_mov_b32 v115, 0\n\tv_mov_b32 v116, 0\n\tv_mov_b32 v117, 0\n\tv_mov_b32 v118, 0\n\tv_mov_b32 v119, 0\n\tv_mov_b32 v120, 0\n\tv_mov_b32 v121, 0\n\tv_mov_b32 v122, 0\n\tv_mov_b32 v123, 0\n\tv_mov_b32 v124, 0\n\tv_mov_b32 v125, 0\n\tv_mov_b32 v126, 0\n\tv_mov_b32 v127, 0\n\tv_mov_b32 v128, 0\n\tv_mov_b32 v129, 0\n\tv_mov_b32 v130, 0\n\tv_mov_b32 v131, 0\n\tv_mov_b32 v132, 0\n\tv_mov_b32 v133, 0\n\tv_mov_b32 v134, 0\n\tv_mov_b32 v135, 0\n\tv_mov_b32 v136, 0\n\tv_mov_b32 v137, 0\n\tv_mov_b32 v138, 0\n\tv_mov_b32 v139, 0\n\tv_mov_b32 v140, 0\n\tv_mov_b32 v141, 0\n\tv_mov_b32 v142, 0\n\tv_mov_b32 v143, 0\n\tv_mov_b32 v144, 0\n\tv_mov_b32 v145, 0\n\tv_mov_b32 v146, 0\n\tv_mov_b32 v147, 0\n\tv_mov_b32 v148, 0\n\tv_mov_b32 v149, 0\n\tv_mov_b32 v150, 0\n\tv_mov_b32 v151, 0\n\tv_mov_b32 v152, 0\n\tv_mov_b32 v153, 0\n\tv_mov_b32 v154, 0\n\tv_mov_b32 v155, 0\n\tv_mov_b32 v156, 0\n\tv_mov_b32 v157, 0\n\tv_mov_b32 v158, 0\n\tv_mov_b32 v159, 0\n\tv_mov_b32 v160, 0\n\tv_mov_b32 v161, 0\n\tv_mov_b32 v162, 0\n\tv_mov_b32 v163, 0\n\tv_mov_b32 v164, 0\n\tv_mov_b32 v165, 0\n\tv_mov_b32 v166, 0\n\tv_mov_b32 v167, 0\n\tv_mov_b32 v168, 0\n\tv_mov_b32 v169, 0\n\tv_mov_b32 v170, 0\n\tv_mov_b32 v171, 0\n\tv_mov_b32 v172, 0\n\tv_mov_b32 v173, 0\n\tv_mov_b32 v174, 0\n\tv_mov_b32 v175, 0\n\tv_mov_b32 v176, 0\n\tv_mov_b32 v177, 0\n\tv_mov_b32 v178, 0\n\tv_mov_b32 v179, 0\n\tv_mov_b32 v180, 0\n\tv_mov_b32 v181, 0\n\tv_mov_b32 v182, 0\n\tv_mov_b32 v183, 0\n\tv_mov_b32 v184, 0\n\tv_mov_b32 v185, 0\n\tv_mov_b32 v186, 0\n\tv_mov_b32 v187, 0\n\tv_mov_b32 v188, 0\n\tv_mov_b32 v189, 0\n\tv_mov_b32 v190, 0\n\tv_mov_b32 v191, 0\n\tv_mov_b32 v192, 0\n\tv_mov_b32 v193, 0\n\tv_mov_b32 v194, 0\n\tv_mov_b32 v195, 0\n\tv_mov_b32 v196, 0\n\tv_mov_b32 v197, 0\n\tv_mov_b32 v198, 0\n\tv_mov_b32 v199, 0\n\tv_mov_b32 v200, 0\n\tv_mov_b32 v201, 0\n\tv_mov_b32 v202, 0\n\tv_mov_b32 v203, 0\n\tv_mov_b32 v204, 0\n\tv_mov_b32 v205, 0\n\tv_mov_b32 v206, 0\n\tv_mov_b32 v207, 0\n\tv_mov_b32 v208, 0\n\tv_mov_b32 v209, 0\n\tv_mov_b32 v210, 0\n\tv_mov_b32 v211, 0\n\tv_mov_b32 v212, 0\n\tv_mov_b32 v213, 0\n\tv_mov_b32 v214, 0\n\tv_mov_b32 v215, 0\n\tv_mov_b32 v216, 0\n\tv_mov_b32 v217, 0\n\tv_mov_b32 v218, 0\n\tv_mov_b32 v219, 0\n\tv_mov_b32 v220, 0\n\tv_mov_b32 v221, 0\n\tv_mov_b32 v222, 0\n\tv_mov_b32 v223, 0\n\tv_mov_b32 v224, 0\n\tv_mov_b32 v225, 0\n\tv_mov_b32 v226, 0\n\tv_mov_b32 v227, 0\n\tv_mov_b32 v228, 0\n\tv_mov_b32 v229, 0\n\tv_mov_b32 v230, 0\n\tv_mov_b32 v231, 0\n\tv_mov_b32 v232, 0\n\tv_mov_b32 v233, 0\n\tv_mov_b32 v234, 0\n\tv_mov_b32 v235, 0\n\tv_mov_b32 v236, 0\n\tv_mov_b32 v237, 0\n\tv_mov_b32 v238, 0\n\tv_mov_b32 v239, 0\n\tv_mov_b32 v240, 0\n\tv_mov_b32 v241, 0\n\tv_mov_b32 v242, 0\n\tv_mov_b32 v243, 0\n\ts_mov_b32 s20, 0\n\ts_mov_b32 s21, 0\n\ts_mov_b32 s22, 0\n\ts_mov_b32 s23, 0\n\ts_mov_b32 s24, 0\n\ts_mov_b32 s25, 0\n\ts_mov_b32 s26, 0\n\ts_mov_b32 s27, 0\n\ts_mov_b32 s28, 0\n\ts_mov_b32 s29, 0\n\ts_mov_b32 s30, 0\n\ts_mov_b32 s31, 0\n\ts_mov_b32 s32, 0\n\ts_mov_b32 s33, 0\n\ts_mov_b32 s34, 0\n\ts_mov_b32 s35, 0\n\ts_mov_b32 s36, 0\n\ts_mov_b32 s37, 0\n\ts_mov_b32 s38, 0\n\ts_mov_b32 s39, 0\n\ts_mov_b32 s40, 0\n\ts_mov_b32 s41, 0\n\ts_mov_b32 s42, 0\n\ts_mov_b32 s43, 0\n\ts_mov_b32 s44, 0\n\ts_mov_b32 s45, 0\n\ts_mov_b32 s46, 0\n\ts_mov_b32 s47, 0\n\ts_mov_b32 s48, 0\n\ts_mov_b32 s49, 0\n\ts_mov_b32 s50, 0\n\ts_mov_b32 s51, 0\n\ts_mov_b32 s52, 0\n\ts_mov_b32 s53, 0\n\ts_mov_b32 s54, 0\n\ts_mov_b32 s55, 0\n\ts_mov_b32 s56, 0\n\ts_mov_b32 s57, 0\n\ts_mov_b32 s58, 0\n\ts_mov_b32 s59, 0\n\ts_mov_b32 s60, 0\n\ts_mov_b32 s61, 0\n\ts_mov_b32 s62, 0\n\ts_mov_b32 s63, 0\n\ts_mov_b32 s64, 0\n\ts_mov_b32 s65, 0\n\ts_mov_b32 s66, 0\n\ts_mov_b32 s67, 0\n\ts_mov_b32 s68, 0\n\ts_mov_b32 s69, 0\n\ts_mov_b32 s70, 0\n\ts_mov_b32 s71, 0\n\ts_mov_b32 s72, 0\n\ts_mov_b32 s73, 0\n\ts_mov_b32 s74, 0\n\ts_mov_b32 s75, 0\n\ts_mov_b32 s76, 0\n\ts_mov_b32 s77, 0\n\ts_mov_b32 s78, 0\n\ts_mov_b32 s79, 0\n\ts_mov_b32 s80, 0\n\ts_mov_b32 s81, 0\n\ts_mov_b32 s82, 0\n\ts_mov_b32 s83, 0\n\ts_mov_b32 s84, 0\n\ts_mov_b32 s85, 0\n\ts_mov_b32 s86, 0\n\ts_mov_b32 s87, 0\n\ts_mov_b32 s88, 0\n\ts_mov_b32 s89, 0\n\ts_mov_b32 s90, 0\n\ts_mov_b32 s91, 0\n\ts_mov_b32 s92, 0\n\ts_mov_b32 s93, 0\n\ts_mov_b32 s94, 0\n\ts_mov_b32 s95, 0\n\ts_mov_b32 s96, 0\n\ts_mov_b32 s97, 0\n\ts_mov_b32 s98, 0\n\ts_mov_b32 s99, 0\n\t" ::: "v1", "v2", "v3", "v4", "v5", "v6", "v7", "v8", "v9", "v10", "v11", "v12", "v13", "v14", "v15", "v16", "v17", "v18", "v19", "v20", "v21", "v22", "v23", "v24", "v25", "v26", "v27", "v28", "v29", "v30", "v31", "v32", "v33", "v34", "v35", "v36", "v37", "v38", "v39", "v40", "v41", "v42", "v43", "v44", "v45", "v46", "v47", "v48", "v49", "v50", "v51", "v52", "v53", "v54", "v55", "v56", "v57", "v58", "v59", "v60", "v61", "v62", "v63", "v64", "v65", "v66", "v67", "v68", "v69", "v70", "v71", "v72", "v73", "v74", "v75", "v76", "v77", "v78", "v79", "v80", "v81", "v82", "v83", "v84", "v85", "v86", "v87", "v88", "v89", "v90", "v91", "v92", "v93", "v94", "v95", "v96", "v97", "v98", "v99", "v100", "v101", "v102", "v103", "v104", "v105", "v106", "v107", "v108", "v109", "v110", "v111", "v112", "v113", "v114", "v115", "v116", "v117", "v118", "v119", "v120", "v121", "v122", "v123", "v124", "v125", "v126", "v127", "v128", "v129", "v130", "v131", "v132", "v133", "v134", "v135", "v136", "v137", "v138", "v139", "v140", "v141", "v142", "v143", "v144", "v145", "v146", "v147", "v148", "v149", "v150", "v151", "v152", "v153", "v154", "v155", "v156", "v157", "v158", "v159", "v160", "v161", "v162", "v163", "v164", "v165", "v166", "v167", "v168", "v169", "v170", "v171", "v172", "v173", "v174", "v175", "v176", "v177", "v178", "v179", "v180", "v181", "v182", "v183", "v184", "v185", "v186", "v187", "v188", "v189", "v190", "v191", "v192", "v193", "v194", "v195", "v196", "v197", "v198", "v199", "v200", "v201", "v202", "v203", "v204", "v205", "v206", "v207", "v208", "v209", "v210", "v211", "v212", "v213", "v214", "v215", "v216", "v217", "v218", "v219", "v220", "v221", "v222", "v223", "v224", "v225", "v226", "v227", "v228", "v229", "v230", "v231", "v232", "v233", "v234", "v235", "v236", "v237", "v238", "v239", "v240", "v241", "v242", "v243", "s20", "s21", "s22", "s23", "s24", "s25", "s26", "s27", "s28", "s29", "s30", "s31", "s32", "s33", "s34", "s35", "s36", "s37", "s38", "s39", "s40", "s41", "s42", "s43", "s44", "s45", "s46", "s47", "s48", "s49", "s50", "s51", "s52", "s53", "s54", "s55", "s56", "s57", "s58", "s59", "s60", "s61", "s62", "s63", "s64", "s65", "s66", "s67", "s68", "s69", "s70", "s71", "s72", "s73", "s74", "s75", "s76", "s77", "s78", "s79", "s80", "s81", "s82", "s83", "s84", "s85", "s86", "s87", "s88", "s89", "s90", "s91", "s92", "s93", "s94", "s95", "s96", "s97", "s98", "s99");
    volatile LAS unsigned* misc = (volatile LAS unsigned*)(lds + LDS_MISC);
    if (threadIdx.x < 64) misc[threadIdx.x] = 0u;
    __syncthreads();
    XcdBarrier bar = xcd_barrier_post(((unsigned*)(args.ws + WSM.ctl)), misc + 8, otid() == 0);
#define GRID_BAR() xcd_barrier(bar, otid() == 0)
    const float* const* in = args.in;
    float* X = args.out;
    constexpr int G = NWG; const int bx = (int)blockIdx.x;

#pragma unroll 1
    for (int j = 0; j < 21; ++j) {
        const int l = (j >= 10 && j < 20) ? 1 : 0, k = (j < 20) ? j - 10 * l : 10;
        const float* W; int K_, Nsrc, Nout, mode = 0; const float* scale = nullptr; bf16_t* out; float mul = 1.f;
        if (k == 0)      { W = in[3] + (size_t)l * D * INC; K_ = D; Nsrc = INC; scale = in[2] + l * D; out = ((bf16_t*)(args.ws + WSM.WinT)) + (size_t)l * PCW * D; Nout = PCW; mode = 1; }
        else if (k == 1) { W = in[3] + (size_t)l * D * INC; K_ = D; Nsrc = INC; scale = in[2] + l * D; out = ((bf16_t*)(args.ws + WSM.WvT)) + (size_t)l * 512 * D; Nout = 512; mode = 2; }
        else if (k == 2) { W = in[21] + (size_t)l * D * D; K_ = D; Nsrc = D; out = ((bf16_t*)(args.ws + WSM.WoutT)) + (size_t)l * D * D; Nout = D; }
        else if (k == 3) { W = in[23] + (size_t)l * D * UPC; K_ = D; Nsrc = UPC; scale = in[22] + l * D; out = ((bf16_t*)(args.ws + WSM.WupT)) + (size_t)l * UPC * D; Nout = UPC; mode = 3; }
        else if (k == 4) { W = in[26] + (size_t)l * DFF * D; K_ = DFF; Nsrc = D; out = ((bf16_t*)(args.ws + WSM.WdnT)) + (size_t)l * D * DFF; Nout = D; }
        else if (k <= 6) { const int d = k - 5; W = in[6] + (size_t)(l * 2 + d) * 64 * 512; K_ = 64; Nsrc = 512; out = ((bf16_t*)(args.ws + WSM.WdecT)) + (size_t)(l * 2 + d) * 512 * 64; Nout = 512; mul = -1.44269504f; }
        else if (k <= 8) { const int d = k - 7; W = in[8] + (size_t)(l * 2 + d) * 64 * 512; K_ = 64; Nsrc = 512; out = ((bf16_t*)(args.ws + WSM.WaaaT)) + (size_t)(l * 2 + d) * 512 * 64; Nout = 512; mul = -1.44269504f; }
        else if (k == 9) { W = in[9] + (size_t)l * 128 * 512; K_ = 128; Nsrc = 512; out = ((bf16_t*)(args.ws + WSM.WgT)) + (size_t)l * 512 * 128; Nout = 512; }
        else             { W = in[12]; K_ = 32; Nsrc = 512; out = ((bf16_t*)(args.ws + WSM.WvuT)); Nout = 512; mul = -1.44269504f; }
        ph_prep_w(lds, W, K_, Nsrc, scale, out, Nout, mode, mul);
    }
    GRID_BAR();
    ph_fold(in[3] + (size_t)1 * D * INC, in[2] + D, in[4] + (size_t)1 * 2 * RWC, in[11], ((bf16_t*)(args.ws + WSM.WinT)) + (size_t)1 * PCW * D);

    for (int grp = 0; grp < NGRP; ++grp) {
        const size_t g0 = (size_t)grp * GR;
        float* Xg = X + g0 * D;
        {
            const float* xin = (g0 < (size_t)8 * SEQ) ? in[0] + g0 * D : in[1] + (g0 - (size_t)8 * SEQ) * D;
            ph_rms_in(xin, ((bf16_t*)(args.ws + WSM.xb)), ((float*)(args.ws + WSM.rstd)), GR);
        }
        GRID_BAR();
        for (int l = 0; l < DEPTH; ++l) {
#pragma unroll 1
            for (int k = 0; k < 2; ++k) {
                const bf16_t* xb_ = (const bf16_t*)(args.ws + WSM.xb); const float* rs_ = (const float*)(args.ws + WSM.rstd);
                const bf16_t* wi_ = ((const bf16_t*)(args.ws + WSM.WinT)) + (size_t)l * PCW * D; const bf16_t* wv_ = ((const bf16_t*)(args.ws + WSM.WvT)) + (size_t)l * 512 * D;
                ph_gemm_bf(lds, k ? wv_ : xb_, k ? xb_ : wi_, k ? 512 : GR, k ? GR : PCW, D, k ? (bf16_t*)(args.ws + WSM.VT) : (bf16_t*)(args.ws + WSM.P), k ? nullptr : rs_, k ? rs_ : nullptr, k ? -1 : PCW);
            }
            GRID_BAR();
            {
                ph_qknorm(((bf16_t*)(args.ws + WSM.P)), in[18] + l * 64, in[19] + l * 64, GR);
                constexpr int NUNITS = GSEQ * 16 * NSEG;
                if (bx < NUNITS) {
                    ScanW w;
                    w.mu = in[4] + (size_t)l * 2 * RWC; w.w0 = in[5] + l * 1024; w.a0 = in[7] + l * 1024; w.v0 = in[10]; w.kk_ = in[13] + l * 512; w.ka = in[14] + l * 512; w.rk = in[15] + l * 512;
                    w.WdecT = ((bf16_t*)(args.ws + WSM.WdecT)) + (size_t)l * 2 * 512 * 64; w.WaaaT = ((bf16_t*)(args.ws + WSM.WaaaT)) + (size_t)l * 2 * 512 * 64; w.WgT = ((bf16_t*)(args.ws + WSM.WgT)) + (size_t)l * 512 * 128; w.WvuT = ((bf16_t*)(args.ws + WSM.WvuT));
                    for (int u = bx; u < NUNITS; u += G) scan_unit(lds, u, l, ((bf16_t*)(args.ws + WSM.P)), w, ((bf16_t*)(args.ws + WSM.ybuf)), ((bf16_t*)(args.ws + WSM.gbuf)), ((bf16_t*)(args.ws + WSM.mixb)), ((bf16_t*)(args.ws + WSM.vfirst)), ((float*)(args.ws + WSM.sbon)), (bf16_t*)(args.ws + WSM.yaug), (float*)(args.ws + WSM.segst));
                }
            }
            GRID_BAR();
#pragma unroll 1
            for (int half = 0; half < 2; ++half) {
                if (half == 0) {
                    ph_segfix(lds, (const float*)(args.ws + WSM.segst), (bf16_t*)(args.ws + WSM.SS), GSEQ * 16);
                    ph_natten(lds, ((bf16_t*)(args.ws + WSM.P)), ((bf16_t*)(args.ws + WSM.VT)), GR, GSEQ, in[20] + (size_t)l * 8 * 15 * 31, ((bf16_t*)(args.ws + WSM.mixb)), bx, G);
                    GRID_BAR();
                    ph_post3((const bf16_t*)(args.ws + WSM.ybuf), (const bf16_t*)(args.ws + WSM.yaug), (const bf16_t*)(args.ws + WSM.SS), (const bf16_t*)(args.ws + WSM.gbuf), (const float*)(args.ws + WSM.sbon), in[16] + l * 512, in[17] + l * 512, (bf16_t*)(args.ws + WSM.mixb), GSEQ);
                    GRID_BAR();
                } else {
                    ph_gemm_ffn(lds, ((bf16_t*)(args.ws + WSM.xb)), ((bf16_t*)(args.ws + WSM.WupT)) + (size_t)l * UPC * D, GR, ((bf16_t*)(args.ws + WSM.act)), (float*)(args.ws + WSM.U), ((float*)(args.ws + WSM.rstd)),
                                in[24] + (size_t)l * 3 * UPC, in[25] + (size_t)l * UPC);
                    GRID_BAR();
                    ph_ffn_fix((const float*)(args.ws + WSM.U), in[24] + (size_t)l * 3 * UPC, in[25] + (size_t)l * UPC, ((bf16_t*)(args.ws + WSM.act)), GR);
                    GRID_BAR();
                }
                ph_gemm(lds, half ? (const bf16_t*)(args.ws + WSM.act) : (const bf16_t*)(args.ws + WSM.mixb),
                        half ? ((const bf16_t*)(args.ws + WSM.WdnT)) + (size_t)l * D * DFF : ((const bf16_t*)(args.ws + WSM.WoutT)) + (size_t)l * D * D, GR, D, half ? DFF : D,
                        (bf16_t*)(args.ws + WSM.xb), (half == 1 && l + 1 == DEPTH) ? Xg : nullptr);
                GRID_BAR();
                if (half == 0 || l + 1 < DEPTH) { ph_rstd((const bf16_t*)(args.ws + WSM.xb), ((float*)(args.ws + WSM.rstd)), GR); GRID_BAR(); }
            }
        }
    }
}

extern "C" void kernel_launch(void* const* d_in, const int* in_sizes, int n_in, void* d_out, int out_size, void* d_ws, size_t ws_size, hipStream_t stream) {
    static int grid = 0;
    static Args a{};
    if (grid == 0) {
        int dev = 0, cus = 0;
        if (hipGetDevice(&dev) != hipSuccess || hipDeviceGetAttribute(&cus, hipDeviceAttributeMultiprocessorCount, dev) != hipSuccess) { fprintf(stderr, "device query failed\n"); grid = -1; return; }
        if (hipFuncSetAttribute((const void*)mega, hipFuncAttributeMaxDynamicSharedMemorySize, LDS_BYTES) != hipSuccess) { fprintf(stderr, "hipFuncSetAttribute failed\n"); grid = -1; return; }
        int per_cu = 0;
        if (hipOccupancyMaxActiveBlocksPerMultiprocessor(&per_cu, (const void*)mega, NT, LDS_BYTES) != hipSuccess || per_cu < 1) { fprintf(stderr, "occupancy query: %d\n", per_cu); }
        (void)hipGetLastError();
        if (cus < NWG) { fprintf(stderr, "this kernel needs %d CUs, device has %d\n", NWG, cus); grid = -1; return; }
        grid = NWG;
    }
    if (grid < 0) return;
    if (WSM.end > ws_size || n_in != 27) { fprintf(stderr, "ws too small: need %zu have %zu (n_in %d)\n", (size_t)WSM.end, ws_size, n_in); return; }
    a = Args{};
    for (int i = 0; i < 27; ++i) a.in[i] = (const float*)d_in[i];
    a.out = (float*)d_out; a.ws = (unsigned char*)d_ws;
    (void)hipMemsetAsync(d_ws, 0, WS_CTL_BYTES, stream);
    hipLaunchKernelGGL(mega, dim3(grid), dim3(NT), LDS_BYTES, stream, a);
}
```

```cpp
#include <hip/hip_runtime.h>
#include <cstdio>
#include <cstdint>
namespace pg8 {
#define PG8_LAS __attribute__((address_space(3)))
typedef unsigned short bf16_t;
typedef short bf16x8 __attribute__((ext_vector_type(8)));
typedef float f32x4 __attribute__((ext_vector_type(4)));
typedef unsigned u32x4 __attribute__((ext_vector_type(4)));
constexpr int BM = 256, BK = 64, HALF = 128, HTB = HALF * BK * 2  , STAGE_BYTES = 8 * HTB, NXCD = 8, WGM = 8;

__host__ __device__ __forceinline__ int lds_byte(int r, int c) { const int st = (r >> 4) * 2 + (c >> 5), rr = r & 15, cc = c & 31, ob = rr * 64 + cc * 2; return st * 1024 + (ob ^ (((ob >> 9) & 1) << 5)); }
__host__ __device__ __forceinline__ void stage_rc(int b, int& R, int& C) { const int st = b / 1024, sb = b % 1024, swz = sb ^ (((sb >> 9) & 1) << 5); R = (st >> 1) * 16 + swz / 64; C = (st & 1) * 32 + (swz % 64) / 2; }
__host__ __device__ __forceinline__ int perm32(int rho) { const int n = rho >> 4, i = rho & 15; return 8 * (i >> 2) + 4 * n + (i & 3); }

struct Unit { int pm, pn; };
struct Gemm { const bf16_t* A; const bf16_t* Bt; int M, N, K, pad; };

struct StaticOrder {
    int nM, nN, nwg, G, c;
    __host__ __device__ void init(int M, int N, int G_, int c_) { nM = M / BM; nN = N / BM; nwg = nM * nN; G = G_; c = c_; }
    __host__ __device__ bool next(int i, Unit& u) const {
        const int L = i * G + c; if (L >= nwg) return false;
        int wgid = L; { const int q = nwg / NXCD, r = nwg % NXCD, xcd = wgid % NXCD, off = wgid / NXCD; wgid = (xcd < r ? xcd * (q + 1) : r * (q + 1) + (xcd - r) * q) + off; }
        const int nig = WGM * nN, gid = wgid / nig, fm = gid * WGM, gsz = (nM - fm) < WGM ? (nM - fm) : WGM;
        u.pm = fm + ((wgid % nig) % gsz); u.pn = (wgid % nig) / gsz; return true;
    }
    __device__ __forceinline__ void a_ready(const Unit&) const {}
    __device__ __forceinline__ void done(const Unit&) const {}
};

__device__ __forceinline__ unsigned cvt_pk_bf16(float lo, float hi) { unsigned r; asm volatile("v_cvt_pk_bf16_f32 %0, %1, %2" : "=v"(r) : "v"(lo), "v"(hi)); return r; }
typedef float f32x2 __attribute__((ext_vector_type(2)));
template <class Epi, class Sched, bool ALIGN_EPI = false, bool SP2 = false>
__device__ __forceinline__ void gemm_phase(PG8_LAS unsigned char* lds, const Gemm g, const Sched& S, const Epi& E, const int tid_in) {
    const int tid = tid_in, wid = __builtin_amdgcn_readfirstlane(tid >> 6), lane = tid & 63, wr = wid >> 2, wc = wid & 3, fr = lane & 15, fq = lane >> 4;
    const int K = g.K, nt = K / BK;
    unsigned voffA[2], voffB[2];
#pragma unroll
    for (int i = 0; i < 2; ++i) { int R, C; stage_rc(tid * 16 + i * 8192, R, C); const int Rb = Epi::PERM ? ((R & ~31) + perm32(R & 31)) : R;
        const int Ra = Epi::APERM ? ((R & ~63) + 4 * (R & 15) + ((R >> 4) & 3)) : R;
        voffA[i] = (unsigned)(Ra * K + C) * 2u; voffB[i] = (unsigned)(Rb * K + C) * 2u; }
    const size_t kstep = (size_t)(BK * 2);
    const size_t hstep = (size_t)HALF * K * 2;
    const size_t tstep = 2 * hstep;
    const unsigned ldsw = (unsigned)wid * 1024u;
    const int aoff = lds_byte(wr * 64 + fr, fq * 8), boff = lds_byte(wc * 32 + fr, fq * 8);
#define PG8_SA(b, h) (((b) * 2 + (h)) * HTB)
#define PG8_SB(b, h) ((4 + (b) * 2 + (h)) * HTB)
#define PG8_STAGE(bufoff, gbase, voff) do { _Pragma("unroll") for (int _i = 0; _i < 2; ++_i) \
        __builtin_amdgcn_global_load_lds((const unsigned*)((const char*)(gbase) + (voff)[_i]), (PG8_LAS unsigned*)(lds + (bufoff) + ldsw + _i * 8192), 16, 0, 0); } while (0)
#define PG8_LDA(dst, b, h) do { _Pragma("unroll") for (int m = 0; m < 4; ++m) _Pragma("unroll") for (int k = 0; k < 2; ++k) dst[m][k] = *(const PG8_LAS bf16x8*)(lds + PG8_SA(b, h) + aoff + m * 2048 + k * 1024); } while (0)
#define PG8_LDB(dst, b, h) do { _Pragma("unroll") for (int n = 0; n < 2; ++n) _Pragma("unroll") for (int k = 0; k < 2; ++k) dst[n][k] = *(const PG8_LAS bf16x8*)(lds + PG8_SB(b, h) + boff + n * 2048 + k * 1024); } while (0)
#define PG8_MMA(ai, bj, At, Bt) do { __builtin_amdgcn_s_setprio(1); _Pragma("unroll") for (int m = 0; m < 4; ++m) _Pragma("unroll") for (int n = 0; n < 2; ++n) _Pragma("unroll") for (int k = 0; k < 2; ++k) \
        acc[ai][bj][m][n] = __builtin_amdgcn_mfma_f32_16x16x32_bf16(Bt[n][k], At[m][k], acc[ai][bj][m][n], 0, 0, 0); __builtin_amdgcn_s_setprio(0); } while (0)
#define PG8_WAIT_V(n) asm volatile("s_waitcnt vmcnt(" #n ")" ::: "memory")
#define PG8_WAIT_L(n) asm volatile("s_waitcnt lgkmcnt(" #n ")" ::: "memory")
#define PG8_BAR __builtin_amdgcn_s_barrier()
#define PG8_SCHED __builtin_amdgcn_sched_barrier(0)
    Unit cur, nxt; int ui = 0;
    if (!S.next(0, cur)) return;
    f32x4 acc[2][2][4][2];
#pragma unroll
    for (int a = 0; a < 2; ++a)
#pragma unroll
        for (int b = 0; b < 2; ++b)
#pragma unroll
            for (int m = 0; m < 4; ++m)
#pragma unroll
                for (int n = 0; n < 2; ++n) acc[a][b][m][n] = (f32x4){0.f, 0.f, 0.f, 0.f};
    bf16x8 At[4][2], B0[2][2], B1[2][2];
    const char* cA = (const char*)g.A + (size_t)cur.pm * tstep; const char* cB = (const char*)g.Bt + (size_t)cur.pn * tstep;
    S.a_ready(cur);
    if constexpr (SP2) {
        PG8_STAGE(PG8_SB(0, 0), cB, voffB); PG8_STAGE(PG8_SB(0, 1), cB + hstep, voffB); PG8_STAGE(PG8_SA(0, 0), cA, voffA); PG8_STAGE(PG8_SA(0, 1), cA + hstep, voffA);
        if (wr == 1) PG8_BAR;
        PG8_WAIT_V(2); PG8_BAR;
        PG8_STAGE(PG8_SB(1, 0), cB + kstep, voffB); PG8_STAGE(PG8_SA(1, 0), cA + kstep, voffA); PG8_STAGE(PG8_SB(1, 1), cB + hstep + kstep, voffB);
        PG8_WAIT_V(6); PG8_BAR;
    } else {
        PG8_STAGE(PG8_SB(0, 0), cB, voffB); PG8_STAGE(PG8_SA(0, 0), cA, voffA); PG8_STAGE(PG8_SB(0, 1), cB + hstep, voffB); PG8_STAGE(PG8_SA(0, 1), cA + hstep, voffA);
        if (wr == 1) PG8_BAR;
        PG8_WAIT_V(4); PG8_BAR;
        PG8_STAGE(PG8_SB(1, 0), cB + kstep, voffB); PG8_STAGE(PG8_SA(1, 0), cA + kstep, voffA); PG8_STAGE(PG8_SB(1, 1), cB + hstep + kstep, voffB);
        PG8_WAIT_V(6); PG8_BAR;
    }
    for (;;) {
        const bool has_next = S.next(ui + 1, nxt);
        const char* nA = has_next ? (const char*)g.A + (size_t)nxt.pm * tstep : cA; const char* nB = has_next ? (const char*)g.Bt + (size_t)nxt.pn * tstep : cB;
        for (int t = 0; t < nt; t += 2) {
            const bool last = (t == nt - 2);
            const char* a1 = cA + (size_t)(t + 1) * kstep;
            const char* a2 = last ? nA : cA + (size_t)(t + 2) * kstep; const char* b2 = last ? nB : cB + (size_t)(t + 2) * kstep;
            const char* a3 = a2 + kstep; const char* b3 = b2 + kstep;
            if (last && has_next) S.a_ready(nxt);
            if constexpr (SP2) {
            PG8_LDB(B0, 0, 0); PG8_LDB(B1, 0, 1); PG8_SCHED; PG8_LDA(At, 0, 0); PG8_STAGE(PG8_SA(1, 1), a1 + hstep, voffA);
            PG8_WAIT_V(8); PG8_WAIT_L(0); PG8_BAR; PG8_MMA(0, 0, At, B0); PG8_MMA(0, 1, At, B1); PG8_BAR; PG8_SCHED;
            PG8_LDA(At, 0, 1); PG8_STAGE(PG8_SB(0, 0), b2, voffB); PG8_STAGE(PG8_SB(0, 1), b2 + hstep, voffB); PG8_STAGE(PG8_SA(0, 0), a2, voffA);
            PG8_WAIT_V(8); PG8_WAIT_L(0); PG8_BAR; PG8_MMA(1, 0, At, B0); PG8_MMA(1, 1, At, B1); PG8_BAR; PG8_SCHED;
            PG8_LDB(B0, 1, 0); PG8_LDB(B1, 1, 1); PG8_SCHED; PG8_LDA(At, 1, 0); PG8_STAGE(PG8_SA(0, 1), a2 + hstep, voffA);
            PG8_WAIT_V(8); PG8_WAIT_L(0); PG8_BAR; PG8_MMA(0, 0, At, B0); PG8_MMA(0, 1, At, B1); PG8_BAR; PG8_SCHED;
            PG8_LDA(At, 1, 1); PG8_STAGE(PG8_SB(1, 0), b3, voffB); PG8_STAGE(PG8_SB(1, 1), b3 + hstep, voffB); PG8_STAGE(PG8_SA(1, 0), a3, voffA);
            PG8_WAIT_V(8); PG8_WAIT_L(0); PG8_BAR; PG8_MMA(1, 0, At, B0); PG8_MMA(1, 1, At, B1); PG8_BAR; PG8_SCHED;
            } else {
            PG8_LDB(B0, 0, 0); PG8_SCHED; PG8_LDA(At, 0, 0); PG8_STAGE(PG8_SA(1, 1), a1 + hstep, voffA);
            PG8_WAIT_L(8); PG8_BAR; PG8_WAIT_L(0); PG8_MMA(0, 0, At, B0); PG8_BAR; PG8_SCHED;
            PG8_LDB(B1, 0, 1); PG8_STAGE(PG8_SB(0, 0), b2, voffB);
            PG8_BAR; PG8_WAIT_L(0); PG8_MMA(0, 1, At, B1); PG8_BAR;
            PG8_LDA(At, 0, 1); PG8_STAGE(PG8_SA(0, 0), a2, voffA);
            PG8_BAR; PG8_WAIT_L(0); PG8_MMA(1, 0, At, B0); PG8_BAR; PG8_SCHED;
            PG8_STAGE(PG8_SB(0, 1), b2 + hstep, voffB);
            PG8_WAIT_V(6); PG8_BAR; PG8_MMA(1, 1, At, B1); PG8_BAR;
            PG8_LDB(B0, 1, 0); PG8_SCHED; PG8_LDA(At, 1, 0); PG8_STAGE(PG8_SA(0, 1), a2 + hstep, voffA);
            PG8_WAIT_L(8); PG8_BAR; PG8_WAIT_L(0); PG8_MMA(0, 0, At, B0); PG8_BAR; PG8_SCHED;
            PG8_LDB(B1, 1, 1); PG8_STAGE(PG8_SB(1, 0), b3, voffB);
            PG8_BAR; PG8_WAIT_L(0); PG8_MMA(0, 1, At, B1); PG8_BAR;
            PG8_LDA(At, 1, 1); PG8_STAGE(PG8_SA(1, 0), a3, voffA);
            PG8_BAR; PG8_WAIT_L(0); PG8_MMA(1, 0, At, B0); PG8_BAR; PG8_SCHED;
            PG8_STAGE(PG8_SB(1, 1), b3 + hstep, voffB);
            PG8_WAIT_V(6); PG8_BAR; PG8_MMA(1, 1, At, B1); PG8_BAR;
            }
        }
        if constexpr (ALIGN_EPI) { if (wr == 0) PG8_BAR; }
        if constexpr (!Epi::AFTER_DRAIN) { E(acc, cur, wr, wc, fr, fq); S.done(cur); }
        if (!has_next) break;
#pragma unroll
        for (int a = 0; a < 2; ++a)
#pragma unroll
            for (int b = 0; b < 2; ++b)
#pragma unroll
                for (int m = 0; m < 4; ++m)
#pragma unroll
                    for (int n = 0; n < 2; ++n) acc[a][b][m][n] = (f32x4){0.f, 0.f, 0.f, 0.f};
        cur = nxt; cA = nA; cB = nB; ++ui;
        if constexpr (ALIGN_EPI) { if (wr == 1) PG8_BAR; }
    }
    PG8_WAIT_V(0);
    if constexpr (!ALIGN_EPI) { if (wr == 0) PG8_BAR; }
    PG8_BAR;
    if constexpr (Epi::AFTER_DRAIN) { E.fused(acc, cur, wr, wc, fr, fq, lds, wid, lane); S.done(cur); }
#undef PG8_SA
#undef PG8_SB
#undef PG8_STAGE
#undef PG8_LDA
#undef PG8_LDB
#undef PG8_MMA
#undef PG8_WAIT_V
#undef PG8_WAIT_L
#undef PG8_BAR
#undef PG8_SCHED
}
}
#define XB_TMO      128
#define XB_XCNT(j)  (256  + 64 * (j))
#define XB_XSUB(j)  (1280 + 64 * (j))
#define XB_XGEN(j)  (2304 + 64 * (j))
#define XB_TOP      3328
#define XB_TOPGEN   3392
#define XCD_BAR_WORDS 3456
#define XB_SPIN_CAP (1u << 22)
#define LAS __attribute__((address_space(3)))

__device__ __forceinline__ unsigned xb_ld(unsigned* p)              { return __hip_atomic_load(p, __ATOMIC_RELAXED, __HIP_MEMORY_SCOPE_AGENT); }
__device__ __forceinline__ unsigned xb_add(unsigned* p, unsigned v) { return __hip_atomic_fetch_add(p, v, __ATOMIC_RELAXED, __HIP_MEMORY_SCOPE_AGENT); }
__device__ __forceinline__ unsigned xb_xcc_id() { return (unsigned)__builtin_amdgcn_s_getreg((3 << 11) | 20) & 0xFu; }
#define XB_SPIN(cond, bar) do { unsigned _sp = 0; while (cond) { __builtin_amdgcn_s_sleep(1); \
    if ((++_sp & 255u) == 0u) { if (xb_ld(&(bar)[XB_TMO])) break; if (_sp > XB_SPIN_CAP) { atomicAdd(&(bar)[XB_TMO], 1u); break; } } } } while (0)

struct XcdBarrier {
    unsigned* bar; unsigned x;
    volatile LAS unsigned* st;
};

__device__ __forceinline__ XcdBarrier xcd_barrier_post(unsigned* bar, volatile LAS unsigned* st, const bool lead) {
    XcdBarrier b; b.bar = bar; b.x = xb_xcc_id(); b.st = st;
    if (lead) (void)xb_add(&bar[XB_XCNT(b.x)], 1u);
    return b;
}
__device__ __forceinline__ void xcd_barrier_complete(unsigned* bar, unsigned x, unsigned& nloc, unsigned& nx) {
    const unsigned G = gridDim.x * gridDim.y * gridDim.z;
    unsigned sum, cnt, mine, sp = 0u;
    for (;;) {
        sum = 0u; cnt = 0u; mine = 0u;
#pragma unroll
        for (unsigned j = 0; j < 16; ++j) { const unsigned c = xb_ld(&bar[XB_XCNT(j)]); sum += c; cnt += (c > 0u) ? 1u : 0u; mine = (j == x) ? c : mine; }
        if (sum == G) break;
        __builtin_amdgcn_s_sleep(1);
        if ((++sp & 255u) == 0u) { if (xb_ld(&bar[XB_TMO])) break; if (sp > XB_SPIN_CAP) { atomicAdd(&bar[XB_TMO], 1u); break; } }
    }
    nloc = mine > 0u ? mine : 1u; nx = cnt > 0u ? cnt : 1u;
}

__device__ __forceinline__ void xcd_barrier(const XcdBarrier& b, const bool lead) {
    asm volatile("s_waitcnt vmcnt(0)" ::: "memory");
    __syncthreads();
    if (lead) {
        unsigned* bar = b.bar;
        __builtin_amdgcn_s_waitcnt(0);
        unsigned nloc = b.st[0], nx = b.st[1];
        if (nloc == 0u) { xcd_barrier_complete(bar, b.x, nloc, nx); b.st[0] = nloc; b.st[1] = nx; }
        const unsigned old = xb_add(&bar[XB_XSUB(b.x)], 1u);
        const unsigned gen = old / nloc;
        if (old + 1u == (gen + 1u) * nloc) {
            __builtin_amdgcn_fence(__ATOMIC_RELEASE, "agent");
            asm volatile("s_waitcnt vmcnt(0)" ::: "memory");
            const unsigned og = xb_add(&bar[XB_TOP], 1u);
            const unsigned tg = og / nx;
            if (og + 1u == (tg + 1u) * nx) xb_add(&bar[XB_TOPGEN], 1u);
            else XB_SPIN(xb_ld(&bar[XB_TOPGEN]) == tg, bar);
            __builtin_amdgcn_fence(__ATOMIC_ACQUIRE, "agent");
            xb_add(&bar[XB_XGEN(b.x)], 1u);
            asm volatile("s_waitcnt vmcnt(0)" ::: "memory");
        } else {
            XB_SPIN(xb_ld(&bar[XB_XGEN(b.x)]) == gen, bar);
            __builtin_amdgcn_fence(__ATOMIC_ACQUIRE, "agent");
            asm volatile("s_waitcnt vmcnt(0)" ::: "memory");
        }
    }
    __syncthreads();
}

typedef unsigned short bf16_t;
typedef float f32x4 __attribute__((ext_vector_type(4)));
typedef short bf16x8 __attribute__((ext_vector_type(8)));
typedef unsigned u32x4 __attribute__((ext_vector_type(4)));
typedef unsigned u32x2 __attribute__((ext_vector_type(2)));

constexpr int D = 1024, NSEQ = 12, SEQ = 4096, NTOK = NSEQ * SEQ, DEPTH = 2;
constexpr int RWC = 1920, INC = 3456, PCW = 3072, QOFF = 2048, KOFF = 2560, DFF = 2816, UPC = 5632;
constexpr int O_WD = 1536, O_AD = 1664, O_GD = 1792;
constexpr int NT = 512, NWG = 256;
constexpr int LDS_MISC = 161792, LDS_BYTES = LDS_MISC + 1024;
constexpr size_t WS_CTL_BYTES = 65536;
constexpr int GSEQ = 4, GR = GSEQ * SEQ, NGRP = NSEQ / GSEQ;

typedef __bf16 bf16v2_t __attribute__((ext_vector_type(2)));
typedef float f32v2_t __attribute__((ext_vector_type(2)));
__device__ __forceinline__ unsigned cvtpk(float lo, float hi) { f32v2_t f = {lo, hi}; bf16v2_t b = __builtin_convertvector(f, bf16v2_t); return __builtin_bit_cast(unsigned, b); }
__device__ __forceinline__ unsigned short f2bf(float f) { return __builtin_bit_cast(unsigned short, (__bf16)f); }
__device__ __forceinline__ float bf2f(unsigned short b) { return __uint_as_float(((unsigned)b) << 16); }
__device__ __forceinline__ unsigned pk2bf(float lo, float hi) { return cvtpk(lo, hi); }
__device__ __forceinline__ float shx(float v, int m, int lane) { return __int_as_float(__builtin_amdgcn_ds_bpermute((lane ^ m) << 2, __float_as_int(v))); }
__device__ __forceinline__ float shl_(float v, int src) { return __int_as_float(__builtin_amdgcn_ds_bpermute(src << 2, __float_as_int(v))); }
__device__ __forceinline__ float wave_sum(float v, int lane) {
#pragma unroll
    for (int o = 1; o < 64; o <<= 1) v += shx(v, o, lane);
    return v;
}
__device__ __forceinline__ int olane() { unsigned z = 0u; asm volatile("" : "+s"(z)); int l = (int)__builtin_amdgcn_mbcnt_hi(~0u, __builtin_amdgcn_mbcnt_lo(~0u, z)); asm volatile("" : "+v"(l)); return l; }
__device__ __forceinline__ int otid() { return (__builtin_amdgcn_readfirstlane((int)threadIdx.x >> 6) << 6) | olane(); }
__device__ __forceinline__ float sigmoidf_(float x) { return 1.f / (1.f + expf(-x)); }

__device__ __forceinline__ void ph_prep_w(LAS unsigned char* lds, const float* __restrict__ W, int K, int Nsrc, const float* __restrict__ scale, bf16_t* __restrict__ out, int Nout, int mode, float mul) {
    const int tid0 = otid(); const int half = tid0 >> 8, t8 = tid0 & 255, tx = t8 & 31, ty = t8 >> 5;
    LAS float* tile = (LAS float*)(lds + half * 4352);
    const int ntn = Nout / 32, ntiles = ntn * (K / 32);
    for (int vb = blockIdx.x; 2 * vb < ntiles; vb += NWG) {
        const int ti = 2 * vb + half; const bool on = ti < ntiles;
        const int n0 = (ti % ntn) * 32, k0 = (ti / ntn) * 32;
        if (on) for (int i = ty; i < 32; i += 8) {
            const int n = n0 + tx, k = k0 + i; int ns = n; bool valid = true;
            if (mode == 1) { if (n < 1920) ns = n; else if (n < 2048) valid = false; else ns = n - 128; }
            if (mode == 2) ns = n + 2944;
            if (mode == 3) ns = ((n >> 7) & 1) * DFF + (n >> 8) * 128 + (n & 127);
            float v = 0.f;
            if (valid) v = W[(size_t)k * Nsrc + ns] * (scale ? scale[k] : 1.f) * mul;
            if (mode == 1) { if (n >= O_WD && n < O_WD + 128) v *= 2.88539008f; else if (n >= O_GD && n < O_GD + 128) v *= -1.44269504f; }
            tile[i * 33 + tx] = v;
        }
        __syncthreads();
        if (on) for (int i = ty; i < 32; i += 8) { const int n = n0 + i, k = k0 + tx; out[(size_t)n * K + k] = f2bf(tile[tx * 33 + i]); }
        __syncthreads();
    }
}

__device__ __forceinline__ void ph_rms_in(const float* __restrict__ xin, bf16_t* __restrict__ xb, float* __restrict__ rstd, int rows) {
    const int tid0 = otid(); const int lane = tid0 & 63;
    for (int row = blockIdx.x * 8 + (tid0 >> 6); row < rows; row += NWG * 8) {
        const f32x4* xr = (const f32x4*)(xin + (size_t)row * D);
        f32x4 v[4]; float s = 0.f;
#pragma unroll
        for (int j = 0; j < 4; ++j) { v[j] = xr[lane + 64 * j]; s += v[j].x * v[j].x + v[j].y * v[j].y + v[j].z * v[j].z + v[j].w * v[j].w; }
        s = wave_sum(s, lane);
        if (lane < 4) rstd[lane * GR + row] = (lane == 0) ? s : 0.f;
#pragma unroll
        for (int j = 0; j < 4; ++j) {
            const int c = (lane + 64 * j) * 4;
            u32x2 w; w.x = pk2bf(v[j].x, v[j].y); w.y = pk2bf(v[j].z, v[j].w);
            *(u32x2*)(xb + (size_t)row * D + c) = w;
        }
    }
}
__device__ __forceinline__ void ph_rstd(const bf16_t* __restrict__ xb, float* __restrict__ rstd, int rows) {
    const int tid0 = otid(); const int lane = tid0 & 63;
#pragma unroll 4
    for (int row = blockIdx.x * 8 + (tid0 >> 6); row < rows; row += NWG * 8) {
        const u32x4* xr = (const u32x4*)(xb + (size_t)row * D);
        float s = 0.f;
#pragma unroll
        for (int j = 0; j < 2; ++j) {
            const u32x4 q = xr[lane + 64 * j];
            const unsigned w[4] = {q.x, q.y, q.z, q.w};
#pragma unroll
            for (int k = 0; k < 4; ++k) { const float a = __uint_as_float(w[k] << 16), c = __uint_as_float(w[k] & 0xffff0000u); s += a * a + c * c; }
        }
        s = wave_sum(s, lane);
        if (lane == 0) rstd[row] = rsqrtf(s * (1.f / D) + 1e-6f);
    }
}

constexpr int RS_A = 140288, RS_B = 141312;
__device__ __forceinline__ void wg_rstd_from_slots(const float* __restrict__ ssq, int row0, LAS float* dst) {
    const int tid0 = otid();
    if (tid0 < 256) {
        const float* p = ssq + row0 + tid0;
        dst[tid0] = rsqrtf(((p[0] + p[GR]) + (p[2 * GR] + p[3 * GR])) * (1.f / D) + 1e-6f);
    }
    __syncthreads();
}

constexpr int EPI_S = 135168;
struct EpiRow {
    static constexpr bool PERM = true, AFTER_DRAIN = false, APERM = false;
    bf16_t* X; float* outf; float* ssq; LAS unsigned char* lds;
    __device__ __forceinline__ void operator()(const pg8::f32x4 (&acc)[2][2][4][2], const pg8::Unit& u, int wr, int wc, int fr, int fq) const {
        const int row0 = u.pm * 256 + wr * 64 + fr, col0 = u.pn * 256 + wc * 32 + 8 * fq;
        const unsigned off0 = (unsigned)row0 * (unsigned)D + (unsigned)col0;
        pg8::u32x4 r[2][4][2];
#pragma unroll
        for (int ai = 0; ai < 2; ++ai)
#pragma unroll
            for (int m = 0; m < 4; ++m)
#pragma unroll
                for (int bj = 0; bj < 2; ++bj) r[ai][m][bj] = *(const pg8::u32x4*)(X + off0 + (unsigned)((ai * 128 + m * 16) * D + bj * 128));
        float ss[2][4];
#pragma unroll
        for (int ai = 0; ai < 2; ++ai)
#pragma unroll
            for (int m = 0; m < 4; ++m) {
                const unsigned off = off0 + (unsigned)((ai * 128 + m * 16) * D);
                float sq = 0.f;
#pragma unroll
                for (int bj = 0; bj < 2; ++bj) {
                    const pg8::u32x4 rr = r[ai][m][bj];
                    pg8::f32x4 v0 = acc[ai][bj][m][0], v1 = acc[ai][bj][m][1];
                    v0[0] += __uint_as_float(rr.x << 16); v0[1] += __uint_as_float(rr.x & 0xffff0000u); v0[2] += __uint_as_float(rr.y << 16); v0[3] += __uint_as_float(rr.y & 0xffff0000u);
                    v1[0] += __uint_as_float(rr.z << 16); v1[1] += __uint_as_float(rr.z & 0xffff0000u); v1[2] += __uint_as_float(rr.w << 16); v1[3] += __uint_as_float(rr.w & 0xffff0000u);
                    if (outf) { *(pg8::f32x4*)(outf + off + bj * 128) = v0; *(pg8::f32x4*)(outf + off + bj * 128 + 4) = v1; }
                    else {
                        pg8::u32x4 w; w.x = pg8::cvt_pk_bf16(v0[0], v0[1]); w.y = pg8::cvt_pk_bf16(v0[2], v0[3]); w.z = pg8::cvt_pk_bf16(v1[0], v1[1]); w.w = pg8::cvt_pk_bf16(v1[2], v1[3]);
                        *(pg8::u32x4*)(X + off + bj * 128) = w;
                        const unsigned ww[4] = {w.x, w.y, w.z, w.w};
#pragma unroll
                        for (int k = 0; k < 4; ++k) { const float a = __uint_as_float(ww[k] << 16), c = __uint_as_float(ww[k] & 0xffff0000u); sq = fmaf(a, a, fmaf(c, c, sq)); }
                    }
                }
                ss[ai][m] = sq;
            }
        if (!outf) {
            const int lane_ = olane();
            LAS float* LS = (LAS float*)(lds + EPI_S);
#pragma unroll
            for (int ai = 0; ai < 2; ++ai)
#pragma unroll
                for (int m = 0; m < 4; ++m) {
                    float s = ss[ai][m];
                    s += shx(s, 16, lane_); s += shx(s, 32, lane_);
                    if (lane_ < 16) LS[wc * 256 + wr * 64 + ai * 128 + m * 16 + lane_] = s;
                }
            __syncthreads();
            const int tid_ = (wr * 4 + wc) * 64 + lane_;
            if (tid_ < 256) ssq[u.pn * GR + u.pm * 256 + tid_] = (LS[tid_] + LS[256 + tid_]) + (LS[512 + tid_] + LS[768 + tid_]);
        }
    }
};
struct EpiBf {
    static constexpr bool PERM = true, AFTER_DRAIN = false, APERM = false;
    bf16_t* O; const LAS float* rowscale; const LAS float* colscale; int ldc; int pad;
    __device__ __forceinline__ void operator()(const pg8::f32x4 (&acc)[2][2][4][2], const pg8::Unit& u, int wr, int wc, int fr, int fq) const {
        const int row0 = u.pm * 256 + wr * 64 + fr, col0 = u.pn * 256 + wc * 32 + 8 * fq;
        pg8::f32x4 cs[2][2];
#pragma unroll
        for (int bj = 0; bj < 2; ++bj)
#pragma unroll
            for (int n = 0; n < 2; ++n) cs[bj][n] = colscale ? *(const LAS pg8::f32x4*)(colscale + wc * 32 + 8 * fq + bj * 128 + 4 * n) : (pg8::f32x4){1.f, 1.f, 1.f, 1.f};
        float rsc[2][4];
#pragma unroll
        for (int ai = 0; ai < 2; ++ai)
#pragma unroll
            for (int m = 0; m < 4; ++m) rsc[ai][m] = rowscale ? rowscale[wr * 64 + fr + ai * 128 + m * 16] : 1.f;
#pragma unroll
        for (int ai = 0; ai < 2; ++ai)
#pragma unroll
            for (int m = 0; m < 4; ++m) {
                const int row = row0 + ai * 128 + m * 16; const float s = rsc[ai][m];
                bf16_t* rowp = (ldc < 0) ? O + (size_t)(col0 >> 3) * 4096 + row * 8 : O + (size_t)row * ldc + col0;
#pragma unroll
                for (int bj = 0; bj < 2; ++bj) {
                    const pg8::f32x4 v0 = acc[ai][bj][m][0] * s * cs[bj][0], v1 = acc[ai][bj][m][1] * s * cs[bj][1];
                    pg8::u32x4 w; w.x = pg8::cvt_pk_bf16(v0[0], v0[1]); w.y = pg8::cvt_pk_bf16(v0[2], v0[3]); w.z = pg8::cvt_pk_bf16(v1[0], v1[1]); w.w = pg8::cvt_pk_bf16(v1[2], v1[3]);
                    *(pg8::u32x4*)(rowp + (ldc < 0 ? bj * 16 * 4096 : bj * 128)) = w;
                }
            }
    }
};
__device__ __forceinline__ void ph_gemm(LAS unsigned char* lds, const bf16_t* A, const bf16_t* Bt, int M, int N, int K, bf16_t* X, float* outf, float* ssq) {
    pg8::Gemm g{A, Bt, M, N, K, 0}; EpiRow e{X, outf, ssq, lds};
    pg8::StaticOrder S; S.init(M, N, NWG, (int)blockIdx.x);
    pg8::gemm_phase<EpiRow, pg8::StaticOrder, true, true>(lds, g, S, e, otid());
}
__device__ __forceinline__ void ph_gemm_bf(LAS unsigned char* lds, const bf16_t* A, const bf16_t* Bt, int M, int N, int K, bf16_t* O, const LAS float* rowscale, const LAS float* colscale, int ldc) {
    pg8::Gemm g{A, Bt, M, N, K, 0}; EpiBf e{O, rowscale, colscale, ldc, 0};
    pg8::StaticOrder S; S.init(M, N, NWG, (int)blockIdx.x);
    pg8::gemm_phase<EpiBf, pg8::StaticOrder, true, true>(lds, g, S, e, otid());
}

__device__ __forceinline__ void ph_qknorm(bf16_t* __restrict__ P, const float* __restrict__ qg, const float* __restrict__ kg, int rows) {
    const int tid0 = otid(); const int lane = tid0 & 63;
    const float* gp = (lane < 32 ? qg : kg) + 16 * (lane & 3); const float gs = lane < 32 ? 0.125f * 1.44269504f : 1.f;
    float gv[16];
#pragma unroll
    for (int j = 0; j < 16; ++j) gv[j] = gp[j] * gs;
#pragma unroll 2
    for (int row = blockIdx.x * 8 + (tid0 >> 6); row < rows; row += NWG * 8) {
        bf16_t* p = P + (size_t)row * PCW + QOFF + 16 * lane;
        const u32x4 a = *(const u32x4*)p, c = *(const u32x4*)(p + 8);
        const unsigned w[8] = {a.x, a.y, a.z, a.w, c.x, c.y, c.z, c.w};
        float f[16]; float ss = 0.f;
#pragma unroll
        for (int j = 0; j < 8; ++j) { f[2 * j] = __uint_as_float(w[j] << 16); f[2 * j + 1] = __uint_as_float(w[j] & 0xffff0000u); ss += f[2 * j] * f[2 * j] + f[2 * j + 1] * f[2 * j + 1]; }
        ss += __int_as_float(__builtin_amdgcn_update_dpp(0, __float_as_int(ss), 0xB1, 0xf, 0xf, false));
        ss += __int_as_float(__builtin_amdgcn_update_dpp(0, __float_as_int(ss), 0x4E, 0xf, 0xf, false));
        const float sc = rsqrtf(ss * (1.f / 64.f) + 1e-6f);
        u32x4 o0, o1;
        o0.x = pk2bf(f[0] * sc * gv[0], f[1] * sc * gv[1]); o0.y = pk2bf(f[2] * sc * gv[2], f[3] * sc * gv[3]); o0.z = pk2bf(f[4] * sc * gv[4], f[5] * sc * gv[5]); o0.w = pk2bf(f[6] * sc * gv[6], f[7] * sc * gv[7]);
        o1.x = pk2bf(f[8] * sc * gv[8], f[9] * sc * gv[9]); o1.y = pk2bf(f[10] * sc * gv[10], f[11] * sc * gv[11]); o1.z = pk2bf(f[12] * sc * gv[12], f[13] * sc * gv[13]); o1.w = pk2bf(f[14] * sc * gv[14], f[15] * sc * gv[15]);
        *(u32x4*)p = o0; *(u32x4*)(p + 8) = o1;
    }
}
__device__ __forceinline__ void natten_item(const bf16_t* __restrict__ P, const bf16_t* __restrict__ VT, int gr, const LAS float* rpbl, bf16_t* __restrict__ mixb, int item, int lane) {
    const int g = item & 3, r = (item >> 2) & 63, h = (item >> 8) & 7, b = item >> 11;
    const int rs = min(max(r - 4, 0), 56);
    const int kc0 = (g == 0) ? 0 : (g == 1) ? 8 : (g == 2) ? 24 : 32;
    const int n = lane & 15, kq = lane >> 4;
    const int tok0 = b * SEQ;
    const char* qb = (const char*)(P + (size_t)(tok0 + r * 64 + 16 * g) * PCW + QOFF + h * 64);
    const unsigned qofs = (unsigned)(n * PCW + 8 * kq) * 2u;
    const u32x4 q0 = *(const u32x4*)(qb + qofs), q1 = *(const u32x4*)(qb + qofs + 64);
    u32x4 ka[16], kc[16];
    const unsigned kofs = (unsigned)((8 * (n >> 2) + (n & 3)) * PCW + 8 * kq) * 2u;
#pragma unroll
    for (int bi = 0; bi < 16; ++bi) {
        const char* kb = (const char*)(P + (size_t)(tok0 + (rs + (bi >> 1)) * 64 + kc0 + 4 * (bi & 1)) * PCW + KOFF + h * 64);
        ka[bi] = *(const u32x4*)(kb + kofs); kc[bi] = *(const u32x4*)(kb + kofs + 64);
    }
    f32x4 sc_[16];
    const int cq = 16 * g + n, cs = min(max(cq - 8, 0), 48);
#pragma unroll
    for (int bi = 0; bi < 16; ++bi) {
        const int i = bi >> 1, nb = bi & 1;
        f32x4 acc = (f32x4){0.f, 0.f, 0.f, 0.f};
        acc = __builtin_amdgcn_mfma_f32_16x16x32_bf16(__builtin_bit_cast(bf16x8, ka[bi]), __builtin_bit_cast(bf16x8, q0), acc, 0, 0, 0);
        acc = __builtin_amdgcn_mfma_f32_16x16x32_bf16(__builtin_bit_cast(bf16x8, kc[bi]), __builtin_bit_cast(bf16x8, q1), acc, 0, 0, 0);
        const LAS float* brow = rpbl + (rs + i - r + 7) * 32;
#pragma unroll
        for (int e = 0; e < 4; ++e) {
            const int kcn = kc0 + 8 * kq + 4 * nb + e;
            const bool valid = (kcn >= cs) && (kcn < cs + 16);
            const int ci = valid ? min(max(kcn - cq + 15, 0), 30) : 31;
            float bv = brow[ci]; asm volatile("" : "+v"(bv));
            acc[e] += bv;
        }
        sc_[bi] = acc;
    }
    u32x4 vv[8][4];
    {
        const unsigned vofs = (unsigned)(kq * 4096 + n * 8) * 2u;
#pragma unroll
        for (int i = 0; i < 8; ++i)
#pragma unroll
            for (int d = 0; d < 4; ++d) vv[i][d] = *(const u32x4*)((const char*)(VT + (size_t)((tok0 + (rs + i) * 64 + kc0) >> 3) * 4096 + (h * 64 + 16 * d) * 8) + vofs);
    }
    float mx = -1e30f;
#pragma unroll
    for (int q = 0; q < 16; ++q) mx = fmaxf(fmaxf(fmaxf(mx, sc_[q][0]), fmaxf(sc_[q][1], sc_[q][2])), sc_[q][3]);
    mx = fmaxf(mx, shx(mx, 16, lane)); mx = fmaxf(mx, shx(mx, 32, lane));
    float l = 0.f;
#pragma unroll
    for (int q = 0; q < 16; ++q)
#pragma unroll
        for (int e = 0; e < 4; ++e) { const float pe = __builtin_amdgcn_exp2f(sc_[q][e] - mx); sc_[q][e] = pe; l += pe; }
    l += shx(l, 16, lane); l += shx(l, 32, lane);
    f32x4 o[4];
#pragma unroll
    for (int d = 0; d < 4; ++d) o[d] = (f32x4){0.f, 0.f, 0.f, 0.f};
#pragma unroll
    for (int i = 0; i < 8; ++i) {
        u32x4 pa; pa.x = pk2bf(sc_[2 * i][0], sc_[2 * i][1]); pa.y = pk2bf(sc_[2 * i][2], sc_[2 * i][3]); pa.z = pk2bf(sc_[2 * i + 1][0], sc_[2 * i + 1][1]); pa.w = pk2bf(sc_[2 * i + 1][2], sc_[2 * i + 1][3]);
        const bf16x8 pf = __builtin_bit_cast(bf16x8, pa);
#pragma unroll
        for (int d = 0; d < 4; ++d) o[d] = __builtin_amdgcn_mfma_f32_16x16x32_bf16(__builtin_bit_cast(bf16x8, vv[i][d]), pf, o[d], 0, 0, 0);
    }
    const float li = 1.f / l;
    char* ob = (char*)(mixb + (size_t)(tok0 + r * 64 + 16 * g) * 1024 + 512 + h * 64);
    const unsigned oo = (unsigned)(n * 1024 + 4 * kq) * 2u;
#pragma unroll
    for (int d = 0; d < 4; ++d) *(u32x2*)(ob + oo + 32 * d) = (u32x2){pk2bf(o[d][0] * li, o[d][1] * li), pk2bf(o[d][2] * li, o[d][3] * li)};
}
constexpr int L_RPB = 32768;
__device__ __forceinline__ void ph_natten(LAS unsigned char* lds, const bf16_t* P, const bf16_t* VT, int gr, int nseq, const float* rpb, bf16_t* mixb, int wg, int nwg) {
    const int tid0 = otid(); const int lane = tid0 & 63, wave = __builtin_amdgcn_readfirstlane(tid0 >> 6);
    const int h = wg & 7, r = 2 * (wg >> 3) + (wave >> 2), g = wave & 3;
    __syncthreads();
    for (int i = tid0; i < 15 * 32; i += NT) { const int rr = i >> 5, cc = i & 31; ((LAS float*)(lds + L_RPB))[i] = (cc < 31) ? 1.44269504f * rpb[h * 15 * 31 + rr * 31 + cc] : -1e30f; }
    __syncthreads();
    for (int b = 0; b < nseq; ++b) natten_item(P, VT, gr, (const LAS float*)(lds + L_RPB), mixb, (b << 11) | (h << 8) | (r << 2) | g, lane);
}
template <int CTRL> __device__ __forceinline__ float dppf(float x) { return __int_as_float(__builtin_amdgcn_update_dpp(0, __float_as_int(x), CTRL, 0xf, 0xf, true)); }
constexpr int EPI_W = 135168, EPI_R = EPI_W + 4096;
struct EpiFfn {
    static constexpr bool PERM = true, AFTER_DRAIN = false, APERM = true;
    LAS unsigned char* lds;
    bf16_t* act; float* edge; const float* rstd; const float* cw; const float* cb;
    typedef float f32x2v __attribute__((ext_vector_type(2)));
    static __device__ __forceinline__ f32x2v ld2(const float* base, unsigned byteoff) { return *(const f32x2v*)((const char*)base + byteoff); }
    __device__ __forceinline__ void operator()(const pg8::f32x4 (&acc)[2][2][4][2], const pg8::Unit& u, int wr, int wc, int fr_in, int fq_in) const {
        const int lane_ = olane();
        const int fr = lane_ & 15, fq = lane_ >> 4; (void)fr_in; (void)fq_in;
        const unsigned g0 = (unsigned)(u.pn * 128 + wc * 32 + 8 * fq);
        {
            const int tid_ = (wr * 4 + wc) * 64 + lane_;
            LAS float* Wl = (LAS float*)(lds + EPI_W);
#pragma unroll
            for (int q = 0; q < 2; ++q) {
                const int idx = tid_ + 512 * q, k = idx >> 7, j = idx & 127;
                const float* src = ((k & 3) < 3 ? cw + (k & 3) * UPC : cb) + (k >> 2) * DFF + u.pn * 128 + j;
                Wl[idx] = *src;
            }
            __syncthreads();
        }
#pragma unroll
        for (int n = 0; n < 2; ++n) {
#pragma unroll
            for (int ai = 0; ai < 2; ++ai) {
                const int lane2 = olane();
                const int fr = lane2 & 15, fq = lane2 >> 4;
                const unsigned g0 = (unsigned)(u.pn * 128 + wc * 32 + 8 * fq);
                const LAS float* Wl = (const LAS float*)(lds + EPI_W) + (wc * 32 + 8 * fq);
                const bool isedge = (fr == 0) || (fr == 15);
                const unsigned rowbase = (unsigned)(u.pm * 256 + ai * 128 + wr * 64);
                const f32x4 rs = *(const LAS f32x4*)((const LAS float*)(lds + RS_A) + (wr * 64 + ai * 128 + 4 * fr));
                const unsigned eoff = (((rowbase >> 6) * 4 + (unsigned)(fr == 0 ? 0 : 2)) * UPC + g0 + 4 * n) * 4u;
                unsigned outp[4][2];
                const f32x4 wg0 = *(const LAS f32x4*)(Wl + 0 * 128 + 4 * n), wg1 = *(const LAS f32x4*)(Wl + 1 * 128 + 4 * n), wg2 = *(const LAS f32x4*)(Wl + 2 * 128 + 4 * n), bg4 = *(const LAS f32x4*)(Wl + 3 * 128 + 4 * n);
                const f32x4 wv0 = *(const LAS f32x4*)(Wl + 4 * 128 + 4 * n), wv1 = *(const LAS f32x4*)(Wl + 5 * 128 + 4 * n), wv2 = *(const LAS f32x4*)(Wl + 6 * 128 + 4 * n), bv4 = *(const LAS f32x4*)(Wl + 7 * 128 + 4 * n);
#pragma unroll
                for (int e = 0; e < 4; ++e) {
                    float cg[4], cv[4];
                    const float wg0e = wg0[e], wg1e = wg1[e], wg2e = wg2[e], bge = bg4[e], wv0e = wv0[e], wv1e = wv1[e], wv2e = wv2[e], bve = bv4[e];
                    {
                        float x[4];
#pragma unroll
                        for (int m = 0; m < 4; ++m) x[m] = acc[ai][0][m][n][e] * rs[m];
                        if (isedge) { *(float*)((char*)edge + eoff + 4u * e) = (fr == 0) ? x[0] : x[2]; *(float*)((char*)edge + eoff + UPC * 4u + 4u * e) = (fr == 0) ? x[1] : x[3]; }
                        const float up = dppf<0x111>(x[3]), dn = dppf<0x101>(x[0]);
                        cg[0] = fmaf(wg0e, up, fmaf(wg1e, x[0], fmaf(wg2e, x[1], bge))); cg[1] = fmaf(wg0e, x[0], fmaf(wg1e, x[1], fmaf(wg2e, x[2], bge)));
                        cg[2] = fmaf(wg0e, x[1], fmaf(wg1e, x[2], fmaf(wg2e, x[3], bge))); cg[3] = fmaf(wg0e, x[2], fmaf(wg1e, x[3], fmaf(wg2e, dn, bge)));
                    }
                    {
                        float x[4];
#pragma unroll
                        for (int m = 0; m < 4; ++m) x[m] = acc[ai][1][m][n][e] * rs[m];
                        if (isedge) { *(float*)((char*)edge + eoff + DFF * 4u + 4u * e) = (fr == 0) ? x[0] : x[2]; *(float*)((char*)edge + eoff + (UPC + DFF) * 4u + 4u * e) = (fr == 0) ? x[1] : x[3]; }
                        const float up = dppf<0x111>(x[3]), dn = dppf<0x101>(x[0]);
                        cv[0] = fmaf(wv0e, up, fmaf(wv1e, x[0], fmaf(wv2e, x[1], bve))); cv[1] = fmaf(wv0e, x[0], fmaf(wv1e, x[1], fmaf(wv2e, x[2], bve)));
                        cv[2] = fmaf(wv0e, x[1], fmaf(wv1e, x[2], fmaf(wv2e, x[3], bve))); cv[3] = fmaf(wv0e, x[2], fmaf(wv1e, x[3], fmaf(wv2e, dn, bve)));
                    }
#pragma unroll
                    for (int m = 0; m < 4; ++m) {
                        const float o = (cg[m] * cv[m]) * __builtin_amdgcn_rcpf(1.f + __builtin_amdgcn_exp2f(-1.44269504f * cg[m]));
                        outp[m][e >> 1] = (e & 1) ? cvtpk(__uint_as_float(outp[m][e >> 1]), o) : __float_as_uint(o);
                    }
                    __builtin_amdgcn_sched_barrier(0);
                }
#pragma unroll
                for (int m = 0; m < 4; ++m) {
                    const unsigned rib = 4 * (unsigned)fr + m;
                    if (rib != 0 && rib != 63) *(u32x2*)((char*)act + ((rowbase + rib) * DFF + g0 + 4 * n) * 2u) = (u32x2){outp[m][0], outp[m][1]};
                }
                asm volatile("" ::: "memory");
            }
        }
    }
};
__device__ __forceinline__ void ph_gemm_ffn(LAS unsigned char* lds, const bf16_t* A, const bf16_t* Bt, int M, bf16_t* act, float* edge, const float* rstd, const float* cw, const float* cb) {
    pg8::Gemm g{A, Bt, M, UPC, D, 0}; EpiFfn e{lds, act, edge, rstd, cw, cb};
    pg8::StaticOrder S; S.init(M, UPC, NWG, (int)blockIdx.x);
    pg8::gemm_phase<EpiFfn, pg8::StaticOrder, true, true>(lds, g, S, e, otid());
}
__device__ __forceinline__ void ph_ffn_fix(const float* __restrict__ edge, const float* __restrict__ cw, const float* __restrict__ cb, bf16_t* __restrict__ act, int rows) {
    typedef float f2 __attribute__((ext_vector_type(2)));
    const int tid0 = otid(); const int nb = rows / 64;
    constexpr int CP = DFF / 2;
    const int total = 2 * nb * CP;
#pragma unroll 3
    for (int p = blockIdx.x * NT + tid0; p < total; p += NWG * NT) {
        const int it = p / CP, c = 2 * (p - it * CP);
        const int blk = it >> 1, last = it & 1;
        const int row = blk * 64 + (last ? 63 : 0), t = row & (SEQ - 1);
        const float* cur = edge + ((size_t)blk * 4 + (last ? 3 : 0)) * UPC;
        const bool hp = last ? true : (t > 0), hn = last ? (t < SEQ - 1) : true;
        const float* prv = last ? edge + ((size_t)blk * 4 + 2) * UPC : edge + ((size_t)(hp ? blk - 1 : blk) * 4 + 3) * UPC;
        const float* nxt = last ? edge + ((size_t)(hn ? blk + 1 : blk) * 4 + 0) * UPC : edge + ((size_t)blk * 4 + 1) * UPC;
        const f2 w0g = *(const f2*)(cw + c), w1g = *(const f2*)(cw + UPC + c), w2g = *(const f2*)(cw + 2 * UPC + c), bg = *(const f2*)(cb + c);
        const f2 w0v = *(const f2*)(cw + DFF + c), w1v = *(const f2*)(cw + UPC + DFF + c), w2v = *(const f2*)(cw + 2 * UPC + DFF + c), bv = *(const f2*)(cb + DFF + c);
        const f2 cg = *(const f2*)(cur + c), cv = *(const f2*)(cur + DFF + c);
        f2 pg = *(const f2*)(prv + c), pv = *(const f2*)(prv + DFF + c), ng = *(const f2*)(nxt + c), nv = *(const f2*)(nxt + DFF + c);
        if (!hp) { pg = (f2){0.f, 0.f}; pv = pg; }
        if (!hn) { ng = (f2){0.f, 0.f}; nv = ng; }
        const f2 g = w1g * cg + bg + w0g * pg + w2g * ng, v = w1v * cv + bv + w0v * pv + w2v * nv;
        const float o0 = g[0] * sigmoidf_(g[0]) * v[0], o1 = g[1] * sigmoidf_(g[1]) * v[1];
        *(unsigned*)(act + (size_t)row * DFF + c) = cvtpk(o0, o1);
    }
}

constexpr int NSEG = 4, SEGTOK = SEQ / NSEG;
constexpr int OP_AP = 0, OP_RP = 2048, OP_MX2 = 4096, OP_MD = 5120, OP_MY = 6144, OP_GP = 7168, OP_VT = 11264, OP_GC = 13312, OP_SIZE = 13568;
constexpr int LS_OPS = 0, LS_LABT = 8 * OP_SIZE, LS_MU = LS_LABT + 8 * 1024, LS_CST = LS_MU + 3 * 7 * 64 * 4, LS_WL = LS_CST + 6 * 64 * 4, LS_EOF = LS_WL + 36 * 1024, LS_END = LS_EOF + 1024;
constexpr int WL_DEC = 0, WL_AAA = 8 * 1024, WL_VU = 16 * 1024, WL_G = 20 * 1024;
static_assert(LS_END <= LDS_MISC, "scan unit LDS map");

template <int CTRL> __device__ __forceinline__ float dpp_mov(float x) { return __int_as_float(__builtin_amdgcn_update_dpp(0, __float_as_int(x), CTRL, 0xf, 0xf, false)); }
template <int CTRL> __device__ __forceinline__ unsigned dpp_keep(unsigned old, unsigned src) { return (unsigned)__builtin_amdgcn_update_dpp((int)old, (int)src, CTRL, 0xf, 0xf, false); }
__device__ __forceinline__ float fsig(float z) { return __builtin_amdgcn_rcpf(1.f + __builtin_amdgcn_exp2f(z)); }
__device__ __forceinline__ float ftanh(float z) { return 1.f - 2.f * __builtin_amdgcn_rcpf(1.f + __builtin_amdgcn_exp2f(z)); }
__device__ __forceinline__ f32v2_t bfpair(unsigned u) { return (f32v2_t){__uint_as_float(u << 16), __uint_as_float(u & 0xffff0000u)}; }
__device__ __forceinline__ u32x4 pack8(const float* v) { u32x4 r; r.x = cvtpk(v[0], v[1]); r.y = cvtpk(v[2], v[3]); r.z = cvtpk(v[4], v[5]); r.w = cvtpk(v[6], v[7]); return r; }

struct ScanW {
    const float *mu, *w0, *a0, *v0, *kk_, *ka, *rk;
    const bf16_t *WdecT, *WaaaT, *WgT, *WvuT;
};

template <int NKS> __device__ __forceinline__ void lora_mm(const LAS unsigned char* wl, const u32x4 (&xf)[NKS], float (&out)[16]) {
#pragma unroll
    for (int nb = 0; nb < 4; ++nb) {
        f32x4 acc = (f32x4){0.f, 0.f, 0.f, 0.f};
#pragma unroll
        for (int ks = 0; ks < NKS; ++ks)
            acc = __builtin_amdgcn_mfma_f32_16x16x32_bf16(*(const LAS bf16x8*)(wl + (nb * NKS + ks) * 1024), __builtin_bit_cast(bf16x8, xf[ks]), acc, 0, 0, 0);
        out[4 * nb + 0] = acc[0]; out[4 * nb + 1] = acc[1]; out[4 * nb + 2] = acc[2]; out[4 * nb + 3] = acc[3];
    }
}

template <int V> struct IC { static constexpr int value = V; };
template <int N> __device__ __forceinline__ unsigned edge_lo(unsigned v) { if constexpr (N == 0) return v; else return (unsigned)__builtin_amdgcn_update_dpp(0, (int)v, 0x100 + N, 0xf, 0xf, true); }
template <int N> __device__ __forceinline__ unsigned edge_hi(unsigned v) { if constexpr (N == 0) return v; else return (unsigned)__builtin_amdgcn_update_dpp(0, (int)v, 0x110 + N, 0xf, 0xf, true); }
__device__ __forceinline__ void scan_unit(LAS unsigned char* lds, int unit, int layer, const bf16_t* __restrict__ P, const ScanW& w,
                                          bf16_t* __restrict__ ybuf, bf16_t* __restrict__ gbuf, bf16_t* __restrict__ mixb, bf16_t* __restrict__ vfirst, float* __restrict__ sbon,
                                          bf16_t* __restrict__ yaug, float* __restrict__ segst) {
    const int tid = otid(), lane = tid & 63, wave = __builtin_amdgcn_readfirstlane(tid >> 6);
    const int seg = unit & (NSEG - 1), chain = unit / NSEG;
    const int h = chain & 7, dir = (chain >> 3) & 1, b = chain >> 4;
    const int tokbase = b * SEQ;
    const int t = lane & 15, kq = lane >> 4;
    auto segcol = [&](int s_) { return s_ < 3 ? s_ * 512 + h * 64 : s_ == 3 ? O_WD + dir * 64 : s_ == 4 ? O_AD + dir * 64 : O_GD + (s_ - 5) * 64; };
    for (int i = tid; i < 3 * 7 * 64; i += NT) {
        const int m = i / 448, r = i % 448, sg = r >> 6, c = r & 63; const int col = segcol(sg) + c;
        ((LAS float*)(lds + LS_MU))[i] = (m < 2) ? w.mu[(m ^ dir) * RWC + col] : 1.f - w.mu[col] - w.mu[RWC + col];
    }
    if (tid < 384) {
        const int which = tid >> 6, ch = h * 64 + (tid & 63);
        const float v = (which == 0) ? w.kk_[ch] : (which == 1) ? w.ka[ch] : (which == 2) ? w.rk[ch] : (which == 3) ? w.w0[dir * 512 + ch] : (which == 4) ? w.a0[dir * 512 + ch] : ((layer > 0) ? w.v0[ch] : 0.f);
        ((LAS float*)(lds + LS_CST))[tid] = (which >= 3) ? -1.44269504f * v : v;
    }
    for (int i = tid; i < 36 * 64; i += NT) {
        const int f = i >> 6, n = i & 15, q = (i >> 4) & 3;
        const bf16_t* src; int Kw, nb, ks;
        if (f < 8)       { src = w.WdecT + (size_t)dir * 512 * 64; Kw = 64; nb = f >> 1; ks = f & 1; }
        else if (f < 16) { src = w.WaaaT + (size_t)dir * 512 * 64; Kw = 64; nb = (f - 8) >> 1; ks = f & 1; }
        else if (f < 20) { src = w.WvuT; Kw = 32; nb = f - 16; ks = 0; }
        else             { src = w.WgT; Kw = 128; nb = (f - 20) >> 2; ks = (f - 20) & 3; }
        const bf16_t* p = src + (h * 64 + 16 * nb + n) * Kw + 32 * ks + 4 * q;
        const u32x2 lo = *(const u32x2*)p, hi = *(const u32x2*)(p + 16);
        *(LAS u32x4*)(lds + LS_WL + i * 16) = (u32x4){lo.x, lo.y, hi.x, hi.y};
    }
    __syncthreads();

    f32x4 St[4];
    const bool augw = wave >= 4; const int colw = 16 * (wave & 3) + t;
#pragma unroll
    for (int jb = 0; jb < 4; ++jb)
#pragma unroll
        for (int e = 0; e < 4; ++e) St[jb][e] = (augw && (16 * jb + 4 * kq + e) == colw) ? 1.f : 0.f;

    const char* Pc = (const char*)P;
    u32x2 rc[7][4], fz[3][2], EL[2], EH[2];
    const int colLo = dir ? 1984 : 1952, colHi = dir ? 1952 : 1984;
    auto piece_col = [&](int p, int foldcol) { const int sg = p >> 2, g = p & 3; return (p < 28 ? segcol(sg) + 16 * g : foldcol + 16 * (p & 1)) * 2 + 8 * kq; };
    if (tid < 64) *(LAS u32x4*)(lds + LS_EOF + tid * 16) = (u32x4){(unsigned)piece_col(t, colLo), (unsigned)piece_col((t + 16) & 31, colLo), (unsigned)piece_col(15 - t, colHi), (unsigned)piece_col(31 - t, colHi)};
    auto issue_loads = [&](int it_) {
        const int gb = seg * (SEGTOK / 16) + it_ * 8 + wave;
        const int st = 16 * gb + t;
        const int tok = dir ? (SEQ - 1 - st) : st;
        const unsigned ro = (unsigned)(tokbase + tok) * (unsigned)(PCW * 2) + 8u * kq;
        const int sL = 16 * gb - 1, sH = 16 * gb + 16;
        const bool vL_ = gb > 0, vH_ = gb < SEQ / 16 - 1;
        const int tL = vL_ ? (dir ? (SEQ - 1 - sL) : sL) : 0, tH = vH_ ? (dir ? (SEQ - 1 - sH) : sH) : 0;
        const unsigned rl = (unsigned)(tokbase + tL) * (unsigned)(PCW * 2), rh = (unsigned)(tokbase + tH) * (unsigned)(PCW * 2);
#pragma unroll
        for (int sg = 0; sg < 7; ++sg) {
            if (sg >= 5 && (it_ & 1)) continue;
            const int col = segcol(sg);
#pragma unroll
            for (int g = 0; g < 4; ++g) rc[sg][g] = *(const u32x2*)(Pc + ro + col * 2 + 32 * g);
        }
        const u32x4 eo4 = *(const LAS u32x4*)(lds + LS_EOF + lane * 16);
        const unsigned zo_ = 2016u * 2u + 8u * (unsigned)(lane & 3);
        EL[0] = *(const u32x2*)(Pc + (rl + (vL_ ? eo4.x : zo_))); EL[1] = *(const u32x2*)(Pc + (rl + (vL_ ? eo4.y : zo_)));
        EH[0] = *(const u32x2*)(Pc + (rh + (vH_ ? eo4.z : zo_))); EH[1] = *(const u32x2*)(Pc + (rh + (vH_ ? eo4.w : zo_)));
        if (layer > 0) {
#pragma unroll
            for (int g = 0; g < 2; ++g) { fz[0][g] = *(const u32x2*)(Pc + ro + 1920 * 2 + 32 * g); fz[1][g] = *(const u32x2*)(Pc + ro + colLo * 2 + 32 * g); fz[2][g] = *(const u32x2*)(Pc + ro + colHi * 2 + 32 * g); }
        }
    };
#pragma unroll
    for (int sg = 0; sg < 7; ++sg)
#pragma unroll
        for (int g = 0; g < 4; ++g) rc[sg][g] = (u32x2){0u, 0u};
#pragma unroll
    for (int g = 0; g < 2; ++g) { fz[0][g] = fz[1][g] = fz[2][g] = (u32x2){0u, 0u}; }
    __syncthreads();
    issue_loads(0);
    for (int it = 0; it < SEGTOK / 128; ++it) {
        {
            if (wave >= 4) __builtin_amdgcn_s_sleep(3);
            int lane_o = lane; asm volatile("" : "+v"(lane_o));
            const int t = lane_o & 15, kq = lane_o >> 4;
            const LAS unsigned char* WL = lds + LS_WL + lane_o * 16;
            const LAS float* MU = (const LAS float*)(lds + LS_MU) + 4 * kq;
            const LAS float* CST = (const LAS float*)(lds + LS_CST) + 4 * kq;
            LAS unsigned char* myop = lds + LS_OPS + wave * OP_SIZE;
            LAS float* labt = (LAS float*)(lds + LS_LABT + wave * 1024);
            const int lane = lane_o;
            const int gb = seg * (SEGTOK / 16) + it * 8 + wave;
            const int st = 16 * gb + t;
            const int tok = dir ? (SEQ - 1 - st) : st;
            const unsigned grow = (unsigned)(tokbase + tok);
            u32x2 vf[4];
#pragma unroll
            for (int g = 0; g < 4; ++g) vf[g] = (u32x2){0u, 0u};
            if (layer > 0) {
#pragma unroll
                for (int g = 0; g < 4; ++g) vf[g] = *(const u32x2*)((const char*)vfirst + (grow * 1024u + (unsigned)((h * 64 + 16 * g + 4 * kq) * 2)));
            }
            auto seg_mix = [&](auto sgc, float (&out)[16]) {
                constexpr int sg = decltype(sgc)::value;
                auto grp = [&](auto gc) {
                    constexpr int g = decltype(gc)::value, p = 4 * sg + g, n = p & 15, j = p >> 4;
                    const u32x2 c = rc[sg][g];
                    const unsigned elx = edge_lo<n>(EL[j].x), ely = edge_lo<n>(EL[j].y), ehx = edge_hi<n>(EH[j].x), ehy = edge_hi<n>(EH[j].y);
                    const f32x4 ml = *(const LAS f32x4*)(MU + sg * 64 + 16 * g), mh = *(const LAS f32x4*)(MU + 448 + sg * 64 + 16 * g), m0 = *(const LAS f32x4*)(MU + 896 + sg * 64 + 16 * g);
                    {
                        const f32v2_t cc = bfpair(c.x), lo = bfpair(dpp_keep<0x111>(elx, c.x)), hi = bfpair(dpp_keep<0x101>(ehx, c.x));
                        const f32v2_t v = (f32v2_t){m0[0], m0[1]} * cc + (f32v2_t){ml[0], ml[1]} * lo + (f32v2_t){mh[0], mh[1]} * hi;
                        out[4 * g + 0] = v[0]; out[4 * g + 1] = v[1];
                    }
                    {
                        const f32v2_t cc = bfpair(c.y), lo = bfpair(dpp_keep<0x111>(ely, c.y)), hi = bfpair(dpp_keep<0x101>(ehy, c.y));
                        const f32v2_t v = (f32v2_t){m0[2], m0[3]} * cc + (f32v2_t){ml[2], ml[3]} * lo + (f32v2_t){mh[2], mh[3]} * hi;
                        out[4 * g + 2] = v[0]; out[4 * g + 3] = v[1];
                    }
                };
                grp(IC<0>{}); grp(IC<1>{}); grp(IC<2>{}); grp(IC<3>{});
            };
            auto cst16 = [&](int which, float (&out)[16]) {
#pragma unroll
                for (int g = 0; g < 4; ++g) { const f32x4 v = *(const LAS f32x4*)(CST + which * 64 + 16 * g); out[4 * g] = v[0]; out[4 * g + 1] = v[1]; out[4 * g + 2] = v[2]; out[4 * g + 3] = v[3]; }
            };
            u32x4 selE, selO;
            {
                const unsigned wv = (kq == (t >> 2)) ? (0x3F80u << (16 * (t & 1))) : 0u;
                const unsigned w0_ = (t & 2) ? 0u : wv, w1_ = (t & 2) ? wv : 0u;
                selE = (u32x4){w0_, w1_, 0u, 0u}; selO = (u32x4){0u, 0u, w0_, w1_};
            }
            if ((it & 1) == 0) {
                float g0[16], g1[16]; seg_mix(IC<5>{}, g0); seg_mix(IC<6>{}, g1);
#pragma unroll
                for (int i = 0; i < 16; ++i) { g0[i] = fsig(g0[i]); g1[i] = fsig(g1[i]); }
                u32x4 xf[4]; xf[0] = pack8(g0); xf[1] = pack8(g0 + 8); xf[2] = pack8(g1); xf[3] = pack8(g1 + 8);
                float go[16]; lora_mm<4>(WL + WL_G, xf, go);
#pragma unroll
                for (int g = 0; g < 4; ++g) *(u32x2*)((char*)gbuf + (grow * 1024u + (unsigned)((h * 64 + 16 * g + 4 * kq) * 2))) = (u32x2){cvtpk(go[4 * g], go[4 * g + 1]), cvtpk(go[4 * g + 2], go[4 * g + 3])};
            }
            float kv[16], kk[16];
            seg_mix(IC<1>{}, kv);
            {
                float c_[16]; cst16(0, c_);
                float ss = 0.f;
#pragma unroll
                for (int i = 0; i < 16; ++i) { kk[i] = kv[i] * c_[i]; ss += kk[i] * kk[i]; }
                ss += shx(ss, 16, lane); ss += shx(ss, 32, lane);
                const float rn = __builtin_amdgcn_rsqf(fmaxf(ss, 1e-12f));
#pragma unroll
                for (int i = 0; i < 16; ++i) kk[i] *= rn;
            }
            float kd[16], bb[16];
            {
                float ain[16]; seg_mix(IC<4>{}, ain);
                u32x4 xf[2]; xf[0] = pack8(ain); xf[1] = pack8(ain + 8);
                float xa[16]; lora_mm<2>(WL + WL_AAA, xf, xa);
                float a0c[16], kac[16]; cst16(4, a0c); cst16(1, kac);
#pragma unroll
                for (int i = 0; i < 16; ++i) { const float a = fsig(xa[i] + a0c[i]); kd[i] = kv[i] * (1.f + (a - 1.f) * kac[i]); bb[i] = kk[i] * a; }
            }
            float rv[16];
            seg_mix(IC<0>{}, rv);
            {
                float rkc[16]; cst16(2, rkc);
                float bon = 0.f;
#pragma unroll
                for (int i = 0; i < 16; ++i) bon += rv[i] * kd[i] * rkc[i];
                bon += shx(bon, 16, lane); bon += shx(bon, 32, lane);
                if (kq == 0) *(float*)((char*)sbon + (grow * 64u + (unsigned)((dir * 8 + h) * 4))) = bon;
            }
            {
                float vv[16]; seg_mix(IC<2>{}, vv);
                if (layer > 0) {
                    float hid[8];
                    {
                        const u32x2 z0 = fz[0][0], cl = fz[1][0], ch_ = fz[2][0];
                        const f32v2_t s0 = bfpair(z0.x) + bfpair(dpp_keep<0x111>(edge_lo<12>(EL[1].x), cl.x)) + bfpair(dpp_keep<0x101>(edge_hi<12>(EH[1].x), ch_.x));
                        const f32v2_t s1 = bfpair(z0.y) + bfpair(dpp_keep<0x111>(edge_lo<12>(EL[1].y), cl.y)) + bfpair(dpp_keep<0x101>(edge_hi<12>(EH[1].y), ch_.y));
                        hid[0] = s0[0]; hid[1] = s0[1]; hid[2] = s1[0]; hid[3] = s1[1];
                    }
                    {
                        const u32x2 z0 = fz[0][1], cl = fz[1][1], ch_ = fz[2][1];
                        const f32v2_t s0 = bfpair(z0.x) + bfpair(dpp_keep<0x111>(edge_lo<13>(EL[1].x), cl.x)) + bfpair(dpp_keep<0x101>(edge_hi<13>(EH[1].x), ch_.x));
                        const f32v2_t s1 = bfpair(z0.y) + bfpair(dpp_keep<0x111>(edge_lo<13>(EL[1].y), cl.y)) + bfpair(dpp_keep<0x101>(edge_hi<13>(EH[1].y), ch_.y));
                        hid[4] = s0[0]; hid[5] = s0[1]; hid[6] = s1[0]; hid[7] = s1[1];
                    }
                    u32x4 xf[1]; xf[0] = pack8(hid);
                    float xm[16]; lora_mm<1>(WL + WL_VU, xf, xm);
                    float v0c[16]; cst16(5, v0c);
#pragma unroll
                    for (int g = 0; g < 4; ++g) {
                        const f32v2_t f0 = bfpair(vf[g].x), f1 = bfpair(vf[g].y);
                        vv[4 * g + 0] += (f0[0] - vv[4 * g + 0]) * fsig(xm[4 * g + 0] + v0c[4 * g + 0]); vv[4 * g + 1] += (f0[1] - vv[4 * g + 1]) * fsig(xm[4 * g + 1] + v0c[4 * g + 1]);
                        vv[4 * g + 2] += (f1[0] - vv[4 * g + 2]) * fsig(xm[4 * g + 2] + v0c[4 * g + 2]); vv[4 * g + 3] += (f1[1] - vv[4 * g + 3]) * fsig(xm[4 * g + 3] + v0c[4 * g + 3]);
                    }
                }
                u32x4 vp[2]; vp[0] = pack8(vv); vp[1] = pack8(vv + 8);
                if (dir == 1) {
                    const unsigned pv[8] = {vp[0].x, vp[0].y, vp[0].z, vp[0].w, vp[1].x, vp[1].y, vp[1].z, vp[1].w};
#pragma unroll
                    for (int g = 0; g < 4; ++g) {
                        const u32x2 q = (u32x2){pv[2 * g], pv[2 * g + 1]};
                        *(u32x2*)((char*)mixb + (grow * 2048u + (unsigned)((h * 64 + 16 * g + 4 * kq) * 2))) = q;
                        if (layer == 0) *(u32x2*)((char*)vfirst + (grow * 1024u + (unsigned)((h * 64 + 16 * g + 4 * kq) * 2))) = q;
                    }
                }
#pragma unroll
                for (int ib = 0; ib < 4; ++ib) {
                    const f32x4 z = (f32x4){0.f, 0.f, 0.f, 0.f};
                    const f32x4 d = __builtin_amdgcn_mfma_f32_16x16x32_bf16(__builtin_bit_cast(bf16x8, vp[ib >> 1]), __builtin_bit_cast(bf16x8, (ib & 1) ? selO : selE), z, 0, 0, 0);
                    *(LAS u32x2*)(myop + OP_VT + (ib * 64 + lane) * 8) = (u32x2){cvtpk(d[0], d[1]), cvtpk(d[2], d[3])};
                }
            }
            u32x4 apf[2], rpf[2], btf[2], ktf[2], bgf[2], kgf[2];
            {
                float lw[16];
                {
                    float win[16]; seg_mix(IC<3>{}, win);
#pragma unroll
                    for (int i = 0; i < 16; ++i) win[i] = ftanh(win[i]);
                    u32x4 xf[2]; xf[0] = pack8(win); xf[1] = pack8(win + 8);
                    float xw[16]; lora_mm<2>(WL + WL_DEC, xf, xw);
                    float w0c[16]; cst16(3, w0c);
#pragma unroll
                    for (int i = 0; i < 16; ++i) lw[i] = -0.87503878f * fsig(xw[i] + w0c[i]);
                }
                float at[16], rt[16], bt[16], kt[16], bg[16], kg[16], gC[16];
#pragma unroll
                for (int i = 0; i < 16; ++i) {
                    float lam = lw[i];
                    lam += dpp_mov<0x111>(lam); lam += dpp_mov<0x112>(lam); lam += dpp_mov<0x114>(lam); lam += dpp_mov<0x118>(lam);
                    const float e3 = __builtin_amdgcn_exp2f(lam), e2 = __builtin_amdgcn_exp2f(-lam);
                    const float g = shl_(e3, (lane & 48) | 15);
                    const float e1 = __int_as_float(__builtin_amdgcn_update_dpp(0x3f800000, __float_as_int(e3), 0x111, 0xf, 0xf, false));
                    const float ge = g * e2;
                    gC[i] = g; at[i] = kk[i] * e1; rt[i] = rv[i] * e3; bt[i] = bb[i] * e2; kt[i] = kd[i] * e2; bg[i] = -bb[i] * ge; kg[i] = kd[i] * ge;
                }
                apf[0] = pack8(at); apf[1] = pack8(at + 8); rpf[0] = pack8(rt); rpf[1] = pack8(rt + 8); btf[0] = pack8(bt); btf[1] = pack8(bt + 8);
                ktf[0] = pack8(kt); ktf[1] = pack8(kt + 8); bgf[0] = pack8(bg); bgf[1] = pack8(bg + 8); kgf[0] = pack8(kg); kgf[1] = pack8(kg + 8);
                if (t == 0) {
#pragma unroll
                    for (int g = 0; g < 4; ++g) *(LAS f32x4*)(myop + OP_GC + (kq * 16 + 4 * g) * 4) = (f32x4){gC[4 * g], gC[4 * g + 1], gC[4 * g + 2], gC[4 * g + 3]};
                }
            }
            *(LAS u32x4*)(myop + OP_AP + lane * 16) = apf[0]; *(LAS u32x4*)(myop + OP_AP + 1024 + lane * 16) = apf[1];
            *(LAS u32x4*)(myop + OP_RP + lane * 16) = rpf[0]; *(LAS u32x4*)(myop + OP_RP + 1024 + lane * 16) = rpf[1];
            {
                f32x4 lab = (f32x4){0.f, 0.f, 0.f, 0.f}, lak = lab, lrb = lab, lrk = lab;
#pragma unroll
                for (int ks = 0; ks < 2; ++ks) {
                    lab = __builtin_amdgcn_mfma_f32_16x16x32_bf16(__builtin_bit_cast(bf16x8, btf[ks]), __builtin_bit_cast(bf16x8, apf[ks]), lab, 0, 0, 0);
                    lak = __builtin_amdgcn_mfma_f32_16x16x32_bf16(__builtin_bit_cast(bf16x8, ktf[ks]), __builtin_bit_cast(bf16x8, apf[ks]), lak, 0, 0, 0);
                    lrb = __builtin_amdgcn_mfma_f32_16x16x32_bf16(__builtin_bit_cast(bf16x8, btf[ks]), __builtin_bit_cast(bf16x8, rpf[ks]), lrb, 0, 0, 0);
                    lrk = __builtin_amdgcn_mfma_f32_16x16x32_bf16(__builtin_bit_cast(bf16x8, ktf[ks]), __builtin_bit_cast(bf16x8, rpf[ks]), lrk, 0, 0, 0);
                }
#pragma unroll
                for (int e = 0; e < 4; ++e) {
                    const int s = 4 * kq + e;
                    const bool lo = s < t, le = s <= t;
                    lab[e] = lo ? lab[e] : 0.f; lak[e] = lo ? lak[e] : 0.f; lrb[e] = le ? -lrb[e] : 0.f; lrk[e] = le ? lrk[e] : 0.f;
                    labt[s * 16 + t] = lab[e];
                }
                u32x4 mx; mx.x = 0u; mx.y = 0u; mx.z = cvtpk(lak[0], lak[1]); mx.w = cvtpk(lak[2], lak[3]);
                u32x4 my; my.x = cvtpk(lrb[0], lrb[1]); my.y = cvtpk(lrb[2], lrb[3]); my.z = cvtpk(lrk[0], lrk[1]); my.w = cvtpk(lrk[2], lrk[3]);
                *(LAS u32x4*)(myop + OP_MX2 + lane * 16) = mx; *(LAS u32x4*)(myop + OP_MY + lane * 16) = my;
            }
#pragma unroll
            for (int jb = 0; jb < 4; ++jb) {
                const f32x4 z = (f32x4){0.f, 0.f, 0.f, 0.f};
                const bf16x8 sel = __builtin_bit_cast(bf16x8, (jb & 1) ? selO : selE);
                const f32x4 d0 = __builtin_amdgcn_mfma_f32_16x16x32_bf16(__builtin_bit_cast(bf16x8, bgf[jb >> 1]), sel, z, 0, 0, 0);
                const f32x4 d1 = __builtin_amdgcn_mfma_f32_16x16x32_bf16(__builtin_bit_cast(bf16x8, kgf[jb >> 1]), sel, z, 0, 0, 0);
                u32x4 gp; gp.x = cvtpk(d0[0], d0[1]); gp.y = cvtpk(d0[2], d0[3]); gp.z = cvtpk(d1[0], d1[1]); gp.w = cvtpk(d1[2], d1[3]);
                *(LAS u32x4*)(myop + OP_GP + (jb * 64 + lane) * 16) = gp;
            }
            {
                const int s = t;
                float x[16];
#pragma unroll
                for (int q = 0; q < 16; ++q) x[q] = (q == s) ? 1.f : 0.f;
#pragma unroll
                for (int q = 0; q < 15; ++q) {
                    const f32x4 l0 = *(const LAS f32x4*)(labt + q * 16), l1 = *(const LAS f32x4*)(labt + q * 16 + 4), l2 = *(const LAS f32x4*)(labt + q * 16 + 8), l3 = *(const LAS f32x4*)(labt + q * 16 + 12);
                    const float lq[16] = {l0[0], l0[1], l0[2], l0[3], l1[0], l1[1], l1[2], l1[3], l2[0], l2[1], l2[2], l2[3], l3[0], l3[1], l3[2], l3[3]};
#pragma unroll
                    for (int r = q + 1; r < 16; ++r) x[r] -= lq[r] * x[q];
                }
                LAS bf16_t* md = (LAS bf16_t*)(myop + OP_MD) + (16 * (s >> 2)) * 8 + (s & 3);
#pragma unroll
                for (int j = 0; j < 4; ++j) {
                    const float xv = (kq == 0) ? x[j] : (kq == 1) ? x[4 + j] : (kq == 2) ? x[8 + j] : x[12 + j];
                    md[(4 * kq + j) * 8] = f2bf(xv);
                }
                { unsigned z_ = 0u; asm volatile("" : "+v"(z_)); *(LAS u32x2*)(myop + OP_MD + lane * 16 + 8) = (u32x2){z_, z_}; }
            }
        }
        __syncthreads();
        if (it + 1 < SEGTOK / 128) issue_loads(it + 1);
        int lane_c = lane; asm volatile("" : "+v"(lane_c));
#pragma unroll 1
        for (int c = 0; c < 8; ++c) {
            const int lane = lane_c, kq = lane_c >> 4, colc = 16 * (wave & 3) + (lane_c & 15);
            const LAS unsigned char* op = lds + LS_OPS + c * OP_SIZE;
            u32x2 vt = *(const LAS u32x2*)(op + OP_VT + ((wave & 3) * 64 + lane) * 8);
            if (augw) vt = (u32x2){0u, 0u};
            u32x4 sb0, sb1;
            sb0.x = cvtpk(St[0][0], St[0][1]); sb0.y = cvtpk(St[0][2], St[0][3]); sb0.z = cvtpk(St[1][0], St[1][1]); sb0.w = cvtpk(St[1][2], St[1][3]);
            sb1.x = cvtpk(St[2][0], St[2][1]); sb1.y = cvtpk(St[2][2], St[2][3]); sb1.z = cvtpk(St[3][0], St[3][1]); sb1.w = cvtpk(St[3][2], St[3][3]);
            const bf16x8 ap0 = *(const LAS bf16x8*)(op + OP_AP + lane * 16), ap1 = *(const LAS bf16x8*)(op + OP_AP + 1024 + lane * 16);
            const bf16x8 rp0 = *(const LAS bf16x8*)(op + OP_RP + lane * 16), rp1 = *(const LAS bf16x8*)(op + OP_RP + 1024 + lane * 16);
            const bf16x8 mx2 = *(const LAS bf16x8*)(op + OP_MX2 + lane * 16), mdm = *(const LAS bf16x8*)(op + OP_MD + lane * 16), mym = *(const LAS bf16x8*)(op + OP_MY + lane * 16);
            u32x4 b0v; b0v.x = 0u; b0v.y = 0u; b0v.z = vt.x; b0v.w = vt.y;
            f32x4 ax = (f32x4){0.f, 0.f, 0.f, 0.f};
            ax = __builtin_amdgcn_mfma_f32_16x16x32_bf16(mx2, __builtin_bit_cast(bf16x8, b0v), ax, 0, 0, 0);
            ax = __builtin_amdgcn_mfma_f32_16x16x32_bf16(ap0, __builtin_bit_cast(bf16x8, sb0), ax, 0, 0, 0);
            ax = __builtin_amdgcn_mfma_f32_16x16x32_bf16(ap1, __builtin_bit_cast(bf16x8, sb1), ax, 0, 0, 0);
            f32x4 ay = (f32x4){0.f, 0.f, 0.f, 0.f};
            ay = __builtin_amdgcn_mfma_f32_16x16x32_bf16(rp0, __builtin_bit_cast(bf16x8, sb0), ay, 0, 0, 0);
            ay = __builtin_amdgcn_mfma_f32_16x16x32_bf16(rp1, __builtin_bit_cast(bf16x8, sb1), ay, 0, 0, 0);
            u32x4 bx; bx.x = cvtpk(ax[0], ax[1]); bx.y = cvtpk(ax[2], ax[3]); bx.z = 0u; bx.w = 0u;
            f32x4 ad = (f32x4){0.f, 0.f, 0.f, 0.f};
            ad = __builtin_amdgcn_mfma_f32_16x16x32_bf16(mdm, __builtin_bit_cast(bf16x8, bx), ad, 0, 0, 0);
            u32x4 dv; dv.x = cvtpk(ad[0], ad[1]); dv.y = cvtpk(ad[2], ad[3]); dv.z = vt.x; dv.w = vt.y;
            ay = __builtin_amdgcn_mfma_f32_16x16x32_bf16(mym, __builtin_bit_cast(bf16x8, dv), ay, 0, 0, 0);
#pragma unroll
            for (int jb = 0; jb < 4; ++jb) {
                const f32x4 gc = *(const LAS f32x4*)(op + OP_GC + (kq * 16 + 4 * jb) * 4);
                const bf16x8 gp = *(const LAS bf16x8*)(op + OP_GP + (jb * 64 + lane) * 16);
                St[jb] = __builtin_amdgcn_mfma_f32_16x16x32_bf16(gp, __builtin_bit_cast(bf16x8, dv), St[jb] * gc, 0, 0, 0);
            }
            if (!augw || seg > 0) {
                bf16_t* yb = augw ? yaug : ybuf;
                const int sg0 = 16 * (seg * (SEGTOK / 16) + it * 8 + c) + 4 * kq;
#pragma unroll
                for (int e = 0; e < 4; ++e) { const int tk = dir ? (SEQ - 1 - (sg0 + e)) : (sg0 + e); *(bf16_t*)((char*)yb + ((unsigned)((tokbase + tk) * 2 + dir) * 1024u + (unsigned)((h * 64 + colc) * 2))) = f2bf(ay[e]); }
            }
        }
        __syncthreads();
    }
    if (seg + 1 < NSEG) {
        int lane_f = lane; asm volatile("" : "+v"(lane_f));
        const int kq = lane_f >> 4, colw = 16 * (wave & 3) + (lane_f & 15);
        float* dst = segst + ((size_t)unit * 2 + (augw ? 1 : 0)) * 4096;
#pragma unroll
        for (int jb = 0; jb < 4; ++jb)
#pragma unroll
            for (int e = 0; e < 4; ++e) dst[(16 * jb + 4 * kq + e) * 64 + colw] = St[jb][e];
    }
}

__device__ __forceinline__ void ph_segfix(LAS unsigned char* lds, const float* __restrict__ segst, bf16_t* __restrict__ SS, int nchain) {
    const int tid = otid(), j = tid >> 3, ig = tid & 7;
    LAS float* Sp = (LAS float*)lds;
    for (int chain = blockIdx.x; chain < nchain; chain += NWG) {
        float acc[8];
        for (int k = 1; k < NSEG; ++k) {
            const float* Cp = segst + ((size_t)(chain * NSEG + k - 1) * 2 + 0) * 4096 + j * 64 + 8 * ig;
            const float* Ap = segst + ((size_t)(chain * NSEG + k - 1) * 2 + 1) * 4096 + j * 64;
#pragma unroll
            for (int e = 0; e < 8; ++e) acc[e] = Cp[e];
            if (k > 1) {
                f32x4 ar[16];
#pragma unroll
                for (int q4 = 0; q4 < 16; ++q4) ar[q4] = *(const f32x4*)(Ap + 4 * q4);
#pragma unroll
                for (int q = 0; q < 64; ++q) {
                    const float a = ar[q >> 2][q & 3];
                    const f32x4 s0 = *(const LAS f32x4*)(Sp + q * 64 + 8 * ig), s1 = *(const LAS f32x4*)(Sp + q * 64 + 8 * ig + 4);
                    acc[0] += a * s0[0]; acc[1] += a * s0[1]; acc[2] += a * s0[2]; acc[3] += a * s0[3]; acc[4] += a * s1[0]; acc[5] += a * s1[1]; acc[6] += a * s1[2]; acc[7] += a * s1[3];
                }
            }
            __syncthreads();
#pragma unroll
            for (int e = 0; e < 8; ++e) { Sp[j * 64 + 8 * ig + e] = acc[e]; SS[((size_t)(chain * NSEG + k) * 64 + 8 * ig + e) * 64 + j] = f2bf(acc[e]); }
            __syncthreads();
        }
    }
}
__device__ __forceinline__ void ph_ycorr(const bf16_t* __restrict__ yaug, const bf16_t* __restrict__ SS, bf16_t* __restrict__ ybuf, int nchain) {
    const int tid = otid(), lane = tid & 63, wave = tid >> 6, il = lane & 15, kq = lane >> 4;
    constexpr int TPS = SEGTOK / 16, IPC = (NSEG - 1) * TPS;
    for (int it = blockIdx.x * 8 + wave; it < nchain * IPC; it += NWG * 8) {
        const int chain = it / IPC, r = it % IPC, seg = 1 + r / TPS, tile = r % TPS;
        const int h = chain & 7, dir = (chain >> 3) & 1, b = chain >> 4;
        const int st0 = seg * SEGTOK + 16 * tile, t0 = dir ? (SEQ - 16 - st0) : st0;
        const size_t rowbase = ((size_t)(b * SEQ + t0) * 2 + dir) * 512 + h * 64;
        const bf16x8 a0 = *(const bf16x8*)(yaug + rowbase + (size_t)il * 1024 + 8 * kq), a1 = *(const bf16x8*)(yaug + rowbase + (size_t)il * 1024 + 32 + 8 * kq);
        const bf16_t* ssp = SS + (size_t)(chain * NSEG + seg) * 4096;
#pragma unroll
        for (int nb = 0; nb < 4; ++nb) {
            const bf16x8 b0 = *(const bf16x8*)(ssp + (16 * nb + il) * 64 + 8 * kq), b1 = *(const bf16x8*)(ssp + (16 * nb + il) * 64 + 32 + 8 * kq);
            f32x4 acc = (f32x4){0.f, 0.f, 0.f, 0.f};
            acc = __builtin_amdgcn_mfma_f32_16x16x32_bf16(a0, b0, acc, 0, 0, 0);
            acc = __builtin_amdgcn_mfma_f32_16x16x32_bf16(a1, b1, acc, 0, 0, 0);
#pragma unroll
            for (int e = 0; e < 4; ++e) { bf16_t* yp = ybuf + rowbase + (size_t)(4 * kq + e) * 1024 + 16 * nb + il; *yp = f2bf(bf2f(*yp) + acc[e]); }
        }
    }
}

__device__ __forceinline__ void ph_post2(const bf16_t* __restrict__ ybuf, const bf16_t* __restrict__ gbuf, const float* __restrict__ sbon, const float* __restrict__ lg, const float* __restrict__ lb,
                                         bf16_t* __restrict__ mixb, int rows) {
    const int c = otid(), h = c >> 6, lane = c & 63;
    const float lgc = lg[c], lbc = lb[c];
    for (int t = blockIdx.x; t < rows; t += NWG) {
        const float y = bf2f(ybuf[(size_t)t * 1024 + c]) + bf2f(ybuf[(size_t)t * 1024 + 512 + c]);
        const float mu = wave_sum(y, lane) * (1.f / 64.f); const float dv = y - mu; const float var = wave_sum(dv * dv, lane) * (1.f / 64.f);
        const float yn = dv * rsqrtf(var + 64e-5f) * lgc + lbc;
        const float bon = sbon[(size_t)t * 16 + h] + sbon[(size_t)t * 16 + 8 + h];
        const float o = (yn + bon * bf2f(mixb[(size_t)t * 1024 + c])) * bf2f(gbuf[(size_t)t * 512 + c]);
        mixb[(size_t)t * 1024 + c] = f2bf(o);
    }
}

__device__ __forceinline__ void ph_fold(const float* __restrict__ win1, const float* __restrict__ g1, const float* __restrict__ mu1, const float* __restrict__ vdown, bf16_t* __restrict__ WinT1) {
    const int tid0 = otid();
    for (int idx = blockIdx.x * NT + tid0; idx < 96 * D; idx += NWG * NT) {
        const int jj = idx / D, k = idx % D, which = jj >> 5, j = jj & 31;
        const float* wr = win1 + (size_t)k * INC + 1024;
        float s = 0.f;
        for (int c = 0; c < 512; ++c) {
            const float m0 = mu1[1024 + c], m1 = mu1[RWC + 1024 + c];
            const float cf = (which == 0) ? (1.f - m0 - m1) : (which == 1) ? m0 : m1;
            s += wr[c] * cf * vdown[c * 32 + j];
        }
        WinT1[(size_t)(1920 + jj) * D + k] = f2bf(s * g1[k]);
    }
}


__device__ __forceinline__ void ph_post3(const bf16_t* __restrict__ ybuf, const bf16_t* __restrict__ yaug, const bf16_t* __restrict__ SS, const bf16_t* __restrict__ gbuf, const float* __restrict__ sbon,
                                         const float* __restrict__ lg, const float* __restrict__ lb, bf16_t* __restrict__ mixb, int nseq) {
    const int tid = otid(), lane = tid & 63, wave = tid >> 6, il = lane & 15, kq = lane >> 4;
    const int nitems = nseq * 8 * (SEQ / 16);
    for (int it = blockIdx.x * 8 + wave; it < nitems; it += NWG * 8) {
        const int tb = it % (SEQ / 16), h = (it / (SEQ / 16)) & 7, b = it / (8 * (SEQ / 16));
        const int t0 = 16 * tb;
        const size_t tokrow = (size_t)(b * SEQ + t0 + il);
        u32x2 vq_[4], gq_[4]; f32x4 g4_[4], b4_[4];
#pragma unroll
        for (int mb = 0; mb < 4; ++mb) {
            const int ch = h * 64 + 16 * mb + 4 * kq;
            g4_[mb] = *(const f32x4*)(lg + ch); b4_[mb] = *(const f32x4*)(lb + ch);
            vq_[mb] = *(const u32x2*)(mixb + tokrow * 1024 + ch); gq_[mb] = *(const u32x2*)(gbuf + tokrow * 512 + ch);
        }
        const float bon = sbon[tokrow * 16 + h] + sbon[tokrow * 16 + 8 + h];
        float y[4][4];
#pragma unroll
        for (int mb = 0; mb < 4; ++mb)
#pragma unroll
            for (int e = 0; e < 4; ++e) y[mb][e] = 0.f;
#pragma unroll
        for (int dir = 0; dir < 2; ++dir) {
            const size_t ro = (tokrow * 2 + dir) * 512 + h * 64;
#pragma unroll
            for (int mb = 0; mb < 4; ++mb) {
                const u32x2 q = *(const u32x2*)(ybuf + ro + 16 * mb + 4 * kq);
                y[mb][0] += __uint_as_float(q.x << 16); y[mb][1] += __uint_as_float(q.x & 0xffff0000u); y[mb][2] += __uint_as_float(q.y << 16); y[mb][3] += __uint_as_float(q.y & 0xffff0000u);
            }
            const int st0 = dir ? (SEQ - 16 - t0) : t0, seg = st0 / SEGTOK;
            if (seg > 0) {
                const int chain = (b * 2 + dir) * 8 + h;
                const bf16x8 y0 = *(const bf16x8*)(yaug + ro + 8 * kq), y1 = *(const bf16x8*)(yaug + ro + 32 + 8 * kq);
                const bf16_t* ssp = SS + (size_t)(chain * NSEG + seg) * 4096;
#pragma unroll
                for (int mb = 0; mb < 4; ++mb) {
                    const bf16x8 a0 = *(const bf16x8*)(ssp + (16 * mb + il) * 64 + 8 * kq), a1 = *(const bf16x8*)(ssp + (16 * mb + il) * 64 + 32 + 8 * kq);
                    f32x4 acc = (f32x4){y[mb][0], y[mb][1], y[mb][2], y[mb][3]};
                    acc = __builtin_amdgcn_mfma_f32_16x16x32_bf16(a0, y0, acc, 0, 0, 0);
                    acc = __builtin_amdgcn_mfma_f32_16x16x32_bf16(a1, y1, acc, 0, 0, 0);
                    y[mb][0] = acc[0]; y[mb][1] = acc[1]; y[mb][2] = acc[2]; y[mb][3] = acc[3];
                }
            }
        }
        float s = 0.f;
#pragma unroll
        for (int mb = 0; mb < 4; ++mb) s += (y[mb][0] + y[mb][1]) + (y[mb][2] + y[mb][3]);
        s += shx(s, 16, lane); s += shx(s, 32, lane);
        const float mu = s * (1.f / 64.f); float q2 = 0.f;
#pragma unroll
        for (int mb = 0; mb < 4; ++mb)
#pragma unroll
            for (int e = 0; e < 4; ++e) { y[mb][e] -= mu; q2 += y[mb][e] * y[mb][e]; }
        q2 += shx(q2, 16, lane); q2 += shx(q2, 32, lane);
        const float rs = rsqrtf(q2 * (1.f / 64.f) + 64e-5f);
#pragma unroll
        for (int mb = 0; mb < 4; ++mb) {
            const int ch = h * 64 + 16 * mb + 4 * kq;
            const f32x4 g4 = g4_[mb], b4 = b4_[mb];
            const u32x2 vq = vq_[mb], gq = gq_[mb];
            const float v0 = __uint_as_float(vq.x << 16), v1 = __uint_as_float(vq.x & 0xffff0000u), v2 = __uint_as_float(vq.y << 16), v3 = __uint_as_float(vq.y & 0xffff0000u);
            const float g0 = __uint_as_float(gq.x << 16), g1 = __uint_as_float(gq.x & 0xffff0000u), g2 = __uint_as_float(gq.y << 16), g3 = __uint_as_float(gq.y & 0xffff0000u);
            const float o0 = (y[mb][0] * rs * g4[0] + b4[0] + bon * v0) * g0, o1 = (y[mb][1] * rs * g4[1] + b4[1] + bon * v1) * g1;
            const float o2 = (y[mb][2] * rs * g4[2] + b4[2] + bon * v2) * g2, o3 = (y[mb][3] * rs * g4[3] + b4[3] + bon * v3) * g3;
            u32x2 o; o.x = cvtpk(o0, o1); o.y = cvtpk(o2, o3);
            *(u32x2*)(mixb + tokrow * 1024 + ch) = o;
        }
    }
}
struct Args { const float* in[27]; float* out; unsigned char* ws; };
struct WsMap { size_t ctl, WinT, WvT, WoutT, WupT, WdnT, WdecT, WaaaT, WgT, WvuT, xb, rstd, vfirst, mixb, act, P, VT, ybuf, gbuf, sbon, yaug, segst, SS, U, end; };
__host__ __device__ constexpr size_t al256(size_t x) { return (x + 255) & ~(size_t)255; }
__host__ __device__ constexpr WsMap make_map() {
    WsMap m{}; size_t off = 0;
    m.ctl = off; off += al256(WS_CTL_BYTES);
    m.WinT = off; off += al256((size_t)DEPTH * PCW * D * 2); m.WvT = off; off += al256((size_t)DEPTH * 512 * D * 2); m.WoutT = off; off += al256((size_t)DEPTH * D * D * 2);
    m.WupT = off; off += al256((size_t)DEPTH * UPC * D * 2); m.WdnT = off; off += al256((size_t)DEPTH * D * DFF * 2);
    m.WdecT = off; off += al256((size_t)DEPTH * 2 * 512 * 64 * 2); m.WaaaT = off; off += al256((size_t)DEPTH * 2 * 512 * 64 * 2); m.WgT = off; off += al256((size_t)DEPTH * 512 * 128 * 2); m.WvuT = off; off += al256((size_t)512 * 32 * 2);
    m.xb = off; off += al256((size_t)GR * D * 2); m.rstd = off; off += al256((size_t)4 * GR * 4); m.vfirst = off; off += al256((size_t)GR * 512 * 2);
    m.mixb = off; off += al256((size_t)GR * 1024 * 2); m.act = off; off += al256((size_t)GR * DFF * 2);
    m.U = off;
    m.P = off; off += al256((size_t)GR * PCW * 2); m.VT = off; off += al256((size_t)512 * GR * 2);
    m.ybuf = off; off += al256((size_t)GR * 1024 * 2); m.gbuf = off; off += al256((size_t)GR * 512 * 2); m.sbon = off; off += al256((size_t)GR * 16 * 4);
    m.yaug = off; off += al256((size_t)GR * 1024 * 2); m.segst = off; off += al256((size_t)GSEQ * 16 * NSEG * 2 * 4096 * 4); m.SS = off; off += al256((size_t)GSEQ * 16 * NSEG * 4096 * 2);
    if (off < m.U + (size_t)GR * UPC * 2) off = m.U + (size_t)GR * UPC * 2;
    m.end = off; return m;
}
constexpr WsMap WSM = make_map();

__global__ void __launch_bounds__(NT, 2) mega(Args args) {
    extern __shared__ __attribute__((aligned(16))) unsigned char lds_raw[];
    LAS unsigned char* lds = (LAS unsigned char*)lds_raw;
    asm volatile("v_mov_b32 v1, 0\n\tv_mov_b32 v2, 0\n\tv_mov_b32 v3, 0\n\tv_mov_b32 v4, 0\n\tv_mov_b32 v5, 0\n\tv_mov_b32 v6, 0\n\tv_mov_b32 v7, 0\n\tv_mov_b32 v8, 0\n\tv_mov_b32 v9, 0\n\tv_mov_b32 v10, 0\n\tv_mov_b32 v11, 0\n\tv_mov_b32 v12, 0\n\tv_mov_b32 v13, 0\n\tv_mov_b32 v14, 0\n\tv_mov_b32 v15, 0\n\tv_mov_b32 v16, 0\n\tv_mov_b32 v17, 0\n\tv_mov_b32 v18, 0\n\tv_mov_b32 v19, 0\n\tv_mov_b32 v20, 0\n\tv_mov_b32 v21, 0\n\tv_mov_b32 v22, 0\n\tv_mov_b32 v23, 0\n\tv_mov_b32 v24, 0\n\tv_mov_b32 v25, 0\n\tv_mov_b32 v26, 0\n\tv_mov_b32 v27, 0\n\tv_mov_b32 v28, 0\n\tv_mov_b32 v29, 0\n\tv_mov_b32 v30, 0\n\tv_mov_b32 v31, 0\n\tv_mov_b32 v32, 0\n\tv_mov_b32 v33, 0\n\tv_mov_b32 v34, 0\n\tv_mov_b32 v35, 0\n\tv_mov_b32 v36, 0\n\tv_mov_b32 v37, 0\n\tv_mov_b32 v38, 0\n\tv_mov_b32 v39, 0\n\tv_mov_b32 v40, 0\n\tv_mov_b32 v41, 0\n\tv_mov_b32 v42, 0\n\tv_mov_b32 v43, 0\n\tv_mov_b32 v44, 0\n\tv_mov_b32 v45, 0\n\tv_mov_b32 v46, 0\n\tv_mov_b32 v47, 0\n\tv_mov_b32 v48, 0\n\tv_mov_b32 v49, 0\n\tv_mov_b32 v50, 0\n\tv_mov_b32 v51, 0\n\tv_mov_b32 v52, 0\n\tv_mov_b32 v53, 0\n\tv_mov_b32 v54, 0\n\tv_mov_b32 v55, 0\n\tv_mov_b32 v56, 0\n\tv_mov_b32 v57, 0\n\tv_mov_b32 v58, 0\n\tv_mov_b32 v59, 0\n\tv_mov_b32 v60, 0\n\tv_mov_b32 v61, 0\n\tv_mov_b32 v62, 0\n\tv_mov_b32 v63, 0\n\tv_mov_b32 v64, 0\n\tv_mov_b32 v65, 0\n\tv_mov_b32 v66, 0\n\tv_mov_b32 v67, 0\n\tv_mov_b32 v68, 0\n\tv_mov_b32 v69, 0\n\tv_mov_b32 v70, 0\n\tv_mov_b32 v71, 0\n\tv_mov_b32 v72, 0\n\tv_mov_b32 v73, 0\n\tv_mov_b32 v74, 0\n\tv_mov_b32 v75, 0\n\tv_mov_b32 v76, 0\n\tv_mov_b32 v77, 0\n\tv_mov_b32 v78, 0\n\tv_mov_b32 v79, 0\n\tv_mov_b32 v80, 0\n\tv_mov_b32 v81, 0\n\tv_mov_b32 v82, 0\n\tv_mov_b32 v83, 0\n\tv_mov_b32 v84, 0\n\tv_mov_b32 v85, 0\n\tv_mov_b32 v86, 0\n\tv_mov_b32 v87, 0\n\tv_mov_b32 v88, 0\n\tv_mov_b32 v89, 0\n\tv_mov_b32 v90, 0\n\tv_mov_b32 v91, 0\n\tv_mov_b32 v92, 0\n\tv_mov_b32 v93, 0\n\tv_mov_b32 v94, 0\n\tv_mov_b32 v95, 0\n\tv_mov_b32 v96, 0\n\tv_mov_b32 v97, 0\n\tv_mov_b32 v98, 0\n\tv_mov_b32 v99, 0\n\tv_mov_b32 v100, 0\n\tv_mov_b32 v101, 0\n\tv_mov_b32 v102, 0\n\tv_mov_b32 v103, 0\n\tv_mov_b32 v104, 0\n\tv_mov_b32 v105, 0\n\tv_mov_b32 v106, 0\n\tv_mov_b32 v107, 0\n\tv_mov_b32 v108, 0\n\tv_mov_b32 v109, 0\n\tv_mov_b32 v110, 0\n\tv_mov_b32 v111, 0\n\tv_mov_b32 v112, 0\n\tv_mov_b32 v113, 0\n\tv_mov_b32 v114, 0\n\tv_mov_b32 v115, 0\n\tv_mov_b32 v116, 0\n\tv_mov_b32 v117, 0\n\tv_mov_b32 v118, 0\n\tv_mov_b32 v119, 0\n\tv_mov_b32 v120, 0\n\tv_mov_b32 v121, 0\n\tv_mov_b32 v122, 0\n\tv_mov_b32 v123, 0\n\tv_mov_b32 v124, 0\n\tv_mov_b32 v125, 0\n\tv_mov_b32 v126, 0\n\tv_mov_b32 v127, 0\n\tv_mov_b32 v128, 0\n\tv_mov_b32 v129, 0\n\tv_mov_b32 v130, 0\n\tv_mov_b32 v131, 0\n\tv_mov_b32 v132, 0\n\tv_mov_b32 v133, 0\n\tv_mov_b32 v134, 0\n\tv_mov_b32 v135, 0\n\tv_mov_b32 v136, 0\n\tv_mov_b32 v137, 0\n\tv_mov_b32 v138, 0\n\tv_mov_b32 v139, 0\n\tv_mov_b32 v140, 0\n\tv_mov_b32 v141, 0\n\tv_mov_b32 v142, 0\n\tv_mov_b32 v143, 0\n\tv_mov_b32 v144, 0\n\tv_mov_b32 v145, 0\n\tv_mov_b32 v146, 0\n\tv_mov_b32 v147, 0\n\tv_mov_b32 v148, 0\n\tv_mov_b32 v149, 0\n\tv_mov_b32 v150, 0\n\tv_mov_b32 v151, 0\n\tv_mov_b32 v152, 0\n\tv_mov_b32 v153, 0\n\tv_mov_b32 v154, 0\n\tv_mov_b32 v155, 0\n\tv_mov_b32 v156, 0\n\tv_mov_b32 v157, 0\n\tv_mov_b32 v158, 0\n\tv_mov_b32 v159, 0\n\tv_mov_b32 v160, 0\n\tv_mov_b32 v161, 0\n\tv_mov_b32 v162, 0\n\tv_mov_b32 v163, 0\n\tv_mov_b32 v164, 0\n\tv_mov_b32 v165, 0\n\tv_mov_b32 v166, 0\n\tv_mov_b32 v167, 0\n\tv_mov_b32 v168, 0\n\tv_mov_b32 v169, 0\n\tv_mov_b32 v170, 0\n\tv_mov_b32 v171, 0\n\tv_mov_b32 v172, 0\n\tv_mov_b32 v173, 0\n\tv_mov_b32 v174, 0\n\tv_mov_b32 v175, 0\n\tv_mov_b32 v176, 0\n\tv_mov_b32 v177, 0\n\tv_mov_b32 v178, 0\n\tv_mov_b32 v179, 0\n\tv_mov_b32 v180, 0\n\tv_mov_b32 v181, 0\n\tv_mov_b32 v182, 0\n\tv_mov_b32 v183, 0\n\tv_mov_b32 v184, 0\n\tv_mov_b32 v185, 0\n\tv_mov_b32 v186, 0\n\tv_mov_b32 v187, 0\n\tv_mov_b32 v188, 0\n\tv_mov_b32 v189, 0\n\tv_mov_b32 v190, 0\n\tv_mov_b32 v191, 0\n\tv_mov_b32 v192, 0\n\tv_mov_b32 v193, 0\n\tv_mov_b32 v194, 0\n\tv_mov_b32 v195, 0\n\tv_mov_b32 v196, 0\n\tv_mov_b32 v197, 0\n\tv_mov_b32 v198, 0\n\tv_mov_b32 v199, 0\n\tv_mov_b32 v200, 0\n\tv_mov_b32 v201, 0\n\tv_mov_b32 v202, 0\n\tv_mov_b32 v203, 0\n\tv_mov_b32 v204, 0\n\tv_mov_b32 v205, 0\n\tv_mov_b32 v206, 0\n\tv_mov_b32 v207, 0\n\tv_mov_b32 v208, 0\n\tv_mov_b32 v209, 0\n\tv_mov_b32 v210, 0\n\tv_mov_b32 v211, 0\n\tv_mov_b32 v212, 0\n\tv_mov_b32 v213, 0\n\tv_mov_b32 v214, 0\n\tv_mov_b32 v215, 0\n\tv_mov_b32 v216, 0\n\tv_mov_b32 v217, 0\n\tv_mov_b32 v218, 0\n\tv_mov_b32 v219, 0\n\tv_mov_b32 v220, 0\n\tv_mov_b32 v221, 0\n\tv_mov_b32 v222, 0\n\tv_mov_b32 v223, 0\n\tv_mov_b32 v224, 0\n\tv_mov_b32 v225, 0\n\tv_mov_b32 v226, 0\n\tv_mov_b32 v227, 0\n\tv_mov_b32 v228, 0\n\tv_mov_b32 v229, 0\n\tv_mov_b32 v230, 0\n\tv_mov_b32 v231, 0\n\tv_mov_b32 v232, 0\n\tv_mov_b32 v233, 0\n\tv_mov_b32 v234, 0\n\tv_mov_b32 v235, 0\n\tv_mov_b32 v236, 0\n\tv_mov_b32 v237, 0\n\tv_mov_b32 v238, 0\n\tv_mov_b32 v239, 0\n\tv_mov_b32 v240, 0\n\tv_mov_b32 v241, 0\n\tv_mov_b32 v242, 0\n\tv_mov_b32 v243, 0\n\ts_mov_b32 s20, 0\n\ts_mov_b32 s21, 0\n\ts_mov_b32 s22, 0\n\ts_mov_b32 s23, 0\n\ts_mov_b32 s24, 0\n\ts_mov_b32 s25, 0\n\ts_mov_b32 s26, 0\n\ts_mov_b32 s27, 0\n\ts_mov_b32 s28, 0\n\ts_mov_b32 s29, 0\n\ts_mov_b32 s30, 0\n\ts_mov_b32 s31, 0\n\ts_mov_b32 s32, 0\n\ts_mov_b32 s33, 0\n\ts_mov_b32 s34, 0\n\ts_mov_b32 s35, 0\n\ts_mov_b32 s36, 0\n\ts_mov_b32 s37, 0\n\ts_mov_b32 s38, 0\n\ts_mov_b32 s39, 0\n\ts_mov_b32 s40, 0\n\ts_mov_b32 s41, 0\n\ts_mov_b32 s42, 0\n\ts_mov_b32 s43, 0\n\ts_mov_b32 s44, 0\n\ts_mov_b32 s45, 0\n\ts_mov_b32 s46, 0\n\ts_mov_b32 s47, 0\n\ts_mov_b32 s48, 0\n\ts_mov_b32 s49, 0\n\ts_mov_b32 s50, 0\n\ts_mov_b32 s51, 0\n\ts_mov_b32 s52, 0\n\ts_mov_b32 s53, 0\n\ts_mov_b32 s54, 0\n\ts_mov_b32 s55, 0\n\ts_mov_b32 s56, 0\n\ts_mov_b32 s57, 0\n\ts_mov_b32 s58, 0\n\ts_mov_b32 s59, 0\n\ts_mov_b32 s60, 0\n\ts_mov_b32 s61, 0\n\ts_mov_b32 s62, 0\n\ts_mov_b32 s63, 0\n\ts_mov_b32 s64, 0\n\ts_mov_b32 s65, 0\n\ts_mov_b32 s66, 0\n\ts_mov_b32 s67, 0\n\ts_mov_b32 s68, 0\n\ts_mov_b32 s69, 0\n\ts_mov_b32 s70, 0\n\ts_mov_b32 s71, 0\n\ts_mov_b32 s72, 0\n\ts_mov_b32 s73, 0\n\ts_mov_b32 s74, 0\n\ts_mov_b32 s75, 0\n\ts_mov_b32 s76, 0\n\ts_mov_b32 s77, 0\n\ts_mov_b32 s78, 0\n\ts_mov_b32 s79, 0\n\ts_mov_b32 s80, 0\n\ts_mov_b32 s81, 0\n\ts_mov_b32 s82, 0\n\ts_mov_b32 s83, 0\n\ts_mov_b32 s84, 0\n\ts_mov_b32 s85, 0\n\ts_mov_b32 s86, 0\n\ts_mov_b32 s87, 0\n\ts_mov_b32 s88, 0\n\ts_mov_b32 s89, 0\n\ts_mov_b32 s90, 0\n\ts_mov_b32 s91, 0\n\ts_mov_b32 s92, 0\n\ts_mov_b32 s93, 0\n\ts_mov_b32 s94, 0\n\ts_mov_b32 s95, 0\n\ts_mov_b32 s96, 0\n\ts_mov_b32 s97, 0\n\ts_mov_b32 s98, 0\n\ts_mov_b32 s99, 0\n\t" ::: "v1", "v2", "v3", "v4", "v5", "v6", "v7", "v8", "v9", "v10", "v11", "v12", "v13", "v14", "v15", "v16", "v17", "v18", "v19", "v20", "v21", "v22", "v23", "v24", "v25", "v26", "v27", "v28", "v29", "v30", "v31", "v32", "v33", "v34", "v35", "v36", "v37", "v38", "v39", "v40", "v41", "v42", "v43", "v44", "v45", "v46", "v47", "v48", "v49", "v50", "v51", "v52", "v53", "v54", "v55", "v56", "v57", "v58", "v59", "v60", "v61", "v62", "v63", "v64", "v65", "v66", "v67", "v68", "v69", "v70", "v71", "v72", "v73", "v74", "v75", "v76", "v77", "v78", "v79", "v80", "v81", "v82", "v83", "v84", "v85", "v86", "v87", "v88", "v89", "v90", "v91", "v92", "v93", "v94", "v95", "v96", "v97", "v98", "v99", "v100", "v101", "v102", "v103", "v104", "v105", "v106", "v107", "v108", "v109", "v110", "v111", "v112", "v113", "v114", "v115", "v116", "v117", "v118", "v119", "v120", "v121", "v122", "v123", "v124", "v125", "v126", "v127", "v128", "v129", "v130", "v131", "v132", "v133", "v134", "v135", "v136", "v137", "v138", "v139", "v140", "v141", "v142", "v143", "v144", "v145", "v146", "v147", "v148", "v149", "v150", "v151", "v152", "v153", "v154", "v155", "v156", "v157", "v158", "v159", "v160", "v161", "v162", "v163", "v164", "v165", "v166", "v167", "v168", "v169", "v170", "v171", "v172", "v173", "v174", "v175", "v176", "v177", "v178", "v179", "v180", "v181", "v182", "v183", "v184", "v185", "v186", "v187", "v188", "v189", "v190", "v191", "v192", "v193", "v194", "v195", "v196", "v197", "v198", "v199", "v200", "v201", "v202", "v203", "v204", "v205", "v206", "v207", "v208", "v209", "v210", "v211", "v212", "v213", "v214", "v215", "v216", "v217", "v218", "v219", "v220", "v221", "v222", "v223", "v224", "v225", "v226", "v227", "v228", "v229", "v230", "v231", "v232", "v233", "v234", "v235", "v236", "v237", "v238", "v239", "v240", "v241", "v242", "v243", "s20", "s21", "s22", "s23", "s24", "s25", "s26", "s27", "s28", "s29", "s30", "s31", "s32", "s33", "s34", "s35", "s36", "s37", "s38", "s39", "s40", "s41", "s42", "s43", "s44", "s45", "s46", "s47", "s48", "s49", "s50", "s51", "s52", "s53", "s54", "s55", "s56", "s57", "s58", "s59", "s60", "s61", "s62", "s63", "s64", "s65", "s66", "s67", "s68", "s69", "s70", "s71", "s72", "s73", "s74", "s75", "s76", "s77", "s78", "s79", "s80", "s81", "s82", "s83", "s84", "s85", "s86", "s87", "s88", "s89", "s90", "s91", "s92", "s93", "s94", "s95", "s96", "s97", "s98", "s99");
    volatile LAS unsigned* misc = (volatile LAS unsigned*)(lds + LDS_MISC);
    if (threadIdx.x < 64) misc[threadIdx.x] = 0u;
    __syncthreads();
    XcdBarrier bar = xcd_barrier_post(((unsigned*)(args.ws + WSM.ctl)), misc + 8, otid() == 0);
#define GRID_BAR() xcd_barrier(bar, otid() == 0)
    const float* const* in = args.in;
    float* X = args.out;
    constexpr int G = NWG; const int bx = (int)blockIdx.x;

#pragma unroll 1
    for (int j = 0; j < 21; ++j) {
        const int l = (j >= 10 && j < 20) ? 1 : 0, k = (j < 20) ? j - 10 * l : 10;
        const float* W; int K_, Nsrc, Nout, mode = 0; const float* scale = nullptr; bf16_t* out; float mul = 1.f;
        if (k == 0)      { W = in[3] + (size_t)l * D * INC; K_ = D; Nsrc = INC; scale = in[2] + l * D; out = ((bf16_t*)(args.ws + WSM.WinT)) + (size_t)l * PCW * D; Nout = PCW; mode = 1; }
        else if (k == 1) { W = in[3] + (size_t)l * D * INC; K_ = D; Nsrc = INC; scale = in[2] + l * D; out = ((bf16_t*)(args.ws + WSM.WvT)) + (size_t)l * 512 * D; Nout = 512; mode = 2; }
        else if (k == 2) { W = in[21] + (size_t)l * D * D; K_ = D; Nsrc = D; out = ((bf16_t*)(args.ws + WSM.WoutT)) + (size_t)l * D * D; Nout = D; }
        else if (k == 3) { W = in[23] + (size_t)l * D * UPC; K_ = D; Nsrc = UPC; scale = in[22] + l * D; out = ((bf16_t*)(args.ws + WSM.WupT)) + (size_t)l * UPC * D; Nout = UPC; mode = 3; }
        else if (k == 4) { W = in[26] + (size_t)l * DFF * D; K_ = DFF; Nsrc = D; out = ((bf16_t*)(args.ws + WSM.WdnT)) + (size_t)l * D * DFF; Nout = D; }
        else if (k <= 6) { const int d = k - 5; W = in[6] + (size_t)(l * 2 + d) * 64 * 512; K_ = 64; Nsrc = 512; out = ((bf16_t*)(args.ws + WSM.WdecT)) + (size_t)(l * 2 + d) * 512 * 64; Nout = 512; mul = -1.44269504f; }
        else if (k <= 8) { const int d = k - 7; W = in[8] + (size_t)(l * 2 + d) * 64 * 512; K_ = 64; Nsrc = 512; out = ((bf16_t*)(args.ws + WSM.WaaaT)) + (size_t)(l * 2 + d) * 512 * 64; Nout = 512; mul = -1.44269504f; }
        else if (k == 9) { W = in[9] + (size_t)l * 128 * 512; K_ = 128; Nsrc = 512; out = ((bf16_t*)(args.ws + WSM.WgT)) + (size_t)l * 512 * 128; Nout = 512; }
        else             { W = in[12]; K_ = 32; Nsrc = 512; out = ((bf16_t*)(args.ws + WSM.WvuT)); Nout = 512; mul = -1.44269504f; }
        ph_prep_w(lds, W, K_, Nsrc, scale, out, Nout, mode, mul);
    }
    GRID_BAR();
    ph_fold(in[3] + (size_t)1 * D * INC, in[2] + D, in[4] + (size_t)1 * 2 * RWC, in[11], ((bf16_t*)(args.ws + WSM.WinT)) + (size_t)1 * PCW * D);

    for (int grp = 0; grp < NGRP; ++grp) {
        const size_t g0 = (size_t)grp * GR;
        float* Xg = X + g0 * D;
        {
            const float* xin = (g0 < (size_t)8 * SEQ) ? in[0] + g0 * D : in[1] + (g0 - (size_t)8 * SEQ) * D;
            ph_rms_in(xin, ((bf16_t*)(args.ws + WSM.xb)), ((float*)(args.ws + WSM.rstd)), GR);
        }
        GRID_BAR();
        for (int l = 0; l < DEPTH; ++l) {
            {
                pg8::StaticOrder S; pg8::Unit u0;
                S.init(GR, PCW, NWG, bx); if (S.next(0, u0)) wg_rstd_from_slots((const float*)(args.ws + WSM.rstd), u0.pm * 256, (LAS float*)(lds + RS_A));
                S.init(512, GR, NWG, bx); if (S.next(0, u0)) wg_rstd_from_slots((const float*)(args.ws + WSM.rstd), u0.pn * 256, (LAS float*)(lds + RS_B));
            }
#pragma unroll 1
            for (int k = 0; k < 2; ++k) {
                const bf16_t* xb_ = (const bf16_t*)(args.ws + WSM.xb);
                const bf16_t* wi_ = ((const bf16_t*)(args.ws + WSM.WinT)) + (size_t)l * PCW * D; const bf16_t* wv_ = ((const bf16_t*)(args.ws + WSM.WvT)) + (size_t)l * 512 * D;
                ph_gemm_bf(lds, k ? wv_ : xb_, k ? xb_ : wi_, k ? 512 : GR, k ? GR : PCW, D, k ? (bf16_t*)(args.ws + WSM.VT) : (bf16_t*)(args.ws + WSM.P),
                           k ? (const LAS float*)nullptr : (const LAS float*)(lds + RS_A), k ? (const LAS float*)(lds + RS_B) : (const LAS float*)nullptr, k ? -1 : PCW);
            }
            GRID_BAR();
            {
                ph_qknorm(((bf16_t*)(args.ws + WSM.P)), in[18] + l * 64, in[19] + l * 64, GR);
                constexpr int NUNITS = GSEQ * 16 * NSEG;
                if (bx < NUNITS) {
                    ScanW w;
                    w.mu = in[4] + (size_t)l * 2 * RWC; w.w0 = in[5] + l * 1024; w.a0 = in[7] + l * 1024; w.v0 = in[10]; w.kk_ = in[13] + l * 512; w.ka = in[14] + l * 512; w.rk = in[15] + l * 512;
                    w.WdecT = ((bf16_t*)(args.ws + WSM.WdecT)) + (size_t)l * 2 * 512 * 64; w.WaaaT = ((bf16_t*)(args.ws + WSM.WaaaT)) + (size_t)l * 2 * 512 * 64; w.WgT = ((bf16_t*)(args.ws + WSM.WgT)) + (size_t)l * 512 * 128; w.WvuT = ((bf16_t*)(args.ws + WSM.WvuT));
                    for (int u = bx; u < NUNITS; u += G) scan_unit(lds, u, l, ((bf16_t*)(args.ws + WSM.P)), w, ((bf16_t*)(args.ws + WSM.ybuf)), ((bf16_t*)(args.ws + WSM.gbuf)), ((bf16_t*)(args.ws + WSM.mixb)), ((bf16_t*)(args.ws + WSM.vfirst)), ((float*)(args.ws + WSM.sbon)), (bf16_t*)(args.ws + WSM.yaug), (float*)(args.ws + WSM.segst));
                }
            }
            GRID_BAR();
#pragma unroll 1
            for (int half = 0; half < 2; ++half) {
                if (half == 0) {
                    ph_segfix(lds, (const float*)(args.ws + WSM.segst), (bf16_t*)(args.ws + WSM.SS), GSEQ * 16);
                    ph_natten(lds, ((bf16_t*)(args.ws + WSM.P)), ((bf16_t*)(args.ws + WSM.VT)), GR, GSEQ, in[20] + (size_t)l * 8 * 15 * 31, ((bf16_t*)(args.ws + WSM.mixb)), bx, G);
                    GRID_BAR();
                    ph_post3((const bf16_t*)(args.ws + WSM.ybuf), (const bf16_t*)(args.ws + WSM.yaug), (const bf16_t*)(args.ws + WSM.SS), (const bf16_t*)(args.ws + WSM.gbuf), (const float*)(args.ws + WSM.sbon), in[16] + l * 512, in[17] + l * 512, (bf16_t*)(args.ws + WSM.mixb), GSEQ);
                    GRID_BAR();
                } else {
                    { pg8::StaticOrder S; pg8::Unit u0; S.init(GR, UPC, NWG, bx); if (S.next(0, u0)) wg_rstd_from_slots((const float*)(args.ws + WSM.rstd), u0.pm * 256, (LAS float*)(lds + RS_A)); }
                    ph_gemm_ffn(lds, ((bf16_t*)(args.ws + WSM.xb)), ((bf16_t*)(args.ws + WSM.WupT)) + (size_t)l * UPC * D, GR, ((bf16_t*)(args.ws + WSM.act)), (float*)(args.ws + WSM.U), ((float*)(args.ws + WSM.rstd)),
                                in[24] + (size_t)l * 3 * UPC, in[25] + (size_t)l * UPC);
                    GRID_BAR();
                    ph_ffn_fix((const float*)(args.ws + WSM.U), in[24] + (size_t)l * 3 * UPC, in[25] + (size_t)l * UPC, ((bf16_t*)(args.ws + WSM.act)), GR);
                    GRID_BAR();
                }
                ph_gemm(lds, half ? (const bf16_t*)(args.ws + WSM.act) : (const bf16_t*)(args.ws + WSM.mixb),
                        half ? ((const bf16_t*)(args.ws + WSM.WdnT)) + (size_t)l * D * DFF : ((const bf16_t*)(args.ws + WSM.WoutT)) + (size_t)l * D * D, GR, D, half ? DFF : D,
                        (bf16_t*)(args.ws + WSM.xb), (half == 1 && l + 1 == DEPTH) ? Xg : nullptr, (float*)(args.ws + WSM.rstd));
                GRID_BAR();
            }
        }
    }
}

extern "C" void kernel_launch(void* const* d_in, const int* in_sizes, int n_in, void* d_out, int out_size, void* d_ws, size_t ws_size, hipStream_t stream) {
    static int grid = 0;
    static Args a{};
    if (grid == 0) {
        int dev = 0, cus = 0;
        if (hipGetDevice(&dev) != hipSuccess || hipDeviceGetAttribute(&cus, hipDeviceAttributeMultiprocessorCount, dev) != hipSuccess) { fprintf(stderr, "device query failed\n"); grid = -1; return; }
        if (hipFuncSetAttribute((const void*)mega, hipFuncAttributeMaxDynamicSharedMemorySize, LDS_BYTES) != hipSuccess) { fprintf(stderr, "hipFuncSetAttribute failed\n"); grid = -1; return; }
        int per_cu = 0;
        if (hipOccupancyMaxActiveBlocksPerMultiprocessor(&per_cu, (const void*)mega, NT, LDS_BYTES) != hipSuccess || per_cu < 1) { fprintf(stderr, "occupancy query: %d\n", per_cu); }
        (void)hipGetLastError();
        if (cus < NWG) { fprintf(stderr, "this kernel needs %d CUs, device has %d\n", NWG, cus); grid = -1; return; }
        grid = NWG;
    }
    if (grid < 0) return;
    if (WSM.end > ws_size || n_in != 27) { fprintf(stderr, "ws too small: need %zu have %zu (n_in %d)\n", (size_t)WSM.end, ws_size, n_in); return; }
    a = Args{};
    for (int i = 0; i < 27; ++i) a.in[i] = (const float*)d_in[i];
    a.out = (float*)d_out; a.ws = (unsigned char*)d_ws;
    (void)hipMemsetAsync(d_ws, 0, WS_CTL_BYTES, stream);
    hipLaunchKernelGGL(mega, dim3(grid), dim3(NT), LDS_BYTES, stream, a);
}
```

```cpp
#include <hip/hip_runtime.h>
#include <cstdio>
#include <cstdint>
namespace pg8 {
#define PG8_LAS __attribute__((address_space(3)))
typedef unsigned short bf16_t;
typedef short bf16x8 __attribute__((ext_vector_type(8)));
typedef float f32x4 __attribute__((ext_vector_type(4)));
typedef unsigned u32x4 __attribute__((ext_vector_type(4)));
constexpr int BM = 256, BK = 64, HALF = 128, HTB = HALF * BK * 2  , STAGE_BYTES = 8 * HTB, NXCD = 8, WGM = 8;

__host__ __device__ __forceinline__ int lds_byte(int r, int c) { const int st = (r >> 4) * 2 + (c >> 5), rr = r & 15, cc = c & 31, ob = rr * 64 + cc * 2; return st * 1024 + (ob ^ (((ob >> 9) & 1) << 5)); }
__host__ __device__ __forceinline__ void stage_rc(int b, int& R, int& C) { const int st = b / 1024, sb = b % 1024, swz = sb ^ (((sb >> 9) & 1) << 5); R = (st >> 1) * 16 + swz / 64; C = (st & 1) * 32 + (swz % 64) / 2; }
__host__ __device__ __forceinline__ int perm32(int rho) { const int n = rho >> 4, i = rho & 15; return 8 * (i >> 2) + 4 * n + (i & 3); }

struct Unit { int pm, pn; };
struct Gemm { const bf16_t* A; const bf16_t* Bt; int M, N, K, pad; };

struct StaticOrder {
    int nM, nN, nwg, G, c;
    __host__ __device__ void init(int M, int N, int G_, int c_) { nM = M / BM; nN = N / BM; nwg = nM * nN; G = G_; c = c_; }
    __host__ __device__ bool next(int i, Unit& u) const {
        const int L = i * G + c; if (L >= nwg) return false;
        int wgid = L; { const int q = nwg / NXCD, r = nwg % NXCD, xcd = wgid % NXCD, off = wgid / NXCD; wgid = (xcd < r ? xcd * (q + 1) : r * (q + 1) + (xcd - r) * q) + off; }
        const int nig = WGM * nN, gid = wgid / nig, fm = gid * WGM, gsz = (nM - fm) < WGM ? (nM - fm) : WGM;
        u.pm = fm + ((wgid % nig) % gsz); u.pn = (wgid % nig) / gsz; return true;
    }
    __device__ __forceinline__ void a_ready(const Unit&) const {}
    __device__ __forceinline__ void done(const Unit&) const {}
};

__device__ __forceinline__ unsigned cvt_pk_bf16(float lo, float hi) { unsigned r; asm volatile("v_cvt_pk_bf16_f32 %0, %1, %2" : "=v"(r) : "v"(lo), "v"(hi)); return r; }
typedef float f32x2 __attribute__((ext_vector_type(2)));
template <class Epi, class Sched, bool ALIGN_EPI = false, bool SP2 = false>
__device__ __forceinline__ void gemm_phase(PG8_LAS unsigned char* lds, const Gemm g, const Sched& S, const Epi& E, const int tid_in) {
    const int tid = tid_in, wid = __builtin_amdgcn_readfirstlane(tid >> 6), lane = tid & 63, wr = wid >> 2, wc = wid & 3, fr = lane & 15, fq = lane >> 4;
    const int K = g.K, nt = K / BK;
    unsigned voffA[2], voffB[2];
#pragma unroll
    for (int i = 0; i < 2; ++i) { int R, C; stage_rc(tid * 16 + i * 8192, R, C); const int Rb = Epi::PERM ? ((R & ~31) + perm32(R & 31)) : R;
        const int Ra = Epi::APERM ? ((R & ~63) + 4 * (R & 15) + ((R >> 4) & 3)) : R;
        voffA[i] = (unsigned)(Ra * K + C) * 2u; voffB[i] = (unsigned)(Rb * K + C) * 2u; }
    const size_t kstep = (size_t)(BK * 2);
    const size_t hstep = (size_t)HALF * K * 2;
    const size_t tstep = 2 * hstep;
    const unsigned ldsw = (unsigned)wid * 1024u;
    const int aoff = lds_byte(wr * 64 + fr, fq * 8), boff = lds_byte(wc * 32 + fr, fq * 8);
#define PG8_SA(b, h) (((b) * 2 + (h)) * HTB)
#define PG8_SB(b, h) ((4 + (b) * 2 + (h)) * HTB)
#define PG8_STAGE(bufoff, gbase, voff) do { _Pragma("unroll") for (int _i = 0; _i < 2; ++_i) \
        __builtin_amdgcn_global_load_lds((const unsigned*)((const char*)(gbase) + (voff)[_i]), (PG8_LAS unsigned*)(lds + (bufoff) + ldsw + _i * 8192), 16, 0, 0); } while (0)
#define PG8_LDA(dst, b, h) do { _Pragma("unroll") for (int m = 0; m < 4; ++m) _Pragma("unroll") for (int k = 0; k < 2; ++k) dst[m][k] = *(const PG8_LAS bf16x8*)(lds + PG8_SA(b, h) + aoff + m * 2048 + k * 1024); } while (0)
#define PG8_LDB(dst, b, h) do { _Pragma("unroll") for (int n = 0; n < 2; ++n) _Pragma("unroll") for (int k = 0; k < 2; ++k) dst[n][k] = *(const PG8_LAS bf16x8*)(lds + PG8_SB(b, h) + boff + n * 2048 + k * 1024); } while (0)
#define PG8_MMA(ai, bj, At, Bt) do { __builtin_amdgcn_s_setprio(1); _Pragma("unroll") for (int m = 0; m < 4; ++m) _Pragma("unroll") for (int n = 0; n < 2; ++n) _Pragma("unroll") for (int k = 0; k < 2; ++k) \
        acc[ai][bj][m][n] = __builtin_amdgcn_mfma_f32_16x16x32_bf16(Bt[n][k], At[m][k], acc[ai][bj][m][n], 0, 0, 0); __builtin_amdgcn_s_setprio(0); } while (0)
#define PG8_WAIT_V(n) asm volatile("s_waitcnt vmcnt(" #n ")" ::: "memory")
#define PG8_WAIT_L(n) asm volatile("s_waitcnt lgkmcnt(" #n ")" ::: "memory")
#define PG8_BAR __builtin_amdgcn_s_barrier()
#define PG8_SCHED __builtin_amdgcn_sched_barrier(0)
    Unit cur, nxt; int ui = 0;
    if (!S.next(0, cur)) return;
    f32x4 acc[2][2][4][2];
#pragma unroll
    for (int a = 0; a < 2; ++a)
#pragma unroll
        for (int b = 0; b < 2; ++b)
#pragma unroll
            for (int m = 0; m < 4; ++m)
#pragma unroll
                for (int n = 0; n < 2; ++n) acc[a][b][m][n] = (f32x4){0.f, 0.f, 0.f, 0.f};
    bf16x8 At[4][2], B0[2][2], B1[2][2];
    const char* cA = (const char*)g.A + (size_t)cur.pm * tstep; const char* cB = (const char*)g.Bt + (size_t)cur.pn * tstep;
    S.a_ready(cur);
    if constexpr (SP2) {
        PG8_STAGE(PG8_SB(0, 0), cB, voffB); PG8_STAGE(PG8_SB(0, 1), cB + hstep, voffB); PG8_STAGE(PG8_SA(0, 0), cA, voffA); PG8_STAGE(PG8_SA(0, 1), cA + hstep, voffA);
        if (wr == 1) PG8_BAR;
        PG8_WAIT_V(2); PG8_BAR;
        PG8_STAGE(PG8_SB(1, 0), cB + kstep, voffB); PG8_STAGE(PG8_SA(1, 0), cA + kstep, voffA); PG8_STAGE(PG8_SB(1, 1), cB + hstep + kstep, voffB);
        PG8_WAIT_V(6); PG8_BAR;
    } else {
        PG8_STAGE(PG8_SB(0, 0), cB, voffB); PG8_STAGE(PG8_SA(0, 0), cA, voffA); PG8_STAGE(PG8_SB(0, 1), cB + hstep, voffB); PG8_STAGE(PG8_SA(0, 1), cA + hstep, voffA);
        if (wr == 1) PG8_BAR;
        PG8_WAIT_V(4); PG8_BAR;
        PG8_STAGE(PG8_SB(1, 0), cB + kstep, voffB); PG8_STAGE(PG8_SA(1, 0), cA + kstep, voffA); PG8_STAGE(PG8_SB(1, 1), cB + hstep + kstep, voffB);
        PG8_WAIT_V(6); PG8_BAR;
    }
    for (;;) {
        const bool has_next = S.next(ui + 1, nxt);
        const char* nA = has_next ? (const char*)g.A + (size_t)nxt.pm * tstep : cA; const char* nB = has_next ? (const char*)g.Bt + (size_t)nxt.pn * tstep : cB;
        for (int t = 0; t < nt; t += 2) {
            const bool last = (t == nt - 2);
            const char* a1 = cA + (size_t)(t + 1) * kstep;
            const char* a2 = last ? nA : cA + (size_t)(t + 2) * kstep; const char* b2 = last ? nB : cB + (size_t)(t + 2) * kstep;
            const char* a3 = a2 + kstep; const char* b3 = b2 + kstep;
            if (last && has_next) S.a_ready(nxt);
            if constexpr (SP2) {
            PG8_LDB(B0, 0, 0); PG8_LDB(B1, 0, 1); PG8_SCHED; PG8_LDA(At, 0, 0); PG8_STAGE(PG8_SA(1, 1), a1 + hstep, voffA);
            PG8_WAIT_V(8); PG8_WAIT_L(0); PG8_BAR; PG8_MMA(0, 0, At, B0); PG8_MMA(0, 1, At, B1); PG8_BAR; PG8_SCHED;
            PG8_LDA(At, 0, 1); PG8_STAGE(PG8_SB(0, 0), b2, voffB); PG8_STAGE(PG8_SB(0, 1), b2 + hstep, voffB); PG8_STAGE(PG8_SA(0, 0), a2, voffA);
            PG8_WAIT_V(8); PG8_WAIT_L(0); PG8_BAR; PG8_MMA(1, 0, At, B0); PG8_MMA(1, 1, At, B1); PG8_BAR; PG8_SCHED;
            PG8_LDB(B0, 1, 0); PG8_LDB(B1, 1, 1); PG8_SCHED; PG8_LDA(At, 1, 0); PG8_STAGE(PG8_SA(0, 1), a2 + hstep, voffA);
            PG8_WAIT_V(8); PG8_WAIT_L(0); PG8_BAR; PG8_MMA(0, 0, At, B0); PG8_MMA(0, 1, At, B1); PG8_BAR; PG8_SCHED;
            PG8_LDA(At, 1, 1); PG8_STAGE(PG8_SB(1, 0), b3, voffB); PG8_STAGE(PG8_SB(1, 1), b3 + hstep, voffB); PG8_STAGE(PG8_SA(1, 0), a3, voffA);
            PG8_WAIT_V(8); PG8_WAIT_L(0); PG8_BAR; PG8_MMA(1, 0, At, B0); PG8_MMA(1, 1, At, B1); PG8_BAR; PG8_SCHED;
            } else {
            PG8_LDB(B0, 0, 0); PG8_SCHED; PG8_LDA(At, 0, 0); PG8_STAGE(PG8_SA(1, 1), a1 + hstep, voffA);
            PG8_WAIT_L(8); PG8_BAR; PG8_WAIT_L(0); PG8_MMA(0, 0, At, B0); PG8_BAR; PG8_SCHED;
            PG8_LDB(B1, 0, 1); PG8_STAGE(PG8_SB(0, 0), b2, voffB);
            PG8_BAR; PG8_WAIT_L(0); PG8_MMA(0, 1, At, B1); PG8_BAR;
            PG8_LDA(At, 0, 1); PG8_STAGE(PG8_SA(0, 0), a2, voffA);
            PG8_BAR; PG8_WAIT_L(0); PG8_MMA(1, 0, At, B0); PG8_BAR; PG8_SCHED;
            PG8_STAGE(PG8_SB(0, 1), b2 + hstep, voffB);
            PG8_WAIT_V(6); PG8_BAR; PG8_MMA(1, 1, At, B1); PG8_BAR;
            PG8_LDB(B0, 1, 0); PG8_SCHED; PG8_LDA(At, 1, 0); PG8_STAGE(PG8_SA(0, 1), a2 + hstep, voffA);
            PG8_WAIT_L(8); PG8_BAR; PG8_WAIT_L(0); PG8_MMA(0, 0, At, B0); PG8_BAR; PG8_SCHED;
            PG8_LDB(B1, 1, 1); PG8_STAGE(PG8_SB(1, 0), b3, voffB);
            PG8_BAR; PG8_WAIT_L(0); PG8_MMA(0, 1, At, B1); PG8_BAR;
            PG8_LDA(At, 1, 1); PG8_STAGE(PG8_SA(1, 0), a3, voffA);
            PG8_BAR; PG8_WAIT_L(0); PG8_MMA(1, 0, At, B0); PG8_BAR; PG8_SCHED;
            PG8_STAGE(PG8_SB(1, 1), b3 + hstep, voffB);
            PG8_WAIT_V(6); PG8_BAR; PG8_MMA(1, 1, At, B1); PG8_BAR;
            }
        }
        if constexpr (ALIGN_EPI) { if (wr == 0) PG8_BAR; }
        if constexpr (!Epi::AFTER_DRAIN) { E(acc, cur, wr, wc, fr, fq); S.done(cur); }
        if (!has_next) break;
#pragma unroll
        for (int a = 0; a < 2; ++a)
#pragma unroll
            for (int b = 0; b < 2; ++b)
#pragma unroll
                for (int m = 0; m < 4; ++m)
#pragma unroll
                    for (int n = 0; n < 2; ++n) acc[a][b][m][n] = (f32x4){0.f, 0.f, 0.f, 0.f};
        cur = nxt; cA = nA; cB = nB; ++ui;
        if constexpr (ALIGN_EPI) { if (wr == 1) PG8_BAR; }
    }
    PG8_WAIT_V(0);
    if constexpr (!ALIGN_EPI) { if (wr == 0) PG8_BAR; }
    PG8_BAR;
    if constexpr (Epi::AFTER_DRAIN) { E.fused(acc, cur, wr, wc, fr, fq, lds, wid, lane); S.done(cur); }
#undef PG8_SA
#undef PG8_SB
#undef PG8_STAGE
#undef PG8_LDA
#undef PG8_LDB
#undef PG8_MMA
#undef PG8_WAIT_V
#undef PG8_WAIT_L
#undef PG8_BAR
#undef PG8_SCHED
}
}
#define XB_TMO      128
#define XB_XCNT(j)  (256  + 64 * (j))
#define XB_XSUB(j)  (1280 + 64 * (j))
#define XB_XGEN(j)  (2304 + 64 * (j))
#define XB_TOP      3328
#define XB_TOPGEN   3392
#define XCD_BAR_WORDS 3456
#define XB_SPIN_CAP (1u << 22)
#define LAS __attribute__((address_space(3)))

__device__ __forceinline__ unsigned xb_ld(unsigned* p)              { return __hip_atomic_load(p, __ATOMIC_RELAXED, __HIP_MEMORY_SCOPE_AGENT); }
__device__ __forceinline__ unsigned xb_add(unsigned* p, unsigned v) { return __hip_atomic_fetch_add(p, v, __ATOMIC_RELAXED, __HIP_MEMORY_SCOPE_AGENT); }
__device__ __forceinline__ unsigned xb_xcc_id() { return (unsigned)__builtin_amdgcn_s_getreg((3 << 11) | 20) & 0xFu; }
#define XB_SPIN(cond, bar) do { unsigned _sp = 0; while (cond) { __builtin_amdgcn_s_sleep(1); \
    if ((++_sp & 255u) == 0u) { if (xb_ld(&(bar)[XB_TMO])) break; if (_sp > XB_SPIN_CAP) { atomicAdd(&(bar)[XB_TMO], 1u); break; } } } } while (0)

struct XcdBarrier {
    unsigned* bar; unsigned x;
    volatile LAS unsigned* st;
};

__device__ __forceinline__ XcdBarrier xcd_barrier_post(unsigned* bar, volatile LAS unsigned* st, const bool lead) {
    XcdBarrier b; b.bar = bar; b.x = xb_xcc_id(); b.st = st;
    if (lead) (void)xb_add(&bar[XB_XCNT(b.x)], 1u);
    return b;
}
__device__ __forceinline__ void xcd_barrier_complete(unsigned* bar, unsigned x, unsigned& nloc, unsigned& nx) {
    const unsigned G = gridDim.x * gridDim.y * gridDim.z;
    unsigned sum, cnt, mine, sp = 0u;
    for (;;) {
        sum = 0u; cnt = 0u; mine = 0u;
#pragma unroll
        for (unsigned j = 0; j < 16; ++j) { const unsigned c = xb_ld(&bar[XB_XCNT(j)]); sum += c; cnt += (c > 0u) ? 1u : 0u; mine = (j == x) ? c : mine; }
        if (sum == G) break;
        __builtin_amdgcn_s_sleep(1);
        if ((++sp & 255u) == 0u) { if (xb_ld(&bar[XB_TMO])) break; if (sp > XB_SPIN_CAP) { atomicAdd(&bar[XB_TMO], 1u); break; } }
    }
    nloc = mine > 0u ? mine : 1u; nx = cnt > 0u ? cnt : 1u;
}

__device__ __forceinline__ void xcd_barrier(const XcdBarrier& b, const bool lead) {
    asm volatile("s_waitcnt vmcnt(0)" ::: "memory");
    __syncthreads();
    if (lead) {
        unsigned* bar = b.bar;
        __builtin_amdgcn_s_waitcnt(0);
        unsigned nloc = b.st[0], nx = b.st[1];
        if (nloc == 0u) { xcd_barrier_complete(bar, b.x, nloc, nx); b.st[0] = nloc; b.st[1] = nx; }
        const unsigned old = xb_add(&bar[XB_XSUB(b.x)], 1u);
        const unsigned gen = old / nloc;
        if (old + 1u == (gen + 1u) * nloc) {
            __builtin_amdgcn_fence(__ATOMIC_RELEASE, "agent");
            asm volatile("s_waitcnt vmcnt(0)" ::: "memory");
            const unsigned og = xb_add(&bar[XB_TOP], 1u);
            const unsigned tg = og / nx;
            if (og + 1u == (tg + 1u) * nx) xb_add(&bar[XB_TOPGEN], 1u);
            else XB_SPIN(xb_ld(&bar[XB_TOPGEN]) == tg, bar);
            __builtin_amdgcn_fence(__ATOMIC_ACQUIRE, "agent");
            xb_add(&bar[XB_XGEN(b.x)], 1u);
            asm volatile("s_waitcnt vmcnt(0)" ::: "memory");
        } else {
            XB_SPIN(xb_ld(&bar[XB_XGEN(b.x)]) == gen, bar);
            __builtin_amdgcn_fence(__ATOMIC_ACQUIRE, "agent");
            asm volatile("s_waitcnt vmcnt(0)" ::: "memory");
        }
    }
    __syncthreads();
}

typedef unsigned short bf16_t;
typedef float f32x4 __attribute__((ext_vector_type(4)));
typedef short bf16x8 __attribute__((ext_vector_type(8)));
typedef unsigned u32x4 __attribute__((ext_vector_type(4)));
typedef unsigned u32x2 __attribute__((ext_vector_type(2)));

constexpr int D = 1024, NSEQ = 12, SEQ = 4096, NTOK = NSEQ * SEQ, DEPTH = 2;
constexpr int RWC = 1920, INC = 3456, PCW = 3072, QOFF = 2048, KOFF = 2560, DFF = 2816, UPC = 5632;
constexpr int O_WD = 1536, O_AD = 1664, O_GD = 1792;
constexpr int NT = 512, NWG = 256;
constexpr int LDS_MISC = 161792, LDS_BYTES = LDS_MISC + 1024;
constexpr size_t WS_CTL_BYTES = 65536;
constexpr int GSEQ = 4, GR = GSEQ * SEQ, NGRP = NSEQ / GSEQ;

typedef __bf16 bf16v2_t __attribute__((ext_vector_type(2)));
typedef float f32v2_t __attribute__((ext_vector_type(2)));
__device__ __forceinline__ unsigned cvtpk(float lo, float hi) { f32v2_t f = {lo, hi}; bf16v2_t b = __builtin_convertvector(f, bf16v2_t); return __builtin_bit_cast(unsigned, b); }
__device__ __forceinline__ unsigned short f2bf(float f) { return __builtin_bit_cast(unsigned short, (__bf16)f); }
__device__ __forceinline__ float bf2f(unsigned short b) { return __uint_as_float(((unsigned)b) << 16); }
__device__ __forceinline__ unsigned pk2bf(float lo, float hi) { return cvtpk(lo, hi); }
__device__ __forceinline__ float shx(float v, int m, int lane) { return __int_as_float(__builtin_amdgcn_ds_bpermute((lane ^ m) << 2, __float_as_int(v))); }
__device__ __forceinline__ float shl_(float v, int src) { return __int_as_float(__builtin_amdgcn_ds_bpermute(src << 2, __float_as_int(v))); }
__device__ __forceinline__ float wave_sum(float v, int lane) {
#pragma unroll
    for (int o = 1; o < 64; o <<= 1) v += shx(v, o, lane);
    return v;
}
__device__ __forceinline__ int olane() { unsigned z = 0u; asm volatile("" : "+s"(z)); int l = (int)__builtin_amdgcn_mbcnt_hi(~0u, __builtin_amdgcn_mbcnt_lo(~0u, z)); asm volatile("" : "+v"(l)); return l; }
__device__ __forceinline__ int otid() { return (__builtin_amdgcn_readfirstlane((int)threadIdx.x >> 6) << 6) | olane(); }
__device__ __forceinline__ float sigmoidf_(float x) { return 1.f / (1.f + expf(-x)); }

__device__ __forceinline__ void ph_prep_w(LAS unsigned char* lds, const float* __restrict__ W, int K, int Nsrc, const float* __restrict__ scale, bf16_t* __restrict__ out, int Nout, int mode, float mul) {
    const int tid0 = otid(); const int half = tid0 >> 8, t8 = tid0 & 255, tx = t8 & 31, ty = t8 >> 5;
    LAS float* tile = (LAS float*)(lds + half * 4352);
    const int ntn = Nout / 32, ntiles = ntn * (K / 32);
    for (int vb = blockIdx.x; 2 * vb < ntiles; vb += NWG) {
        const int ti = 2 * vb + half; const bool on = ti < ntiles;
        const int n0 = (ti % ntn) * 32, k0 = (ti / ntn) * 32;
        if (on) for (int i = ty; i < 32; i += 8) {
            const int n = n0 + tx, k = k0 + i; int ns = n; bool valid = true;
            if (mode == 1) { if (n < 1920) ns = n; else if (n < 2048) valid = false; else ns = n - 128; }
            if (mode == 2) ns = n + 2944;
            if (mode == 3) ns = ((n >> 7) & 1) * DFF + (n >> 8) * 128 + (n & 127);
            float v = 0.f;
            if (valid) v = W[(size_t)k * Nsrc + ns] * (scale ? scale[k] : 1.f) * mul;
            if (mode == 1) { if (n >= O_WD && n < O_WD + 128) v *= 2.88539008f; else if (n >= O_GD && n < O_GD + 128) v *= -1.44269504f; }
            tile[i * 33 + tx] = v;
        }
        __syncthreads();
        if (on) for (int i = ty; i < 32; i += 8) { const int n = n0 + i, k = k0 + tx; out[(size_t)n * K + k] = f2bf(tile[tx * 33 + i]); }
        __syncthreads();
    }
}

__device__ __forceinline__ void ph_rms_in(const float* __restrict__ xin, bf16_t* __restrict__ xb, float* __restrict__ rstd, int rows) {
    const int tid0 = otid(); const int lane = tid0 & 63;
    for (int row = blockIdx.x * 8 + (tid0 >> 6); row < rows; row += NWG * 8) {
        const f32x4* xr = (const f32x4*)(xin + (size_t)row * D);
        f32x4 v[4]; float s = 0.f;
#pragma unroll
        for (int j = 0; j < 4; ++j) { v[j] = xr[lane + 64 * j]; s += v[j].x * v[j].x + v[j].y * v[j].y + v[j].z * v[j].z + v[j].w * v[j].w; }
        s = wave_sum(s, lane);
        if (lane < 4) rstd[lane * GR + row] = (lane == 0) ? s : 0.f;
#pragma unroll
        for (int j = 0; j < 4; ++j) {
            const int c = (lane + 64 * j) * 4;
            u32x2 w; w.x = pk2bf(v[j].x, v[j].y); w.y = pk2bf(v[j].z, v[j].w);
            *(u32x2*)(xb + (size_t)row * D + c) = w;
        }
    }
}
__device__ __forceinline__ void ph_rstd(const bf16_t* __restrict__ xb, float* __restrict__ rstd, int rows) {
    const int tid0 = otid(); const int lane = tid0 & 63;
#pragma unroll 4
    for (int row = blockIdx.x * 8 + (tid0 >> 6); row < rows; row += NWG * 8) {
        const u32x4* xr = (const u32x4*)(xb + (size_t)row * D);
        float s = 0.f;
#pragma unroll
        for (int j = 0; j < 2; ++j) {
            const u32x4 q = xr[lane + 64 * j];
            const unsigned w[4] = {q.x, q.y, q.z, q.w};
#pragma unroll
            for (int k = 0; k < 4; ++k) { const float a = __uint_as_float(w[k] << 16), c = __uint_as_float(w[k] & 0xffff0000u); s += a * a + c * c; }
        }
        s = wave_sum(s, lane);
        if (lane == 0) rstd[row] = rsqrtf(s * (1.f / D) + 1e-6f);
    }
}

constexpr int RS_A = 140288, RS_B = 141312;
__device__ __forceinline__ void wg_rstd_from_slots(const float* __restrict__ ssq, int row0, LAS float* dst) {
    const int tid0 = otid();
    if (tid0 < 256) {
        const float* p = ssq + row0 + tid0;
        dst[tid0] = rsqrtf(((p[0] + p[GR]) + (p[2 * GR] + p[3 * GR])) * (1.f / D) + 1e-6f);
    }
    __syncthreads();
}

constexpr int EPI_S = 135168;
struct EpiRow {
    static constexpr bool PERM = true, AFTER_DRAIN = false, APERM = false;
    bf16_t* X; float* outf; float* ssq; LAS unsigned char* lds;
    __device__ __forceinline__ void operator()(const pg8::f32x4 (&acc)[2][2][4][2], const pg8::Unit& u, int wr, int wc, int fr, int fq) const {
        const int row0 = u.pm * 256 + wr * 64 + fr, col0 = u.pn * 256 + wc * 32 + 8 * fq;
        const unsigned off0 = (unsigned)row0 * (unsigned)D + (unsigned)col0;
        pg8::u32x4 r[2][4][2];
#pragma unroll
        for (int ai = 0; ai < 2; ++ai)
#pragma unroll
            for (int m = 0; m < 4; ++m)
#pragma unroll
                for (int bj = 0; bj < 2; ++bj) r[ai][m][bj] = *(const pg8::u32x4*)(X + off0 + (unsigned)((ai * 128 + m * 16) * D + bj * 128));
        float ss[2][4];
#pragma unroll
        for (int ai = 0; ai < 2; ++ai)
#pragma unroll
            for (int m = 0; m < 4; ++m) {
                const unsigned off = off0 + (unsigned)((ai * 128 + m * 16) * D);
                float sq = 0.f;
#pragma unroll
                for (int bj = 0; bj < 2; ++bj) {
                    const pg8::u32x4 rr = r[ai][m][bj];
                    pg8::f32x4 v0 = acc[ai][bj][m][0], v1 = acc[ai][bj][m][1];
                    v0[0] += __uint_as_float(rr.x << 16); v0[1] += __uint_as_float(rr.x & 0xffff0000u); v0[2] += __uint_as_float(rr.y << 16); v0[3] += __uint_as_float(rr.y & 0xffff0000u);
                    v1[0] += __uint_as_float(rr.z << 16); v1[1] += __uint_as_float(rr.z & 0xffff0000u); v1[2] += __uint_as_float(rr.w << 16); v1[3] += __uint_as_float(rr.w & 0xffff0000u);
                    if (outf) { *(pg8::f32x4*)(outf + off + bj * 128) = v0; *(pg8::f32x4*)(outf + off + bj * 128 + 4) = v1; }
                    else {
                        pg8::u32x4 w; w.x = pg8::cvt_pk_bf16(v0[0], v0[1]); w.y = pg8::cvt_pk_bf16(v0[2], v0[3]); w.z = pg8::cvt_pk_bf16(v1[0], v1[1]); w.w = pg8::cvt_pk_bf16(v1[2], v1[3]);
                        *(pg8::u32x4*)(X + off + bj * 128) = w;
                        const unsigned ww[4] = {w.x, w.y, w.z, w.w};
#pragma unroll
                        for (int k = 0; k < 4; ++k) { const float a = __uint_as_float(ww[k] << 16), c = __uint_as_float(ww[k] & 0xffff0000u); sq = fmaf(a, a, fmaf(c, c, sq)); }
                    }
                }
                ss[ai][m] = sq;
            }
        if (!outf) {
            const int lane_ = olane();
            LAS float* LS = (LAS float*)(lds + EPI_S);
#pragma unroll
            for (int ai = 0; ai < 2; ++ai)
#pragma unroll
                for (int m = 0; m < 4; ++m) {
                    float s = ss[ai][m];
                    s += shx(s, 16, lane_); s += shx(s, 32, lane_);
                    if (lane_ < 16) LS[wc * 256 + wr * 64 + ai * 128 + m * 16 + lane_] = s;
                }
            __syncthreads();
            const int tid_ = (wr * 4 + wc) * 64 + lane_;
            if (tid_ < 256) ssq[u.pn * GR + u.pm * 256 + tid_] = (LS[tid_] + LS[256 + tid_]) + (LS[512 + tid_] + LS[768 + tid_]);
        }
    }
};
struct EpiBf {
    static constexpr bool PERM = true, AFTER_DRAIN = false, APERM = false;
    bf16_t* O; const LAS float* rowscale; const LAS float* colscale; int ldc; int pad;
    __device__ __forceinline__ void operator()(const pg8::f32x4 (&acc)[2][2][4][2], const pg8::Unit& u, int wr, int wc, int fr, int fq) const {
        const int row0 = u.pm * 256 + wr * 64 + fr, col0 = u.pn * 256 + wc * 32 + 8 * fq;
        pg8::f32x4 cs[2][2];
#pragma unroll
        for (int bj = 0; bj < 2; ++bj)
#pragma unroll
            for (int n = 0; n < 2; ++n) cs[bj][n] = colscale ? *(const LAS pg8::f32x4*)(colscale + wc * 32 + 8 * fq + bj * 128 + 4 * n) : (pg8::f32x4){1.f, 1.f, 1.f, 1.f};
        float rsc[2][4];
#pragma unroll
        for (int ai = 0; ai < 2; ++ai)
#pragma unroll
            for (int m = 0; m < 4; ++m) rsc[ai][m] = rowscale ? rowscale[wr * 64 + fr + ai * 128 + m * 16] : 1.f;
#pragma unroll
        for (int ai = 0; ai < 2; ++ai)
#pragma unroll
            for (int m = 0; m < 4; ++m) {
                const int row = row0 + ai * 128 + m * 16; const float s = rsc[ai][m];
                bf16_t* rowp = (ldc < 0) ? O + (size_t)(col0 >> 3) * 4096 + row * 8 : O + (size_t)row * ldc + col0;
#pragma unroll
                for (int bj = 0; bj < 2; ++bj) {
                    const pg8::f32x4 v0 = acc[ai][bj][m][0] * s * cs[bj][0], v1 = acc[ai][bj][m][1] * s * cs[bj][1];
                    pg8::u32x4 w; w.x = pg8::cvt_pk_bf16(v0[0], v0[1]); w.y = pg8::cvt_pk_bf16(v0[2], v0[3]); w.z = pg8::cvt_pk_bf16(v1[0], v1[1]); w.w = pg8::cvt_pk_bf16(v1[2], v1[3]);
                    *(pg8::u32x4*)(rowp + (ldc < 0 ? bj * 16 * 4096 : bj * 128)) = w;
                }
            }
    }
};
__device__ __forceinline__ void ph_gemm(LAS unsigned char* lds, const bf16_t* A, const bf16_t* Bt, int M, int N, int K, bf16_t* X, float* outf, float* ssq) {
    pg8::Gemm g{A, Bt, M, N, K, 0}; EpiRow e{X, outf, ssq, lds};
    pg8::StaticOrder S; S.init(M, N, NWG, (int)blockIdx.x);
    pg8::gemm_phase<EpiRow, pg8::StaticOrder, true, true>(lds, g, S, e, otid());
}
__device__ __forceinline__ void ph_gemm_bf(LAS unsigned char* lds, const bf16_t* A, const bf16_t* Bt, int M, int N, int K, bf16_t* O, const LAS float* rowscale, const LAS float* colscale, int ldc) {
    pg8::Gemm g{A, Bt, M, N, K, 0}; EpiBf e{O, rowscale, colscale, ldc, 0};
    pg8::StaticOrder S; S.init(M, N, NWG, (int)blockIdx.x);
    pg8::gemm_phase<EpiBf, pg8::StaticOrder, true, true>(lds, g, S, e, otid());
}

__device__ __forceinline__ void ph_qknorm(bf16_t* __restrict__ P, const float* __restrict__ qg, const float* __restrict__ kg, int rows) {
    const int tid0 = otid(); const int lane = tid0 & 63;
    const float* gp = (lane < 32 ? qg : kg) + 16 * (lane & 3); const float gs = lane < 32 ? 0.125f * 1.44269504f : 1.f;
    float gv[16];
#pragma unroll
    for (int j = 0; j < 16; ++j) gv[j] = gp[j] * gs;
#pragma unroll 2
    for (int row = blockIdx.x * 8 + (tid0 >> 6); row < rows; row += NWG * 8) {
        bf16_t* p = P + (size_t)row * PCW + QOFF + 16 * lane;
        const u32x4 a = *(const u32x4*)p, c = *(const u32x4*)(p + 8);
        const unsigned w[8] = {a.x, a.y, a.z, a.w, c.x, c.y, c.z, c.w};
        float f[16]; float ss = 0.f;
#pragma unroll
        for (int j = 0; j < 8; ++j) { f[2 * j] = __uint_as_float(w[j] << 16); f[2 * j + 1] = __uint_as_float(w[j] & 0xffff0000u); ss += f[2 * j] * f[2 * j] + f[2 * j + 1] * f[2 * j + 1]; }
        ss += __int_as_float(__builtin_amdgcn_update_dpp(0, __float_as_int(ss), 0xB1, 0xf, 0xf, false));
        ss += __int_as_float(__builtin_amdgcn_update_dpp(0, __float_as_int(ss), 0x4E, 0xf, 0xf, false));
        const float sc = rsqrtf(ss * (1.f / 64.f) + 1e-6f);
        u32x4 o0, o1;
        o0.x = pk2bf(f[0] * sc * gv[0], f[1] * sc * gv[1]); o0.y = pk2bf(f[2] * sc * gv[2], f[3] * sc * gv[3]); o0.z = pk2bf(f[4] * sc * gv[4], f[5] * sc * gv[5]); o0.w = pk2bf(f[6] * sc * gv[6], f[7] * sc * gv[7]);
        o1.x = pk2bf(f[8] * sc * gv[8], f[9] * sc * gv[9]); o1.y = pk2bf(f[10] * sc * gv[10], f[11] * sc * gv[11]); o1.z = pk2bf(f[12] * sc * gv[12], f[13] * sc * gv[13]); o1.w = pk2bf(f[14] * sc * gv[14], f[15] * sc * gv[15]);
        *(u32x4*)p = o0; *(u32x4*)(p + 8) = o1;
    }
}
constexpr int NK_PITCH = 144, NK_BYTES = 576 * NK_PITCH, NV_BYTES = 576 * 64 * 2, L_NK = 0, L_NV = NK_BYTES, L_RPB = NK_BYTES + NV_BYTES;
static_assert(L_RPB + 15 * 32 * 4 <= LDS_MISC, "neighbourhood attention LDS map");
__device__ __forceinline__ void natten_item_lds(LAS unsigned char* lds, const LAS float* rpbl, bf16_t* __restrict__ mixb, int b, int h, int r, int g, int lo, const u32x4 q0, const u32x4 q1, int lane) {
    const int rs = min(max(r - 4, 0), 56);
    const int kc0 = (g == 0) ? 0 : (g == 1) ? 8 : (g == 2) ? 24 : 32;
    const int n = lane & 15, kq = lane >> 4;
    const int tok0 = b * SEQ;
    f32x4 sc_[16];
    const int cq = 16 * g + n, cs = min(max(cq - 8, 0), 48);
    const LAS unsigned char* kl = lds + L_NK + (unsigned)((lo * 64 + kc0 + 8 * (n >> 2) + (n & 3)) * NK_PITCH + 16 * kq);
#pragma unroll
    for (int bi = 0; bi < 16; ++bi) {
        const int i = bi >> 1, nb = bi & 1;
        const u32x4 ka = *(const LAS u32x4*)(kl + (i * 64 + 4 * nb) * NK_PITCH), kc = *(const LAS u32x4*)(kl + (i * 64 + 4 * nb) * NK_PITCH + 64);
        f32x4 acc = (f32x4){0.f, 0.f, 0.f, 0.f};
        acc = __builtin_amdgcn_mfma_f32_16x16x32_bf16(__builtin_bit_cast(bf16x8, ka), __builtin_bit_cast(bf16x8, q0), acc, 0, 0, 0);
        acc = __builtin_amdgcn_mfma_f32_16x16x32_bf16(__builtin_bit_cast(bf16x8, kc), __builtin_bit_cast(bf16x8, q1), acc, 0, 0, 0);
        const LAS float* brow = rpbl + (rs + i - r + 7) * 32;
#pragma unroll
        for (int e = 0; e < 4; ++e) {
            const int kcn = kc0 + 8 * kq + 4 * nb + e;
            const bool valid = (kcn >= cs) && (kcn < cs + 16);
            const int ci = valid ? min(max(kcn - cq + 15, 0), 30) : 31;
            float bv = brow[ci]; asm volatile("" : "+v"(bv));
            acc[e] += bv;
        }
        sc_[bi] = acc;
        if ((bi & 3) == 3) __builtin_amdgcn_sched_barrier(0);
    }
    float mx = -1e30f;
#pragma unroll
    for (int q = 0; q < 16; ++q) mx = fmaxf(fmaxf(fmaxf(mx, sc_[q][0]), fmaxf(sc_[q][1], sc_[q][2])), sc_[q][3]);
    mx = fmaxf(mx, shx(mx, 16, lane)); mx = fmaxf(mx, shx(mx, 32, lane));
    float l = 0.f;
#pragma unroll
    for (int q = 0; q < 16; ++q)
#pragma unroll
        for (int e = 0; e < 4; ++e) { const float pe = __builtin_amdgcn_exp2f(sc_[q][e] - mx); sc_[q][e] = pe; l += pe; }
    l += shx(l, 16, lane); l += shx(l, 32, lane);
    __builtin_amdgcn_sched_barrier(0);
    f32x4 o[4];
#pragma unroll
    for (int d = 0; d < 4; ++d) o[d] = (f32x4){0.f, 0.f, 0.f, 0.f};
    const LAS unsigned char* vl = lds + L_NV + (unsigned)((((lo * 64 + kc0) >> 3) + kq) * 1024 + n * 16);
#pragma unroll
    for (int i = 0; i < 8; ++i) {
        u32x4 pa; pa.x = pk2bf(sc_[2 * i][0], sc_[2 * i][1]); pa.y = pk2bf(sc_[2 * i][2], sc_[2 * i][3]); pa.z = pk2bf(sc_[2 * i + 1][0], sc_[2 * i + 1][1]); pa.w = pk2bf(sc_[2 * i + 1][2], sc_[2 * i + 1][3]);
        const bf16x8 pf = __builtin_bit_cast(bf16x8, pa);
#pragma unroll
        for (int d = 0; d < 4; ++d) {
            const u32x4 vf = *(const LAS u32x4*)(vl + i * 8192 + d * 256);
            o[d] = __builtin_amdgcn_mfma_f32_16x16x32_bf16(__builtin_bit_cast(bf16x8, vf), pf, o[d], 0, 0, 0);
        }
        if (i & 1) __builtin_amdgcn_sched_barrier(0);
    }
    const float li = 1.f / l;
    char* ob = (char*)(mixb + (size_t)(tok0 + r * 64 + 16 * g) * 1024 + 512 + h * 64);
    const unsigned oo = (unsigned)(n * 1024 + 4 * kq) * 2u;
#pragma unroll
    for (int d = 0; d < 4; ++d) *(u32x2*)(ob + oo + 32 * d) = (u32x2){pk2bf(o[d][0] * li, o[d][1] * li), pk2bf(o[d][2] * li, o[d][3] * li)};
}
__device__ __forceinline__ void ph_natten(LAS unsigned char* lds, const bf16_t* P, const bf16_t* VT, int gr, int nseq, const float* rpb, bf16_t* mixb, int wg, int nwg) {
    const int tid0 = otid(); const int lane = tid0 & 63, wave = __builtin_amdgcn_readfirstlane(tid0 >> 6);
    const int h = wg & 7, r0 = 2 * (wg >> 3), r = r0 + (wave >> 2), g = wave & 3;
    const int rsA = min(max(r0 - 4, 0), 56), lo = min(max(r - 4, 0), 56) - rsA;
    const int n = lane & 15, kq = lane >> 4;
    (void)gr; (void)nwg;
    __syncthreads();
    for (int i = tid0; i < 15 * 32; i += NT) { const int rr = i >> 5, cc = i & 31; ((LAS float*)(lds + L_RPB))[i] = (cc < 31) ? 1.44269504f * rpb[h * 15 * 31 + rr * 31 + cc] : -1e30f; }
    u32x4 pk[9], pv[9], q0, q1;
    auto issue = [&](int b) {
        const int tok0 = b * SEQ;
#pragma unroll
        for (int k = 0; k < 9; ++k) {
            const int p = tid0 + NT * k, ts = p >> 3, lr = ts >> 6, col = ts & 63;
            const int row = min(rsA + lr, 63);
            pk[k] = *(const u32x4*)((const char*)(P + (size_t)(tok0 + row * 64 + col) * PCW + KOFF + h * 64) + 16 * (p & 7));
            const int tb = p >> 6, dim = p & 63, lrv = tb >> 3, rowv = min(rsA + lrv, 63);
            pv[k] = *(const u32x4*)(VT + (size_t)(((tok0 + rowv * 64) >> 3) + (tb & 7)) * 4096 + (h * 64 + dim) * 8);
        }
        const char* qb = (const char*)(P + (size_t)(tok0 + r * 64 + 16 * g) * PCW + QOFF + h * 64) + (unsigned)(n * PCW + 8 * kq) * 2u;
        q0 = *(const u32x4*)qb; q1 = *(const u32x4*)(qb + 64);
    };
    issue(0);
    for (int b = 0; b < nseq; ++b) {
        __syncthreads();
#pragma unroll
        for (int k = 0; k < 9; ++k) {
            const int p = tid0 + NT * k;
            *(LAS u32x4*)(lds + L_NK + (p >> 3) * NK_PITCH + 16 * (p & 7)) = pk[k];
            *(LAS u32x4*)(lds + L_NV + p * 16) = pv[k];
        }
        const u32x4 cq0 = q0, cq1 = q1;
        __syncthreads();
        if (b + 1 < nseq) issue(b + 1);
        natten_item_lds(lds, (const LAS float*)(lds + L_RPB), mixb, b, h, r, g, lo, cq0, cq1, lane);
    }
}
template <int CTRL> __device__ __forceinline__ float dppf(float x) { return __int_as_float(__builtin_amdgcn_update_dpp(0, __float_as_int(x), CTRL, 0xf, 0xf, true)); }
constexpr int EPI_W = 135168, EPI_R = EPI_W + 4096;
struct EpiFfn {
    static constexpr bool PERM = true, AFTER_DRAIN = false, APERM = true;
    LAS unsigned char* lds;
    bf16_t* act; float* edge; const float* rstd; const float* cw; const float* cb;
    typedef float f32x2v __attribute__((ext_vector_type(2)));
    static __device__ __forceinline__ f32x2v ld2(const float* base, unsigned byteoff) { return *(const f32x2v*)((const char*)base + byteoff); }
    __device__ __forceinline__ void operator()(const pg8::f32x4 (&acc)[2][2][4][2], const pg8::Unit& u, int wr, int wc, int fr_in, int fq_in) const {
        const int lane_ = olane();
        const int fr = lane_ & 15, fq = lane_ >> 4; (void)fr_in; (void)fq_in;
        const unsigned g0 = (unsigned)(u.pn * 128 + wc * 32 + 8 * fq);
        {
            const int tid_ = (wr * 4 + wc) * 64 + lane_;
            LAS float* Wl = (LAS float*)(lds + EPI_W);
#pragma unroll
            for (int q = 0; q < 2; ++q) {
                const int idx = tid_ + 512 * q, k = idx >> 7, j = idx & 127;
                const float* src = ((k & 3) < 3 ? cw + (k & 3) * UPC : cb) + (k >> 2) * DFF + u.pn * 128 + j;
                Wl[idx] = *src;
            }
            __syncthreads();
        }
#pragma unroll
        for (int n = 0; n < 2; ++n) {
#pragma unroll
            for (int ai = 0; ai < 2; ++ai) {
                const int lane2 = olane();
                const int fr = lane2 & 15, fq = lane2 >> 4;
                const unsigned g0 = (unsigned)(u.pn * 128 + wc * 32 + 8 * fq);
                const LAS float* Wl = (const LAS float*)(lds + EPI_W) + (wc * 32 + 8 * fq);
                const bool isedge = (fr == 0) || (fr == 15);
                const unsigned rowbase = (unsigned)(u.pm * 256 + ai * 128 + wr * 64);
                const f32x4 rs = *(const LAS f32x4*)((const LAS float*)(lds + RS_A) + (wr * 64 + ai * 128 + 4 * fr));
                const unsigned eoff = (((rowbase >> 6) * 4 + (unsigned)(fr == 0 ? 0 : 2)) * UPC + g0 + 4 * n) * 4u;
                unsigned outp[4][2];
                const f32x4 wg0 = *(const LAS f32x4*)(Wl + 0 * 128 + 4 * n), wg1 = *(const LAS f32x4*)(Wl + 1 * 128 + 4 * n), wg2 = *(const LAS f32x4*)(Wl + 2 * 128 + 4 * n), bg4 = *(const LAS f32x4*)(Wl + 3 * 128 + 4 * n);
                const f32x4 wv0 = *(const LAS f32x4*)(Wl + 4 * 128 + 4 * n), wv1 = *(const LAS f32x4*)(Wl + 5 * 128 + 4 * n), wv2 = *(const LAS f32x4*)(Wl + 6 * 128 + 4 * n), bv4 = *(const LAS f32x4*)(Wl + 7 * 128 + 4 * n);
#pragma unroll
                for (int e = 0; e < 4; ++e) {
                    float cg[4], cv[4];
                    const float wg0e = wg0[e], wg1e = wg1[e], wg2e = wg2[e], bge = bg4[e], wv0e = wv0[e], wv1e = wv1[e], wv2e = wv2[e], bve = bv4[e];
                    {
                        float x[4];
#pragma unroll
                        for (int m = 0; m < 4; ++m) x[m] = acc[ai][0][m][n][e] * rs[m];
                        if (isedge) { *(float*)((char*)edge + eoff + 4u * e) = (fr == 0) ? x[0] : x[2]; *(float*)((char*)edge + eoff + UPC * 4u + 4u * e) = (fr == 0) ? x[1] : x[3]; }
                        const float up = dppf<0x111>(x[3]), dn = dppf<0x101>(x[0]);
                        cg[0] = fmaf(wg0e, up, fmaf(wg1e, x[0], fmaf(wg2e, x[1], bge))); cg[1] = fmaf(wg0e, x[0], fmaf(wg1e, x[1], fmaf(wg2e, x[2], bge)));
                        cg[2] = fmaf(wg0e, x[1], fmaf(wg1e, x[2], fmaf(wg2e, x[3], bge))); cg[3] = fmaf(wg0e, x[2], fmaf(wg1e, x[3], fmaf(wg2e, dn, bge)));
                    }
                    {
                        float x[4];
#pragma unroll
                        for (int m = 0; m < 4; ++m) x[m] = acc[ai][1][m][n][e] * rs[m];
                        if (isedge) { *(float*)((char*)edge + eoff + DFF * 4u + 4u * e) = (fr == 0) ? x[0] : x[2]; *(float*)((char*)edge + eoff + (UPC + DFF) * 4u + 4u * e) = (fr == 0) ? x[1] : x[3]; }
                        const float up = dppf<0x111>(x[3]), dn = dppf<0x101>(x[0]);
                        cv[0] = fmaf(wv0e, up, fmaf(wv1e, x[0], fmaf(wv2e, x[1], bve))); cv[1] = fmaf(wv0e, x[0], fmaf(wv1e, x[1], fmaf(wv2e, x[2], bve)));
                        cv[2] = fmaf(wv0e, x[1], fmaf(wv1e, x[2], fmaf(wv2e, x[3], bve))); cv[3] = fmaf(wv0e, x[2], fmaf(wv1e, x[3], fmaf(wv2e, dn, bve)));
                    }
#pragma unroll
                    for (int m = 0; m < 4; ++m) {
                        const float o = (cg[m] * cv[m]) * __builtin_amdgcn_rcpf(1.f + __builtin_amdgcn_exp2f(-1.44269504f * cg[m]));
                        outp[m][e >> 1] = (e & 1) ? cvtpk(__uint_as_float(outp[m][e >> 1]), o) : __float_as_uint(o);
                    }
                    __builtin_amdgcn_sched_barrier(0);
                }
#pragma unroll
                for (int m = 0; m < 4; ++m) {
                    const unsigned rib = 4 * (unsigned)fr + m;
                    if (rib != 0 && rib != 63) *(u32x2*)((char*)act + ((rowbase + rib) * DFF + g0 + 4 * n) * 2u) = (u32x2){outp[m][0], outp[m][1]};
                }
                asm volatile("" ::: "memory");
            }
        }
    }
};
__device__ __forceinline__ void ph_gemm_ffn(LAS unsigned char* lds, const bf16_t* A, const bf16_t* Bt, int M, bf16_t* act, float* edge, const float* rstd, const float* cw, const float* cb) {
    pg8::Gemm g{A, Bt, M, UPC, D, 0}; EpiFfn e{lds, act, edge, rstd, cw, cb};
    pg8::StaticOrder S; S.init(M, UPC, NWG, (int)blockIdx.x);
    pg8::gemm_phase<EpiFfn, pg8::StaticOrder, true, true>(lds, g, S, e, otid());
}
__device__ __forceinline__ void ph_ffn_fix(const float* __restrict__ edge, const float* __restrict__ cw, const float* __restrict__ cb, bf16_t* __restrict__ act, int rows) {
    typedef float f2 __attribute__((ext_vector_type(2)));
    const int tid0 = otid(); const int nb = rows / 64;
    constexpr int CP = DFF / 2;
    const int total = 2 * nb * CP;
#pragma unroll 3
    for (int p = blockIdx.x * NT + tid0; p < total; p += NWG * NT) {
        const int it = p / CP, c = 2 * (p - it * CP);
        const int blk = it >> 1, last = it & 1;
        const int row = blk * 64 + (last ? 63 : 0), t = row & (SEQ - 1);
        const float* cur = edge + ((size_t)blk * 4 + (last ? 3 : 0)) * UPC;
        const bool hp = last ? true : (t > 0), hn = last ? (t < SEQ - 1) : true;
        const float* prv = last ? edge + ((size_t)blk * 4 + 2) * UPC : edge + ((size_t)(hp ? blk - 1 : blk) * 4 + 3) * UPC;
        const float* nxt = last ? edge + ((size_t)(hn ? blk + 1 : blk) * 4 + 0) * UPC : edge + ((size_t)blk * 4 + 1) * UPC;
        const f2 w0g = *(const f2*)(cw + c), w1g = *(const f2*)(cw + UPC + c), w2g = *(const f2*)(cw + 2 * UPC + c), bg = *(const f2*)(cb + c);
        const f2 w0v = *(const f2*)(cw + DFF + c), w1v = *(const f2*)(cw + UPC + DFF + c), w2v = *(const f2*)(cw + 2 * UPC + DFF + c), bv = *(const f2*)(cb + DFF + c);
        const f2 cg = *(const f2*)(cur + c), cv = *(const f2*)(cur + DFF + c);
        f2 pg = *(const f2*)(prv + c), pv = *(const f2*)(prv + DFF + c), ng = *(const f2*)(nxt + c), nv = *(const f2*)(nxt + DFF + c);
        if (!hp) { pg = (f2){0.f, 0.f}; pv = pg; }
        if (!hn) { ng = (f2){0.f, 0.f}; nv = ng; }
        const f2 g = w1g * cg + bg + w0g * pg + w2g * ng, v = w1v * cv + bv + w0v * pv + w2v * nv;
        const float o0 = g[0] * sigmoidf_(g[0]) * v[0], o1 = g[1] * sigmoidf_(g[1]) * v[1];
        *(unsigned*)(act + (size_t)row * DFF + c) = cvtpk(o0, o1);
    }
}

constexpr int NSEG = 4, SEGTOK = SEQ / NSEG;
constexpr int OP_AP = 0, OP_RP = 2048, OP_MX2 = 4096, OP_MD = 5120, OP_MY = 6144, OP_GP = 7168, OP_VT = 11264, OP_GC = 13312, OP_SIZE = 13568;
constexpr int LS_OPS = 0, LS_LABT = 8 * OP_SIZE, LS_MU = LS_LABT + 8 * 1024, LS_CST = LS_MU + 3 * 7 * 64 * 4, LS_WL = LS_CST + 6 * 64 * 4, LS_EOF = LS_WL + 36 * 1024, LS_END = LS_EOF + 1024;
constexpr int WL_DEC = 0, WL_AAA = 8 * 1024, WL_VU = 16 * 1024, WL_G = 20 * 1024;
static_assert(LS_END <= LDS_MISC, "scan unit LDS map");

template <int CTRL> __device__ __forceinline__ float dpp_mov(float x) { return __int_as_float(__builtin_amdgcn_update_dpp(0, __float_as_int(x), CTRL, 0xf, 0xf, false)); }
template <int CTRL> __device__ __forceinline__ unsigned dpp_keep(unsigned old, unsigned src) { return (unsigned)__builtin_amdgcn_update_dpp((int)old, (int)src, CTRL, 0xf, 0xf, false); }
__device__ __forceinline__ float fsig(float z) { return __builtin_amdgcn_rcpf(1.f + __builtin_amdgcn_exp2f(z)); }
__device__ __forceinline__ float ftanh(float z) { return 1.f - 2.f * __builtin_amdgcn_rcpf(1.f + __builtin_amdgcn_exp2f(z)); }
__device__ __forceinline__ f32v2_t bfpair(unsigned u) { return (f32v2_t){__uint_as_float(u << 16), __uint_as_float(u & 0xffff0000u)}; }
__device__ __forceinline__ u32x4 pack8(const float* v) { u32x4 r; r.x = cvtpk(v[0], v[1]); r.y = cvtpk(v[2], v[3]); r.z = cvtpk(v[4], v[5]); r.w = cvtpk(v[6], v[7]); return r; }

struct ScanW {
    const float *mu, *w0, *a0, *v0, *kk_, *ka, *rk;
    const bf16_t *WdecT, *WaaaT, *WgT, *WvuT;
};

template <int NKS> __device__ __forceinline__ void lora_mm(const LAS unsigned char* wl, const u32x4 (&xf)[NKS], float (&out)[16]) {
#pragma unroll
    for (int nb = 0; nb < 4; ++nb) {
        f32x4 acc = (f32x4){0.f, 0.f, 0.f, 0.f};
#pragma unroll
        for (int ks = 0; ks < NKS; ++ks)
            acc = __builtin_amdgcn_mfma_f32_16x16x32_bf16(*(const LAS bf16x8*)(wl + (nb * NKS + ks) * 1024), __builtin_bit_cast(bf16x8, xf[ks]), acc, 0, 0, 0);
        out[4 * nb + 0] = acc[0]; out[4 * nb + 1] = acc[1]; out[4 * nb + 2] = acc[2]; out[4 * nb + 3] = acc[3];
    }
}

template <int V> struct IC { static constexpr int value = V; };
template <int N> __device__ __forceinline__ unsigned edge_lo(unsigned v) { if constexpr (N == 0) return v; else return (unsigned)__builtin_amdgcn_update_dpp(0, (int)v, 0x100 + N, 0xf, 0xf, true); }
template <int N> __device__ __forceinline__ unsigned edge_hi(unsigned v) { if constexpr (N == 0) return v; else return (unsigned)__builtin_amdgcn_update_dpp(0, (int)v, 0x110 + N, 0xf, 0xf, true); }
__device__ __forceinline__ void scan_unit(LAS unsigned char* lds, int unit, int layer, const bf16_t* __restrict__ P, const ScanW& w,
                                          bf16_t* __restrict__ ybuf, bf16_t* __restrict__ gbuf, bf16_t* __restrict__ mixb, bf16_t* __restrict__ vfirst, float* __restrict__ sbon,
                                          bf16_t* __restrict__ yaug, float* __restrict__ segst) {
    const int tid = otid(), lane = tid & 63, wave = __builtin_amdgcn_readfirstlane(tid >> 6);
    const int seg = unit & (NSEG - 1), chain = unit / NSEG;
    const int h = chain & 7, dir = (chain >> 3) & 1, b = chain >> 4;
    const int tokbase = b * SEQ;
    const int t = lane & 15, kq = lane >> 4;
    auto segcol = [&](int s_) { return s_ < 3 ? s_ * 512 + h * 64 : s_ == 3 ? O_WD + dir * 64 : s_ == 4 ? O_AD + dir * 64 : O_GD + (s_ - 5) * 64; };
    for (int i = tid; i < 3 * 7 * 64; i += NT) {
        const int m = i / 448, r = i % 448, sg = r >> 6, c = r & 63; const int col = segcol(sg) + c;
        ((LAS float*)(lds + LS_MU))[i] = (m < 2) ? w.mu[(m ^ dir) * RWC + col] : 1.f - w.mu[col] - w.mu[RWC + col];
    }
    if (tid < 384) {
        const int which = tid >> 6, ch = h * 64 + (tid & 63);
        const float v = (which == 0) ? w.kk_[ch] : (which == 1) ? w.ka[ch] : (which == 2) ? w.rk[ch] : (which == 3) ? w.w0[dir * 512 + ch] : (which == 4) ? w.a0[dir * 512 + ch] : ((layer > 0) ? w.v0[ch] : 0.f);
        ((LAS float*)(lds + LS_CST))[tid] = (which >= 3) ? -1.44269504f * v : v;
    }
    for (int i = tid; i < 36 * 64; i += NT) {
        const int f = i >> 6, n = i & 15, q = (i >> 4) & 3;
        const bf16_t* src; int Kw, nb, ks;
        if (f < 8)       { src = w.WdecT + (size_t)dir * 512 * 64; Kw = 64; nb = f >> 1; ks = f & 1; }
        else if (f < 16) { src = w.WaaaT + (size_t)dir * 512 * 64; Kw = 64; nb = (f - 8) >> 1; ks = f & 1; }
        else if (f < 20) { src = w.WvuT; Kw = 32; nb = f - 16; ks = 0; }
        else             { src = w.WgT; Kw = 128; nb = (f - 20) >> 2; ks = (f - 20) & 3; }
        const bf16_t* p = src + (h * 64 + 16 * nb + n) * Kw + 32 * ks + 4 * q;
        const u32x2 lo = *(const u32x2*)p, hi = *(const u32x2*)(p + 16);
        *(LAS u32x4*)(lds + LS_WL + i * 16) = (u32x4){lo.x, lo.y, hi.x, hi.y};
    }
    __syncthreads();

    f32x4 St[4];
    const bool augw = wave >= 4; const int colw = 16 * (wave & 3) + t;
#pragma unroll
    for (int jb = 0; jb < 4; ++jb)
#pragma unroll
        for (int e = 0; e < 4; ++e) St[jb][e] = (augw && (16 * jb + 4 * kq + e) == colw) ? 1.f : 0.f;

    const char* Pc = (const char*)P;
    u32x2 rc[7][4], fz[3][2], EL[2], EH[2];
    const int colLo = dir ? 1984 : 1952, colHi = dir ? 1952 : 1984;
    auto piece_col = [&](int p, int foldcol) { const int sg = p >> 2, g = p & 3; return (p < 28 ? segcol(sg) + 16 * g : foldcol + 16 * (p & 1)) * 2 + 8 * kq; };
    if (tid < 64) *(LAS u32x4*)(lds + LS_EOF + tid * 16) = (u32x4){(unsigned)piece_col(t, colLo), (unsigned)piece_col((t + 16) & 31, colLo), (unsigned)piece_col(15 - t, colHi), (unsigned)piece_col(31 - t, colHi)};
    auto issue_loads = [&](int it_) {
        const int gb = seg * (SEGTOK / 16) + it_ * 8 + wave;
        const int st = 16 * gb + t;
        const int tok = dir ? (SEQ - 1 - st) : st;
        const unsigned ro = (unsigned)(tokbase + tok) * (unsigned)(PCW * 2) + 8u * kq;
        const int sL = 16 * gb - 1, sH = 16 * gb + 16;
        const bool vL_ = gb > 0, vH_ = gb < SEQ / 16 - 1;
        const int tL = vL_ ? (dir ? (SEQ - 1 - sL) : sL) : 0, tH = vH_ ? (dir ? (SEQ - 1 - sH) : sH) : 0;
        const unsigned rl = (unsigned)(tokbase + tL) * (unsigned)(PCW * 2), rh = (unsigned)(tokbase + tH) * (unsigned)(PCW * 2);
#pragma unroll
        for (int sg = 0; sg < 7; ++sg) {
            if (sg >= 5 && (it_ & 1)) continue;
            const int col = segcol(sg);
#pragma unroll
            for (int g = 0; g < 4; ++g) rc[sg][g] = *(const u32x2*)(Pc + ro + col * 2 + 32 * g);
        }
        const u32x4 eo4 = *(const LAS u32x4*)(lds + LS_EOF + lane * 16);
        const unsigned zo_ = 2016u * 2u + 8u * (unsigned)(lane & 3);
        EL[0] = *(const u32x2*)(Pc + (rl + (vL_ ? eo4.x : zo_))); EL[1] = *(const u32x2*)(Pc + (rl + (vL_ ? eo4.y : zo_)));
        EH[0] = *(const u32x2*)(Pc + (rh + (vH_ ? eo4.z : zo_))); EH[1] = *(const u32x2*)(Pc + (rh + (vH_ ? eo4.w : zo_)));
        if (layer > 0) {
#pragma unroll
            for (int g = 0; g < 2; ++g) { fz[0][g] = *(const u32x2*)(Pc + ro + 1920 * 2 + 32 * g); fz[1][g] = *(const u32x2*)(Pc + ro + colLo * 2 + 32 * g); fz[2][g] = *(const u32x2*)(Pc + ro + colHi * 2 + 32 * g); }
        }
    };
#pragma unroll
    for (int sg = 0; sg < 7; ++sg)
#pragma unroll
        for (int g = 0; g < 4; ++g) rc[sg][g] = (u32x2){0u, 0u};
#pragma unroll
    for (int g = 0; g < 2; ++g) { fz[0][g] = fz[1][g] = fz[2][g] = (u32x2){0u, 0u}; }
    __syncthreads();
    issue_loads(0);
    for (int it = 0; it < SEGTOK / 128; ++it) {
        {
            if (wave >= 4) __builtin_amdgcn_s_sleep(3);
            int lane_o = lane; asm volatile("" : "+v"(lane_o));
            const int t = lane_o & 15, kq = lane_o >> 4;
            const LAS unsigned char* WL = lds + LS_WL + lane_o * 16;
            const LAS float* MU = (const LAS float*)(lds + LS_MU) + 4 * kq;
            const LAS float* CST = (const LAS float*)(lds + LS_CST) + 4 * kq;
            LAS unsigned char* myop = lds + LS_OPS + wave * OP_SIZE;
            LAS float* labt = (LAS float*)(lds + LS_LABT + wave * 1024);
            const int lane = lane_o;
            const int gb = seg * (SEGTOK / 16) + it * 8 + wave;
            const int st = 16 * gb + t;
            const int tok = dir ? (SEQ - 1 - st) : st;
            const unsigned grow = (unsigned)(tokbase + tok);
            u32x2 vf[4];
#pragma unroll
            for (int g = 0; g < 4; ++g) vf[g] = (u32x2){0u, 0u};
            if (layer > 0) {
#pragma unroll
                for (int g = 0; g < 4; ++g) vf[g] = *(const u32x2*)((const char*)vfirst + (grow * 1024u + (unsigned)((h * 64 + 16 * g + 4 * kq) * 2)));
            }
            auto seg_mix = [&](auto sgc, float (&out)[16]) {
                constexpr int sg = decltype(sgc)::value;
                auto grp = [&](auto gc) {
                    constexpr int g = decltype(gc)::value, p = 4 * sg + g, n = p & 15, j = p >> 4;
                    const u32x2 c = rc[sg][g];
                    const unsigned elx = edge_lo<n>(EL[j].x), ely = edge_lo<n>(EL[j].y), ehx = edge_hi<n>(EH[j].x), ehy = edge_hi<n>(EH[j].y);
                    const f32x4 ml = *(const LAS f32x4*)(MU + sg * 64 + 16 * g), mh = *(const LAS f32x4*)(MU + 448 + sg * 64 + 16 * g), m0 = *(const LAS f32x4*)(MU + 896 + sg * 64 + 16 * g);
                    {
                        const f32v2_t cc = bfpair(c.x), lo = bfpair(dpp_keep<0x111>(elx, c.x)), hi = bfpair(dpp_keep<0x101>(ehx, c.x));
                        const f32v2_t v = (f32v2_t){m0[0], m0[1]} * cc + (f32v2_t){ml[0], ml[1]} * lo + (f32v2_t){mh[0], mh[1]} * hi;
                        out[4 * g + 0] = v[0]; out[4 * g + 1] = v[1];
                    }
                    {
                        const f32v2_t cc = bfpair(c.y), lo = bfpair(dpp_keep<0x111>(ely, c.y)), hi = bfpair(dpp_keep<0x101>(ehy, c.y));
                        const f32v2_t v = (f32v2_t){m0[2], m0[3]} * cc + (f32v2_t){ml[2], ml[3]} * lo + (f32v2_t){mh[2], mh[3]} * hi;
                        out[4 * g + 2] = v[0]; out[4 * g + 3] = v[1];
                    }
                };
                grp(IC<0>{}); grp(IC<1>{}); grp(IC<2>{}); grp(IC<3>{});
            };
            auto cst16 = [&](int which, float (&out)[16]) {
#pragma unroll
                for (int g = 0; g < 4; ++g) { const f32x4 v = *(const LAS f32x4*)(CST + which * 64 + 16 * g); out[4 * g] = v[0]; out[4 * g + 1] = v[1]; out[4 * g + 2] = v[2]; out[4 * g + 3] = v[3]; }
            };
            u32x4 selE, selO;
            {
                const unsigned wv = (kq == (t >> 2)) ? (0x3F80u << (16 * (t & 1))) : 0u;
                const unsigned w0_ = (t & 2) ? 0u : wv, w1_ = (t & 2) ? wv : 0u;
                selE = (u32x4){w0_, w1_, 0u, 0u}; selO = (u32x4){0u, 0u, w0_, w1_};
            }
            if ((it & 1) == 0) {
                float g0[16], g1[16]; seg_mix(IC<5>{}, g0); seg_mix(IC<6>{}, g1);
#pragma unroll
                for (int i = 0; i < 16; ++i) { g0[i] = fsig(g0[i]); g1[i] = fsig(g1[i]); }
                u32x4 xf[4]; xf[0] = pack8(g0); xf[1] = pack8(g0 + 8); xf[2] = pack8(g1); xf[3] = pack8(g1 + 8);
                float go[16]; lora_mm<4>(WL + WL_G, xf, go);
#pragma unroll
                for (int g = 0; g < 4; ++g) *(u32x2*)((char*)gbuf + (grow * 1024u + (unsigned)((h * 64 + 16 * g + 4 * kq) * 2))) = (u32x2){cvtpk(go[4 * g], go[4 * g + 1]), cvtpk(go[4 * g + 2], go[4 * g + 3])};
            }
            float kv[16], kk[16];
            seg_mix(IC<1>{}, kv);
            {
                float c_[16]; cst16(0, c_);
                float ss = 0.f;
#pragma unroll
                for (int i = 0; i < 16; ++i) { kk[i] = kv[i] * c_[i]; ss += kk[i] * kk[i]; }
                ss += shx(ss, 16, lane); ss += shx(ss, 32, lane);
                const float rn = __builtin_amdgcn_rsqf(fmaxf(ss, 1e-12f));
#pragma unroll
                for (int i = 0; i < 16; ++i) kk[i] *= rn;
            }
            float kd[16], bb[16];
            {
                float ain[16]; seg_mix(IC<4>{}, ain);
                u32x4 xf[2]; xf[0] = pack8(ain); xf[1] = pack8(ain + 8);
                float xa[16]; lora_mm<2>(WL + WL_AAA, xf, xa);
                float a0c[16], kac[16]; cst16(4, a0c); cst16(1, kac);
#pragma unroll
                for (int i = 0; i < 16; ++i) { const float a = fsig(xa[i] + a0c[i]); kd[i] = kv[i] * (1.f + (a - 1.f) * kac[i]); bb[i] = kk[i] * a; }
            }
            float rv[16];
            seg_mix(IC<0>{}, rv);
            {
                float rkc[16]; cst16(2, rkc);
                float bon = 0.f;
#pragma unroll
                for (int i = 0; i < 16; ++i) bon += rv[i] * kd[i] * rkc[i];
                bon += shx(bon, 16, lane); bon += shx(bon, 32, lane);
                if (kq == 0) *(float*)((char*)sbon + (grow * 64u + (unsigned)((dir * 8 + h) * 4))) = bon;
            }
            {
                float vv[16]; seg_mix(IC<2>{}, vv);
                if (layer > 0) {
                    float hid[8];
                    {
                        const u32x2 z0 = fz[0][0], cl = fz[1][0], ch_ = fz[2][0];
                        const f32v2_t s0 = bfpair(z0.x) + bfpair(dpp_keep<0x111>(edge_lo<12>(EL[1].x), cl.x)) + bfpair(dpp_keep<0x101>(edge_hi<12>(EH[1].x), ch_.x));
                        const f32v2_t s1 = bfpair(z0.y) + bfpair(dpp_keep<0x111>(edge_lo<12>(EL[1].y), cl.y)) + bfpair(dpp_keep<0x101>(edge_hi<12>(EH[1].y), ch_.y));
                        hid[0] = s0[0]; hid[1] = s0[1]; hid[2] = s1[0]; hid[3] = s1[1];
                    }
                    {
                        const u32x2 z0 = fz[0][1], cl = fz[1][1], ch_ = fz[2][1];
                        const f32v2_t s0 = bfpair(z0.x) + bfpair(dpp_keep<0x111>(edge_lo<13>(EL[1].x), cl.x)) + bfpair(dpp_keep<0x101>(edge_hi<13>(EH[1].x), ch_.x));
                        const f32v2_t s1 = bfpair(z0.y) + bfpair(dpp_keep<0x111>(edge_lo<13>(EL[1].y), cl.y)) + bfpair(dpp_keep<0x101>(edge_hi<13>(EH[1].y), ch_.y));
                        hid[4] = s0[0]; hid[5] = s0[1]; hid[6] = s1[0]; hid[7] = s1[1];
                    }
                    u32x4 xf[1]; xf[0] = pack8(hid);
                    float xm[16]; lora_mm<1>(WL + WL_VU, xf, xm);
                    float v0c[16]; cst16(5, v0c);
#pragma unroll
                    for (int g = 0; g < 4; ++g) {
                        const f32v2_t f0 = bfpair(vf[g].x), f1 = bfpair(vf[g].y);
                        vv[4 * g + 0] += (f0[0] - vv[4 * g + 0]) * fsig(xm[4 * g + 0] + v0c[4 * g + 0]); vv[4 * g + 1] += (f0[1] - vv[4 * g + 1]) * fsig(xm[4 * g + 1] + v0c[4 * g + 1]);
                        vv[4 * g + 2] += (f1[0] - vv[4 * g + 2]) * fsig(xm[4 * g + 2] + v0c[4 * g + 2]); vv[4 * g + 3] += (f1[1] - vv[4 * g + 3]) * fsig(xm[4 * g + 3] + v0c[4 * g + 3]);
                    }
                }
                u32x4 vp[2]; vp[0] = pack8(vv); vp[1] = pack8(vv + 8);
                if (dir == 1) {
                    const unsigned pv[8] = {vp[0].x, vp[0].y, vp[0].z, vp[0].w, vp[1].x, vp[1].y, vp[1].z, vp[1].w};
#pragma unroll
                    for (int g = 0; g < 4; ++g) {
                        const u32x2 q = (u32x2){pv[2 * g], pv[2 * g + 1]};
                        *(u32x2*)((char*)mixb + (grow * 2048u + (unsigned)((h * 64 + 16 * g + 4 * kq) * 2))) = q;
                        if (layer == 0) *(u32x2*)((char*)vfirst + (grow * 1024u + (unsigned)((h * 64 + 16 * g + 4 * kq) * 2))) = q;
                    }
                }
#pragma unroll
                for (int ib = 0; ib < 4; ++ib) {
                    const f32x4 z = (f32x4){0.f, 0.f, 0.f, 0.f};
                    const f32x4 d = __builtin_amdgcn_mfma_f32_16x16x32_bf16(__builtin_bit_cast(bf16x8, vp[ib >> 1]), __builtin_bit_cast(bf16x8, (ib & 1) ? selO : selE), z, 0, 0, 0);
                    *(LAS u32x2*)(myop + OP_VT + (ib * 64 + lane) * 8) = (u32x2){cvtpk(d[0], d[1]), cvtpk(d[2], d[3])};
                }
            }
            u32x4 apf[2], rpf[2], btf[2], ktf[2], bgf[2], kgf[2];
            {
                float lw[16];
                {
                    float win[16]; seg_mix(IC<3>{}, win);
#pragma unroll
                    for (int i = 0; i < 16; ++i) win[i] = ftanh(win[i]);
                    u32x4 xf[2]; xf[0] = pack8(win); xf[1] = pack8(win + 8);
                    float xw[16]; lora_mm<2>(WL + WL_DEC, xf, xw);
                    float w0c[16]; cst16(3, w0c);
#pragma unroll
                    for (int i = 0; i < 16; ++i) lw[i] = -0.87503878f * fsig(xw[i] + w0c[i]);
                }
                float at[16], rt[16], bt[16], kt[16], bg[16], kg[16], gC[16];
#pragma unroll
                for (int i = 0; i < 16; ++i) {
                    float lam = lw[i];
                    lam += dpp_mov<0x111>(lam); lam += dpp_mov<0x112>(lam); lam += dpp_mov<0x114>(lam); lam += dpp_mov<0x118>(lam);
                    const float e3 = __builtin_amdgcn_exp2f(lam), e2 = __builtin_amdgcn_exp2f(-lam);
                    const float g = shl_(e3, (lane & 48) | 15);
                    const float e1 = __int_as_float(__builtin_amdgcn_update_dpp(0x3f800000, __float_as_int(e3), 0x111, 0xf, 0xf, false));
                    const float ge = g * e2;
                    gC[i] = g; at[i] = kk[i] * e1; rt[i] = rv[i] * e3; bt[i] = bb[i] * e2; kt[i] = kd[i] * e2; bg[i] = -bb[i] * ge; kg[i] = kd[i] * ge;
                }
                apf[0] = pack8(at); apf[1] = pack8(at + 8); rpf[0] = pack8(rt); rpf[1] = pack8(rt + 8); btf[0] = pack8(bt); btf[1] = pack8(bt + 8);
                ktf[0] = pack8(kt); ktf[1] = pack8(kt + 8); bgf[0] = pack8(bg); bgf[1] = pack8(bg + 8); kgf[0] = pack8(kg); kgf[1] = pack8(kg + 8);
                if (t == 0) {
#pragma unroll
                    for (int g = 0; g < 4; ++g) *(LAS f32x4*)(myop + OP_GC + (kq * 16 + 4 * g) * 4) = (f32x4){gC[4 * g], gC[4 * g + 1], gC[4 * g + 2], gC[4 * g + 3]};
                }
            }
            *(LAS u32x4*)(myop + OP_AP + lane * 16) = apf[0]; *(LAS u32x4*)(myop + OP_AP + 1024 + lane * 16) = apf[1];
            *(LAS u32x4*)(myop + OP_RP + lane * 16) = rpf[0]; *(LAS u32x4*)(myop + OP_RP + 1024 + lane * 16) = rpf[1];
            {
                f32x4 lab = (f32x4){0.f, 0.f, 0.f, 0.f}, lak = lab, lrb = lab, lrk = lab;
#pragma unroll
                for (int ks = 0; ks < 2; ++ks) {
                    lab = __builtin_amdgcn_mfma_f32_16x16x32_bf16(__builtin_bit_cast(bf16x8, btf[ks]), __builtin_bit_cast(bf16x8, apf[ks]), lab, 0, 0, 0);
                    lak = __builtin_amdgcn_mfma_f32_16x16x32_bf16(__builtin_bit_cast(bf16x8, ktf[ks]), __builtin_bit_cast(bf16x8, apf[ks]), lak, 0, 0, 0);
                    lrb = __builtin_amdgcn_mfma_f32_16x16x32_bf16(__builtin_bit_cast(bf16x8, btf[ks]), __builtin_bit_cast(bf16x8, rpf[ks]), lrb, 0, 0, 0);
                    lrk = __builtin_amdgcn_mfma_f32_16x16x32_bf16(__builtin_bit_cast(bf16x8, ktf[ks]), __builtin_bit_cast(bf16x8, rpf[ks]), lrk, 0, 0, 0);
                }
#pragma unroll
                for (int e = 0; e < 4; ++e) {
                    const int s = 4 * kq + e;
                    const bool lo = s < t, le = s <= t;
                    lab[e] = lo ? lab[e] : 0.f; lak[e] = lo ? lak[e] : 0.f; lrb[e] = le ? -lrb[e] : 0.f; lrk[e] = le ? lrk[e] : 0.f;
                    labt[s * 16 + t] = lab[e];
                }
                u32x4 mx; mx.x = 0u; mx.y = 0u; mx.z = cvtpk(lak[0], lak[1]); mx.w = cvtpk(lak[2], lak[3]);
                u32x4 my; my.x = cvtpk(lrb[0], lrb[1]); my.y = cvtpk(lrb[2], lrb[3]); my.z = cvtpk(lrk[0], lrk[1]); my.w = cvtpk(lrk[2], lrk[3]);
                *(LAS u32x4*)(myop + OP_MX2 + lane * 16) = mx; *(LAS u32x4*)(myop + OP_MY + lane * 16) = my;
            }
#pragma unroll
            for (int jb = 0; jb < 4; ++jb) {
                const f32x4 z = (f32x4){0.f, 0.f, 0.f, 0.f};
                const bf16x8 sel = __builtin_bit_cast(bf16x8, (jb & 1) ? selO : selE);
                const f32x4 d0 = __builtin_amdgcn_mfma_f32_16x16x32_bf16(__builtin_bit_cast(bf16x8, bgf[jb >> 1]), sel, z, 0, 0, 0);
                const f32x4 d1 = __builtin_amdgcn_mfma_f32_16x16x32_bf16(__builtin_bit_cast(bf16x8, kgf[jb >> 1]), sel, z, 0, 0, 0);
                u32x4 gp; gp.x = cvtpk(d0[0], d0[1]); gp.y = cvtpk(d0[2], d0[3]); gp.z = cvtpk(d1[0], d1[1]); gp.w = cvtpk(d1[2], d1[3]);
                *(LAS u32x4*)(myop + OP_GP + (jb * 64 + lane) * 16) = gp;
            }
            {
                const int s = t;
                float x[16];
#pragma unroll
                for (int q = 0; q < 16; ++q) x[q] = (q == s) ? 1.f : 0.f;
#pragma unroll
                for (int q = 0; q < 15; ++q) {
                    const f32x4 l0 = *(const LAS f32x4*)(labt + q * 16), l1 = *(const LAS f32x4*)(labt + q * 16 + 4), l2 = *(const LAS f32x4*)(labt + q * 16 + 8), l3 = *(const LAS f32x4*)(labt + q * 16 + 12);
                    const float lq[16] = {l0[0], l0[1], l0[2], l0[3], l1[0], l1[1], l1[2], l1[3], l2[0], l2[1], l2[2], l2[3], l3[0], l3[1], l3[2], l3[3]};
#pragma unroll
                    for (int r = q + 1; r < 16; ++r) x[r] -= lq[r] * x[q];
                }
                LAS bf16_t* md = (LAS bf16_t*)(myop + OP_MD) + (16 * (s >> 2)) * 8 + (s & 3);
#pragma unroll
                for (int j = 0; j < 4; ++j) {
                    const float xv = (kq == 0) ? x[j] : (kq == 1) ? x[4 + j] : (kq == 2) ? x[8 + j] : x[12 + j];
                    md[(4 * kq + j) * 8] = f2bf(xv);
                }
                { unsigned z_ = 0u; asm volatile("" : "+v"(z_)); *(LAS u32x2*)(myop + OP_MD + lane * 16 + 8) = (u32x2){z_, z_}; }
            }
        }
        __syncthreads();
        if (it + 1 < SEGTOK / 128) issue_loads(it + 1);
        int lane_c = lane; asm volatile("" : "+v"(lane_c));
#pragma unroll 1
        for (int c = 0; c < 8; ++c) {
            const int lane = lane_c, kq = lane_c >> 4, colc = 16 * (wave & 3) + (lane_c & 15);
            const LAS unsigned char* op = lds + LS_OPS + c * OP_SIZE;
            u32x2 vt = *(const LAS u32x2*)(op + OP_VT + ((wave & 3) * 64 + lane) * 8);
            if (augw) vt = (u32x2){0u, 0u};
            u32x4 sb0, sb1;
            sb0.x = cvtpk(St[0][0], St[0][1]); sb0.y = cvtpk(St[0][2], St[0][3]); sb0.z = cvtpk(St[1][0], St[1][1]); sb0.w = cvtpk(St[1][2], St[1][3]);
            sb1.x = cvtpk(St[2][0], St[2][1]); sb1.y = cvtpk(St[2][2], St[2][3]); sb1.z = cvtpk(St[3][0], St[3][1]); sb1.w = cvtpk(St[3][2], St[3][3]);
            const bf16x8 ap0 = *(const LAS bf16x8*)(op + OP_AP + lane * 16), ap1 = *(const LAS bf16x8*)(op + OP_AP + 1024 + lane * 16);
            const bf16x8 rp0 = *(const LAS bf16x8*)(op + OP_RP + lane * 16), rp1 = *(const LAS bf16x8*)(op + OP_RP + 1024 + lane * 16);
            const bf16x8 mx2 = *(const LAS bf16x8*)(op + OP_MX2 + lane * 16), mdm = *(const LAS bf16x8*)(op + OP_MD + lane * 16), mym = *(const LAS bf16x8*)(op + OP_MY + lane * 16);
            u32x4 b0v; b0v.x = 0u; b0v.y = 0u; b0v.z = vt.x; b0v.w = vt.y;
            f32x4 ax = (f32x4){0.f, 0.f, 0.f, 0.f};
            ax = __builtin_amdgcn_mfma_f32_16x16x32_bf16(mx2, __builtin_bit_cast(bf16x8, b0v), ax, 0, 0, 0);
            ax = __builtin_amdgcn_mfma_f32_16x16x32_bf16(ap0, __builtin_bit_cast(bf16x8, sb0), ax, 0, 0, 0);
            ax = __builtin_amdgcn_mfma_f32_16x16x32_bf16(ap1, __builtin_bit_cast(bf16x8, sb1), ax, 0, 0, 0);
            f32x4 ay = (f32x4){0.f, 0.f, 0.f, 0.f};
            ay = __builtin_amdgcn_mfma_f32_16x16x32_bf16(rp0, __builtin_bit_cast(bf16x8, sb0), ay, 0, 0, 0);
            ay = __builtin_amdgcn_mfma_f32_16x16x32_bf16(rp1, __builtin_bit_cast(bf16x8, sb1), ay, 0, 0, 0);
            u32x4 bx; bx.x = cvtpk(ax[0], ax[1]); bx.y = cvtpk(ax[2], ax[3]); bx.z = 0u; bx.w = 0u;
            f32x4 ad = (f32x4){0.f, 0.f, 0.f, 0.f};
            ad = __builtin_amdgcn_mfma_f32_16x16x32_bf16(mdm, __builtin_bit_cast(bf16x8, bx), ad, 0, 0, 0);
            u32x4 dv; dv.x = cvtpk(ad[0], ad[1]); dv.y = cvtpk(ad[2], ad[3]); dv.z = vt.x; dv.w = vt.y;
            ay = __builtin_amdgcn_mfma_f32_16x16x32_bf16(mym, __builtin_bit_cast(bf16x8, dv), ay, 0, 0, 0);
#pragma unroll
            for (int jb = 0; jb < 4; ++jb) {
                const f32x4 gc = *(const LAS f32x4*)(op + OP_GC + (kq * 16 + 4 * jb) * 4);
                const bf16x8 gp = *(const LAS bf16x8*)(op + OP_GP + (jb * 64 + lane) * 16);
                St[jb] = __builtin_amdgcn_mfma_f32_16x16x32_bf16(gp, __builtin_bit_cast(bf16x8, dv), St[jb] * gc, 0, 0, 0);
            }
            if (!augw || seg > 0) {
                bf16_t* yb = augw ? yaug : ybuf;
                const int sg0 = 16 * (seg * (SEGTOK / 16) + it * 8 + c) + 4 * kq;
#pragma unroll
                for (int e = 0; e < 4; ++e) { const int tk = dir ? (SEQ - 1 - (sg0 + e)) : (sg0 + e); *(bf16_t*)((char*)yb + ((unsigned)((tokbase + tk) * 2 + dir) * 1024u + (unsigned)((h * 64 + colc) * 2))) = f2bf(ay[e]); }
            }
        }
        __syncthreads();
    }
    if (seg + 1 < NSEG) {
        int lane_f = lane; asm volatile("" : "+v"(lane_f));
        const int kq = lane_f >> 4, colw = 16 * (wave & 3) + (lane_f & 15);
        float* dst = segst + ((size_t)unit * 2 + (augw ? 1 : 0)) * 4096;
#pragma unroll
        for (int jb = 0; jb < 4; ++jb)
#pragma unroll
            for (int e = 0; e < 4; ++e) dst[(16 * jb + 4 * kq + e) * 64 + colw] = St[jb][e];
    }
}

__device__ __forceinline__ void ph_segfix(LAS unsigned char* lds, const float* __restrict__ segst, bf16_t* __restrict__ SS, int nchain) {
    const int tid = otid(), j = tid >> 3, ig = tid & 7;
    LAS float* Sp = (LAS float*)lds;
    for (int chain = blockIdx.x; chain < nchain; chain += NWG) {
        float acc[8];
        for (int k = 1; k < NSEG; ++k) {
            const float* Cp = segst + ((size_t)(chain * NSEG + k - 1) * 2 + 0) * 4096 + j * 64 + 8 * ig;
            const float* Ap = segst + ((size_t)(chain * NSEG + k - 1) * 2 + 1) * 4096 + j * 64;
#pragma unroll
            for (int e = 0; e < 8; ++e) acc[e] = Cp[e];
            if (k > 1) {
                f32x4 ar[16];
#pragma unroll
                for (int q4 = 0; q4 < 16; ++q4) ar[q4] = *(const f32x4*)(Ap + 4 * q4);
#pragma unroll
                for (int q = 0; q < 64; ++q) {
                    const float a = ar[q >> 2][q & 3];
                    const f32x4 s0 = *(const LAS f32x4*)(Sp + q * 64 + 8 * ig), s1 = *(const LAS f32x4*)(Sp + q * 64 + 8 * ig + 4);
                    acc[0] += a * s0[0]; acc[1] += a * s0[1]; acc[2] += a * s0[2]; acc[3] += a * s0[3]; acc[4] += a * s1[0]; acc[5] += a * s1[1]; acc[6] += a * s1[2]; acc[7] += a * s1[3];
                }
            }
            __syncthreads();
#pragma unroll
            for (int e = 0; e < 8; ++e) { Sp[j * 64 + 8 * ig + e] = acc[e]; SS[((size_t)(chain * NSEG + k) * 64 + 8 * ig + e) * 64 + j] = f2bf(acc[e]); }
            __syncthreads();
        }
    }
}
__device__ __forceinline__ void ph_ycorr(const bf16_t* __restrict__ yaug, const bf16_t* __restrict__ SS, bf16_t* __restrict__ ybuf, int nchain) {
    const int tid = otid(), lane = tid & 63, wave = tid >> 6, il = lane & 15, kq = lane >> 4;
    constexpr int TPS = SEGTOK / 16, IPC = (NSEG - 1) * TPS;
    for (int it = blockIdx.x * 8 + wave; it < nchain * IPC; it += NWG * 8) {
        const int chain = it / IPC, r = it % IPC, seg = 1 + r / TPS, tile = r % TPS;
        const int h = chain & 7, dir = (chain >> 3) & 1, b = chain >> 4;
        const int st0 = seg * SEGTOK + 16 * tile, t0 = dir ? (SEQ - 16 - st0) : st0;
        const size_t rowbase = ((size_t)(b * SEQ + t0) * 2 + dir) * 512 + h * 64;
        const bf16x8 a0 = *(const bf16x8*)(yaug + rowbase + (size_t)il * 1024 + 8 * kq), a1 = *(const bf16x8*)(yaug + rowbase + (size_t)il * 1024 + 32 + 8 * kq);
        const bf16_t* ssp = SS + (size_t)(chain * NSEG + seg) * 4096;
#pragma unroll
        for (int nb = 0; nb < 4; ++nb) {
            const bf16x8 b0 = *(const bf16x8*)(ssp + (16 * nb + il) * 64 + 8 * kq), b1 = *(const bf16x8*)(ssp + (16 * nb + il) * 64 + 32 + 8 * kq);
            f32x4 acc = (f32x4){0.f, 0.f, 0.f, 0.f};
            acc = __builtin_amdgcn_mfma_f32_16x16x32_bf16(a0, b0, acc, 0, 0, 0);
            acc = __builtin_amdgcn_mfma_f32_16x16x32_bf16(a1, b1, acc, 0, 0, 0);
#pragma unroll
            for (int e = 0; e < 4; ++e) { bf16_t* yp = ybuf + rowbase + (size_t)(4 * kq + e) * 1024 + 16 * nb + il; *yp = f2bf(bf2f(*yp) + acc[e]); }
        }
    }
}

__device__ __forceinline__ void ph_post2(const bf16_t* __restrict__ ybuf, const bf16_t* __restrict__ gbuf, const float* __restrict__ sbon, const float* __restrict__ lg, const float* __restrict__ lb,
                                         bf16_t* __restrict__ mixb, int rows) {
    const int c = otid(), h = c >> 6, lane = c & 63;
    const float lgc = lg[c], lbc = lb[c];
    for (int t = blockIdx.x; t < rows; t += NWG) {
        const float y = bf2f(ybuf[(size_t)t * 1024 + c]) + bf2f(ybuf[(size_t)t * 1024 + 512 + c]);
        const float mu = wave_sum(y, lane) * (1.f / 64.f); const float dv = y - mu; const float var = wave_sum(dv * dv, lane) * (1.f / 64.f);
        const float yn = dv * rsqrtf(var + 64e-5f) * lgc + lbc;
        const float bon = sbon[(size_t)t * 16 + h] + sbon[(size_t)t * 16 + 8 + h];
        const float o = (yn + bon * bf2f(mixb[(size_t)t * 1024 + c])) * bf2f(gbuf[(size_t)t * 512 + c]);
        mixb[(size_t)t * 1024 + c] = f2bf(o);
    }
}

__device__ __forceinline__ void ph_fold(const float* __restrict__ win1, const float* __restrict__ g1, const float* __restrict__ mu1, const float* __restrict__ vdown, bf16_t* __restrict__ WinT1) {
    const int tid0 = otid();
    for (int idx = blockIdx.x * NT + tid0; idx < 96 * D; idx += NWG * NT) {
        const int jj = idx / D, k = idx % D, which = jj >> 5, j = jj & 31;
        const float* wr = win1 + (size_t)k * INC + 1024;
        float s = 0.f;
        for (int c = 0; c < 512; ++c) {
            const float m0 = mu1[1024 + c], m1 = mu1[RWC + 1024 + c];
            const float cf = (which == 0) ? (1.f - m0 - m1) : (which == 1) ? m0 : m1;
            s += wr[c] * cf * vdown[c * 32 + j];
        }
        WinT1[(size_t)(1920 + jj) * D + k] = f2bf(s * g1[k]);
    }
}


__device__ __forceinline__ void ph_post3(const bf16_t* __restrict__ ybuf, const bf16_t* __restrict__ yaug, const bf16_t* __restrict__ SS, const bf16_t* __restrict__ gbuf, const float* __restrict__ sbon,
                                         const float* __restrict__ lg, const float* __restrict__ lb, bf16_t* __restrict__ mixb, int nseq) {
    const int tid = otid(), lane = tid & 63, wave = tid >> 6, il = lane & 15, kq = lane >> 4;
    const int nitems = nseq * 8 * (SEQ / 16);
    for (int it = blockIdx.x * 8 + wave; it < nitems; it += NWG * 8) {
        const int tb = it % (SEQ / 16), h = (it / (SEQ / 16)) & 7, b = it / (8 * (SEQ / 16));
        const int t0 = 16 * tb;
        const size_t tokrow = (size_t)(b * SEQ + t0 + il);
        u32x2 vq_[4], gq_[4]; f32x4 g4_[4], b4_[4];
#pragma unroll
        for (int mb = 0; mb < 4; ++mb) {
            const int ch = h * 64 + 16 * mb + 4 * kq;
            g4_[mb] = *(const f32x4*)(lg + ch); b4_[mb] = *(const f32x4*)(lb + ch);
            vq_[mb] = *(const u32x2*)(mixb + tokrow * 1024 + ch); gq_[mb] = *(const u32x2*)(gbuf + tokrow * 512 + ch);
        }
        const float bon = sbon[tokrow * 16 + h] + sbon[tokrow * 16 + 8 + h];
        float y[4][4];
#pragma unroll
        for (int mb = 0; mb < 4; ++mb)
#pragma unroll
            for (int e = 0; e < 4; ++e) y[mb][e] = 0.f;
#pragma unroll
        for (int dir = 0; dir < 2; ++dir) {
            const size_t ro = (tokrow * 2 + dir) * 512 + h * 64;
#pragma unroll
            for (int mb = 0; mb < 4; ++mb) {
                const u32x2 q = *(const u32x2*)(ybuf + ro + 16 * mb + 4 * kq);
                y[mb][0] += __uint_as_float(q.x << 16); y[mb][1] += __uint_as_float(q.x & 0xffff0000u); y[mb][2] += __uint_as_float(q.y << 16); y[mb][3] += __uint_as_float(q.y & 0xffff0000u);
            }
            const int st0 = dir ? (SEQ - 16 - t0) : t0, seg = st0 / SEGTOK;
            if (seg > 0) {
                const int chain = (b * 2 + dir) * 8 + h;
                const bf16x8 y0 = *(const bf16x8*)(yaug + ro + 8 * kq), y1 = *(const bf16x8*)(yaug + ro + 32 + 8 * kq);
                const bf16_t* ssp = SS + (size_t)(chain * NSEG + seg) * 4096;
#pragma unroll
                for (int mb = 0; mb < 4; ++mb) {
                    const bf16x8 a0 = *(const bf16x8*)(ssp + (16 * mb + il) * 64 + 8 * kq), a1 = *(const bf16x8*)(ssp + (16 * mb + il) * 64 + 32 + 8 * kq);
                    f32x4 acc = (f32x4){y[mb][0], y[mb][1], y[mb][2], y[mb][3]};
                    acc = __builtin_amdgcn_mfma_f32_16x16x32_bf16(a0, y0, acc, 0, 0, 0);
                    acc = __builtin_amdgcn_mfma_f32_16x16x32_bf16(a1, y1, acc, 0, 0, 0);
                    y[mb][0] = acc[0]; y[mb][1] = acc[1]; y[mb][2] = acc[2]; y[mb][3] = acc[3];
                }
            }
        }
        float s = 0.f;
#pragma unroll
        for (int mb = 0; mb < 4; ++mb) s += (y[mb][0] + y[mb][1]) + (y[mb][2] + y[mb][3]);
        s += shx(s, 16, lane); s += shx(s, 32, lane);
        const float mu = s * (1.f / 64.f); float q2 = 0.f;
#pragma unroll
        for (int mb = 0; mb < 4; ++mb)
#pragma unroll
            for (int e = 0; e < 4; ++e) { y[mb][e] -= mu; q2 += y[mb][e] * y[mb][e]; }
        q2 += shx(q2, 16, lane); q2 += shx(q2, 32, lane);
        const float rs = rsqrtf(q2 * (1.f / 64.f) + 64e-5f);
#pragma unroll
        for (int mb = 0; mb < 4; ++mb) {
            const int ch = h * 64 + 16 * mb + 4 * kq;
            const f32x4 g4 = g4_[mb], b4 = b4_[mb];
            const u32x2 vq = vq_[mb], gq = gq_[mb];
            const float v0 = __uint_as_float(vq.x << 16), v1 = __uint_as_float(vq.x & 0xffff0000u), v2 = __uint_as_float(vq.y << 16), v3 = __uint_as_float(vq.y & 0xffff0000u);
            const float g0 = __uint_as_float(gq.x << 16), g1 = __uint_as_float(gq.x & 0xffff0000u), g2 = __uint_as_float(gq.y << 16), g3 = __uint_as_float(gq.y & 0xffff0000u);
            const float o0 = (y[mb][0] * rs * g4[0] + b4[0] + bon * v0) * g0, o1 = (y[mb][1] * rs * g4[1] + b4[1] + bon * v1) * g1;
            const float o2 = (y[mb][2] * rs * g4[2] + b4[2] + bon * v2) * g2, o3 = (y[mb][3] * rs * g4[3] + b4[3] + bon * v3) * g3;
            u32x2 o; o.x = cvtpk(o0, o1); o.y = cvtpk(o2, o3);
            *(u32x2*)(mixb + tokrow * 1024 + ch) = o;
        }
    }
}
struct Args { const float* in[27]; float* out; unsigned char* ws; };
struct WsMap { size_t ctl, WinT, WvT, WoutT, WupT, WdnT, WdecT, WaaaT, WgT, WvuT, xb, rstd, vfirst, mixb, act, P, VT, ybuf, gbuf, sbon, yaug, segst, SS, U, end; };
__host__ __device__ constexpr size_t al256(size_t x) { return (x + 255) & ~(size_t)255; }
__host__ __device__ constexpr WsMap make_map() {
    WsMap m{}; size_t off = 0;
    m.ctl = off; off += al256(WS_CTL_BYTES);
    m.WinT = off; off += al256((size_t)DEPTH * PCW * D * 2); m.WvT = off; off += al256((size_t)DEPTH * 512 * D * 2); m.WoutT = off; off += al256((size_t)DEPTH * D * D * 2);
    m.WupT = off; off += al256((size_t)DEPTH * UPC * D * 2); m.WdnT = off; off += al256((size_t)DEPTH * D * DFF * 2);
    m.WdecT = off; off += al256((size_t)DEPTH * 2 * 512 * 64 * 2); m.WaaaT = off; off += al256((size_t)DEPTH * 2 * 512 * 64 * 2); m.WgT = off; off += al256((size_t)DEPTH * 512 * 128 * 2); m.WvuT = off; off += al256((size_t)512 * 32 * 2);
    m.xb = off; off += al256((size_t)GR * D * 2); m.rstd = off; off += al256((size_t)4 * GR * 4); m.vfirst = off; off += al256((size_t)GR * 512 * 2);
    m.mixb = off; off += al256((size_t)GR * 1024 * 2); m.act = off; off += al256((size_t)GR * DFF * 2);
    m.U = off;
    m.P = off; off += al256((size_t)GR * PCW * 2); m.VT = off; off += al256((size_t)512 * GR * 2);
    m.ybuf = off; off += al256((size_t)GR * 1024 * 2); m.gbuf = off; off += al256((size_t)GR * 512 * 2); m.sbon = off; off += al256((size_t)GR * 16 * 4);
    m.yaug = off; off += al256((size_t)GR * 1024 * 2); m.segst = off; off += al256((size_t)GSEQ * 16 * NSEG * 2 * 4096 * 4); m.SS = off; off += al256((size_t)GSEQ * 16 * NSEG * 4096 * 2);
    if (off < m.U + (size_t)GR * UPC * 2) off = m.U + (size_t)GR * UPC * 2;
    m.end = off; return m;
}
constexpr WsMap WSM = make_map();

__global__ void __launch_bounds__(NT, 2) mega(Args args) {
    extern __shared__ __attribute__((aligned(16))) unsigned char lds_raw[];
    LAS unsigned char* lds = (LAS unsigned char*)lds_raw;
    asm volatile("v_mov_b32 v1, 0\n\tv_mov_b32 v2, 0\n\tv_mov_b32 v3, 0\n\tv_mov_b32 v4, 0\n\tv_mov_b32 v5, 0\n\tv_mov_b32 v6, 0\n\tv_mov_b32 v7, 0\n\tv_mov_b32 v8, 0\n\tv_mov_b32 v9, 0\n\tv_mov_b32 v10, 0\n\tv_mov_b32 v11, 0\n\tv_mov_b32 v12, 0\n\tv_mov_b32 v13, 0\n\tv_mov_b32 v14, 0\n\tv_mov_b32 v15, 0\n\tv_mov_b32 v16, 0\n\tv_mov_b32 v17, 0\n\tv_mov_b32 v18, 0\n\tv_mov_b32 v19, 0\n\tv_mov_b32 v20, 0\n\tv_mov_b32 v21, 0\n\tv_mov_b32 v22, 0\n\tv_mov_b32 v23, 0\n\tv_mov_b32 v24, 0\n\tv_mov_b32 v25, 0\n\tv_mov_b32 v26, 0\n\tv_mov_b32 v27, 0\n\tv_mov_b32 v28, 0\n\tv_mov_b32 v29, 0\n\tv_mov_b32 v30, 0\n\tv_mov_b32 v31, 0\n\tv_mov_b32 v32, 0\n\tv_mov_b32 v33, 0\n\tv_mov_b32 v34, 0\n\tv_mov_b32 v35, 0\n\tv_mov_b32 v36, 0\n\tv_mov_b32 v37, 0\n\tv_mov_b32 v38, 0\n\tv_mov_b32 v39, 0\n\tv_mov_b32 v40, 0\n\tv_mov_b32 v41, 0\n\tv_mov_b32 v42, 0\n\tv_mov_b32 v43, 0\n\tv_mov_b32 v44, 0\n\tv_mov_b32 v45, 0\n\tv_mov_b32 v46, 0\n\tv_mov_b32 v47, 0\n\tv_mov_b32 v48, 0\n\tv_mov_b32 v49, 0\n\tv_mov_b32 v50, 0\n\tv_mov_b32 v51, 0\n\tv_mov_b32 v52, 0\n\tv_mov_b32 v53, 0\n\tv_mov_b32 v54, 0\n\tv_mov_b32 v55, 0\n\tv_mov_b32 v56, 0\n\tv_mov_b32 v57, 0\n\tv_mov_b32 v58, 0\n\tv_mov_b32 v59, 0\n\tv_mov_b32 v60, 0\n\tv_mov_b32 v61, 0\n\tv_mov_b32 v62, 0\n\tv_mov_b32 v63, 0\n\tv_mov_b32 v64, 0\n\tv_mov_b32 v65, 0\n\tv_mov_b32 v66, 0\n\tv_mov_b32 v67, 0\n\tv_mov_b32 v68, 0\n\tv_mov_b32 v69, 0\n\tv_mov_b32 v70, 0\n\tv_mov_b32 v71, 0\n\tv_mov_b32 v72, 0\n\tv_mov_b32 v73, 0\n\tv_mov_b32 v74, 0\n\tv_mov_b32 v75, 0\n\tv_mov_b32 v76, 0\n\tv_mov_b32 v77, 0\n\tv_mov_b32 v78, 0\n\tv_mov_b32 v79, 0\n\tv_mov_b32 v80, 0\n\tv_mov_b32 v81, 0\n\tv_mov_b32 v82, 0\n\tv_mov_b32 v83, 0\n\tv_mov_b32 v84, 0\n\tv_mov_b32 v85, 0\n\tv_mov_b32 v86, 0\n\tv_mov_b32 v87, 0\n\tv_mov_b32 v88, 0\n\tv_mov_b32 v89, 0\n\tv_mov_b32 v90, 0\n\tv_mov_b32 v91, 0\n\tv_mov_b32 v92, 0\n\tv_mov_b32 v93, 0\n\tv_mov_b32 v94, 0\n\tv_mov_b32 v95, 0\n\tv_mov_b32 v96, 0\n\tv_mov_b32 v97, 0\n\tv_mov_b32 v98, 0\n\tv_mov_b32 v99, 0\n\tv_mov_b32 v100, 0\n\tv_mov_b32 v101, 0\n\tv_mov_b32 v102, 0\n\tv_mov_b32 v103, 0\n\tv_mov_b32 v104, 0\n\tv_mov_b32 v105, 0\n\tv_mov_b32 v106, 0\n\tv_mov_b32 v107, 0\n\tv_mov_b32 v108, 0\n\tv_mov_b32 v109, 0\n\tv_mov_b32 v110, 0\n\tv_mov_b32 v111, 0\n\tv_mov_b32 v112, 0\n\tv_mov_b32 v113, 0\n\tv_mov_b32 v114, 0\n\tv_mov_b32 v115, 0\n\tv_mov_b32 v116, 0\n\tv_mov_b32 v117, 0\n\tv_mov_b32 v118, 0\n\tv_mov_b32 v119, 0\n\tv_mov_b32 v120, 0\n\tv_mov_b32 v121, 0\n\tv_mov_b32 v122, 0\n\tv_mov_b32 v123, 0\n\tv_mov_b32 v124, 0\n\tv_mov_b32 v125, 0\n\tv_mov_b32 v126, 0\n\tv_mov_b32 v127, 0\n\tv_mov_b32 v128, 0\n\tv_mov_b32 v129, 0\n\tv_mov_b32 v130, 0\n\tv_mov_b32 v131, 0\n\tv_mov_b32 v132, 0\n\tv_mov_b32 v133, 0\n\tv_mov_b32 v134, 0\n\tv_mov_b32 v135, 0\n\tv_mov_b32 v136, 0\n\tv_mov_b32 v137, 0\n\tv_mov_b32 v138, 0\n\tv_mov_b32 v139, 0\n\tv_mov_b32 v140, 0\n\tv_mov_b32 v141, 0\n\tv_mov_b32 v142, 0\n\tv_mov_b32 v143, 0\n\tv_mov_b32 v144, 0\n\tv_mov_b32 v145, 0\n\tv_mov_b32 v146, 0\n\tv_mov_b32 v147, 0\n\tv_mov_b32 v148, 0\n\tv_mov_b32 v149, 0\n\tv_mov_b32 v150, 0\n\tv_mov_b32 v151, 0\n\tv_mov_b32 v152, 0\n\tv_mov_b32 v153, 0\n\tv_mov_b32 v154, 0\n\tv_mov_b32 v155, 0\n\tv_mov_b32 v156, 0\n\tv_mov_b32 v157, 0\n\tv_mov_b32 v158, 0\n\tv_mov_b32 v159, 0\n\tv_mov_b32 v160, 0\n\tv_mov_b32 v161, 0\n\tv_mov_b32 v162, 0\n\tv_mov_b32 v163, 0\n\tv_mov_b32 v164, 0\n\tv_mov_b32 v165, 0\n\tv_mov_b32 v166, 0\n\tv_mov_b32 v167, 0\n\tv_mov_b32 v168, 0\n\tv_mov_b32 v169, 0\n\tv_mov_b32 v170, 0\n\tv_mov_b32 v171, 0\n\tv_mov_b32 v172, 0\n\tv_mov_b32 v173, 0\n\tv_mov_b32 v174, 0\n\tv_mov_b32 v175, 0\n\tv_mov_b32 v176, 0\n\tv_mov_b32 v177, 0\n\tv_mov_b32 v178, 0\n\tv_mov_b32 v179, 0\n\tv_mov_b32 v180, 0\n\tv_mov_b32 v181, 0\n\tv_mov_b32 v182, 0\n\tv_mov_b32 v183, 0\n\tv_mov_b32 v184, 0\n\tv_mov_b32 v185, 0\n\tv_mov_b32 v186, 0\n\tv_mov_b32 v187, 0\n\tv_mov_b32 v188, 0\n\tv_mov_b32 v189, 0\n\tv_mov_b32 v190, 0\n\tv_mov_b32 v191, 0\n\tv_mov_b32 v192, 0\n\tv_mov_b32 v193, 0\n\tv_mov_b32 v194, 0\n\tv_mov_b32 v195, 0\n\tv_mov_b32 v196, 0\n\tv_mov_b32 v197, 0\n\tv_mov_b32 v198, 0\n\tv_mov_b32 v199, 0\n\tv_mov_b32 v200, 0\n\tv_mov_b32 v201, 0\n\tv_mov_b32 v202, 0\n\tv_mov_b32 v203, 0\n\tv_mov_b32 v204, 0\n\tv_mov_b32 v205, 0\n\tv_mov_b32 v206, 0\n\tv_mov_b32 v207, 0\n\tv_mov_b32 v208, 0\n\tv_mov_b32 v209, 0\n\tv_mov_b32 v210, 0\n\tv_mov_b32 v211, 0\n\tv_mov_b32 v212, 0\n\tv_mov_b32 v213, 0\n\tv_mov_b32 v214, 0\n\tv_mov_b32 v215, 0\n\tv_mov_b32 v216, 0\n\tv_mov_b32 v217, 0\n\tv_mov_b32 v218, 0\n\tv_mov_b32 v219, 0\n\tv_mov_b32 v220, 0\n\tv_mov_b32 v221, 0\n\tv_mov_b32 v222, 0\n\tv_mov_b32 v223, 0\n\tv_mov_b32 v224, 0\n\tv_mov_b32 v225, 0\n\tv_mov_b32 v226, 0\n\tv_mov_b32 v227, 0\n\tv_mov_b32 v228, 0\n\tv_mov_b32 v229, 0\n\tv_mov_b32 v230, 0\n\tv_mov_b32 v231, 0\n\tv_mov_b32 v232, 0\n\tv_mov_b32 v233, 0\n\tv_mov_b32 v234, 0\n\tv_mov_b32 v235, 0\n\tv_mov_b32 v236, 0\n\tv_mov_b32 v237, 0\n\tv_mov_b32 v238, 0\n\tv_mov_b32 v239, 0\n\tv_mov_b32 v240, 0\n\tv_mov_b32 v241, 0\n\tv_mov_b32 v242, 0\n\tv_mov_b32 v243, 0\n\ts_mov_b32 s20, 0\n\ts_mov_b32 s21, 0\n\ts_mov_b32 s22, 0\n\ts_mov_b32 s23, 0\n\ts_mov_b32 s24, 0\n\ts_mov_b32 s25, 0\n\ts_mov_b32 s26, 0\n\ts_mov_b32 s27, 0\n\ts_mov_b32 s28, 0\n\ts_mov_b32 s29, 0\n\ts_mov_b32 s30, 0\n\ts_mov_b32 s31, 0\n\ts_mov_b32 s32, 0\n\ts_mov_b32 s33, 0\n\ts_mov_b32 s34, 0\n\ts_mov_b32 s35, 0\n\ts_mov_b32 s36, 0\n\ts_mov_b32 s37, 0\n\ts_mov_b32 s38, 0\n\ts_mov_b32 s39, 0\n\ts_mov_b32 s40, 0\n\ts_mov_b32 s41, 0\n\ts_mov_b32 s42, 0\n\ts_mov_b32 s43, 0\n\ts_mov_b32 s44, 0\n\ts_mov_b32 s45, 0\n\ts_mov_b32 s46, 0\n\ts_mov_b32 s47, 0\n\ts_mov_b32 s48, 0\n\ts_mov_b32 s49, 0\n\ts_mov_b32 s50, 0\n\ts_mov_b32 s51, 0\n\ts_mov_b32 s52, 0\n\ts_mov_b32 s53, 0\n\ts_mov_b32 s54, 0\n\ts_mov_b32 s55, 0\n\ts_mov_b32 s56, 0\n\ts_mov_b32 s57, 0\n\ts_mov_b32 s58, 0\n\ts_mov_b32 s59, 0\n\ts_mov_b32 s60, 0\n\ts_mov_b32 s61, 0\n\ts_mov_b32 s62, 0\n\ts_mov_b32 s63, 0\n\ts_mov_b32 s64, 0\n\ts_mov_b32 s65, 0\n\ts_mov_b32 s66, 0\n\ts_mov_b32 s67, 0\n\ts_mov_b32 s68, 0\n\ts_mov_b32 s69, 0\n\ts_mov_b32 s70, 0\n\ts_mov_b32 s71, 0\n\ts_mov_b32 s72, 0\n\ts_mov_b32 s73, 0\n\ts_mov_b32 s74, 0\n\ts_mov_b32 s75, 0\n\ts_mov_b32 s76, 0\n\ts_mov_b32 s77, 0\n\ts_mov_b32 s78, 0\n\ts_mov_b32 s79, 0\n\ts_mov_b32 s80, 0\n\ts_mov_b32 s81, 0\n\ts_mov_b32 s82, 0\n\ts_mov_b32 s83, 0\n\ts_mov_b32 s84, 0\n\ts_mov_b32 s85, 0\n\ts_mov_b32 s86, 0\n\ts_mov_b32 s87, 0\n\ts_mov_b32 s88, 0\n\ts_mov_b32 s89, 0\n\ts_mov_b32 s90, 0\n\ts_mov_b32 s91, 0\n\ts_mov_b32 s92, 0\n\ts_mov_b32 s93, 0\n\ts_mov_b32 s94, 0\n\ts_mov_b32 s95, 0\n\ts_mov_b32 s96, 0\n\ts_mov_b32 s97, 0\n\ts_mov_b32 s98, 0\n\ts_mov_b32 s99, 0\n\t" ::: "v1", "v2", "v3", "v4", "v5", "v6", "v7", "v8", "v9", "v10", "v11", "v12", "v13", "v14", "v15", "v16", "v17", "v18", "v19", "v20", "v21", "v22", "v23", "v24", "v25", "v26", "v27", "v28", "v29", "v30", "v31", "v32", "v33", "v34", "v35", "v36", "v37", "v38", "v39", "v40", "v41", "v42", "v43", "v44", "v45", "v46", "v47", "v48", "v49", "v50", "v51", "v52", "v53", "v54", "v55", "v56", "v57", "v58", "v59", "v60", "v61", "v62", "v63", "v64", "v65", "v66", "v67", "v68", "v69", "v70", "v71", "v72", "v73", "v74", "v75", "v76", "v77", "v78", "v79", "v80", "v81", "v82", "v83", "v84", "v85", "v86", "v87", "v88", "v89", "v90", "v91", "v92", "v93", "v94", "v95", "v96", "v97", "v98", "v99", "v100", "v101", "v102", "v103", "v104", "v105", "v106", "v107", "v108", "v109", "v110", "v111", "v112", "v113", "v114", "v115", "v116", "v117", "v118", "v119", "v120", "v121", "v122", "v123", "v124", "v125", "v126", "v127", "v128", "v129", "v130", "v131", "v132", "v133", "v134", "v135", "v136", "v137", "v138", "v139", "v140", "v141", "v142", "v143", "v144", "v145", "v146", "v147", "v148", "v149", "v150", "v151", "v152", "v153", "v154", "v155", "v156", "v157", "v158", "v159", "v160", "v161", "v162", "v163", "v164", "v165", "v166", "v167", "v168", "v169", "v170", "v171", "v172", "v173", "v174", "v175", "v176", "v177", "v178", "v179", "v180", "v181", "v182", "v183", "v184", "v185", "v186", "v187", "v188", "v189", "v190", "v191", "v192", "v193", "v194", "v195", "v196", "v197", "v198", "v199", "v200", "v201", "v202", "v203", "v204", "v205", "v206", "v207", "v208", "v209", "v210", "v211", "v212", "v213", "v214", "v215", "v216", "v217", "v218", "v219", "v220", "v221", "v222", "v223", "v224", "v225", "v226", "v227", "v228", "v229", "v230", "v231", "v232", "v233", "v234", "v235", "v236", "v237", "v238", "v239", "v240", "v241", "v242", "v243", "s20", "s21", "s22", "s23", "s24", "s25", "s26", "s27", "s28", "s29", "s30", "s31", "s32", "s33", "s34", "s35", "s36", "s37", "s38", "s39", "s40", "s41", "s42", "s43", "s44", "s45", "s46", "s47", "s48", "s49", "s50", "s51", "s52", "s53", "s54", "s55", "s56", "s57", "s58", "s59", "s60", "s61", "s62", "s63", "s64", "s65", "s66", "s67", "s68", "s69", "s70", "s71", "s72", "s73", "s74", "s75", "s76", "s77", "s78", "s79", "s80", "s81", "s82", "s83", "s84", "s85", "s86", "s87", "s88", "s89", "s90", "s91", "s92", "s93", "s94", "s95", "s96", "s97", "s98", "s99");
    volatile LAS unsigned* misc = (volatile LAS unsigned*)(lds + LDS_MISC);
    if (threadIdx.x < 64) misc[threadIdx.x] = 0u;
    __syncthreads();
    XcdBarrier bar = xcd_barrier_post(((unsigned*)(args.ws + WSM.ctl)), misc + 8, otid() == 0);
#define GRID_BAR() xcd_barrier(bar, otid() == 0)
    const float* const* in = args.in;
    float* X = args.out;
    constexpr int G = NWG; const int bx = (int)blockIdx.x;

#pragma unroll 1
    for (int j = 0; j < 21; ++j) {
        const int l = (j >= 10 && j < 20) ? 1 : 0, k = (j < 20) ? j - 10 * l : 10;
        const float* W; int K_, Nsrc, Nout, mode = 0; const float* scale = nullptr; bf16_t* out; float mul = 1.f;
        if (k == 0)      { W = in[3] + (size_t)l * D * INC; K_ = D; Nsrc = INC; scale = in[2] + l * D; out = ((bf16_t*)(args.ws + WSM.WinT)) + (size_t)l * PCW * D; Nout = PCW; mode = 1; }
        else if (k == 1) { W = in[3] + (size_t)l * D * INC; K_ = D; Nsrc = INC; scale = in[2] + l * D; out = ((bf16_t*)(args.ws + WSM.WvT)) + (size_t)l * 512 * D; Nout = 512; mode = 2; }
        else if (k == 2) { W = in[21] + (size_t)l * D * D; K_ = D; Nsrc = D; out = ((bf16_t*)(args.ws + WSM.WoutT)) + (size_t)l * D * D; Nout = D; }
        else if (k == 3) { W = in[23] + (size_t)l * D * UPC; K_ = D; Nsrc = UPC; scale = in[22] + l * D; out = ((bf16_t*)(args.ws + WSM.WupT)) + (size_t)l * UPC * D; Nout = UPC; mode = 3; }
        else if (k == 4) { W = in[26] + (size_t)l * DFF * D; K_ = DFF; Nsrc = D; out = ((bf16_t*)(args.ws + WSM.WdnT)) + (size_t)l * D * DFF; Nout = D; }
        else if (k <= 6) { const int d = k - 5; W = in[6] + (size_t)(l * 2 + d) * 64 * 512; K_ = 64; Nsrc = 512; out = ((bf16_t*)(args.ws + WSM.WdecT)) + (size_t)(l * 2 + d) * 512 * 64; Nout = 512; mul = -1.44269504f; }
        else if (k <= 8) { const int d = k - 7; W = in[8] + (size_t)(l * 2 + d) * 64 * 512; K_ = 64; Nsrc = 512; out = ((bf16_t*)(args.ws + WSM.WaaaT)) + (size_t)(l * 2 + d) * 512 * 64; Nout = 512; mul = -1.44269504f; }
        else if (k == 9) { W = in[9] + (size_t)l * 128 * 512; K_ = 128; Nsrc = 512; out = ((bf16_t*)(args.ws + WSM.WgT)) + (size_t)l * 512 * 128; Nout = 512; }
        else             { W = in[12]; K_ = 32; Nsrc = 512; out = ((bf16_t*)(args.ws + WSM.WvuT)); Nout = 512; mul = -1.44269504f; }
        ph_prep_w(lds, W, K_, Nsrc, scale, out, Nout, mode, mul);
    }
    GRID_BAR();
    ph_fold(in[3] + (size_t)1 * D * INC, in[2] + D, in[4] + (size_t)1 * 2 * RWC, in[11], ((bf16_t*)(args.ws + WSM.WinT)) + (size_t)1 * PCW * D);

    for (int grp = 0; grp < NGRP; ++grp) {
        const size_t g0 = (size_t)grp * GR;
        float* Xg = X + g0 * D;
        {
            const float* xin = (g0 < (size_t)8 * SEQ) ? in[0] + g0 * D : in[1] + (g0 - (size_t)8 * SEQ) * D;
            ph_rms_in(xin, ((bf16_t*)(args.ws + WSM.xb)), ((float*)(args.ws + WSM.rstd)), GR);
        }
        GRID_BAR();
        for (int l = 0; l < DEPTH; ++l) {
            {
                pg8::StaticOrder S; pg8::Unit u0;
                S.init(GR, PCW, NWG, bx); if (S.next(0, u0)) wg_rstd_from_slots((const float*)(args.ws + WSM.rstd), u0.pm * 256, (LAS float*)(lds + RS_A));
                S.init(512, GR, NWG, bx); if (S.next(0, u0)) wg_rstd_from_slots((const float*)(args.ws + WSM.rstd), u0.pn * 256, (LAS float*)(lds + RS_B));
            }
#pragma unroll 1
            for (int k = 0; k < 2; ++k) {
                const bf16_t* xb_ = (const bf16_t*)(args.ws + WSM.xb);
                const bf16_t* wi_ = ((const bf16_t*)(args.ws + WSM.WinT)) + (size_t)l * PCW * D; const bf16_t* wv_ = ((const bf16_t*)(args.ws + WSM.WvT)) + (size_t)l * 512 * D;
                ph_gemm_bf(lds, k ? wv_ : xb_, k ? xb_ : wi_, k ? 512 : GR, k ? GR : PCW, D, k ? (bf16_t*)(args.ws + WSM.VT) : (bf16_t*)(args.ws + WSM.P),
                           k ? (const LAS float*)nullptr : (const LAS float*)(lds + RS_A), k ? (const LAS float*)(lds + RS_B) : (const LAS float*)nullptr, k ? -1 : PCW);
            }
            GRID_BAR();
            {
                ph_qknorm(((bf16_t*)(args.ws + WSM.P)), in[18] + l * 64, in[19] + l * 64, GR);
                constexpr int NUNITS = GSEQ * 16 * NSEG;
                if (bx < NUNITS) {
                    ScanW w;
                    w.mu = in[4] + (size_t)l * 2 * RWC; w.w0 = in[5] + l * 1024; w.a0 = in[7] + l * 1024; w.v0 = in[10]; w.kk_ = in[13] + l * 512; w.ka = in[14] + l * 512; w.rk = in[15] + l * 512;
                    w.WdecT = ((bf16_t*)(args.ws + WSM.WdecT)) + (size_t)l * 2 * 512 * 64; w.WaaaT = ((bf16_t*)(args.ws + WSM.WaaaT)) + (size_t)l * 2 * 512 * 64; w.WgT = ((bf16_t*)(args.ws + WSM.WgT)) + (size_t)l * 512 * 128; w.WvuT = ((bf16_t*)(args.ws + WSM.WvuT));
                    for (int u = bx; u < NUNITS; u += G) scan_unit(lds, u, l, ((bf16_t*)(args.ws + WSM.P)), w, ((bf16_t*)(args.ws + WSM.ybuf)), ((bf16_t*)(args.ws + WSM.gbuf)), ((bf16_t*)(args.ws + WSM.mixb)), ((bf16_t*)(args.ws + WSM.vfirst)), ((float*)(args.ws + WSM.sbon)), (bf16_t*)(args.ws + WSM.yaug), (float*)(args.ws + WSM.segst));
                }
            }
            GRID_BAR();
#pragma unroll 1
            for (int half = 0; half < 2; ++half) {
                if (half == 0) {
                    ph_segfix(lds, (const float*)(args.ws + WSM.segst), (bf16_t*)(args.ws + WSM.SS), GSEQ * 16);
                    ph_natten(lds, ((bf16_t*)(args.ws + WSM.P)), ((bf16_t*)(args.ws + WSM.VT)), GR, GSEQ, in[20] + (size_t)l * 8 * 15 * 31, ((bf16_t*)(args.ws + WSM.mixb)), bx, G);
                    GRID_BAR();
                    ph_post3((const bf16_t*)(args.ws + WSM.ybuf), (const bf16_t*)(args.ws + WSM.yaug), (const bf16_t*)(args.ws + WSM.SS), (const bf16_t*)(args.ws + WSM.gbuf), (const float*)(args.ws + WSM.sbon), in[16] + l * 512, in[17] + l * 512, (bf16_t*)(args.ws + WSM.mixb), GSEQ);
                    GRID_BAR();
                } else {
                    { pg8::StaticOrder S; pg8::Unit u0; S.init(GR, UPC, NWG, bx); if (S.next(0, u0)) wg_rstd_from_slots((const float*)(args.ws + WSM.rstd), u0.pm * 256, (LAS float*)(lds + RS_A)); }
                    ph_gemm_ffn(lds, ((bf16_t*)(args.ws + WSM.xb)), ((bf16_t*)(args.ws + WSM.WupT)) + (size_t)l * UPC * D, GR, ((bf16_t*)(args.ws + WSM.act)), (float*)(args.ws + WSM.U), ((float*)(args.ws + WSM.rstd)),
                                in[24] + (size_t)l * 3 * UPC, in[25] + (size_t)l * UPC);
                    GRID_BAR();
                    ph_ffn_fix((const float*)(args.ws + WSM.U), in[24] + (size_t)l * 3 * UPC, in[25] + (size_t)l * UPC, ((bf16_t*)(args.ws + WSM.act)), GR);
                    GRID_BAR();
                }
                ph_gemm(lds, half ? (const bf16_t*)(args.ws + WSM.act) : (const bf16_t*)(args.ws + WSM.mixb),
                        half ? ((const bf16_t*)(args.ws + WSM.WdnT)) + (size_t)l * D * DFF : ((const bf16_t*)(args.ws + WSM.WoutT)) + (size_t)l * D * D, GR, D, half ? DFF : D,
                        (bf16_t*)(args.ws + WSM.xb), (half == 1 && l + 1 == DEPTH) ? Xg : nullptr, (float*)(args.ws + WSM.rstd));
                GRID_BAR();
            }
        }
    }
}

extern "C" void kernel_launch(void* const* d_in, const int* in_sizes, int n_in, void* d_out, int out_size, void* d_ws, size_t ws_size, hipStream_t stream) {
    static int grid = 0;
    static Args a{};
    if (grid == 0) {
        int dev = 0, cus = 0;
        if (hipGetDevice(&dev) != hipSuccess || hipDeviceGetAttribute(&cus, hipDeviceAttributeMultiprocessorCount, dev) != hipSuccess) { fprintf(stderr, "device query failed\n"); grid = -1; return; }
        if (hipFuncSetAttribute((const void*)mega, hipFuncAttributeMaxDynamicSharedMemorySize, LDS_BYTES) != hipSuccess) { fprintf(stderr, "hipFuncSetAttribute failed\n"); grid = -1; return; }
        int per_cu = 0;
        if (hipOccupancyMaxActiveBlocksPerMultiprocessor(&per_cu, (const void*)mega, NT, LDS_BYTES) != hipSuccess || per_cu < 1) { fprintf(stderr, "occupancy query: %d\n", per_cu); }
        (void)hipGetLastError();
        if (cus < NWG) { fprintf(stderr, "this kernel needs %d CUs, device has %d\n", NWG, cus); grid = -1; return; }
        grid = NWG;
    }
    if (grid < 0) return;
    if (WSM.end > ws_size || n_in != 27) { fprintf(stderr, "ws too small: need %zu have %zu (n_in %d)\n", (size_t)WSM.end, ws_size, n_in); return; }
    a = Args{};
    for (int i = 0; i < 27; ++i) a.in[i] = (const float*)d_in[i];
    a.out = (float*)d_out; a.ws = (unsigned char*)d_ws;
    (void)hipMemsetAsync(d_ws, 0, WS_CTL_BYTES, stream);
    hipLaunchKernelGGL(mega, dim3(grid), dim3(NT), LDS_BYTES, stream, a);
}
```

```cpp
#include <hip/hip_runtime.h>
#include <cstdio>
#include <cstdint>
namespace pg8 {
#define PG8_LAS __attribute__((address_space(3)))
typedef unsigned short bf16_t;
typedef short bf16x8 __attribute__((ext_vector_type(8)));
typedef float f32x4 __attribute__((ext_vector_type(4)));
typedef unsigned u32x4 __attribute__((ext_vector_type(4)));
constexpr int BM = 256, BK = 64, HALF = 128, HTB = HALF * BK * 2  , STAGE_BYTES = 8 * HTB, NXCD = 8, WGM = 8;

__host__ __device__ __forceinline__ int lds_byte(int r, int c) { const int st = (r >> 4) * 2 + (c >> 5), rr = r & 15, cc = c & 31, ob = rr * 64 + cc * 2; return st * 1024 + (ob ^ (((ob >> 9) & 1) << 5)); }
__host__ __device__ __forceinline__ void stage_rc(int b, int& R, int& C) { const int st = b / 1024, sb = b % 1024, swz = sb ^ (((sb >> 9) & 1) << 5); R = (st >> 1) * 16 + swz / 64; C = (st & 1) * 32 + (swz % 64) / 2; }
__host__ __device__ __forceinline__ int perm32(int rho) { const int n = rho >> 4, i = rho & 15; return 8 * (i >> 2) + 4 * n + (i & 3); }

struct Unit { int pm, pn; };
struct Gemm { const bf16_t* A; const bf16_t* Bt; int M, N, K, pad; };

struct StaticOrder {
    int nM, nN, nwg, G, c;
    __host__ __device__ void init(int M, int N, int G_, int c_) { nM = M / BM; nN = N / BM; nwg = nM * nN; G = G_; c = c_; }
    __host__ __device__ bool next(int i, Unit& u) const {
        const int L = i * G + c; if (L >= nwg) return false;
        int wgid = L; { const int q = nwg / NXCD, r = nwg % NXCD, xcd = wgid % NXCD, off = wgid / NXCD; wgid = (xcd < r ? xcd * (q + 1) : r * (q + 1) + (xcd - r) * q) + off; }
        const int nig = WGM * nN, gid = wgid / nig, fm = gid * WGM, gsz = (nM - fm) < WGM ? (nM - fm) : WGM;
        u.pm = fm + ((wgid % nig) % gsz); u.pn = (wgid % nig) / gsz; return true;
    }
    __device__ __forceinline__ void a_ready(const Unit&) const {}
    __device__ __forceinline__ void done(const Unit&) const {}
};

__device__ __forceinline__ unsigned cvt_pk_bf16(float lo, float hi) { unsigned r; asm volatile("v_cvt_pk_bf16_f32 %0, %1, %2" : "=v"(r) : "v"(lo), "v"(hi)); return r; }
typedef float f32x2 __attribute__((ext_vector_type(2)));
template <class Epi, class Sched, bool ALIGN_EPI = false, bool SP2 = false>
__device__ __forceinline__ void gemm_phase(PG8_LAS unsigned char* lds, const Gemm g, const Sched& S, const Epi& E, const int tid_in) {
    const int tid = tid_in, wid = __builtin_amdgcn_readfirstlane(tid >> 6), lane = tid & 63, wr = wid >> 2, wc = wid & 3, fr = lane & 15, fq = lane >> 4;
    const int K = g.K, nt = K / BK;
    unsigned voffA[2], voffB[2];
#pragma unroll
    for (int i = 0; i < 2; ++i) { int R, C; stage_rc(tid * 16 + i * 8192, R, C); const int Rb = Epi::PERM ? ((R & ~31) + perm32(R & 31)) : R;
        const int Ra = Epi::APERM ? ((R & ~63) + 4 * (R & 15) + ((R >> 4) & 3)) : R;
        voffA[i] = (unsigned)(Ra * K + C) * 2u; voffB[i] = (unsigned)(Rb * K + C) * 2u; }
    const size_t kstep = (size_t)(BK * 2);
    const size_t hstep = (size_t)HALF * K * 2;
    const size_t tstep = 2 * hstep;
    const unsigned ldsw = (unsigned)wid * 1024u;
    const int aoff = lds_byte(wr * 64 + fr, fq * 8), boff = lds_byte(wc * 32 + fr, fq * 8);
#define PG8_SA(b, h) (((b) * 2 + (h)) * HTB)
#define PG8_SB(b, h) ((4 + (b) * 2 + (h)) * HTB)
#define PG8_STAGE(bufoff, gbase, voff) do { _Pragma("unroll") for (int _i = 0; _i < 2; ++_i) \
        __builtin_amdgcn_global_load_lds((const unsigned*)((const char*)(gbase) + (voff)[_i]), (PG8_LAS unsigned*)(lds + (bufoff) + ldsw + _i * 8192), 16, 0, 0); } while (0)
#define PG8_LDA(dst, b, h) do { _Pragma("unroll") for (int m = 0; m < 4; ++m) _Pragma("unroll") for (int k = 0; k < 2; ++k) dst[m][k] = *(const PG8_LAS bf16x8*)(lds + PG8_SA(b, h) + aoff + m * 2048 + k * 1024); } while (0)
#define PG8_LDB(dst, b, h) do { _Pragma("unroll") for (int n = 0; n < 2; ++n) _Pragma("unroll") for (int k = 0; k < 2; ++k) dst[n][k] = *(const PG8_LAS bf16x8*)(lds + PG8_SB(b, h) + boff + n * 2048 + k * 1024); } while (0)
#define PG8_MMA(ai, bj, At, Bt) do { __builtin_amdgcn_s_setprio(1); _Pragma("unroll") for (int m = 0; m < 4; ++m) _Pragma("unroll") for (int n = 0; n < 2; ++n) _Pragma("unroll") for (int k = 0; k < 2; ++k) \
        acc[ai][bj][m][n] = __builtin_amdgcn_mfma_f32_16x16x32_bf16(Bt[n][k], At[m][k], acc[ai][bj][m][n], 0, 0, 0); __builtin_amdgcn_s_setprio(0); } while (0)
#define PG8_WAIT_V(n) asm volatile("s_waitcnt vmcnt(" #n ")" ::: "memory")
#define PG8_WAIT_L(n) asm volatile("s_waitcnt lgkmcnt(" #n ")" ::: "memory")
#define PG8_BAR __builtin_amdgcn_s_barrier()
#define PG8_SCHED __builtin_amdgcn_sched_barrier(0)
    Unit cur, nxt; int ui = 0;
    if (!S.next(0, cur)) return;
    f32x4 acc[2][2][4][2];
#pragma unroll
    for (int a = 0; a < 2; ++a)
#pragma unroll
        for (int b = 0; b < 2; ++b)
#pragma unroll
            for (int m = 0; m < 4; ++m)
#pragma unroll
                for (int n = 0; n < 2; ++n) acc[a][b][m][n] = (f32x4){0.f, 0.f, 0.f, 0.f};
    bf16x8 At[4][2], B0[2][2], B1[2][2];
    const char* cA = (const char*)g.A + (size_t)cur.pm * tstep; const char* cB = (const char*)g.Bt + (size_t)cur.pn * tstep;
    S.a_ready(cur);
    if constexpr (SP2) {
        PG8_STAGE(PG8_SB(0, 0), cB, voffB); PG8_STAGE(PG8_SB(0, 1), cB + hstep, voffB); PG8_STAGE(PG8_SA(0, 0), cA, voffA); PG8_STAGE(PG8_SA(0, 1), cA + hstep, voffA);
        if (wr == 1) PG8_BAR;
        PG8_WAIT_V(2); PG8_BAR;
        PG8_STAGE(PG8_SB(1, 0), cB + kstep, voffB); PG8_STAGE(PG8_SA(1, 0), cA + kstep, voffA); PG8_STAGE(PG8_SB(1, 1), cB + hstep + kstep, voffB);
        PG8_WAIT_V(6); PG8_BAR;
    } else {
        PG8_STAGE(PG8_SB(0, 0), cB, voffB); PG8_STAGE(PG8_SA(0, 0), cA, voffA); PG8_STAGE(PG8_SB(0, 1), cB + hstep, voffB); PG8_STAGE(PG8_SA(0, 1), cA + hstep, voffA);
        if (wr == 1) PG8_BAR;
        PG8_WAIT_V(4); PG8_BAR;
        PG8_STAGE(PG8_SB(1, 0), cB + kstep, voffB); PG8_STAGE(PG8_SA(1, 0), cA + kstep, voffA); PG8_STAGE(PG8_SB(1, 1), cB + hstep + kstep, voffB);
        PG8_WAIT_V(6); PG8_BAR;
    }
    for (;;) {
        const bool has_next = S.next(ui + 1, nxt);
        const char* nA = has_next ? (const char*)g.A + (size_t)nxt.pm * tstep : cA; const char* nB = has_next ? (const char*)g.Bt + (size_t)nxt.pn * tstep : cB;
        for (int t = 0; t < nt; t += 2) {
            const bool last = (t == nt - 2);
            const char* a1 = cA + (size_t)(t + 1) * kstep;
            const char* a2 = last ? nA : cA + (size_t)(t + 2) * kstep; const char* b2 = last ? nB : cB + (size_t)(t + 2) * kstep;
            const char* a3 = a2 + kstep; const char* b3 = b2 + kstep;
            if (last && has_next) S.a_ready(nxt);
            if constexpr (SP2) {
            PG8_LDB(B0, 0, 0); PG8_LDB(B1, 0, 1); PG8_SCHED; PG8_LDA(At, 0, 0); PG8_STAGE(PG8_SA(1, 1), a1 + hstep, voffA);
            PG8_WAIT_V(8); PG8_WAIT_L(0); PG8_BAR; PG8_MMA(0, 0, At, B0); PG8_MMA(0, 1, At, B1); PG8_BAR; PG8_SCHED;
            PG8_LDA(At, 0, 1); PG8_STAGE(PG8_SB(0, 0), b2, voffB); PG8_STAGE(PG8_SB(0, 1), b2 + hstep, voffB); PG8_STAGE(PG8_SA(0, 0), a2, voffA);
            PG8_WAIT_V(8); PG8_WAIT_L(0); PG8_BAR; PG8_MMA(1, 0, At, B0); PG8_MMA(1, 1, At, B1); PG8_BAR; PG8_SCHED;
            PG8_LDB(B0, 1, 0); PG8_LDB(B1, 1, 1); PG8_SCHED; PG8_LDA(At, 1, 0); PG8_STAGE(PG8_SA(0, 1), a2 + hstep, voffA);
            PG8_WAIT_V(8); PG8_WAIT_L(0); PG8_BAR; PG8_MMA(0, 0, At, B0); PG8_MMA(0, 1, At, B1); PG8_BAR; PG8_SCHED;
            PG8_LDA(At, 1, 1); PG8_STAGE(PG8_SB(1, 0), b3, voffB); PG8_STAGE(PG8_SB(1, 1), b3 + hstep, voffB); PG8_STAGE(PG8_SA(1, 0), a3, voffA);
            PG8_WAIT_V(8); PG8_WAIT_L(0); PG8_BAR; PG8_MMA(1, 0, At, B0); PG8_MMA(1, 1, At, B1); PG8_BAR; PG8_SCHED;
            } else {
            PG8_LDB(B0, 0, 0); PG8_SCHED; PG8_LDA(At, 0, 0); PG8_STAGE(PG8_SA(1, 1), a1 + hstep, voffA);
            PG8_WAIT_L(8); PG8_BAR; PG8_WAIT_L(0); PG8_MMA(0, 0, At, B0); PG8_BAR; PG8_SCHED;
            PG8_LDB(B1, 0, 1); PG8_STAGE(PG8_SB(0, 0), b2, voffB);
            PG8_BAR; PG8_WAIT_L(0); PG8_MMA(0, 1, At, B1); PG8_BAR;
            PG8_LDA(At, 0, 1); PG8_STAGE(PG8_SA(0, 0), a2, voffA);
            PG8_BAR; PG8_WAIT_L(0); PG8_MMA(1, 0, At, B0); PG8_BAR; PG8_SCHED;
            PG8_STAGE(PG8_SB(0, 1), b2 + hstep, voffB);
            PG8_WAIT_V(6); PG8_BAR; PG8_MMA(1, 1, At, B1); PG8_BAR;
            PG8_LDB(B0, 1, 0); PG8_SCHED; PG8_LDA(At, 1, 0); PG8_STAGE(PG8_SA(0, 1), a2 + hstep, voffA);
            PG8_WAIT_L(8); PG8_BAR; PG8_WAIT_L(0); PG8_MMA(0, 0, At, B0); PG8_BAR; PG8_SCHED;
            PG8_LDB(B1, 1, 1); PG8_STAGE(PG8_SB(1, 0), b3, voffB);
            PG8_BAR; PG8_WAIT_L(0); PG8_MMA(0, 1, At, B1); PG8_BAR;
            PG8_LDA(At, 1, 1); PG8_STAGE(PG8_SA(1, 0), a3, voffA);
            PG8_BAR; PG8_WAIT_L(0); PG8_MMA(1, 0, At, B0); PG8_BAR; PG8_SCHED;
            PG8_STAGE(PG8_SB(1, 1), b3 + hstep, voffB);
            PG8_WAIT_V(6); PG8_BAR; PG8_MMA(1, 1, At, B1); PG8_BAR;
            }
        }
        if constexpr (ALIGN_EPI) { if (wr == 0) PG8_BAR; }
        if constexpr (!Epi::AFTER_DRAIN) { E(acc, cur, wr, wc, fr, fq); S.done(cur); }
        if (!has_next) break;
#pragma unroll
        for (int a = 0; a < 2; ++a)
#pragma unroll
            for (int b = 0; b < 2; ++b)
#pragma unroll
                for (int m = 0; m < 4; ++m)
#pragma unroll
                    for (int n = 0; n < 2; ++n) acc[a][b][m][n] = (f32x4){0.f, 0.f, 0.f, 0.f};
        cur = nxt; cA = nA; cB = nB; ++ui;
        if constexpr (ALIGN_EPI) { if (wr == 1) PG8_BAR; }
    }
    PG8_WAIT_V(0);
    if constexpr (!ALIGN_EPI) { if (wr == 0) PG8_BAR; }
    PG8_BAR;
    if constexpr (Epi::AFTER_DRAIN) { E.fused(acc, cur, wr, wc, fr, fq, lds, wid, lane); S.done(cur); }
#undef PG8_SA
#undef PG8_SB
#undef PG8_STAGE
#undef PG8_LDA
#undef PG8_LDB
#undef PG8_MMA
#undef PG8_WAIT_V
#undef PG8_WAIT_L
#undef PG8_BAR
#undef PG8_SCHED
}
}
#define XB_TMO      128
#define XB_XCNT(j)  (256  + 64 * (j))
#define XB_XSUB(j)  (1280 + 64 * (j))
#define XB_XGEN(j)  (2304 + 64 * (j))
#define XB_TOP      3328
#define XB_TOPGEN   3392
#define XCD_BAR_WORDS 3456
#define XB_SPIN_CAP (1u << 22)
#define LAS __attribute__((address_space(3)))

__device__ __forceinline__ unsigned xb_ld(unsigned* p)              { return __hip_atomic_load(p, __ATOMIC_RELAXED, __HIP_MEMORY_SCOPE_AGENT); }
__device__ __forceinline__ unsigned xb_add(unsigned* p, unsigned v) { return __hip_atomic_fetch_add(p, v, __ATOMIC_RELAXED, __HIP_MEMORY_SCOPE_AGENT); }
__device__ __forceinline__ unsigned xb_xcc_id() { return (unsigned)__builtin_amdgcn_s_getreg((3 << 11) | 20) & 0xFu; }
#define XB_SPIN(cond, bar) do { unsigned _sp = 0; while (cond) { __builtin_amdgcn_s_sleep(1); \
    if ((++_sp & 255u) == 0u) { if (xb_ld(&(bar)[XB_TMO])) break; if (_sp > XB_SPIN_CAP) { atomicAdd(&(bar)[XB_TMO], 1u); break; } } } } while (0)

struct XcdBarrier {
    unsigned* bar; unsigned x;
    volatile LAS unsigned* st;
};

__device__ __forceinline__ XcdBarrier xcd_barrier_post(unsigned* bar, volatile LAS unsigned* st, const bool lead) {
    XcdBarrier b; b.bar = bar; b.x = xb_xcc_id(); b.st = st;
    if (lead) (void)xb_add(&bar[XB_XCNT(b.x)], 1u);
    return b;
}
__device__ __forceinline__ void xcd_barrier_complete(unsigned* bar, unsigned x, unsigned& nloc, unsigned& nx) {
    const unsigned G = gridDim.x * gridDim.y * gridDim.z;
    unsigned sum, cnt, mine, sp = 0u;
    for (;;) {
        sum = 0u; cnt = 0u; mine = 0u;
#pragma unroll
        for (unsigned j = 0; j < 16; ++j) { const unsigned c = xb_ld(&bar[XB_XCNT(j)]); sum += c; cnt += (c > 0u) ? 1u : 0u; mine = (j == x) ? c : mine; }
        if (sum == G) break;
        __builtin_amdgcn_s_sleep(1);
        if ((++sp & 255u) == 0u) { if (xb_ld(&bar[XB_TMO])) break; if (sp > XB_SPIN_CAP) { atomicAdd(&bar[XB_TMO], 1u); break; } }
    }
    nloc = mine > 0u ? mine : 1u; nx = cnt > 0u ? cnt : 1u;
}

__device__ __forceinline__ void xcd_barrier(const XcdBarrier& b, const bool lead) {
    asm volatile("s_waitcnt vmcnt(0)" ::: "memory");
    __syncthreads();
    if (lead) {
        unsigned* bar = b.bar;
        __builtin_amdgcn_s_waitcnt(0);
        unsigned nloc = b.st[0], nx = b.st[1];
        if (nloc == 0u) { xcd_barrier_complete(bar, b.x, nloc, nx); b.st[0] = nloc; b.st[1] = nx; }
        const unsigned old = xb_add(&bar[XB_XSUB(b.x)], 1u);
        const unsigned gen = old / nloc;
        if (old + 1u == (gen + 1u) * nloc) {
            __builtin_amdgcn_fence(__ATOMIC_RELEASE, "agent");
            asm volatile("s_waitcnt vmcnt(0)" ::: "memory");
            const unsigned og = xb_add(&bar[XB_TOP], 1u);
            const unsigned tg = og / nx;
            if (og + 1u == (tg + 1u) * nx) xb_add(&bar[XB_TOPGEN], 1u);
            else XB_SPIN(xb_ld(&bar[XB_TOPGEN]) == tg, bar);
            __builtin_amdgcn_fence(__ATOMIC_ACQUIRE, "agent");
            xb_add(&bar[XB_XGEN(b.x)], 1u);
            asm volatile("s_waitcnt vmcnt(0)" ::: "memory");
        } else {
            XB_SPIN(xb_ld(&bar[XB_XGEN(b.x)]) == gen, bar);
            __builtin_amdgcn_fence(__ATOMIC_ACQUIRE, "agent");
            asm volatile("s_waitcnt vmcnt(0)" ::: "memory");
        }
    }
    __syncthreads();
}

typedef unsigned short bf16_t;
typedef float f32x4 __attribute__((ext_vector_type(4)));
typedef short bf16x8 __attribute__((ext_vector_type(8)));
typedef unsigned u32x4 __attribute__((ext_vector_type(4)));
typedef unsigned u32x2 __attribute__((ext_vector_type(2)));

constexpr int D = 1024, NSEQ = 12, SEQ = 4096, NTOK = NSEQ * SEQ, DEPTH = 2;
constexpr int RWC = 1920, INC = 3456, PCW = 3072, QOFF = 2048, KOFF = 2560, DFF = 2816, UPC = 5632;
constexpr int O_WD = 1536, O_AD = 1664, O_GD = 1792;
constexpr int NT = 512, NWG = 256;
constexpr int LDS_MISC = 161792, LDS_BYTES = LDS_MISC + 1024;
constexpr size_t WS_CTL_BYTES = 65536;
constexpr int GSEQ = 4, GR = GSEQ * SEQ, NGRP = NSEQ / GSEQ;

typedef __bf16 bf16v2_t __attribute__((ext_vector_type(2)));
typedef float f32v2_t __attribute__((ext_vector_type(2)));
__device__ __forceinline__ unsigned cvtpk(float lo, float hi) { f32v2_t f = {lo, hi}; bf16v2_t b = __builtin_convertvector(f, bf16v2_t); return __builtin_bit_cast(unsigned, b); }
__device__ __forceinline__ unsigned short f2bf(float f) { return __builtin_bit_cast(unsigned short, (__bf16)f); }
__device__ __forceinline__ float bf2f(unsigned short b) { return __uint_as_float(((unsigned)b) << 16); }
__device__ __forceinline__ unsigned pk2bf(float lo, float hi) { return cvtpk(lo, hi); }
__device__ __forceinline__ float shx(float v, int m, int lane) { return __int_as_float(__builtin_amdgcn_ds_bpermute((lane ^ m) << 2, __float_as_int(v))); }
__device__ __forceinline__ float shl_(float v, int src) { return __int_as_float(__builtin_amdgcn_ds_bpermute(src << 2, __float_as_int(v))); }
__device__ __forceinline__ float wave_sum(float v, int lane) {
#pragma unroll
    for (int o = 1; o < 64; o <<= 1) v += shx(v, o, lane);
    return v;
}
__device__ __forceinline__ int olane() { unsigned z = 0u; asm volatile("" : "+s"(z)); int l = (int)__builtin_amdgcn_mbcnt_hi(~0u, __builtin_amdgcn_mbcnt_lo(~0u, z)); asm volatile("" : "+v"(l)); return l; }
__device__ __forceinline__ int otid() { return (__builtin_amdgcn_readfirstlane((int)threadIdx.x >> 6) << 6) | olane(); }
__device__ __forceinline__ float sigmoidf_(float x) { return 1.f / (1.f + expf(-x)); }

__device__ __forceinline__ void ph_prep_w(LAS unsigned char* lds, const float* __restrict__ W, int K, int Nsrc, const float* __restrict__ scale, bf16_t* __restrict__ out, int Nout, int mode, float mul) {
    const int tid0 = otid(); const int half = tid0 >> 8, t8 = tid0 & 255, tx = t8 & 31, ty = t8 >> 5;
    LAS float* tile = (LAS float*)(lds + half * 4352);
    const int ntn = Nout / 32, ntiles = ntn * (K / 32);
    for (int vb = blockIdx.x; 2 * vb < ntiles; vb += NWG) {
        const int ti = 2 * vb + half; const bool on = ti < ntiles;
        const int n0 = (ti % ntn) * 32, k0 = (ti / ntn) * 32;
        if (on) for (int i = ty; i < 32; i += 8) {
            const int n = n0 + tx, k = k0 + i; int ns = n; bool valid = true;
            if (mode == 1) { if (n < 1920) ns = n; else if (n < 2048) valid = false; else ns = n - 128; }
            if (mode == 2) ns = n + 2944;
            if (mode == 3) ns = ((n >> 7) & 1) * DFF + (n >> 8) * 128 + (n & 127);
            float v = 0.f;
            if (valid) v = W[(size_t)k * Nsrc + ns] * (scale ? scale[k] : 1.f) * mul;
            if (mode == 1) { if (n >= O_WD && n < O_WD + 128) v *= 2.88539008f; else if (n >= O_GD && n < O_GD + 128) v *= -1.44269504f; }
            tile[i * 33 + tx] = v;
        }
        __syncthreads();
        if (on) for (int i = ty; i < 32; i += 8) { const int n = n0 + i, k = k0 + tx; out[(size_t)n * K + k] = f2bf(tile[tx * 33 + i]); }
        __syncthreads();
    }
}

__device__ __forceinline__ void ph_rms_in(const float* __restrict__ xin, bf16_t* __restrict__ xb, float* __restrict__ rstd, int rows) {
    const int tid0 = otid(); const int lane = tid0 & 63;
    for (int row = blockIdx.x * 8 + (tid0 >> 6); row < rows; row += NWG * 8) {
        const f32x4* xr = (const f32x4*)(xin + (size_t)row * D);
        f32x4 v[4]; float s = 0.f;
#pragma unroll
        for (int j = 0; j < 4; ++j) { v[j] = xr[lane + 64 * j]; s += v[j].x * v[j].x + v[j].y * v[j].y + v[j].z * v[j].z + v[j].w * v[j].w; }
        s = wave_sum(s, lane);
        if (lane < 4) rstd[lane * GR + row] = (lane == 0) ? s : 0.f;
#pragma unroll
        for (int j = 0; j < 4; ++j) {
            const int c = (lane + 64 * j) * 4;
            u32x2 w; w.x = pk2bf(v[j].x, v[j].y); w.y = pk2bf(v[j].z, v[j].w);
            *(u32x2*)(xb + (size_t)row * D + c) = w;
        }
    }
}
__device__ __forceinline__ void ph_rstd(const bf16_t* __restrict__ xb, float* __restrict__ rstd, int rows) {
    const int tid0 = otid(); const int lane = tid0 & 63;
#pragma unroll 4
    for (int row = blockIdx.x * 8 + (tid0 >> 6); row < rows; row += NWG * 8) {
        const u32x4* xr = (const u32x4*)(xb + (size_t)row * D);
        float s = 0.f;
#pragma unroll
        for (int j = 0; j < 2; ++j) {
            const u32x4 q = xr[lane + 64 * j];
            const unsigned w[4] = {q.x, q.y, q.z, q.w};
#pragma unroll
            for (int k = 0; k < 4; ++k) { const float a = __uint_as_float(w[k] << 16), c = __uint_as_float(w[k] & 0xffff0000u); s += a * a + c * c; }
        }
        s = wave_sum(s, lane);
        if (lane == 0) rstd[row] = rsqrtf(s * (1.f / D) + 1e-6f);
    }
}

constexpr int RS_A = 140288, RS_B = 141312;
__device__ __forceinline__ void wg_rstd_from_slots(const float* __restrict__ ssq, int row0, LAS float* dst) {
    const int tid0 = otid();
    if (tid0 < 256) {
        const float* p = ssq + row0 + tid0;
        dst[tid0] = rsqrtf(((p[0] + p[GR]) + (p[2 * GR] + p[3 * GR])) * (1.f / D) + 1e-6f);
    }
    __syncthreads();
}

constexpr int EPI_S = 135168;
struct EpiRow {
    static constexpr bool PERM = true, AFTER_DRAIN = false, APERM = false;
    bf16_t* X; float* outf; float* ssq; LAS unsigned char* lds;
    __device__ __forceinline__ void operator()(const pg8::f32x4 (&acc)[2][2][4][2], const pg8::Unit& u, int wr, int wc, int fr, int fq) const {
        const int row0 = u.pm * 256 + wr * 64 + fr, col0 = u.pn * 256 + wc * 32 + 8 * fq;
        const unsigned off0 = (unsigned)row0 * (unsigned)D + (unsigned)col0;
        pg8::u32x4 r[2][4][2];
#pragma unroll
        for (int ai = 0; ai < 2; ++ai)
#pragma unroll
            for (int m = 0; m < 4; ++m)
#pragma unroll
                for (int bj = 0; bj < 2; ++bj) r[ai][m][bj] = *(const pg8::u32x4*)(X + off0 + (unsigned)((ai * 128 + m * 16) * D + bj * 128));
        float ss[2][4];
#pragma unroll
        for (int ai = 0; ai < 2; ++ai)
#pragma unroll
            for (int m = 0; m < 4; ++m) {
                const unsigned off = off0 + (unsigned)((ai * 128 + m * 16) * D);
                float sq = 0.f;
#pragma unroll
                for (int bj = 0; bj < 2; ++bj) {
                    const pg8::u32x4 rr = r[ai][m][bj];
                    pg8::f32x4 v0 = acc[ai][bj][m][0], v1 = acc[ai][bj][m][1];
                    v0[0] += __uint_as_float(rr.x << 16); v0[1] += __uint_as_float(rr.x & 0xffff0000u); v0[2] += __uint_as_float(rr.y << 16); v0[3] += __uint_as_float(rr.y & 0xffff0000u);
                    v1[0] += __uint_as_float(rr.z << 16); v1[1] += __uint_as_float(rr.z & 0xffff0000u); v1[2] += __uint_as_float(rr.w << 16); v1[3] += __uint_as_float(rr.w & 0xffff0000u);
                    if (outf) { *(pg8::f32x4*)(outf + off + bj * 128) = v0; *(pg8::f32x4*)(outf + off + bj * 128 + 4) = v1; }
                    else {
                        pg8::u32x4 w; w.x = pg8::cvt_pk_bf16(v0[0], v0[1]); w.y = pg8::cvt_pk_bf16(v0[2], v0[3]); w.z = pg8::cvt_pk_bf16(v1[0], v1[1]); w.w = pg8::cvt_pk_bf16(v1[2], v1[3]);
                        *(pg8::u32x4*)(X + off + bj * 128) = w;
                        const unsigned ww[4] = {w.x, w.y, w.z, w.w};
#pragma unroll
                        for (int k = 0; k < 4; ++k) { const float a = __uint_as_float(ww[k] << 16), c = __uint_as_float(ww[k] & 0xffff0000u); sq = fmaf(a, a, fmaf(c, c, sq)); }
                    }
                }
                ss[ai][m] = sq;
            }
        if (!outf) {
            const int lane_ = olane();
            LAS float* LS = (LAS float*)(lds + EPI_S);
#pragma unroll
            for (int ai = 0; ai < 2; ++ai)
#pragma unroll
                for (int m = 0; m < 4; ++m) {
                    float s = ss[ai][m];
                    s += shx(s, 16, lane_); s += shx(s, 32, lane_);
                    if (lane_ < 16) LS[wc * 256 + wr * 64 + ai * 128 + m * 16 + lane_] = s;
                }
            __syncthreads();
            const int tid_ = (wr * 4 + wc) * 64 + lane_;
            if (tid_ < 256) ssq[u.pn * GR + u.pm * 256 + tid_] = (LS[tid_] + LS[256 + tid_]) + (LS[512 + tid_] + LS[768 + tid_]);
        }
    }
};
struct EpiBf {
    static constexpr bool PERM = true, AFTER_DRAIN = false, APERM = false;
    bf16_t* O; const LAS float* rowscale; const LAS float* colscale; int ldc; int pad;
    __device__ __forceinline__ void operator()(const pg8::f32x4 (&acc)[2][2][4][2], const pg8::Unit& u, int wr, int wc, int fr, int fq) const {
        const int row0 = u.pm * 256 + wr * 64 + fr, col0 = u.pn * 256 + wc * 32 + 8 * fq;
        pg8::f32x4 cs[2][2];
#pragma unroll
        for (int bj = 0; bj < 2; ++bj)
#pragma unroll
            for (int n = 0; n < 2; ++n) cs[bj][n] = colscale ? *(const LAS pg8::f32x4*)(colscale + wc * 32 + 8 * fq + bj * 128 + 4 * n) : (pg8::f32x4){1.f, 1.f, 1.f, 1.f};
        float rsc[2][4];
#pragma unroll
        for (int ai = 0; ai < 2; ++ai)
#pragma unroll
            for (int m = 0; m < 4; ++m) rsc[ai][m] = rowscale ? rowscale[wr * 64 + fr + ai * 128 + m * 16] : 1.f;
#pragma unroll
        for (int ai = 0; ai < 2; ++ai)
#pragma unroll
            for (int m = 0; m < 4; ++m) {
                const int row = row0 + ai * 128 + m * 16; const float s = rsc[ai][m];
                bf16_t* rowp = (ldc < 0) ? O + (size_t)(col0 >> 3) * 4096 + row * 8 : O + (size_t)row * ldc + col0;
#pragma unroll
                for (int bj = 0; bj < 2; ++bj) {
                    const pg8::f32x4 v0 = acc[ai][bj][m][0] * s * cs[bj][0], v1 = acc[ai][bj][m][1] * s * cs[bj][1];
                    pg8::u32x4 w; w.x = pg8::cvt_pk_bf16(v0[0], v0[1]); w.y = pg8::cvt_pk_bf16(v0[2], v0[3]); w.z = pg8::cvt_pk_bf16(v1[0], v1[1]); w.w = pg8::cvt_pk_bf16(v1[2], v1[3]);
                    *(pg8::u32x4*)(rowp + (ldc < 0 ? bj * 16 * 4096 : bj * 128)) = w;
                }
            }
    }
};
__device__ __forceinline__ void ph_gemm(LAS unsigned char* lds, const bf16_t* A, const bf16_t* Bt, int M, int N, int K, bf16_t* X, float* outf, float* ssq) {
    pg8::Gemm g{A, Bt, M, N, K, 0}; EpiRow e{X, outf, ssq, lds};
    pg8::StaticOrder S; S.init(M, N, NWG, (int)blockIdx.x);
    pg8::gemm_phase<EpiRow, pg8::StaticOrder, true, true>(lds, g, S, e, otid());
}
__device__ __forceinline__ void ph_gemm_bf(LAS unsigned char* lds, const bf16_t* A, const bf16_t* Bt, int M, int N, int K, bf16_t* O, const LAS float* rowscale, const LAS float* colscale, int ldc) {
    pg8::Gemm g{A, Bt, M, N, K, 0}; EpiBf e{O, rowscale, colscale, ldc, 0};
    pg8::StaticOrder S; S.init(M, N, NWG, (int)blockIdx.x);
    pg8::gemm_phase<EpiBf, pg8::StaticOrder, true, true>(lds, g, S, e, otid());
}

__device__ __forceinline__ void ph_qknorm(bf16_t* __restrict__ P, const float* __restrict__ qg, const float* __restrict__ kg, int rows) {
    const int tid0 = otid(); const int lane = tid0 & 63;
    const float* gp = (lane < 32 ? qg : kg) + 16 * (lane & 3); const float gs = lane < 32 ? 0.125f * 1.44269504f : 1.f;
    float gv[16];
#pragma unroll
    for (int j = 0; j < 16; ++j) gv[j] = gp[j] * gs;
#pragma unroll 2
    for (int row = blockIdx.x * 8 + (tid0 >> 6); row < rows; row += NWG * 8) {
        bf16_t* p = P + (size_t)row * PCW + QOFF + 16 * lane;
        const u32x4 a = *(const u32x4*)p, c = *(const u32x4*)(p + 8);
        const unsigned w[8] = {a.x, a.y, a.z, a.w, c.x, c.y, c.z, c.w};
        float f[16]; float ss = 0.f;
#pragma unroll
        for (int j = 0; j < 8; ++j) { f[2 * j] = __uint_as_float(w[j] << 16); f[2 * j + 1] = __uint_as_float(w[j] & 0xffff0000u); ss += f[2 * j] * f[2 * j] + f[2 * j + 1] * f[2 * j + 1]; }
        ss += __int_as_float(__builtin_amdgcn_update_dpp(0, __float_as_int(ss), 0xB1, 0xf, 0xf, false));
        ss += __int_as_float(__builtin_amdgcn_update_dpp(0, __float_as_int(ss), 0x4E, 0xf, 0xf, false));
        const float sc = rsqrtf(ss * (1.f / 64.f) + 1e-6f);
        u32x4 o0, o1;
        o0.x = pk2bf(f[0] * sc * gv[0], f[1] * sc * gv[1]); o0.y = pk2bf(f[2] * sc * gv[2], f[3] * sc * gv[3]); o0.z = pk2bf(f[4] * sc * gv[4], f[5] * sc * gv[5]); o0.w = pk2bf(f[6] * sc * gv[6], f[7] * sc * gv[7]);
        o1.x = pk2bf(f[8] * sc * gv[8], f[9] * sc * gv[9]); o1.y = pk2bf(f[10] * sc * gv[10], f[11] * sc * gv[11]); o1.z = pk2bf(f[12] * sc * gv[12], f[13] * sc * gv[13]); o1.w = pk2bf(f[14] * sc * gv[14], f[15] * sc * gv[15]);
        *(u32x4*)p = o0; *(u32x4*)(p + 8) = o1;
    }
}
constexpr int NK_PITCH = 144, NK_BYTES = 576 * NK_PITCH, NV_BYTES = 576 * 64 * 2, L_NK = 0, L_NV = NK_BYTES, L_RPB = NK_BYTES + NV_BYTES;
static_assert(L_RPB + 15 * 32 * 4 <= LDS_MISC, "neighbourhood attention LDS map");
__device__ __forceinline__ void natten_item_lds(LAS unsigned char* lds, const LAS float* rpbl, bf16_t* __restrict__ mixb, int b, int h, int r, int g, int lo, const u32x4 q0, const u32x4 q1, int lane) {
    const int rs = min(max(r - 4, 0), 56);
    const int kc0 = (g == 0) ? 0 : (g == 1) ? 8 : (g == 2) ? 24 : 32;
    const int n = lane & 15, kq = lane >> 4;
    const int tok0 = b * SEQ;
    f32x4 sc_[16];
    const int cq = 16 * g + n, cs = min(max(cq - 8, 0), 48);
    const LAS unsigned char* kl = lds + L_NK + (unsigned)((lo * 64 + kc0 + 8 * (n >> 2) + (n & 3)) * NK_PITCH + 16 * kq);
#pragma unroll
    for (int bi = 0; bi < 16; ++bi) {
        const int i = bi >> 1, nb = bi & 1;
        const u32x4 ka = *(const LAS u32x4*)(kl + (i * 64 + 4 * nb) * NK_PITCH), kc = *(const LAS u32x4*)(kl + (i * 64 + 4 * nb) * NK_PITCH + 64);
        f32x4 acc = (f32x4){0.f, 0.f, 0.f, 0.f};
        acc = __builtin_amdgcn_mfma_f32_16x16x32_bf16(__builtin_bit_cast(bf16x8, ka), __builtin_bit_cast(bf16x8, q0), acc, 0, 0, 0);
        acc = __builtin_amdgcn_mfma_f32_16x16x32_bf16(__builtin_bit_cast(bf16x8, kc), __builtin_bit_cast(bf16x8, q1), acc, 0, 0, 0);
        const LAS float* brow = rpbl + (rs + i - r + 7) * 32;
#pragma unroll
        for (int e = 0; e < 4; ++e) {
            const int kcn = kc0 + 8 * kq + 4 * nb + e;
            const bool valid = (kcn >= cs) && (kcn < cs + 16);
            const int ci = valid ? min(max(kcn - cq + 15, 0), 30) : 31;
            float bv = brow[ci]; asm volatile("" : "+v"(bv));
            acc[e] += bv;
        }
        sc_[bi] = acc;
        if ((bi & 3) == 3) __builtin_amdgcn_sched_barrier(0);
    }
    float mx = -1e30f;
#pragma unroll
    for (int q = 0; q < 16; ++q) mx = fmaxf(fmaxf(fmaxf(mx, sc_[q][0]), fmaxf(sc_[q][1], sc_[q][2])), sc_[q][3]);
    mx = fmaxf(mx, shx(mx, 16, lane)); mx = fmaxf(mx, shx(mx, 32, lane));
    float l = 0.f;
#pragma unroll
    for (int q = 0; q < 16; ++q)
#pragma unroll
        for (int e = 0; e < 4; ++e) { const float pe = __builtin_amdgcn_exp2f(sc_[q][e] - mx); sc_[q][e] = pe; l += pe; }
    l += shx(l, 16, lane); l += shx(l, 32, lane);
    __builtin_amdgcn_sched_barrier(0);
    f32x4 o[4];
#pragma unroll
    for (int d = 0; d < 4; ++d) o[d] = (f32x4){0.f, 0.f, 0.f, 0.f};
    const LAS unsigned char* vl = lds + L_NV + (unsigned)((((lo * 64 + kc0) >> 3) + kq) * 1024 + n * 16);
#pragma unroll
    for (int i = 0; i < 8; ++i) {
        u32x4 pa; pa.x = pk2bf(sc_[2 * i][0], sc_[2 * i][1]); pa.y = pk2bf(sc_[2 * i][2], sc_[2 * i][3]); pa.z = pk2bf(sc_[2 * i + 1][0], sc_[2 * i + 1][1]); pa.w = pk2bf(sc_[2 * i + 1][2], sc_[2 * i + 1][3]);
        const bf16x8 pf = __builtin_bit_cast(bf16x8, pa);
#pragma unroll
        for (int d = 0; d < 4; ++d) {
            const u32x4 vf = *(const LAS u32x4*)(vl + i * 8192 + d * 256);
            o[d] = __builtin_amdgcn_mfma_f32_16x16x32_bf16(__builtin_bit_cast(bf16x8, vf), pf, o[d], 0, 0, 0);
        }
        if (i & 1) __builtin_amdgcn_sched_barrier(0);
    }
    const float li = 1.f / l;
    char* ob = (char*)(mixb + (size_t)(tok0 + r * 64 + 16 * g) * 1024 + 512 + h * 64);
    const unsigned oo = (unsigned)(n * 1024 + 4 * kq) * 2u;
#pragma unroll
    for (int d = 0; d < 4; ++d) *(u32x2*)(ob + oo + 32 * d) = (u32x2){pk2bf(o[d][0] * li, o[d][1] * li), pk2bf(o[d][2] * li, o[d][3] * li)};
}
__device__ __forceinline__ void ph_natten(LAS unsigned char* lds, const bf16_t* P, const bf16_t* VT, int gr, int nseq, const float* rpb, bf16_t* mixb, int wg, int nwg) {
    const int tid0 = otid(); const int lane = tid0 & 63, wave = __builtin_amdgcn_readfirstlane(tid0 >> 6);
    const int h = wg & 7, r0 = 2 * (wg >> 3), r = r0 + (wave >> 2), g = wave & 3;
    const int rsA = min(max(r0 - 4, 0), 56), lo = min(max(r - 4, 0), 56) - rsA;
    const int n = lane & 15, kq = lane >> 4;
    (void)gr; (void)nwg;
    __syncthreads();
    for (int i = tid0; i < 15 * 32; i += NT) { const int rr = i >> 5, cc = i & 31; ((LAS float*)(lds + L_RPB))[i] = (cc < 31) ? 1.44269504f * rpb[h * 15 * 31 + rr * 31 + cc] : -1e30f; }
    u32x4 pk[9], pv[9], q0, q1;
    auto issue = [&](int b) {
        const int tok0 = b * SEQ;
#pragma unroll
        for (int k = 0; k < 9; ++k) {
            const int p = tid0 + NT * k, ts = p >> 3, lr = ts >> 6, col = ts & 63;
            const int row = min(rsA + lr, 63);
            pk[k] = *(const u32x4*)((const char*)(P + (size_t)(tok0 + row * 64 + col) * PCW + KOFF + h * 64) + 16 * (p & 7));
            const int tb = p >> 6, dim = p & 63, lrv = tb >> 3, rowv = min(rsA + lrv, 63);
            pv[k] = *(const u32x4*)(VT + (size_t)(((tok0 + rowv * 64) >> 3) + (tb & 7)) * 4096 + (h * 64 + dim) * 8);
        }
        const char* qb = (const char*)(P + (size_t)(tok0 + r * 64 + 16 * g) * PCW + QOFF + h * 64) + (unsigned)(n * PCW + 8 * kq) * 2u;
        q0 = *(const u32x4*)qb; q1 = *(const u32x4*)(qb + 64);
    };
    issue(0);
    for (int b = 0; b < nseq; ++b) {
        __syncthreads();
#pragma unroll
        for (int k = 0; k < 9; ++k) {
            const int p = tid0 + NT * k;
            *(LAS u32x4*)(lds + L_NK + (p >> 3) * NK_PITCH + 16 * (p & 7)) = pk[k];
            *(LAS u32x4*)(lds + L_NV + p * 16) = pv[k];
        }
        const u32x4 cq0 = q0, cq1 = q1;
        __syncthreads();
        if (b + 1 < nseq) issue(b + 1);
        natten_item_lds(lds, (const LAS float*)(lds + L_RPB), mixb, b, h, r, g, lo, cq0, cq1, lane);
    }
}
template <int CTRL> __device__ __forceinline__ float dppf(float x) { return __int_as_float(__builtin_amdgcn_update_dpp(0, __float_as_int(x), CTRL, 0xf, 0xf, true)); }
constexpr int EPI_W = 135168, EPI_R = EPI_W + 4096;
struct EpiFfn {
    static constexpr bool PERM = true, AFTER_DRAIN = false, APERM = true;
    LAS unsigned char* lds;
    bf16_t* act; float* edge; const float* rstd; const float* cw; const float* cb;
    typedef float f32x2v __attribute__((ext_vector_type(2)));
    static __device__ __forceinline__ f32x2v ld2(const float* base, unsigned byteoff) { return *(const f32x2v*)((const char*)base + byteoff); }
    __device__ __forceinline__ void operator()(const pg8::f32x4 (&acc)[2][2][4][2], const pg8::Unit& u, int wr, int wc, int fr_in, int fq_in) const {
        const int lane_ = olane();
        const int fr = lane_ & 15, fq = lane_ >> 4; (void)fr_in; (void)fq_in;
        const unsigned g0 = (unsigned)(u.pn * 128 + wc * 32 + 8 * fq);
        {
            const int tid_ = (wr * 4 + wc) * 64 + lane_;
            LAS float* Wl = (LAS float*)(lds + EPI_W);
#pragma unroll
            for (int q = 0; q < 2; ++q) {
                const int idx = tid_ + 512 * q, k = idx >> 7, j = idx & 127;
                const float* src = ((k & 3) < 3 ? cw + (k & 3) * UPC : cb) + (k >> 2) * DFF + u.pn * 128 + j;
                Wl[idx] = *src;
            }
            __syncthreads();
        }
#pragma unroll
        for (int n = 0; n < 2; ++n) {
#pragma unroll
            for (int ai = 0; ai < 2; ++ai) {
                const int lane2 = olane();
                const int fr = lane2 & 15, fq = lane2 >> 4;
                const unsigned g0 = (unsigned)(u.pn * 128 + wc * 32 + 8 * fq);
                const LAS float* Wl = (const LAS float*)(lds + EPI_W) + (wc * 32 + 8 * fq);
                const bool isedge = (fr == 0) || (fr == 15);
                const unsigned rowbase = (unsigned)(u.pm * 256 + ai * 128 + wr * 64);
                const f32x4 rs = *(const LAS f32x4*)((const LAS float*)(lds + RS_A) + (wr * 64 + ai * 128 + 4 * fr));
                const unsigned eoff = (((rowbase >> 6) * 4 + (unsigned)(fr == 0 ? 0 : 2)) * UPC + g0 + 4 * n) * 4u;
                unsigned outp[4][2];
                const f32x4 wg0 = *(const LAS f32x4*)(Wl + 0 * 128 + 4 * n), wg1 = *(const LAS f32x4*)(Wl + 1 * 128 + 4 * n), wg2 = *(const LAS f32x4*)(Wl + 2 * 128 + 4 * n), bg4 = *(const LAS f32x4*)(Wl + 3 * 128 + 4 * n);
                const f32x4 wv0 = *(const LAS f32x4*)(Wl + 4 * 128 + 4 * n), wv1 = *(const LAS f32x4*)(Wl + 5 * 128 + 4 * n), wv2 = *(const LAS f32x4*)(Wl + 6 * 128 + 4 * n), bv4 = *(const LAS f32x4*)(Wl + 7 * 128 + 4 * n);
#pragma unroll
                for (int e = 0; e < 4; ++e) {
                    float cg[4], cv[4];
                    const float wg0e = wg0[e], wg1e = wg1[e], wg2e = wg2[e], bge = bg4[e], wv0e = wv0[e], wv1e = wv1[e], wv2e = wv2[e], bve = bv4[e];
                    {
                        float x[4];
#pragma unroll
                        for (int m = 0; m < 4; ++m) x[m] = acc[ai][0][m][n][e] * rs[m];
                        if (isedge) { *(float*)((char*)edge + eoff + 4u * e) = (fr == 0) ? x[0] : x[2]; *(float*)((char*)edge + eoff + UPC * 4u + 4u * e) = (fr == 0) ? x[1] : x[3]; }
                        const float up = dppf<0x111>(x[3]), dn = dppf<0x101>(x[0]);
                        cg[0] = fmaf(wg0e, up, fmaf(wg1e, x[0], fmaf(wg2e, x[1], bge))); cg[1] = fmaf(wg0e, x[0], fmaf(wg1e, x[1], fmaf(wg2e, x[2], bge)));
                        cg[2] = fmaf(wg0e, x[1], fmaf(wg1e, x[2], fmaf(wg2e, x[3], bge))); cg[3] = fmaf(wg0e, x[2], fmaf(wg1e, x[3], fmaf(wg2e, dn, bge)));
                    }
                    {
                        float x[4];
#pragma unroll
                        for (int m = 0; m < 4; ++m) x[m] = acc[ai][1][m][n][e] * rs[m];
                        if (isedge) { *(float*)((char*)edge + eoff + DFF * 4u + 4u * e) = (fr == 0) ? x[0] : x[2]; *(float*)((char*)edge + eoff + (UPC + DFF) * 4u + 4u * e) = (fr == 0) ? x[1] : x[3]; }
                        const float up = dppf<0x111>(x[3]), dn = dppf<0x101>(x[0]);
                        cv[0] = fmaf(wv0e, up, fmaf(wv1e, x[0], fmaf(wv2e, x[1], bve))); cv[1] = fmaf(wv0e, x[0], fmaf(wv1e, x[1], fmaf(wv2e, x[2], bve)));
                        cv[2] = fmaf(wv0e, x[1], fmaf(wv1e, x[2], fmaf(wv2e, x[3], bve))); cv[3] = fmaf(wv0e, x[2], fmaf(wv1e, x[3], fmaf(wv2e, dn, bve)));
                    }
#pragma unroll
                    for (int m = 0; m < 4; ++m) {
                        const float o = (cg[m] * cv[m]) * __builtin_amdgcn_rcpf(1.f + __builtin_amdgcn_exp2f(-1.44269504f * cg[m]));
                        outp[m][e >> 1] = (e & 1) ? cvtpk(__uint_as_float(outp[m][e >> 1]), o) : __float_as_uint(o);
                    }
                    __builtin_amdgcn_sched_barrier(0);
                }
#pragma unroll
                for (int m = 0; m < 4; ++m) {
                    const unsigned rib = 4 * (unsigned)fr + m;
                    if (rib != 0 && rib != 63) *(u32x2*)((char*)act + ((rowbase + rib) * DFF + g0 + 4 * n) * 2u) = (u32x2){outp[m][0], outp[m][1]};
                }
                asm volatile("" ::: "memory");
            }
        }
    }
};
__device__ __forceinline__ void ph_gemm_ffn(LAS unsigned char* lds, const bf16_t* A, const bf16_t* Bt, int M, bf16_t* act, float* edge, const float* rstd, const float* cw, const float* cb) {
    pg8::Gemm g{A, Bt, M, UPC, D, 0}; EpiFfn e{lds, act, edge, rstd, cw, cb};
    pg8::StaticOrder S; S.init(M, UPC, NWG, (int)blockIdx.x);
    pg8::gemm_phase<EpiFfn, pg8::StaticOrder, true, true>(lds, g, S, e, otid());
}
__device__ __forceinline__ void ph_ffn_fix(const float* __restrict__ edge, const float* __restrict__ cw, const float* __restrict__ cb, bf16_t* __restrict__ act, int rows) {
    typedef float f2 __attribute__((ext_vector_type(2)));
    const int tid0 = otid(); const int nb = rows / 64;
    constexpr int CP = DFF / 2;
    const int total = 2 * nb * CP;
#pragma unroll 3
    for (int p = blockIdx.x * NT + tid0; p < total; p += NWG * NT) {
        const int it = p / CP, c = 2 * (p - it * CP);
        const int blk = it >> 1, last = it & 1;
        const int row = blk * 64 + (last ? 63 : 0), t = row & (SEQ - 1);
        const float* cur = edge + ((size_t)blk * 4 + (last ? 3 : 0)) * UPC;
        const bool hp = last ? true : (t > 0), hn = last ? (t < SEQ - 1) : true;
        const float* prv = last ? edge + ((size_t)blk * 4 + 2) * UPC : edge + ((size_t)(hp ? blk - 1 : blk) * 4 + 3) * UPC;
        const float* nxt = last ? edge + ((size_t)(hn ? blk + 1 : blk) * 4 + 0) * UPC : edge + ((size_t)blk * 4 + 1) * UPC;
        const f2 w0g = *(const f2*)(cw + c), w1g = *(const f2*)(cw + UPC + c), w2g = *(const f2*)(cw + 2 * UPC + c), bg = *(const f2*)(cb + c);
        const f2 w0v = *(const f2*)(cw + DFF + c), w1v = *(const f2*)(cw + UPC + DFF + c), w2v = *(const f2*)(cw + 2 * UPC + DFF + c), bv = *(const f2*)(cb + DFF + c);
        const f2 cg = *(const f2*)(cur + c), cv = *(const f2*)(cur + DFF + c);
        f2 pg = *(const f2*)(prv + c), pv = *(const f2*)(prv + DFF + c), ng = *(const f2*)(nxt + c), nv = *(const f2*)(nxt + DFF + c);
        if (!hp) { pg = (f2){0.f, 0.f}; pv = pg; }
        if (!hn) { ng = (f2){0.f, 0.f}; nv = ng; }
        const f2 g = w1g * cg + bg + w0g * pg + w2g * ng, v = w1v * cv + bv + w0v * pv + w2v * nv;
        const float o0 = g[0] * sigmoidf_(g[0]) * v[0], o1 = g[1] * sigmoidf_(g[1]) * v[1];
        *(unsigned*)(act + (size_t)row * DFF + c) = cvtpk(o0, o1);
    }
}

constexpr int NSEG = 4, SEGTOK = SEQ / NSEG;
constexpr int OP_AP = 0, OP_RP = 2048, OP_MX2 = 4096, OP_MD = 5120, OP_MY = 6144, OP_GP = 7168, OP_VT = 11264, OP_GC = 13312, OP_SIZE = 13568;
constexpr int LS_OPS = 0, LS_LABT = 8 * OP_SIZE, LS_MU = LS_LABT + 8 * 1024, LS_CST = LS_MU + 3 * 7 * 64 * 4, LS_WL = LS_CST + 6 * 64 * 4, LS_EOF = LS_WL + 36 * 1024, LS_END = LS_EOF + 1024;
constexpr int WL_DEC = 0, WL_AAA = 8 * 1024, WL_VU = 16 * 1024, WL_G = 20 * 1024;
static_assert(LS_END <= LDS_MISC, "scan unit LDS map");

template <int CTRL> __device__ __forceinline__ float dpp_mov(float x) { return __int_as_float(__builtin_amdgcn_update_dpp(0, __float_as_int(x), CTRL, 0xf, 0xf, false)); }
template <int CTRL> __device__ __forceinline__ unsigned dpp_keep(unsigned old, unsigned src) { return (unsigned)__builtin_amdgcn_update_dpp((int)old, (int)src, CTRL, 0xf, 0xf, false); }
__device__ __forceinline__ float fsig(float z) { return __builtin_amdgcn_rcpf(1.f + __builtin_amdgcn_exp2f(z)); }
__device__ __forceinline__ float ftanh(float z) { return 1.f - 2.f * __builtin_amdgcn_rcpf(1.f + __builtin_amdgcn_exp2f(z)); }
__device__ __forceinline__ f32v2_t bfpair(unsigned u) { return (f32v2_t){__uint_as_float(u << 16), __uint_as_float(u & 0xffff0000u)}; }
__device__ __forceinline__ u32x4 pack8(const float* v) { u32x4 r; r.x = cvtpk(v[0], v[1]); r.y = cvtpk(v[2], v[3]); r.z = cvtpk(v[4], v[5]); r.w = cvtpk(v[6], v[7]); return r; }

struct ScanW {
    const float *mu, *w0, *a0, *v0, *kk_, *ka, *rk;
    const bf16_t *WdecT, *WaaaT, *WgT, *WvuT;
};

template <int NKS> __device__ __forceinline__ void lora_mm(const LAS unsigned char* wl, const u32x4 (&xf)[NKS], float (&out)[16]) {
#pragma unroll
    for (int nb = 0; nb < 4; ++nb) {
        f32x4 acc = (f32x4){0.f, 0.f, 0.f, 0.f};
#pragma unroll
        for (int ks = 0; ks < NKS; ++ks)
            acc = __builtin_amdgcn_mfma_f32_16x16x32_bf16(*(const LAS bf16x8*)(wl + (nb * NKS + ks) * 1024), __builtin_bit_cast(bf16x8, xf[ks]), acc, 0, 0, 0);
        out[4 * nb + 0] = acc[0]; out[4 * nb + 1] = acc[1]; out[4 * nb + 2] = acc[2]; out[4 * nb + 3] = acc[3];
    }
}

template <int V> struct IC { static constexpr int value = V; };
template <int N> __device__ __forceinline__ unsigned edge_lo(unsigned v) { if constexpr (N == 0) return v; else return (unsigned)__builtin_amdgcn_update_dpp(0, (int)v, 0x100 + N, 0xf, 0xf, true); }
template <int N> __device__ __forceinline__ unsigned edge_hi(unsigned v) { if constexpr (N == 0) return v; else return (unsigned)__builtin_amdgcn_update_dpp(0, (int)v, 0x110 + N, 0xf, 0xf, true); }
__device__ __forceinline__ void scan_unit(LAS unsigned char* lds, int unit, int layer, const bf16_t* __restrict__ P, const ScanW& w,
                                          bf16_t* __restrict__ ybuf, bf16_t* __restrict__ gbuf, bf16_t* __restrict__ mixb, bf16_t* __restrict__ vfirst, float* __restrict__ sbon,
                                          bf16_t* __restrict__ yaug, float* __restrict__ segst) {
    const int tid = otid(), lane = tid & 63, wave = __builtin_amdgcn_readfirstlane(tid >> 6);
    const int seg = unit & (NSEG - 1), chain = unit / NSEG;
    const int h = chain & 7, dir = (chain >> 3) & 1, b = chain >> 4;
    const int tokbase = b * SEQ;
    const int t = lane & 15, kq = lane >> 4;
    auto segcol = [&](int s_) { return s_ < 3 ? s_ * 512 + h * 64 : s_ == 3 ? O_WD + dir * 64 : s_ == 4 ? O_AD + dir * 64 : O_GD + (s_ - 5) * 64; };
    for (int i = tid; i < 3 * 7 * 64; i += NT) {
        const int m = i / 448, r = i % 448, sg = r >> 6, c = r & 63; const int col = segcol(sg) + c;
        ((LAS float*)(lds + LS_MU))[i] = (m < 2) ? w.mu[(m ^ dir) * RWC + col] : 1.f - w.mu[col] - w.mu[RWC + col];
    }
    if (tid < 384) {
        const int which = tid >> 6, ch = h * 64 + (tid & 63);
        const float v = (which == 0) ? w.kk_[ch] : (which == 1) ? w.ka[ch] : (which == 2) ? w.rk[ch] : (which == 3) ? w.w0[dir * 512 + ch] : (which == 4) ? w.a0[dir * 512 + ch] : ((layer > 0) ? w.v0[ch] : 0.f);
        ((LAS float*)(lds + LS_CST))[tid] = (which >= 3) ? -1.44269504f * v : v;
    }
    for (int i = tid; i < 36 * 64; i += NT) {
        const int f = i >> 6, n = i & 15, q = (i >> 4) & 3;
        const bf16_t* src; int Kw, nb, ks;
        if (f < 8)       { src = w.WdecT + (size_t)dir * 512 * 64; Kw = 64; nb = f >> 1; ks = f & 1; }
        else if (f < 16) { src = w.WaaaT + (size_t)dir * 512 * 64; Kw = 64; nb = (f - 8) >> 1; ks = f & 1; }
        else if (f < 20) { src = w.WvuT; Kw = 32; nb = f - 16; ks = 0; }
        else             { src = w.WgT; Kw = 128; nb = (f - 20) >> 2; ks = (f - 20) & 3; }
        const bf16_t* p = src + (h * 64 + 16 * nb + n) * Kw + 32 * ks + 4 * q;
        const u32x2 lo = *(const u32x2*)p, hi = *(const u32x2*)(p + 16);
        *(LAS u32x4*)(lds + LS_WL + i * 16) = (u32x4){lo.x, lo.y, hi.x, hi.y};
    }
    __syncthreads();

    f32x4 St[4];
    const bool augw = wave >= 4; const int colw = 16 * (wave & 3) + t;
#pragma unroll
    for (int jb = 0; jb < 4; ++jb)
#pragma unroll
        for (int e = 0; e < 4; ++e) St[jb][e] = (augw && (16 * jb + 4 * kq + e) == colw) ? 1.f : 0.f;

    const char* Pc = (const char*)P;
    u32x2 rc[7][4], fz[3][2], EL[2], EH[2];
    const int colLo = dir ? 1984 : 1952, colHi = dir ? 1952 : 1984;
    auto piece_col = [&](int p, int foldcol) { const int sg = p >> 2, g = p & 3; return (p < 28 ? segcol(sg) + 16 * g : foldcol + 16 * (p & 1)) * 2 + 8 * kq; };
    if (tid < 64) *(LAS u32x4*)(lds + LS_EOF + tid * 16) = (u32x4){(unsigned)piece_col(t, colLo), (unsigned)piece_col((t + 16) & 31, colLo), (unsigned)piece_col(15 - t, colHi), (unsigned)piece_col(31 - t, colHi)};
    auto issue_loads = [&](int it_) {
        const int gb = seg * (SEGTOK / 16) + it_ * 8 + wave;
        const int st = 16 * gb + t;
        const int tok = dir ? (SEQ - 1 - st) : st;
        const unsigned ro = (unsigned)(tokbase + tok) * (unsigned)(PCW * 2) + 8u * kq;
        const int sL = 16 * gb - 1, sH = 16 * gb + 16;
        const bool vL_ = gb > 0, vH_ = gb < SEQ / 16 - 1;
        const int tL = vL_ ? (dir ? (SEQ - 1 - sL) : sL) : 0, tH = vH_ ? (dir ? (SEQ - 1 - sH) : sH) : 0;
        const unsigned rl = (unsigned)(tokbase + tL) * (unsigned)(PCW * 2), rh = (unsigned)(tokbase + tH) * (unsigned)(PCW * 2);
#pragma unroll
        for (int sg = 0; sg < 7; ++sg) {
            if (sg >= 5 && (it_ & 1)) continue;
            const int col = segcol(sg);
#pragma unroll
            for (int g = 0; g < 4; ++g) rc[sg][g] = *(const u32x2*)(Pc + ro + col * 2 + 32 * g);
        }
        const u32x4 eo4 = *(const LAS u32x4*)(lds + LS_EOF + lane * 16);
        const unsigned zo_ = 2016u * 2u + 8u * (unsigned)(lane & 3);
        EL[0] = *(const u32x2*)(Pc + (rl + (vL_ ? eo4.x : zo_))); EL[1] = *(const u32x2*)(Pc + (rl + (vL_ ? eo4.y : zo_)));
        EH[0] = *(const u32x2*)(Pc + (rh + (vH_ ? eo4.z : zo_))); EH[1] = *(const u32x2*)(Pc + (rh + (vH_ ? eo4.w : zo_)));
        if (layer > 0) {
#pragma unroll
            for (int g = 0; g < 2; ++g) { fz[0][g] = *(const u32x2*)(Pc + ro + 1920 * 2 + 32 * g); fz[1][g] = *(const u32x2*)(Pc + ro + colLo * 2 + 32 * g); fz[2][g] = *(const u32x2*)(Pc + ro + colHi * 2 + 32 * g); }
        }
    };
#pragma unroll
    for (int sg = 0; sg < 7; ++sg)
#pragma unroll
        for (int g = 0; g < 4; ++g) rc[sg][g] = (u32x2){0u, 0u};
#pragma unroll
    for (int g = 0; g < 2; ++g) { fz[0][g] = fz[1][g] = fz[2][g] = (u32x2){0u, 0u}; }
    __syncthreads();
    issue_loads(0);
    for (int it = 0; it < SEGTOK / 128; ++it) {
        {
            if (wave >= 4) __builtin_amdgcn_s_sleep(3);
            int lane_o = lane; asm volatile("" : "+v"(lane_o));
            const int t = lane_o & 15, kq = lane_o >> 4;
            const LAS unsigned char* WL = lds + LS_WL + lane_o * 16;
            const LAS float* MU = (const LAS float*)(lds + LS_MU) + 4 * kq;
            const LAS float* CST = (const LAS float*)(lds + LS_CST) + 4 * kq;
            LAS unsigned char* myop = lds + LS_OPS + wave * OP_SIZE;
            LAS float* labt = (LAS float*)(lds + LS_LABT + wave * 1024);
            const int lane = lane_o;
            const int gb = seg * (SEGTOK / 16) + it * 8 + wave;
            const int st = 16 * gb + t;
            const int tok = dir ? (SEQ - 1 - st) : st;
            const unsigned grow = (unsigned)(tokbase + tok);
            u32x2 vf[4];
#pragma unroll
            for (int g = 0; g < 4; ++g) vf[g] = (u32x2){0u, 0u};
            if (layer > 0) {
#pragma unroll
                for (int g = 0; g < 4; ++g) vf[g] = *(const u32x2*)((const char*)vfirst + (grow * 1024u + (unsigned)((h * 64 + 16 * g + 4 * kq) * 2)));
            }
            auto seg_mix = [&](auto sgc, float (&out)[16]) {
                constexpr int sg = decltype(sgc)::value;
                auto grp = [&](auto gc) {
                    constexpr int g = decltype(gc)::value, p = 4 * sg + g, n = p & 15, j = p >> 4;
                    const u32x2 c = rc[sg][g];
                    const unsigned elx = edge_lo<n>(EL[j].x), ely = edge_lo<n>(EL[j].y), ehx = edge_hi<n>(EH[j].x), ehy = edge_hi<n>(EH[j].y);
                    const f32x4 ml = *(const LAS f32x4*)(MU + sg * 64 + 16 * g), mh = *(const LAS f32x4*)(MU + 448 + sg * 64 + 16 * g), m0 = *(const LAS f32x4*)(MU + 896 + sg * 64 + 16 * g);
                    {
                        const f32v2_t cc = bfpair(c.x), lo = bfpair(dpp_keep<0x111>(elx, c.x)), hi = bfpair(dpp_keep<0x101>(ehx, c.x));
                        const f32v2_t v = (f32v2_t){m0[0], m0[1]} * cc + (f32v2_t){ml[0], ml[1]} * lo + (f32v2_t){mh[0], mh[1]} * hi;
                        out[4 * g + 0] = v[0]; out[4 * g + 1] = v[1];
                    }
                    {
                        const f32v2_t cc = bfpair(c.y), lo = bfpair(dpp_keep<0x111>(ely, c.y)), hi = bfpair(dpp_keep<0x101>(ehy, c.y));
                        const f32v2_t v = (f32v2_t){m0[2], m0[3]} * cc + (f32v2_t){ml[2], ml[3]} * lo + (f32v2_t){mh[2], mh[3]} * hi;
                        out[4 * g + 2] = v[0]; out[4 * g + 3] = v[1];
                    }
                };
                grp(IC<0>{}); grp(IC<1>{}); grp(IC<2>{}); grp(IC<3>{});
            };
            auto cst16 = [&](int which, float (&out)[16]) {
#pragma unroll
                for (int g = 0; g < 4; ++g) { const f32x4 v = *(const LAS f32x4*)(CST + which * 64 + 16 * g); out[4 * g] = v[0]; out[4 * g + 1] = v[1]; out[4 * g + 2] = v[2]; out[4 * g + 3] = v[3]; }
            };
            u32x4 selE, selO;
            {
                const unsigned wv = (kq == (t >> 2)) ? (0x3F80u << (16 * (t & 1))) : 0u;
                const unsigned w0_ = (t & 2) ? 0u : wv, w1_ = (t & 2) ? wv : 0u;
                selE = (u32x4){w0_, w1_, 0u, 0u}; selO = (u32x4){0u, 0u, w0_, w1_};
            }
            if ((it & 1) == 0) {
                float g0[16], g1[16]; seg_mix(IC<5>{}, g0); seg_mix(IC<6>{}, g1);
#pragma unroll
                for (int i = 0; i < 16; ++i) { g0[i] = fsig(g0[i]); g1[i] = fsig(g1[i]); }
                u32x4 xf[4]; xf[0] = pack8(g0); xf[1] = pack8(g0 + 8); xf[2] = pack8(g1); xf[3] = pack8(g1 + 8);
                float go[16]; lora_mm<4>(WL + WL_G, xf, go);
#pragma unroll
                for (int g = 0; g < 4; ++g) *(u32x2*)((char*)gbuf + (grow * 1024u + (unsigned)((h * 64 + 16 * g + 4 * kq) * 2))) = (u32x2){cvtpk(go[4 * g], go[4 * g + 1]), cvtpk(go[4 * g + 2], go[4 * g + 3])};
            }
            float kv[16], kk[16];
            seg_mix(IC<1>{}, kv);
            {
                float c_[16]; cst16(0, c_);
                float ss = 0.f;
#pragma unroll
                for (int i = 0; i < 16; ++i) { kk[i] = kv[i] * c_[i]; ss += kk[i] * kk[i]; }
                ss += shx(ss, 16, lane); ss += shx(ss, 32, lane);
                const float rn = __builtin_amdgcn_rsqf(fmaxf(ss, 1e-12f));
#pragma unroll
                for (int i = 0; i < 16; ++i) kk[i] *= rn;
            }
            float kd[16], bb[16];
            {
                float ain[16]; seg_mix(IC<4>{}, ain);
                u32x4 xf[2]; xf[0] = pack8(ain); xf[1] = pack8(ain + 8);
                float xa[16]; lora_mm<2>(WL + WL_AAA, xf, xa);
                float a0c[16], kac[16]; cst16(4, a0c); cst16(1, kac);
#pragma unroll
                for (int i = 0; i < 16; ++i) { const float a = fsig(xa[i] + a0c[i]); kd[i] = kv[i] * (1.f + (a - 1.f) * kac[i]); bb[i] = kk[i] * a; }
            }
            float rv[16];
            seg_mix(IC<0>{}, rv);
            {
                float rkc[16]; cst16(2, rkc);
                float bon = 0.f;
#pragma unroll
                for (int i = 0; i < 16; ++i) bon += rv[i] * kd[i] * rkc[i];
                bon += shx(bon, 16, lane); bon += shx(bon, 32, lane);
                if (kq == 0) *(float*)((char*)sbon + (grow * 64u + (unsigned)((dir * 8 + h) * 4))) = bon;
            }
            {
                float vv[16]; seg_mix(IC<2>{}, vv);
                if (layer > 0) {
                    float hid[8];
                    {
                        const u32x2 z0 = fz[0][0], cl = fz[1][0], ch_ = fz[2][0];
                        const f32v2_t s0 = bfpair(z0.x) + bfpair(dpp_keep<0x111>(edge_lo<12>(EL[1].x), cl.x)) + bfpair(dpp_keep<0x101>(edge_hi<12>(EH[1].x), ch_.x));
                        const f32v2_t s1 = bfpair(z0.y) + bfpair(dpp_keep<0x111>(edge_lo<12>(EL[1].y), cl.y)) + bfpair(dpp_keep<0x101>(edge_hi<12>(EH[1].y), ch_.y));
                        hid[0] = s0[0]; hid[1] = s0[1]; hid[2] = s1[0]; hid[3] = s1[1];
                    }
                    {
                        const u32x2 z0 = fz[0][1], cl = fz[1][1], ch_ = fz[2][1];
                        const f32v2_t s0 = bfpair(z0.x) + bfpair(dpp_keep<0x111>(edge_lo<13>(EL[1].x), cl.x)) + bfpair(dpp_keep<0x101>(edge_hi<13>(EH[1].x), ch_.x));
                        const f32v2_t s1 = bfpair(z0.y) + bfpair(dpp_keep<0x111>(edge_lo<13>(EL[1].y), cl.y)) + bfpair(dpp_keep<0x101>(edge_hi<13>(EH[1].y), ch_.y));
                        hid[4] = s0[0]; hid[5] = s0[1]; hid[6] = s1[0]; hid[7] = s1[1];
                    }
                    u32x4 xf[1]; xf[0] = pack8(hid);
                    float xm[16]; lora_mm<1>(WL + WL_VU, xf, xm);
                    float v0c[16]; cst16(5, v0c);
#pragma unroll
                    for (int g = 0; g < 4; ++g) {
                        const f32v2_t f0 = bfpair(vf[g].x), f1 = bfpair(vf[g].y);
                        vv[4 * g + 0] += (f0[0] - vv[4 * g + 0]) * fsig(xm[4 * g + 0] + v0c[4 * g + 0]); vv[4 * g + 1] += (f0[1] - vv[4 * g + 1]) * fsig(xm[4 * g + 1] + v0c[4 * g + 1]);
                        vv[4 * g + 2] += (f1[0] - vv[4 * g + 2]) * fsig(xm[4 * g + 2] + v0c[4 * g + 2]); vv[4 * g + 3] += (f1[1] - vv[4 * g + 3]) * fsig(xm[4 * g + 3] + v0c[4 * g + 3]);
                    }
                }
                u32x4 vp[2]; vp[0] = pack8(vv); vp[1] = pack8(vv + 8);
                if (dir == 1) {
                    const unsigned pv[8] = {vp[0].x, vp[0].y, vp[0].z, vp[0].w, vp[1].x, vp[1].y, vp[1].z, vp[1].w};
#pragma unroll
                    for (int g = 0; g < 4; ++g) {
                        const u32x2 q = (u32x2){pv[2 * g], pv[2 * g + 1]};
                        *(u32x2*)((char*)mixb + (grow * 2048u + (unsigned)((h * 64 + 16 * g + 4 * kq) * 2))) = q;
                        if (layer == 0) *(u32x2*)((char*)vfirst + (grow * 1024u + (unsigned)((h * 64 + 16 * g + 4 * kq) * 2))) = q;
                    }
                }
#pragma unroll
                for (int ib = 0; ib < 4; ++ib) {
                    const f32x4 z = (f32x4){0.f, 0.f, 0.f, 0.f};
                    const f32x4 d = __builtin_amdgcn_mfma_f32_16x16x32_bf16(__builtin_bit_cast(bf16x8, vp[ib >> 1]), __builtin_bit_cast(bf16x8, (ib & 1) ? selO : selE), z, 0, 0, 0);
                    *(LAS u32x2*)(myop + OP_VT + (ib * 64 + lane) * 8) = (u32x2){cvtpk(d[0], d[1]), cvtpk(d[2], d[3])};
                }
            }
            u32x4 apf[2], rpf[2], btf[2], ktf[2], bgf[2], kgf[2];
            {
                float lw[16];
                {
                    float win[16]; seg_mix(IC<3>{}, win);
#pragma unroll
                    for (int i = 0; i < 16; ++i) win[i] = ftanh(win[i]);
                    u32x4 xf[2]; xf[0] = pack8(win); xf[1] = pack8(win + 8);
                    float xw[16]; lora_mm<2>(WL + WL_DEC, xf, xw);
                    float w0c[16]; cst16(3, w0c);
#pragma unroll
                    for (int i = 0; i < 16; ++i) lw[i] = -0.87503878f * fsig(xw[i] + w0c[i]);
                }
                float at[16], rt[16], bt[16], kt[16], bg[16], kg[16], gC[16];
#pragma unroll
                for (int i = 0; i < 16; ++i) {
                    float lam = lw[i];
                    lam += dpp_mov<0x111>(lam); lam += dpp_mov<0x112>(lam); lam += dpp_mov<0x114>(lam); lam += dpp_mov<0x118>(lam);
                    const float e3 = __builtin_amdgcn_exp2f(lam), e2 = __builtin_amdgcn_exp2f(-lam);
                    const float g = shl_(e3, (lane & 48) | 15);
                    const float e1 = __int_as_float(__builtin_amdgcn_update_dpp(0x3f800000, __float_as_int(e3), 0x111, 0xf, 0xf, false));
                    const float ge = g * e2;
                    gC[i] = g; at[i] = kk[i] * e1; rt[i] = rv[i] * e3; bt[i] = bb[i] * e2; kt[i] = kd[i] * e2; bg[i] = -bb[i] * ge; kg[i] = kd[i] * ge;
                }
                apf[0] = pack8(at); apf[1] = pack8(at + 8); rpf[0] = pack8(rt); rpf[1] = pack8(rt + 8); btf[0] = pack8(bt); btf[1] = pack8(bt + 8);
                ktf[0] = pack8(kt); ktf[1] = pack8(kt + 8); bgf[0] = pack8(bg); bgf[1] = pack8(bg + 8); kgf[0] = pack8(kg); kgf[1] = pack8(kg + 8);
                if (t == 0) {
#pragma unroll
                    for (int g = 0; g < 4; ++g) *(LAS f32x4*)(myop + OP_GC + (kq * 16 + 4 * g) * 4) = (f32x4){gC[4 * g], gC[4 * g + 1], gC[4 * g + 2], gC[4 * g + 3]};
                }
            }
            *(LAS u32x4*)(myop + OP_AP + lane * 16) = apf[0]; *(LAS u32x4*)(myop + OP_AP + 1024 + lane * 16) = apf[1];
            *(LAS u32x4*)(myop + OP_RP + lane * 16) = rpf[0]; *(LAS u32x4*)(myop + OP_RP + 1024 + lane * 16) = rpf[1];
            {
                f32x4 lab = (f32x4){0.f, 0.f, 0.f, 0.f}, lak = lab, lrb = lab, lrk = lab;
#pragma unroll
                for (int ks = 0; ks < 2; ++ks) {
                    lab = __builtin_amdgcn_mfma_f32_16x16x32_bf16(__builtin_bit_cast(bf16x8, btf[ks]), __builtin_bit_cast(bf16x8, apf[ks]), lab, 0, 0, 0);
                    lak = __builtin_amdgcn_mfma_f32_16x16x32_bf16(__builtin_bit_cast(bf16x8, ktf[ks]), __builtin_bit_cast(bf16x8, apf[ks]), lak, 0, 0, 0);
                    lrb = __builtin_amdgcn_mfma_f32_16x16x32_bf16(__builtin_bit_cast(bf16x8, btf[ks]), __builtin_bit_cast(bf16x8, rpf[ks]), lrb, 0, 0, 0);
                    lrk = __builtin_amdgcn_mfma_f32_16x16x32_bf16(__builtin_bit_cast(bf16x8, ktf[ks]), __builtin_bit_cast(bf16x8, rpf[ks]), lrk, 0, 0, 0);
                }
#pragma unroll
                for (int e = 0; e < 4; ++e) {
                    const int s = 4 * kq + e;
                    const bool lo = s < t, le = s <= t;
                    lab[e] = lo ? lab[e] : 0.f; lak[e] = lo ? lak[e] : 0.f; lrb[e] = le ? -lrb[e] : 0.f; lrk[e] = le ? lrk[e] : 0.f;
                    labt[s * 16 + t] = lab[e];
                }
                u32x4 mx; mx.x = 0u; mx.y = 0u; mx.z = cvtpk(lak[0], lak[1]); mx.w = cvtpk(lak[2], lak[3]);
                u32x4 my; my.x = cvtpk(lrb[0], lrb[1]); my.y = cvtpk(lrb[2], lrb[3]); my.z = cvtpk(lrk[0], lrk[1]); my.w = cvtpk(lrk[2], lrk[3]);
                *(LAS u32x4*)(myop + OP_MX2 + lane * 16) = mx; *(LAS u32x4*)(myop + OP_MY + lane * 16) = my;
            }
#pragma unroll
            for (int jb = 0; jb < 4; ++jb) {
                const f32x4 z = (f32x4){0.f, 0.f, 0.f, 0.f};
                const bf16x8 sel = __builtin_bit_cast(bf16x8, (jb & 1) ? selO : selE);
                const f32x4 d0 = __builtin_amdgcn_mfma_f32_16x16x32_bf16(__builtin_bit_cast(bf16x8, bgf[jb >> 1]), sel, z, 0, 0, 0);
                const f32x4 d1 = __builtin_amdgcn_mfma_f32_16x16x32_bf16(__builtin_bit_cast(bf16x8, kgf[jb >> 1]), sel, z, 0, 0, 0);
                u32x4 gp; gp.x = cvtpk(d0[0], d0[1]); gp.y = cvtpk(d0[2], d0[3]); gp.z = cvtpk(d1[0], d1[1]); gp.w = cvtpk(d1[2], d1[3]);
                *(LAS u32x4*)(myop + OP_GP + (jb * 64 + lane) * 16) = gp;
            }
            {
                const int s = t;
                float x[16];
#pragma unroll
                for (int q = 0; q < 16; ++q) x[q] = (q == s) ? 1.f : 0.f;
#pragma unroll
                for (int q = 0; q < 15; ++q) {
                    const f32x4 l0 = *(const LAS f32x4*)(labt + q * 16), l1 = *(const LAS f32x4*)(labt + q * 16 + 4), l2 = *(const LAS f32x4*)(labt + q * 16 + 8), l3 = *(const LAS f32x4*)(labt + q * 16 + 12);
                    const float lq[16] = {l0[0], l0[1], l0[2], l0[3], l1[0], l1[1], l1[2], l1[3], l2[0], l2[1], l2[2], l2[3], l3[0], l3[1], l3[2], l3[3]};
#pragma unroll
                    for (int r = q + 1; r < 16; ++r) x[r] -= lq[r] * x[q];
                }
                LAS bf16_t* md = (LAS bf16_t*)(myop + OP_MD) + (16 * (s >> 2)) * 8 + (s & 3);
#pragma unroll
                for (int j = 0; j < 4; ++j) {
                    const float xv = (kq == 0) ? x[j] : (kq == 1) ? x[4 + j] : (kq == 2) ? x[8 + j] : x[12 + j];
                    md[(4 * kq + j) * 8] = f2bf(xv);
                }
                { unsigned z_ = 0u; asm volatile("" : "+v"(z_)); *(LAS u32x2*)(myop + OP_MD + lane * 16 + 8) = (u32x2){z_, z_}; }
            }
        }
        __syncthreads();
        if (it + 1 < SEGTOK / 128) issue_loads(it + 1);
        int lane_c = lane; asm volatile("" : "+v"(lane_c));
#pragma unroll 1
        for (int c = 0; c < 8; ++c) {
            const int lane = lane_c, kq = lane_c >> 4, colc = 16 * (wave & 3) + (lane_c & 15);
            const LAS unsigned char* op = lds + LS_OPS + c * OP_SIZE;
            u32x2 vt = *(const LAS u32x2*)(op + OP_VT + ((wave & 3) * 64 + lane) * 8);
            if (augw) vt = (u32x2){0u, 0u};
            u32x4 sb0, sb1;
            sb0.x = cvtpk(St[0][0], St[0][1]); sb0.y = cvtpk(St[0][2], St[0][3]); sb0.z = cvtpk(St[1][0], St[1][1]); sb0.w = cvtpk(St[1][2], St[1][3]);
            sb1.x = cvtpk(St[2][0], St[2][1]); sb1.y = cvtpk(St[2][2], St[2][3]); sb1.z = cvtpk(St[3][0], St[3][1]); sb1.w = cvtpk(St[3][2], St[3][3]);
            const bf16x8 ap0 = *(const LAS bf16x8*)(op + OP_AP + lane * 16), ap1 = *(const LAS bf16x8*)(op + OP_AP + 1024 + lane * 16);
            const bf16x8 rp0 = *(const LAS bf16x8*)(op + OP_RP + lane * 16), rp1 = *(const LAS bf16x8*)(op + OP_RP + 1024 + lane * 16);
            const bf16x8 mx2 = *(const LAS bf16x8*)(op + OP_MX2 + lane * 16), mdm = *(const LAS bf16x8*)(op + OP_MD + lane * 16), mym = *(const LAS bf16x8*)(op + OP_MY + lane * 16);
            u32x4 b0v; b0v.x = 0u; b0v.y = 0u; b0v.z = vt.x; b0v.w = vt.y;
            f32x4 ax = (f32x4){0.f, 0.f, 0.f, 0.f};
            ax = __builtin_amdgcn_mfma_f32_16x16x32_bf16(mx2, __builtin_bit_cast(bf16x8, b0v), ax, 0, 0, 0);
            ax = __builtin_amdgcn_mfma_f32_16x16x32_bf16(ap0, __builtin_bit_cast(bf16x8, sb0), ax, 0, 0, 0);
            ax = __builtin_amdgcn_mfma_f32_16x16x32_bf16(ap1, __builtin_bit_cast(bf16x8, sb1), ax, 0, 0, 0);
            f32x4 ay = (f32x4){0.f, 0.f, 0.f, 0.f};
            ay = __builtin_amdgcn_mfma_f32_16x16x32_bf16(rp0, __builtin_bit_cast(bf16x8, sb0), ay, 0, 0, 0);
            ay = __builtin_amdgcn_mfma_f32_16x16x32_bf16(rp1, __builtin_bit_cast(bf16x8, sb1), ay, 0, 0, 0);
            u32x4 bx; bx.x = cvtpk(ax[0], ax[1]); bx.y = cvtpk(ax[2], ax[3]); bx.z = 0u; bx.w = 0u;
            f32x4 ad = (f32x4){0.f, 0.f, 0.f, 0.f};
            ad = __builtin_amdgcn_mfma_f32_16x16x32_bf16(mdm, __builtin_bit_cast(bf16x8, bx), ad, 0, 0, 0);
            u32x4 dv; dv.x = cvtpk(ad[0], ad[1]); dv.y = cvtpk(ad[2], ad[3]); dv.z = vt.x; dv.w = vt.y;
            ay = __builtin_amdgcn_mfma_f32_16x16x32_bf16(mym, __builtin_bit_cast(bf16x8, dv), ay, 0, 0, 0);
#pragma unroll
            for (int jb = 0; jb < 4; ++jb) {
                const f32x4 gc = *(const LAS f32x4*)(op + OP_GC + (kq * 16 + 4 * jb) * 4);
                const bf16x8 gp = *(const LAS bf16x8*)(op + OP_GP + (jb * 64 + lane) * 16);
                St[jb] = __builtin_amdgcn_mfma_f32_16x16x32_bf16(gp, __builtin_bit_cast(bf16x8, dv), St[jb] * gc, 0, 0, 0);
            }
            if (!augw || seg > 0) {
                bf16_t* yb = augw ? yaug : ybuf;
                const int sg0 = 16 * (seg * (SEGTOK / 16) + it * 8 + c) + 4 * kq;
#pragma unroll
                for (int e = 0; e < 4; ++e) { const int tk = dir ? (SEQ - 1 - (sg0 + e)) : (sg0 + e); *(bf16_t*)((char*)yb + ((unsigned)((tokbase + tk) * 2 + dir) * 1024u + (unsigned)((h * 64 + colc) * 2))) = f2bf(ay[e]); }
            }
        }
        __syncthreads();
    }
    if (seg + 1 < NSEG) {
        int lane_f = lane; asm volatile("" : "+v"(lane_f));
        const int kq = lane_f >> 4, colw = 16 * (wave & 3) + (lane_f & 15);
        float* dst = segst + ((size_t)unit * 2 + (augw ? 1 : 0)) * 4096;
#pragma unroll
        for (int jb = 0; jb < 4; ++jb)
#pragma unroll
            for (int e = 0; e < 4; ++e) dst[(16 * jb + 4 * kq + e) * 64 + colw] = St[jb][e];
    }
}

__device__ __forceinline__ void ph_segfix(LAS unsigned char* lds, const float* __restrict__ segst, bf16_t* __restrict__ SS, int nchain) {
    const int tid = otid(), j = tid >> 3, ig = tid & 7;
    LAS float* Sp = (LAS float*)lds;
    for (int chain = blockIdx.x; chain < nchain; chain += NWG) {
        float acc[8];
        for (int k = 1; k < NSEG; ++k) {
            const float* Cp = segst + ((size_t)(chain * NSEG + k - 1) * 2 + 0) * 4096 + j * 64 + 8 * ig;
            const float* Ap = segst + ((size_t)(chain * NSEG + k - 1) * 2 + 1) * 4096 + j * 64;
#pragma unroll
            for (int e = 0; e < 8; ++e) acc[e] = Cp[e];
            if (k > 1) {
                f32x4 ar[16];
#pragma unroll
                for (int q4 = 0; q4 < 16; ++q4) ar[q4] = *(const f32x4*)(Ap + 4 * q4);
#pragma unroll
                for (int q = 0; q < 64; ++q) {
                    const float a = ar[q >> 2][q & 3];
                    const f32x4 s0 = *(const LAS f32x4*)(Sp + q * 64 + 8 * ig), s1 = *(const LAS f32x4*)(Sp + q * 64 + 8 * ig + 4);
                    acc[0] += a * s0[0]; acc[1] += a * s0[1]; acc[2] += a * s0[2]; acc[3] += a * s0[3]; acc[4] += a * s1[0]; acc[5] += a * s1[1]; acc[6] += a * s1[2]; acc[7] += a * s1[3];
                }
            }
            __syncthreads();
#pragma unroll
            for (int e = 0; e < 8; ++e) { Sp[j * 64 + 8 * ig + e] = acc[e]; SS[((size_t)(chain * NSEG + k) * 64 + 8 * ig + e) * 64 + j] = f2bf(acc[e]); }
            __syncthreads();
        }
    }
}
__device__ __forceinline__ void ph_ycorr(const bf16_t* __restrict__ yaug, const bf16_t* __restrict__ SS, bf16_t* __restrict__ ybuf, int nchain) {
    const int tid = otid(), lane = tid & 63, wave = tid >> 6, il = lane & 15, kq = lane >> 4;
    constexpr int TPS = SEGTOK / 16, IPC = (NSEG - 1) * TPS;
    for (int it = blockIdx.x * 8 + wave; it < nchain * IPC; it += NWG * 8) {
        const int chain = it / IPC, r = it % IPC, seg = 1 + r / TPS, tile = r % TPS;
        const int h = chain & 7, dir = (chain >> 3) & 1, b = chain >> 4;
        const int st0 = seg * SEGTOK + 16 * tile, t0 = dir ? (SEQ - 16 - st0) : st0;
        const size_t rowbase = ((size_t)(b * SEQ + t0) * 2 + dir) * 512 + h * 64;
        const bf16x8 a0 = *(const bf16x8*)(yaug + rowbase + (size_t)il * 1024 + 8 * kq), a1 = *(const bf16x8*)(yaug + rowbase + (size_t)il * 1024 + 32 + 8 * kq);
        const bf16_t* ssp = SS + (size_t)(chain * NSEG + seg) * 4096;
#pragma unroll
        for (int nb = 0; nb < 4; ++nb) {
            const bf16x8 b0 = *(const bf16x8*)(ssp + (16 * nb + il) * 64 + 8 * kq), b1 = *(const bf16x8*)(ssp + (16 * nb + il) * 64 + 32 + 8 * kq);
            f32x4 acc = (f32x4){0.f, 0.f, 0.f, 0.f};
            acc = __builtin_amdgcn_mfma_f32_16x16x32_bf16(a0, b0, acc, 0, 0, 0);
            acc = __builtin_amdgcn_mfma_f32_16x16x32_bf16(a1, b1, acc, 0, 0, 0);
#pragma unroll
            for (int e = 0; e < 4; ++e) { bf16_t* yp = ybuf + rowbase + (size_t)(4 * kq + e) * 1024 + 16 * nb + il; *yp = f2bf(bf2f(*yp) + acc[e]); }
        }
    }
}

__device__ __forceinline__ void ph_post2(const bf16_t* __restrict__ ybuf, const bf16_t* __restrict__ gbuf, const float* __restrict__ sbon, const float* __restrict__ lg, const float* __restrict__ lb,
                                         bf16_t* __restrict__ mixb, int rows) {
    const int c = otid(), h = c >> 6, lane = c & 63;
    const float lgc = lg[c], lbc = lb[c];
    for (int t = blockIdx.x; t < rows; t += NWG) {
        const float y = bf2f(ybuf[(size_t)t * 1024 + c]) + bf2f(ybuf[(size_t)t * 1024 + 512 + c]);
        const float mu = wave_sum(y, lane) * (1.f / 64.f); const float dv = y - mu; const float var = wave_sum(dv * dv, lane) * (1.f / 64.f);
        const float yn = dv * rsqrtf(var + 64e-5f) * lgc + lbc;
        const float bon = sbon[(size_t)t * 16 + h] + sbon[(size_t)t * 16 + 8 + h];
        const float o = (yn + bon * bf2f(mixb[(size_t)t * 1024 + c])) * bf2f(gbuf[(size_t)t * 512 + c]);
        mixb[(size_t)t * 1024 + c] = f2bf(o);
    }
}

__device__ __forceinline__ void ph_fold(const float* __restrict__ win1, const float* __restrict__ g1, const float* __restrict__ mu1, const float* __restrict__ vdown, bf16_t* __restrict__ WinT1) {
    const int tid0 = otid();
    for (int idx = blockIdx.x * NT + tid0; idx < 96 * D; idx += NWG * NT) {
        const int jj = idx / D, k = idx % D, which = jj >> 5, j = jj & 31;
        const float* wr = win1 + (size_t)k * INC + 1024;
        float s = 0.f;
        for (int c = 0; c < 512; ++c) {
            const float m0 = mu1[1024 + c], m1 = mu1[RWC + 1024 + c];
            const float cf = (which == 0) ? (1.f - m0 - m1) : (which == 1) ? m0 : m1;
            s += wr[c] * cf * vdown[c * 32 + j];
        }
        WinT1[(size_t)(1920 + jj) * D + k] = f2bf(s * g1[k]);
    }
}


__device__ __forceinline__ void ph_post3(LAS unsigned char* lds, const bf16_t* __restrict__ ybuf, const bf16_t* __restrict__ yaug, const bf16_t* __restrict__ SS, const bf16_t* __restrict__ gbuf, const float* __restrict__ sbon,
                                         const float* __restrict__ lg, const float* __restrict__ lb, bf16_t* __restrict__ mixb, int nseq) {
    const int tid = otid(), lane = tid & 63, wave = tid >> 6, il = lane & 15, kq = lane >> 4;
    (void)nseq;
    const int bh = (int)blockIdx.x >> 3, part = (int)blockIdx.x & 7, b = bh >> 3, h = bh & 7;
    const int segf = part >> 1, segb = (NSEG - 1) - (part >> 1);
    __syncthreads();
    for (int p = tid; p < 2 * 64 * 8; p += NT) {
        const int d = p >> 9, row = (p >> 3) & 63, pc = p & 7, seg = d ? segb : segf;
        const bf16_t* src = SS + (size_t)(((b * 2 + d) * 8 + h) * NSEG + seg) * 4096 + row * 64 + 8 * pc;
        *(LAS u32x4*)(lds + d * (64 * 144) + row * 144 + 16 * pc) = *(const u32x4*)src;
    }
    __syncthreads();
    for (int k = 0; k < 4; ++k) {
        const int tb = 32 * part + wave + 8 * k;
        const int t0 = 16 * tb;
        const size_t tokrow = (size_t)(b * SEQ + t0 + il);
        u32x2 vq_[4], gq_[4]; f32x4 g4_[4], b4_[4];
#pragma unroll
        for (int mb = 0; mb < 4; ++mb) {
            const int ch = h * 64 + 16 * mb + 4 * kq;
            g4_[mb] = *(const f32x4*)(lg + ch); b4_[mb] = *(const f32x4*)(lb + ch);
            vq_[mb] = *(const u32x2*)(mixb + tokrow * 1024 + ch); gq_[mb] = *(const u32x2*)(gbuf + tokrow * 512 + ch);
        }
        const float bon = sbon[tokrow * 16 + h] + sbon[tokrow * 16 + 8 + h];
        float y[4][4];
#pragma unroll
        for (int mb = 0; mb < 4; ++mb)
#pragma unroll
            for (int e = 0; e < 4; ++e) y[mb][e] = 0.f;
#pragma unroll
        for (int dir = 0; dir < 2; ++dir) {
            const size_t ro = (tokrow * 2 + dir) * 512 + h * 64;
#pragma unroll
            for (int mb = 0; mb < 4; ++mb) {
                const u32x2 q = *(const u32x2*)(ybuf + ro + 16 * mb + 4 * kq);
                y[mb][0] += __uint_as_float(q.x << 16); y[mb][1] += __uint_as_float(q.x & 0xffff0000u); y[mb][2] += __uint_as_float(q.y << 16); y[mb][3] += __uint_as_float(q.y & 0xffff0000u);
            }
            const int st0 = dir ? (SEQ - 16 - t0) : t0, seg = st0 / SEGTOK;
            if (seg > 0) {
                const int chain = (b * 2 + dir) * 8 + h;
                const bf16x8 y0 = *(const bf16x8*)(yaug + ro + 8 * kq), y1 = *(const bf16x8*)(yaug + ro + 32 + 8 * kq);
                const LAS unsigned char* ssl = lds + dir * (64 * 144) + il * 144 + 16 * kq;
#pragma unroll
                for (int mb = 0; mb < 4; ++mb) {
                    const bf16x8 a0 = *(const LAS bf16x8*)(ssl + mb * (16 * 144)), a1 = *(const LAS bf16x8*)(ssl + mb * (16 * 144) + 64);
                    f32x4 acc = (f32x4){y[mb][0], y[mb][1], y[mb][2], y[mb][3]};
                    acc = __builtin_amdgcn_mfma_f32_16x16x32_bf16(a0, y0, acc, 0, 0, 0);
                    acc = __builtin_amdgcn_mfma_f32_16x16x32_bf16(a1, y1, acc, 0, 0, 0);
                    y[mb][0] = acc[0]; y[mb][1] = acc[1]; y[mb][2] = acc[2]; y[mb][3] = acc[3];
                }
            }
        }
        float s = 0.f;
#pragma unroll
        for (int mb = 0; mb < 4; ++mb) s += (y[mb][0] + y[mb][1]) + (y[mb][2] + y[mb][3]);
        s += shx(s, 16, lane); s += shx(s, 32, lane);
        const float mu = s * (1.f / 64.f); float q2 = 0.f;
#pragma unroll
        for (int mb = 0; mb < 4; ++mb)
#pragma unroll
            for (int e = 0; e < 4; ++e) { y[mb][e] -= mu; q2 += y[mb][e] * y[mb][e]; }
        q2 += shx(q2, 16, lane); q2 += shx(q2, 32, lane);
        const float rs = rsqrtf(q2 * (1.f / 64.f) + 64e-5f);
#pragma unroll
        for (int mb = 0; mb < 4; ++mb) {
            const int ch = h * 64 + 16 * mb + 4 * kq;
            const f32x4 g4 = g4_[mb], b4 = b4_[mb];
            const u32x2 vq = vq_[mb], gq = gq_[mb];
            const float v0 = __uint_as_float(vq.x << 16), v1 = __uint_as_float(vq.x & 0xffff0000u), v2 = __uint_as_float(vq.y << 16), v3 = __uint_as_float(vq.y & 0xffff0000u);
            const float g0 = __uint_as_float(gq.x << 16), g1 = __uint_as_float(gq.x & 0xffff0000u), g2 = __uint_as_float(gq.y << 16), g3 = __uint_as_float(gq.y & 0xffff0000u);
            const float o0 = (y[mb][0] * rs * g4[0] + b4[0] + bon * v0) * g0, o1 = (y[mb][1] * rs * g4[1] + b4[1] + bon * v1) * g1;
            const float o2 = (y[mb][2] * rs * g4[2] + b4[2] + bon * v2) * g2, o3 = (y[mb][3] * rs * g4[3] + b4[3] + bon * v3) * g3;
            u32x2 o; o.x = cvtpk(o0, o1); o.y = cvtpk(o2, o3);
            *(u32x2*)(mixb + tokrow * 1024 + ch) = o;
        }
    }
}
struct Args { const float* in[27]; float* out; unsigned char* ws; };
struct WsMap { size_t ctl, WinT, WvT, WoutT, WupT, WdnT, WdecT, WaaaT, WgT, WvuT, xb, rstd, vfirst, mixb, act, P, VT, ybuf, gbuf, sbon, yaug, segst, SS, U, end; };
__host__ __device__ constexpr size_t al256(size_t x) { return (x + 255) & ~(size_t)255; }
__host__ __device__ constexpr WsMap make_map() {
    WsMap m{}; size_t off = 0;
    m.ctl = off; off += al256(WS_CTL_BYTES);
    m.WinT = off; off += al256((size_t)DEPTH * PCW * D * 2); m.WvT = off; off += al256((size_t)DEPTH * 512 * D * 2); m.WoutT = off; off += al256((size_t)DEPTH * D * D * 2);
    m.WupT = off; off += al256((size_t)DEPTH * UPC * D * 2); m.WdnT = off; off += al256((size_t)DEPTH * D * DFF * 2);
    m.WdecT = off; off += al256((size_t)DEPTH * 2 * 512 * 64 * 2); m.WaaaT = off; off += al256((size_t)DEPTH * 2 * 512 * 64 * 2); m.WgT = off; off += al256((size_t)DEPTH * 512 * 128 * 2); m.WvuT = off; off += al256((size_t)512 * 32 * 2);
    m.xb = off; off += al256((size_t)GR * D * 2); m.rstd = off; off += al256((size_t)4 * GR * 4); m.vfirst = off; off += al256((size_t)GR * 512 * 2);
    m.mixb = off; off += al256((size_t)GR * 1024 * 2); m.act = off; off += al256((size_t)GR * DFF * 2);
    m.U = off;
    m.P = off; off += al256((size_t)GR * PCW * 2); m.VT = off; off += al256((size_t)512 * GR * 2);
    m.ybuf = off; off += al256((size_t)GR * 1024 * 2); m.gbuf = off; off += al256((size_t)GR * 512 * 2); m.sbon = off; off += al256((size_t)GR * 16 * 4);
    m.yaug = off; off += al256((size_t)GR * 1024 * 2); m.segst = off; off += al256((size_t)GSEQ * 16 * NSEG * 2 * 4096 * 4); m.SS = off; off += al256((size_t)GSEQ * 16 * NSEG * 4096 * 2);
    if (off < m.U + (size_t)GR * UPC * 2) off = m.U + (size_t)GR * UPC * 2;
    m.end = off; return m;
}
constexpr WsMap WSM = make_map();

__global__ void __launch_bounds__(NT, 2) mega(Args args) {
    extern __shared__ __attribute__((aligned(16))) unsigned char lds_raw[];
    LAS unsigned char* lds = (LAS unsigned char*)lds_raw;
    asm volatile("v_mov_b32 v1, 0\n\tv_mov_b32 v2, 0\n\tv_mov_b32 v3, 0\n\tv_mov_b32 v4, 0\n\tv_mov_b32 v5, 0\n\tv_mov_b32 v6, 0\n\tv_mov_b32 v7, 0\n\tv_mov_b32 v8, 0\n\tv_mov_b32 v9, 0\n\tv_mov_b32 v10, 0\n\tv_mov_b32 v11, 0\n\tv_mov_b32 v12, 0\n\tv_mov_b32 v13, 0\n\tv_mov_b32 v14, 0\n\tv_mov_b32 v15, 0\n\tv_mov_b32 v16, 0\n\tv_mov_b32 v17, 0\n\tv_mov_b32 v18, 0\n\tv_mov_b32 v19, 0\n\tv_mov_b32 v20, 0\n\tv_mov_b32 v21, 0\n\tv_mov_b32 v22, 0\n\tv_mov_b32 v23, 0\n\tv_mov_b32 v24, 0\n\tv_mov_b32 v25, 0\n\tv_mov_b32 v26, 0\n\tv_mov_b32 v27, 0\n\tv_mov_b32 v28, 0\n\tv_mov_b32 v29, 0\n\tv_mov_b32 v30, 0\n\tv_mov_b32 v31, 0\n\tv_mov_b32 v32, 0\n\tv_mov_b32 v33, 0\n\tv_mov_b32 v34, 0\n\tv_mov_b32 v35, 0\n\tv_mov_b32 v36, 0\n\tv_mov_b32 v37, 0\n\tv_mov_b32 v38, 0\n\tv_mov_b32 v39, 0\n\tv_mov_b32 v40, 0\n\tv_mov_b32 v41, 0\n\tv_mov_b32 v42, 0\n\tv_mov_b32 v43, 0\n\tv_mov_b32 v44, 0\n\tv_mov_b32 v45, 0\n\tv_mov_b32 v46, 0\n\tv_mov_b32 v47, 0\n\tv_mov_b32 v48, 0\n\tv_mov_b32 v49, 0\n\tv_mov_b32 v50, 0\n\tv_mov_b32 v51, 0\n\tv_mov_b32 v52, 0\n\tv_mov_b32 v53, 0\n\tv_mov_b32 v54, 0\n\tv_mov_b32 v55, 0\n\tv_mov_b32 v56, 0\n\tv_mov_b32 v57, 0\n\tv_mov_b32 v58, 0\n\tv_mov_b32 v59, 0\n\tv_mov_b32 v60, 0\n\tv_mov_b32 v61, 0\n\tv_mov_b32 v62, 0\n\tv_mov_b32 v63, 0\n\tv_mov_b32 v64, 0\n\tv_mov_b32 v65, 0\n\tv_mov_b32 v66, 0\n\tv_mov_b32 v67, 0\n\tv_mov_b32 v68, 0\n\tv_mov_b32 v69, 0\n\tv_mov_b32 v70, 0\n\tv_mov_b32 v71, 0\n\tv_mov_b32 v72, 0\n\tv_mov_b32 v73, 0\n\tv_mov_b32 v74, 0\n\tv_mov_b32 v75, 0\n\tv_mov_b32 v76, 0\n\tv_mov_b32 v77, 0\n\tv_mov_b32 v78, 0\n\tv_mov_b32 v79, 0\n\tv_mov_b32 v80, 0\n\tv_mov_b32 v81, 0\n\tv_mov_b32 v82, 0\n\tv_mov_b32 v83, 0\n\tv_mov_b32 v84, 0\n\tv_mov_b32 v85, 0\n\tv_mov_b32 v86, 0\n\tv_mov_b32 v87, 0\n\tv_mov_b32 v88, 0\n\tv_mov_b32 v89, 0\n\tv_mov_b32 v90, 0\n\tv_mov_b32 v91, 0\n\tv_mov_b32 v92, 0\n\tv_mov_b32 v93, 0\n\tv_mov_b32 v94, 0\n\tv_mov_b32 v95, 0\n\tv_mov_b32 v96, 0\n\tv_mov_b32 v97, 0\n\tv_mov_b32 v98, 0\n\tv_mov_b32 v99, 0\n\tv_mov_b32 v100, 0\n\tv_mov_b32 v101, 0\n\tv_mov_b32 v102, 0\n\tv_mov_b32 v103, 0\n\tv_mov_b32 v104, 0\n\tv_mov_b32 v105, 0\n\tv_mov_b32 v106, 0\n\tv_mov_b32 v107, 0\n\tv_mov_b32 v108, 0\n\tv_mov_b32 v109, 0\n\tv_mov_b32 v110, 0\n\tv_mov_b32 v111, 0\n\tv_mov_b32 v112, 0\n\tv_mov_b32 v113, 0\n\tv_mov_b32 v114, 0\n\tv_mov_b32 v115, 0\n\tv_mov_b32 v116, 0\n\tv_mov_b32 v117, 0\n\tv_mov_b32 v118, 0\n\tv_mov_b32 v119, 0\n\tv_mov_b32 v120, 0\n\tv_mov_b32 v121, 0\n\tv_mov_b32 v122, 0\n\tv_mov_b32 v123, 0\n\tv_mov_b32 v124, 0\n\tv_mov_b32 v125, 0\n\tv_mov_b32 v126, 0\n\tv_mov_b32 v127, 0\n\tv_mov_b32 v128, 0\n\tv_mov_b32 v129, 0\n\tv_mov_b32 v130, 0\n\tv_mov_b32 v131, 0\n\tv_mov_b32 v132, 0\n\tv_mov_b32 v133, 0\n\tv_mov_b32 v134, 0\n\tv_mov_b32 v135, 0\n\tv_mov_b32 v136, 0\n\tv_mov_b32 v137, 0\n\tv_mov_b32 v138, 0\n\tv_mov_b32 v139, 0\n\tv_mov_b32 v140, 0\n\tv_mov_b32 v141, 0\n\tv_mov_b32 v142, 0\n\tv_mov_b32 v143, 0\n\tv_mov_b32 v144, 0\n\tv_mov_b32 v145, 0\n\tv_mov_b32 v146, 0\n\tv_mov_b32 v147, 0\n\tv_mov_b32 v148, 0\n\tv_mov_b32 v149, 0\n\tv_mov_b32 v150, 0\n\tv_mov_b32 v151, 0\n\tv_mov_b32 v152, 0\n\tv_mov_b32 v153, 0\n\tv_mov_b32 v154, 0\n\tv_mov_b32 v155, 0\n\tv_mov_b32 v156, 0\n\tv_mov_b32 v157, 0\n\tv_mov_b32 v158, 0\n\tv_mov_b32 v159, 0\n\tv_mov_b32 v160, 0\n\tv_mov_b32 v161, 0\n\tv_mov_b32 v162, 0\n\tv_mov_b32 v163, 0\n\tv_mov_b32 v164, 0\n\tv_mov_b32 v165, 0\n\tv_mov_b32 v166, 0\n\tv_mov_b32 v167, 0\n\tv_mov_b32 v168, 0\n\tv_mov_b32 v169, 0\n\tv_mov_b32 v170, 0\n\tv_mov_b32 v171, 0\n\tv_mov_b32 v172, 0\n\tv_mov_b32 v173, 0\n\tv_mov_b32 v174, 0\n\tv_mov_b32 v175, 0\n\tv_mov_b32 v176, 0\n\tv_mov_b32 v177, 0\n\tv_mov_b32 v178, 0\n\tv_mov_b32 v179, 0\n\tv_mov_b32 v180, 0\n\tv_mov_b32 v181, 0\n\tv_mov_b32 v182, 0\n\tv_mov_b32 v183, 0\n\tv_mov_b32 v184, 0\n\tv_mov_b32 v185, 0\n\tv_mov_b32 v186, 0\n\tv_mov_b32 v187, 0\n\tv_mov_b32 v188, 0\n\tv_mov_b32 v189, 0\n\tv_mov_b32 v190, 0\n\tv_mov_b32 v191, 0\n\tv_mov_b32 v192, 0\n\tv_mov_b32 v193, 0\n\tv_mov_b32 v194, 0\n\tv_mov_b32 v195, 0\n\tv_mov_b32 v196, 0\n\tv_mov_b32 v197, 0\n\tv_mov_b32 v198, 0\n\tv_mov_b32 v199, 0\n\tv_mov_b32 v200, 0\n\tv_mov_b32 v201, 0\n\tv_mov_b32 v202, 0\n\tv_mov_b32 v203, 0\n\tv_mov_b32 v204, 0\n\tv_mov_b32 v205, 0\n\tv_mov_b32 v206, 0\n\tv_mov_b32 v207, 0\n\tv_mov_b32 v208, 0\n\tv_mov_b32 v209, 0\n\tv_mov_b32 v210, 0\n\tv_mov_b32 v211, 0\n\tv_mov_b32 v212, 0\n\tv_mov_b32 v213, 0\n\tv_mov_b32 v214, 0\n\tv_mov_b32 v215, 0\n\tv_mov_b32 v216, 0\n\tv_mov_b32 v217, 0\n\tv_mov_b32 v218, 0\n\tv_mov_b32 v219, 0\n\tv_mov_b32 v220, 0\n\tv_mov_b32 v221, 0\n\tv_mov_b32 v222, 0\n\tv_mov_b32 v223, 0\n\tv_mov_b32 v224, 0\n\tv_mov_b32 v225, 0\n\tv_mov_b32 v226, 0\n\tv_mov_b32 v227, 0\n\tv_mov_b32 v228, 0\n\tv_mov_b32 v229, 0\n\tv_mov_b32 v230, 0\n\tv_mov_b32 v231, 0\n\tv_mov_b32 v232, 0\n\tv_mov_b32 v233, 0\n\tv_mov_b32 v234, 0\n\tv_mov_b32 v235, 0\n\tv_mov_b32 v236, 0\n\tv_mov_b32 v237, 0\n\tv_mov_b32 v238, 0\n\tv_mov_b32 v239, 0\n\tv_mov_b32 v240, 0\n\tv_mov_b32 v241, 0\n\tv_mov_b32 v242, 0\n\tv_mov_b32 v243, 0\n\ts_mov_b32 s20, 0\n\ts_mov_b32 s21, 0\n\ts_mov_b32 s22, 0\n\ts_mov_b32 s23, 0\n\ts_mov_b32 s24, 0\n\ts_mov_b32 s25, 0\n\ts_mov_b32 s26, 0\n\ts_mov_b32 s27, 0\n\ts_mov_b32 s28, 0\n\ts_mov_b32 s29, 0\n\ts_mov_b32 s30, 0\n\ts_mov_b32 s31, 0\n\ts_mov_b32 s32, 0\n\ts_mov_b32 s33, 0\n\ts_mov_b32 s34, 0\n\ts_mov_b32 s35, 0\n\ts_mov_b32 s36, 0\n\ts_mov_b32 s37, 0\n\ts_mov_b32 s38, 0\n\ts_mov_b32 s39, 0\n\ts_mov_b32 s40, 0\n\ts_mov_b32 s41, 0\n\ts_mov_b32 s42, 0\n\ts_mov_b32 s43, 0\n\ts_mov_b32 s44, 0\n\ts_mov_b32 s45, 0\n\ts_mov_b32 s46, 0\n\ts_mov_b32 s47, 0\n\ts_mov_b32 s48, 0\n\ts_mov_b32 s49, 0\n\ts_mov_b32 s50, 0\n\ts_mov_b32 s51, 0\n\ts_mov_b32 s52, 0\n\ts_mov_b32 s53, 0\n\ts_mov_b32 s54, 0\n\ts_mov_b32 s55, 0\n\ts_mov_b32 s56, 0\n\ts_mov_b32 s57, 0\n\ts_mov_b32 s58, 0\n\ts_mov_b32 s59, 0\n\ts_mov_b32 s60, 0\n\ts_mov_b32 s61, 0\n\ts_mov_b32 s62, 0\n\ts_mov_b32 s63, 0\n\ts_mov_b32 s64, 0\n\ts_mov_b32 s65, 0\n\ts_mov_b32 s66, 0\n\ts_mov_b32 s67, 0\n\ts_mov_b32 s68, 0\n\ts_mov_b32 s69, 0\n\ts_mov_b32 s70, 0\n\ts_mov_b32 s71, 0\n\ts_mov_b32 s72, 0\n\ts_mov_b32 s73, 0\n\ts_mov_b32 s74, 0\n\ts_mov_b32 s75, 0\n\ts_mov_b32 s76, 0\n\ts_mov_b32 s77, 0\n\ts_mov_b32 s78, 0\n\ts_mov_b32 s79, 0\n\ts_mov_b32 s80, 0\n\ts_mov_b32 s81, 0\n\ts_mov_b32 s82, 0\n\ts_mov_b32 s83, 0\n\ts_mov_b32 s84, 0\n\ts_mov_b32 s85, 0\n\ts_mov_b32 s86, 0\n\ts_mov_b32 s87, 0\n\ts_mov_b32 s88, 0\n\ts_mov_b32 s89, 0\n\ts_mov_b32 s90, 0\n\ts_mov_b32 s91, 0\n\ts_mov_b32 s92, 0\n\ts_mov_b32 s93, 0\n\ts_mov_b32 s94, 0\n\ts_mov_b32 s95, 0\n\ts_mov_b32 s96, 0\n\ts_mov_b32 s97, 0\n\ts_mov_b32 s98, 0\n\ts_mov_b32 s99, 0\n\t" ::: "v1", "v2", "v3", "v4", "v5", "v6", "v7", "v8", "v9", "v10", "v11", "v12", "v13", "v14", "v15", "v16", "v17", "v18", "v19", "v20", "v21", "v22", "v23", "v24", "v25", "v26", "v27", "v28", "v29", "v30", "v31", "v32", "v33", "v34", "v35", "v36", "v37", "v38", "v39", "v40", "v41", "v42", "v43", "v44", "v45", "v46", "v47", "v48", "v49", "v50", "v51", "v52", "v53", "v54", "v55", "v56", "v57", "v58", "v59", "v60", "v61", "v62", "v63", "v64", "v65", "v66", "v67", "v68", "v69", "v70", "v71", "v72", "v73", "v74", "v75", "v76", "v77", "v78", "v79", "v80", "v81", "v82", "v83", "v84", "v85", "v86", "v87", "v88", "v89", "v90", "v91", "v92", "v93", "v94", "v95", "v96", "v97", "v98", "v99", "v100", "v101", "v102", "v103", "v104", "v105", "v106", "v107", "v108", "v109", "v110", "v111", "v112", "v113", "v114", "v115", "v116", "v117", "v118", "v119", "v120", "v121", "v122", "v123", "v124", "v125", "v126", "v127", "v128", "v129", "v130", "v131", "v132", "v133", "v134", "v135", "v136", "v137", "v138", "v139", "v140", "v141", "v142", "v143", "v144", "v145", "v146", "v147", "v148", "v149", "v150", "v151", "v152", "v153", "v154", "v155", "v156", "v157", "v158", "v159", "v160", "v161", "v162", "v163", "v164", "v165", "v166", "v167", "v168", "v169", "v170", "v171", "v172", "v173", "v174", "v175", "v176", "v177", "v178", "v179", "v180", "v181", "v182", "v183", "v184", "v185", "v186", "v187", "v188", "v189", "v190", "v191", "v192", "v193", "v194", "v195", "v196", "v197", "v198", "v199", "v200", "v201", "v202", "v203", "v204", "v205", "v206", "v207", "v208", "v209", "v210", "v211", "v212", "v213", "v214", "v215", "v216", "v217", "v218", "v219", "v220", "v221", "v222", "v223", "v224", "v225", "v226", "v227", "v228", "v229", "v230", "v231", "v232", "v233", "v234", "v235", "v236", "v237", "v238", "v239", "v240", "v241", "v242", "v243", "s20", "s21", "s22", "s23", "s24", "s25", "s26", "s27", "s28", "s29", "s30", "s31", "s32", "s33", "s34", "s35", "s36", "s37", "s38", "s39", "s40", "s41", "s42", "s43", "s44", "s45", "s46", "s47", "s48", "s49", "s50", "s51", "s52", "s53", "s54", "s55", "s56", "s57", "s58", "s59", "s60", "s61", "s62", "s63", "s64", "s65", "s66", "s67", "s68", "s69", "s70", "s71", "s72", "s73", "s74", "s75", "s76", "s77", "s78", "s79", "s80", "s81", "s82", "s83", "s84", "s85", "s86", "s87", "s88", "s89", "s90", "s91", "s92", "s93", "s94", "s95", "s96", "s97", "s98", "s99");
    volatile LAS unsigned* misc = (volatile LAS unsigned*)(lds + LDS_MISC);
    if (threadIdx.x < 64) misc[threadIdx.x] = 0u;
    __syncthreads();
    XcdBarrier bar = xcd_barrier_post(((unsigned*)(args.ws + WSM.ctl)), misc + 8, otid() == 0);
#define GRID_BAR() xcd_barrier(bar, otid() == 0)
    const float* const* in = args.in;
    float* X = args.out;
    constexpr int G = NWG; const int bx = (int)blockIdx.x;

#pragma unroll 1
    for (int j = 0; j < 21; ++j) {
        const int l = (j >= 10 && j < 20) ? 1 : 0, k = (j < 20) ? j - 10 * l : 10;
        const float* W; int K_, Nsrc, Nout, mode = 0; const float* scale = nullptr; bf16_t* out; float mul = 1.f;
        if (k == 0)      { W = in[3] + (size_t)l * D * INC; K_ = D; Nsrc = INC; scale = in[2] + l * D; out = ((bf16_t*)(args.ws + WSM.WinT)) + (size_t)l * PCW * D; Nout = PCW; mode = 1; }
        else if (k == 1) { W = in[3] + (size_t)l * D * INC; K_ = D; Nsrc = INC; scale = in[2] + l * D; out = ((bf16_t*)(args.ws + WSM.WvT)) + (size_t)l * 512 * D; Nout = 512; mode = 2; }
        else if (k == 2) { W = in[21] + (size_t)l * D * D; K_ = D; Nsrc = D; out = ((bf16_t*)(args.ws + WSM.WoutT)) + (size_t)l * D * D; Nout = D; }
        else if (k == 3) { W = in[23] + (size_t)l * D * UPC; K_ = D; Nsrc = UPC; scale = in[22] + l * D; out = ((bf16_t*)(args.ws + WSM.WupT)) + (size_t)l * UPC * D; Nout = UPC; mode = 3; }
        else if (k == 4) { W = in[26] + (size_t)l * DFF * D; K_ = DFF; Nsrc = D; out = ((bf16_t*)(args.ws + WSM.WdnT)) + (size_t)l * D * DFF; Nout = D; }
        else if (k <= 6) { const int d = k - 5; W = in[6] + (size_t)(l * 2 + d) * 64 * 512; K_ = 64; Nsrc = 512; out = ((bf16_t*)(args.ws + WSM.WdecT)) + (size_t)(l * 2 + d) * 512 * 64; Nout = 512; mul = -1.44269504f; }
        else if (k <= 8) { const int d = k - 7; W = in[8] + (size_t)(l * 2 + d) * 64 * 512; K_ = 64; Nsrc = 512; out = ((bf16_t*)(args.ws + WSM.WaaaT)) + (size_t)(l * 2 + d) * 512 * 64; Nout = 512; mul = -1.44269504f; }
        else if (k == 9) { W = in[9] + (size_t)l * 128 * 512; K_ = 128; Nsrc = 512; out = ((bf16_t*)(args.ws + WSM.WgT)) + (size_t)l * 512 * 128; Nout = 512; }
        else             { W = in[12]; K_ = 32; Nsrc = 512; out = ((bf16_t*)(args.ws + WSM.WvuT)); Nout = 512; mul = -1.44269504f; }
        ph_prep_w(lds, W, K_, Nsrc, scale, out, Nout, mode, mul);
    }
    GRID_BAR();
    ph_fold(in[3] + (size_t)1 * D * INC, in[2] + D, in[4] + (size_t)1 * 2 * RWC, in[11], ((bf16_t*)(args.ws + WSM.WinT)) + (size_t)1 * PCW * D);

    for (int grp = 0; grp < NGRP; ++grp) {
        const size_t g0 = (size_t)grp * GR;
        float* Xg = X + g0 * D;
        {
            const float* xin = (g0 < (size_t)8 * SEQ) ? in[0] + g0 * D : in[1] + (g0 - (size_t)8 * SEQ) * D;
            ph_rms_in(xin, ((bf16_t*)(args.ws + WSM.xb)), ((float*)(args.ws + WSM.rstd)), GR);
        }
        GRID_BAR();
        for (int l = 0; l < DEPTH; ++l) {
            {
                pg8::StaticOrder S; pg8::Unit u0;
                S.init(GR, PCW, NWG, bx); if (S.next(0, u0)) wg_rstd_from_slots((const float*)(args.ws + WSM.rstd), u0.pm * 256, (LAS float*)(lds + RS_A));
                S.init(512, GR, NWG, bx); if (S.next(0, u0)) wg_rstd_from_slots((const float*)(args.ws + WSM.rstd), u0.pn * 256, (LAS float*)(lds + RS_B));
            }
#pragma unroll 1
            for (int k = 0; k < 2; ++k) {
                const bf16_t* xb_ = (const bf16_t*)(args.ws + WSM.xb);
                const bf16_t* wi_ = ((const bf16_t*)(args.ws + WSM.WinT)) + (size_t)l * PCW * D; const bf16_t* wv_ = ((const bf16_t*)(args.ws + WSM.WvT)) + (size_t)l * 512 * D;
                ph_gemm_bf(lds, k ? wv_ : xb_, k ? xb_ : wi_, k ? 512 : GR, k ? GR : PCW, D, k ? (bf16_t*)(args.ws + WSM.VT) : (bf16_t*)(args.ws + WSM.P),
                           k ? (const LAS float*)nullptr : (const LAS float*)(lds + RS_A), k ? (const LAS float*)(lds + RS_B) : (const LAS float*)nullptr, k ? -1 : PCW);
            }
            GRID_BAR();
            {
                ph_qknorm(((bf16_t*)(args.ws + WSM.P)), in[18] + l * 64, in[19] + l * 64, GR);
                constexpr int NUNITS = GSEQ * 16 * NSEG;
                if (bx < NUNITS) {
                    ScanW w;
                    w.mu = in[4] + (size_t)l * 2 * RWC; w.w0 = in[5] + l * 1024; w.a0 = in[7] + l * 1024; w.v0 = in[10]; w.kk_ = in[13] + l * 512; w.ka = in[14] + l * 512; w.rk = in[15] + l * 512;
                    w.WdecT = ((bf16_t*)(args.ws + WSM.WdecT)) + (size_t)l * 2 * 512 * 64; w.WaaaT = ((bf16_t*)(args.ws + WSM.WaaaT)) + (size_t)l * 2 * 512 * 64; w.WgT = ((bf16_t*)(args.ws + WSM.WgT)) + (size_t)l * 512 * 128; w.WvuT = ((bf16_t*)(args.ws + WSM.WvuT));
                    for (int u = bx; u < NUNITS; u += G) scan_unit(lds, u, l, ((bf16_t*)(args.ws + WSM.P)), w, ((bf16_t*)(args.ws + WSM.ybuf)), ((bf16_t*)(args.ws + WSM.gbuf)), ((bf16_t*)(args.ws + WSM.mixb)), ((bf16_t*)(args.ws + WSM.vfirst)), ((float*)(args.ws + WSM.sbon)), (bf16_t*)(args.ws + WSM.yaug), (float*)(args.ws + WSM.segst));
                }
            }
            GRID_BAR();
#pragma unroll 1
            for (int half = 0; half < 2; ++half) {
                if (half == 0) {
                    ph_segfix(lds, (const float*)(args.ws + WSM.segst), (bf16_t*)(args.ws + WSM.SS), GSEQ * 16);
                    ph_natten(lds, ((bf16_t*)(args.ws + WSM.P)), ((bf16_t*)(args.ws + WSM.VT)), GR, GSEQ, in[20] + (size_t)l * 8 * 15 * 31, ((bf16_t*)(args.ws + WSM.mixb)), bx, G);
                    GRID_BAR();
                    ph_post3(lds, (const bf16_t*)(args.ws + WSM.ybuf), (const bf16_t*)(args.ws + WSM.yaug), (const bf16_t*)(args.ws + WSM.SS), (const bf16_t*)(args.ws + WSM.gbuf), (const float*)(args.ws + WSM.sbon), in[16] + l * 512, in[17] + l * 512, (bf16_t*)(args.ws + WSM.mixb), GSEQ);
                    GRID_BAR();
                } else {
                    { pg8::StaticOrder S; pg8::Unit u0; S.init(GR, UPC, NWG, bx); if (S.next(0, u0)) wg_rstd_from_slots((const float*)(args.ws + WSM.rstd), u0.pm * 256, (LAS float*)(lds + RS_A)); }
                    ph_gemm_ffn(lds, ((bf16_t*)(args.ws + WSM.xb)), ((bf16_t*)(args.ws + WSM.WupT)) + (size_t)l * UPC * D, GR, ((bf16_t*)(args.ws + WSM.act)), (float*)(args.ws + WSM.U), ((float*)(args.ws + WSM.rstd)),
                                in[24] + (size_t)l * 3 * UPC, in[25] + (size_t)l * UPC);
                    GRID_BAR();
                    ph_ffn_fix((const float*)(args.ws + WSM.U), in[24] + (size_t)l * 3 * UPC, in[25] + (size_t)l * UPC, ((bf16_t*)(args.ws + WSM.act)), GR);
                    GRID_BAR();
                }
                ph_gemm(lds, half ? (const bf16_t*)(args.ws + WSM.act) : (const bf16_t*)(args.ws + WSM.mixb),
                        half ? ((const bf16_t*)(args.ws + WSM.WdnT)) + (size_t)l * D * DFF : ((const bf16_t*)(args.ws + WSM.WoutT)) + (size_t)l * D * D, GR, D, half ? DFF : D,
                        (bf16_t*)(args.ws + WSM.xb), (half == 1 && l + 1 == DEPTH) ? Xg : nullptr, (float*)(args.ws + WSM.rstd));
                GRID_BAR();
            }
        }
    }
}

extern "C" void kernel_launch(void* const* d_in, const int* in_sizes, int n_in, void* d_out, int out_size, void* d_ws, size_t ws_size, hipStream_t stream) {
    static int grid = 0;
    static Args a{};
    if (grid == 0) {
        int dev = 0, cus = 0;
        if (hipGetDevice(&dev) != hipSuccess || hipDeviceGetAttribute(&cus, hipDeviceAttributeMultiprocessorCount, dev) != hipSuccess) { fprintf(stderr, "device query failed\n"); grid = -1; return; }
        if (hipFuncSetAttribute((const void*)mega, hipFuncAttributeMaxDynamicSharedMemorySize, LDS_BYTES) != hipSuccess) { fprintf(stderr, "hipFuncSetAttribute failed\n"); grid = -1; return; }
        int per_cu = 0;
        if (hipOccupancyMaxActiveBlocksPerMultiprocessor(&per_cu, (const void*)mega, NT, LDS_BYTES) != hipSuccess || per_cu < 1) { fprintf(stderr, "occupancy query: %d\n", per_cu); }
        (void)hipGetLastError();
        if (cus < NWG) { fprintf(stderr, "this kernel needs %d CUs, device has %d\n", NWG, cus); grid = -1; return; }
        grid = NWG;
    }
    if (grid < 0) return;
    if (WSM.end > ws_size || n_in != 27) { fprintf(stderr, "ws too small: need %zu have %zu (n_in %d)\n", (size_t)WSM.end, ws_size, n_in); return; }
    a = Args{};
    for (int i = 0; i < 27; ++i) a.in[i] = (const float*)d_in[i];
    a.out = (float*)d_out; a.ws = (unsigned char*)d_ws;
    (void)hipMemsetAsync(d_ws, 0, WS_CTL_BYTES, stream);
    hipLaunchKernelGGL(mega, dim3(grid), dim3(NT), LDS_BYTES, stream, a);
}
```

```cpp
#include <hip/hip_runtime.h>
#include <cstdio>
#include <cstdint>
namespace pg8 {
#define PG8_LAS __attribute__((address_space(3)))
typedef unsigned short bf16_t;
typedef short bf16x8 __attribute__((ext_vector_type(8)));
typedef float f32x4 __attribute__((ext_vector_type(4)));
typedef unsigned u32x4 __attribute__((ext_vector_type(4)));
constexpr int BM = 256, BK = 64, HALF = 128, HTB = HALF * BK * 2  , STAGE_BYTES = 8 * HTB, NXCD = 8, WGM = 8;

__host__ __device__ __forceinline__ int lds_byte(int r, int c) { const int st = (r >> 4) * 2 + (c >> 5), rr = r & 15, cc = c & 31, ob = rr * 64 + cc * 2; return st * 1024 + (ob ^ (((ob >> 9) & 1) << 5)); }
__host__ __device__ __forceinline__ void stage_rc(int b, int& R, int& C) { const int st = b / 1024, sb = b % 1024, swz = sb ^ (((sb >> 9) & 1) << 5); R = (st >> 1) * 16 + swz / 64; C = (st & 1) * 32 + (swz % 64) / 2; }
__host__ __device__ __forceinline__ int perm32(int rho) { const int n = rho >> 4, i = rho & 15; return 8 * (i >> 2) + 4 * n + (i & 3); }

struct Unit { int pm, pn; };
struct Gemm { const bf16_t* A; const bf16_t* Bt; int M, N, K, pad; };

struct StaticOrder {
    int nM, nN, nwg, G, c;
    __host__ __device__ void init(int M, int N, int G_, int c_) { nM = M / BM; nN = N / BM; nwg = nM * nN; G = G_; c = c_; }
    __host__ __device__ bool next(int i, Unit& u) const {
        const int L = i * G + c; if (L >= nwg) return false;
        int wgid = L; { const int q = nwg / NXCD, r = nwg % NXCD, xcd = wgid % NXCD, off = wgid / NXCD; wgid = (xcd < r ? xcd * (q + 1) : r * (q + 1) + (xcd - r) * q) + off; }
        const int nig = WGM * nN, gid = wgid / nig, fm = gid * WGM, gsz = (nM - fm) < WGM ? (nM - fm) : WGM;
        u.pm = fm + ((wgid % nig) % gsz); u.pn = (wgid % nig) / gsz; return true;
    }
    __device__ __forceinline__ void a_ready(const Unit&) const {}
    __device__ __forceinline__ void done(const Unit&) const {}
};

__device__ __forceinline__ unsigned cvt_pk_bf16(float lo, float hi) { unsigned r; asm volatile("v_cvt_pk_bf16_f32 %0, %1, %2" : "=v"(r) : "v"(lo), "v"(hi)); return r; }
typedef float f32x2 __attribute__((ext_vector_type(2)));
template <class Epi, class Sched, bool ALIGN_EPI = false, bool SP2 = false>
__device__ __forceinline__ void gemm_phase(PG8_LAS unsigned char* lds, const Gemm g, const Sched& S, const Epi& E, const int tid_in) {
    const int tid = tid_in, wid = __builtin_amdgcn_readfirstlane(tid >> 6), lane = tid & 63, wr = wid >> 2, wc = wid & 3, fr = lane & 15, fq = lane >> 4;
    const int K = g.K, nt = K / BK;
    unsigned voffA[2], voffB[2];
#pragma unroll
    for (int i = 0; i < 2; ++i) { int R, C; stage_rc(tid * 16 + i * 8192, R, C); const int Rb = Epi::PERM ? ((R & ~31) + perm32(R & 31)) : R;
        const int Ra = Epi::APERM ? ((R & ~63) + 4 * (R & 15) + ((R >> 4) & 3)) : R;
        voffA[i] = (unsigned)(Ra * K + C) * 2u; voffB[i] = (unsigned)(Rb * K + C) * 2u; }
    const size_t kstep = (size_t)(BK * 2);
    const size_t hstep = (size_t)HALF * K * 2;
    const size_t tstep = 2 * hstep;
    const unsigned ldsw = (unsigned)wid * 1024u;
    const int aoff = lds_byte(wr * 64 + fr, fq * 8), boff = lds_byte(wc * 32 + fr, fq * 8);
#define PG8_SA(b, h) (((b) * 2 + (h)) * HTB)
#define PG8_SB(b, h) ((4 + (b) * 2 + (h)) * HTB)
#define PG8_STAGE(bufoff, gbase, voff) do { _Pragma("unroll") for (int _i = 0; _i < 2; ++_i) \
        __builtin_amdgcn_global_load_lds((const unsigned*)((const char*)(gbase) + (voff)[_i]), (PG8_LAS unsigned*)(lds + (bufoff) + ldsw + _i * 8192), 16, 0, 0); } while (0)
#define PG8_LDA(dst, b, h) do { _Pragma("unroll") for (int m = 0; m < 4; ++m) _Pragma("unroll") for (int k = 0; k < 2; ++k) dst[m][k] = *(const PG8_LAS bf16x8*)(lds + PG8_SA(b, h) + aoff + m * 2048 + k * 1024); } while (0)
#define PG8_LDB(dst, b, h) do { _Pragma("unroll") for (int n = 0; n < 2; ++n) _Pragma("unroll") for (int k = 0; k < 2; ++k) dst[n][k] = *(const PG8_LAS bf16x8*)(lds + PG8_SB(b, h) + boff + n * 2048 + k * 1024); } while (0)
#define PG8_MMA(ai, bj, At, Bt) do { __builtin_amdgcn_s_setprio(1); _Pragma("unroll") for (int m = 0; m < 4; ++m) _Pragma("unroll") for (int n = 0; n < 2; ++n) _Pragma("unroll") for (int k = 0; k < 2; ++k) \
        acc[ai][bj][m][n] = __builtin_amdgcn_mfma_f32_16x16x32_bf16(Bt[n][k], At[m][k], acc[ai][bj][m][n], 0, 0, 0); __builtin_amdgcn_s_setprio(0); } while (0)
#define PG8_WAIT_V(n) asm volatile("s_waitcnt vmcnt(" #n ")" ::: "memory")
#define PG8_WAIT_L(n) asm volatile("s_waitcnt lgkmcnt(" #n ")" ::: "memory")
#define PG8_BAR __builtin_amdgcn_s_barrier()
#define PG8_SCHED __builtin_amdgcn_sched_barrier(0)
    Unit cur, nxt; int ui = 0;
    if (!S.next(0, cur)) return;
    f32x4 acc[2][2][4][2];
#pragma unroll
    for (int a = 0; a < 2; ++a)
#pragma unroll
        for (int b = 0; b < 2; ++b)
#pragma unroll
            for (int m = 0; m < 4; ++m)
#pragma unroll
                for (int n = 0; n < 2; ++n) acc[a][b][m][n] = (f32x4){0.f, 0.f, 0.f, 0.f};
    bf16x8 At[4][2], B0[2][2], B1[2][2];
    const char* cA = (const char*)g.A + (size_t)cur.pm * tstep; const char* cB = (const char*)g.Bt + (size_t)cur.pn * tstep;
    S.a_ready(cur);
    if constexpr (SP2) {
        PG8_STAGE(PG8_SB(0, 0), cB, voffB); PG8_STAGE(PG8_SB(0, 1), cB + hstep, voffB); PG8_STAGE(PG8_SA(0, 0), cA, voffA); PG8_STAGE(PG8_SA(0, 1), cA + hstep, voffA);
        if (wr == 1) PG8_BAR;
        PG8_WAIT_V(2); PG8_BAR;
        PG8_STAGE(PG8_SB(1, 0), cB + kstep, voffB); PG8_STAGE(PG8_SA(1, 0), cA + kstep, voffA); PG8_STAGE(PG8_SB(1, 1), cB + hstep + kstep, voffB);
        PG8_WAIT_V(6); PG8_BAR;
    } else {
        PG8_STAGE(PG8_SB(0, 0), cB, voffB); PG8_STAGE(PG8_SA(0, 0), cA, voffA); PG8_STAGE(PG8_SB(0, 1), cB + hstep, voffB); PG8_STAGE(PG8_SA(0, 1), cA + hstep, voffA);
        if (wr == 1) PG8_BAR;
        PG8_WAIT_V(4); PG8_BAR;
        PG8_STAGE(PG8_SB(1, 0), cB + kstep, voffB); PG8_STAGE(PG8_SA(1, 0), cA + kstep, voffA); PG8_STAGE(PG8_SB(1, 1), cB + hstep + kstep, voffB);
        PG8_WAIT_V(6); PG8_BAR;
    }
    for (;;) {
        const bool has_next = S.next(ui + 1, nxt);
        const char* nA = has_next ? (const char*)g.A + (size_t)nxt.pm * tstep : cA; const char* nB = has_next ? (const char*)g.Bt + (size_t)nxt.pn * tstep : cB;
        for (int t = 0; t < nt; t += 2) {
            const bool last = (t == nt - 2);
            const char* a1 = cA + (size_t)(t + 1) * kstep;
            const char* a2 = last ? nA : cA + (size_t)(t + 2) * kstep; const char* b2 = last ? nB : cB + (size_t)(t + 2) * kstep;
            const char* a3 = a2 + kstep; const char* b3 = b2 + kstep;
            if (last && has_next) S.a_ready(nxt);
            if constexpr (SP2) {
            PG8_LDB(B0, 0, 0); PG8_LDB(B1, 0, 1); PG8_SCHED; PG8_LDA(At, 0, 0); PG8_STAGE(PG8_SA(1, 1), a1 + hstep, voffA);
            PG8_WAIT_V(8); PG8_WAIT_L(0); PG8_BAR; PG8_MMA(0, 0, At, B0); PG8_MMA(0, 1, At, B1); PG8_BAR; PG8_SCHED;
            PG8_LDA(At, 0, 1); PG8_STAGE(PG8_SB(0, 0), b2, voffB); PG8_STAGE(PG8_SB(0, 1), b2 + hstep, voffB); PG8_STAGE(PG8_SA(0, 0), a2, voffA);
            PG8_WAIT_V(8); PG8_WAIT_L(0); PG8_BAR; PG8_MMA(1, 0, At, B0); PG8_MMA(1, 1, At, B1); PG8_BAR; PG8_SCHED;
            PG8_LDB(B0, 1, 0); PG8_LDB(B1, 1, 1); PG8_SCHED; PG8_LDA(At, 1, 0); PG8_STAGE(PG8_SA(0, 1), a2 + hstep, voffA);
            PG8_WAIT_V(8); PG8_WAIT_L(0); PG8_BAR; PG8_MMA(0, 0, At, B0); PG8_MMA(0, 1, At, B1); PG8_BAR; PG8_SCHED;
            PG8_LDA(At, 1, 1); PG8_STAGE(PG8_SB(1, 0), b3, voffB); PG8_STAGE(PG8_SB(1, 1), b3 + hstep, voffB); PG8_STAGE(PG8_SA(1, 0), a3, voffA);
            PG8_WAIT_V(8); PG8_WAIT_L(0); PG8_BAR; PG8_MMA(1, 0, At, B0); PG8_MMA(1, 1, At, B1); PG8_BAR; PG8_SCHED;
            } else {
            PG8_LDB(B0, 0, 0); PG8_SCHED; PG8_LDA(At, 0, 0); PG8_STAGE(PG8_SA(1, 1), a1 + hstep, voffA);
            PG8_WAIT_L(8); PG8_BAR; PG8_WAIT_L(0); PG8_MMA(0, 0, At, B0); PG8_BAR; PG8_SCHED;
            PG8_LDB(B1, 0, 1); PG8_STAGE(PG8_SB(0, 0), b2, voffB);
            PG8_BAR; PG8_WAIT_L(0); PG8_MMA(0, 1, At, B1); PG8_BAR;
            PG8_LDA(At, 0, 1); PG8_STAGE(PG8_SA(0, 0), a2, voffA);
            PG8_BAR; PG8_WAIT_L(0); PG8_MMA(1, 0, At, B0); PG8_BAR; PG8_SCHED;
            PG8_STAGE(PG8_SB(0, 1), b2 + hstep, voffB);
            PG8_WAIT_V(6); PG8_BAR; PG8_MMA(1, 1, At, B1); PG8_BAR;
            PG8_LDB(B0, 1, 0); PG8_SCHED; PG8_LDA(At, 1, 0); PG8_STAGE(PG8_SA(0, 1), a2 + hstep, voffA);
            PG8_WAIT_L(8); PG8_BAR; PG8_WAIT_L(0); PG8_MMA(0, 0, At, B0); PG8_BAR; PG8_SCHED;
            PG8_LDB(B1, 1, 1); PG8_STAGE(PG8_SB(1, 0), b3, voffB);
            PG8_BAR; PG8_WAIT_L(0); PG8_MMA(0, 1, At, B1); PG8_BAR;
            PG8_LDA(At, 1, 1); PG8_STAGE(PG8_SA(1, 0), a3, voffA);
            PG8_BAR; PG8_WAIT_L(0); PG8_MMA(1, 0, At, B0); PG8_BAR; PG8_SCHED;
            PG8_STAGE(PG8_SB(1, 1), b3 + hstep, voffB);
            PG8_WAIT_V(6); PG8_BAR; PG8_MMA(1, 1, At, B1); PG8_BAR;
            }
        }
        if constexpr (ALIGN_EPI) { if (wr == 0) PG8_BAR; }
        if constexpr (!Epi::AFTER_DRAIN) { E(acc, cur, wr, wc, fr, fq); S.done(cur); }
        if (!has_next) break;
#pragma unroll
        for (int a = 0; a < 2; ++a)
#pragma unroll
            for (int b = 0; b < 2; ++b)
#pragma unroll
                for (int m = 0; m < 4; ++m)
#pragma unroll
                    for (int n = 0; n < 2; ++n) acc[a][b][m][n] = (f32x4){0.f, 0.f, 0.f, 0.f};
        cur = nxt; cA = nA; cB = nB; ++ui;
        if constexpr (ALIGN_EPI) { if (wr == 1) PG8_BAR; }
    }
    PG8_WAIT_V(0);
    if constexpr (!ALIGN_EPI) { if (wr == 0) PG8_BAR; }
    PG8_BAR;
    if constexpr (Epi::AFTER_DRAIN) { E.fused(acc, cur, wr, wc, fr, fq, lds, wid, lane); S.done(cur); }
#undef PG8_SA
#undef PG8_SB
#undef PG8_STAGE
#undef PG8_LDA
#undef PG8_LDB
#undef PG8_MMA
#undef PG8_WAIT_V
#undef PG8_WAIT_L
#undef PG8_BAR
#undef PG8_SCHED
}
}
#define XB_TMO      128
#define XB_XCNT(j)  (256  + 64 * (j))
#define XB_XSUB(j)  (1280 + 64 * (j))
#define XB_XGEN(j)  (2304 + 64 * (j))
#define XB_TOP      3328
#define XB_TOPGEN   3392
#define XCD_BAR_WORDS 3456
#define XB_SPIN_CAP (1u << 22)
#define LAS __attribute__((address_space(3)))

__device__ __forceinline__ unsigned xb_ld(unsigned* p)              { return __hip_atomic_load(p, __ATOMIC_RELAXED, __HIP_MEMORY_SCOPE_AGENT); }
__device__ __forceinline__ unsigned xb_add(unsigned* p, unsigned v) { return __hip_atomic_fetch_add(p, v, __ATOMIC_RELAXED, __HIP_MEMORY_SCOPE_AGENT); }
__device__ __forceinline__ unsigned xb_xcc_id() { return (unsigned)__builtin_amdgcn_s_getreg((3 << 11) | 20) & 0xFu; }
#define XB_SPIN(cond, bar) do { unsigned _sp = 0; while (cond) { __builtin_amdgcn_s_sleep(1); \
    if ((++_sp & 255u) == 0u) { if (xb_ld(&(bar)[XB_TMO])) break; if (_sp > XB_SPIN_CAP) { atomicAdd(&(bar)[XB_TMO], 1u); break; } } } } while (0)

struct XcdBarrier {
    unsigned* bar; unsigned x;
    volatile LAS unsigned* st;
};

__device__ __forceinline__ XcdBarrier xcd_barrier_post(unsigned* bar, volatile LAS unsigned* st, const bool lead) {
    XcdBarrier b; b.bar = bar; b.x = xb_xcc_id(); b.st = st;
    if (lead) (void)xb_add(&bar[XB_XCNT(b.x)], 1u);
    return b;
}
__device__ __forceinline__ void xcd_barrier_complete(unsigned* bar, unsigned x, unsigned& nloc, unsigned& nx) {
    const unsigned G = gridDim.x * gridDim.y * gridDim.z;
    unsigned sum, cnt, mine, sp = 0u;
    for (;;) {
        sum = 0u; cnt = 0u; mine = 0u;
#pragma unroll
        for (unsigned j = 0; j < 16; ++j) { const unsigned c = xb_ld(&bar[XB_XCNT(j)]); sum += c; cnt += (c > 0u) ? 1u : 0u; mine = (j == x) ? c : mine; }
        if (sum == G) break;
        __builtin_amdgcn_s_sleep(1);
        if ((++sp & 255u) == 0u) { if (xb_ld(&bar[XB_TMO])) break; if (sp > XB_SPIN_CAP) { atomicAdd(&bar[XB_TMO], 1u); break; } }
    }
    nloc = mine > 0u ? mine : 1u; nx = cnt > 0u ? cnt : 1u;
}

__device__ __forceinline__ void xcd_barrier(const XcdBarrier& b, const bool lead) {
    asm volatile("s_waitcnt vmcnt(0)" ::: "memory");
    __syncthreads();
    if (lead) {
        unsigned* bar = b.bar;
        __builtin_amdgcn_s_waitcnt(0);
        unsigned nloc = b.st[0], nx = b.st[1];
        if (nloc == 0u) { xcd_barrier_complete(bar, b.x, nloc, nx); b.st[0] = nloc; b.st[1] = nx; }
        const unsigned old = xb_add(&bar[XB_XSUB(b.x)], 1u);
        const unsigned gen = old / nloc;
        if (old + 1u == (gen + 1u) * nloc) {
            __builtin_amdgcn_fence(__ATOMIC_RELEASE, "agent");
            asm volatile("s_waitcnt vmcnt(0)" ::: "memory");
            const unsigned og = xb_add(&bar[XB_TOP], 1u);
            const unsigned tg = og / nx;
            if (og + 1u == (tg + 1u) * nx) xb_add(&bar[XB_TOPGEN], 1u);
            else XB_SPIN(xb_ld(&bar[XB_TOPGEN]) == tg, bar);
            __builtin_amdgcn_fence(__ATOMIC_ACQUIRE, "agent");
            xb_add(&bar[XB_XGEN(b.x)], 1u);
            asm volatile("s_waitcnt vmcnt(0)" ::: "memory");
        } else {
            XB_SPIN(xb_ld(&bar[XB_XGEN(b.x)]) == gen, bar);
            __builtin_amdgcn_fence(__ATOMIC_ACQUIRE, "agent");
            asm volatile("s_waitcnt vmcnt(0)" ::: "memory");
        }
    }
    __syncthreads();
}

typedef unsigned short bf16_t;
typedef float f32x4 __attribute__((ext_vector_type(4)));
typedef short bf16x8 __attribute__((ext_vector_type(8)));
typedef unsigned u32x4 __attribute__((ext_vector_type(4)));
typedef unsigned u32x2 __attribute__((ext_vector_type(2)));

constexpr int D = 1024, NSEQ = 12, SEQ = 4096, NTOK = NSEQ * SEQ, DEPTH = 2;
constexpr int RWC = 1920, INC = 3456, PCW = 3072, QOFF = 2048, KOFF = 2560, DFF = 2816, UPC = 5632;
constexpr int O_WD = 1536, O_AD = 1664, O_GD = 1792;
constexpr int NT = 512, NWG = 256;
constexpr int LDS_MISC = 161792, LDS_BYTES = LDS_MISC + 1024;
constexpr size_t WS_CTL_BYTES = 65536;
constexpr int GSEQ = 4, GR = GSEQ * SEQ, NGRP = NSEQ / GSEQ;

typedef __bf16 bf16v2_t __attribute__((ext_vector_type(2)));
typedef float f32v2_t __attribute__((ext_vector_type(2)));
__device__ __forceinline__ unsigned cvtpk(float lo, float hi) { f32v2_t f = {lo, hi}; bf16v2_t b = __builtin_convertvector(f, bf16v2_t); return __builtin_bit_cast(unsigned, b); }
__device__ __forceinline__ unsigned short f2bf(float f) { return __builtin_bit_cast(unsigned short, (__bf16)f); }
__device__ __forceinline__ float bf2f(unsigned short b) { return __uint_as_float(((unsigned)b) << 16); }
__device__ __forceinline__ unsigned pk2bf(float lo, float hi) { return cvtpk(lo, hi); }
__device__ __forceinline__ float shx(float v, int m, int lane) { return __int_as_float(__builtin_amdgcn_ds_bpermute((lane ^ m) << 2, __float_as_int(v))); }
__device__ __forceinline__ float shl_(float v, int src) { return __int_as_float(__builtin_amdgcn_ds_bpermute(src << 2, __float_as_int(v))); }
__device__ __forceinline__ float wave_sum(float v, int lane) {
#pragma unroll
    for (int o = 1; o < 64; o <<= 1) v += shx(v, o, lane);
    return v;
}
__device__ __forceinline__ int olane() { unsigned z = 0u; asm volatile("" : "+s"(z)); int l = (int)__builtin_amdgcn_mbcnt_hi(~0u, __builtin_amdgcn_mbcnt_lo(~0u, z)); asm volatile("" : "+v"(l)); return l; }
__device__ __forceinline__ int otid() { return (__builtin_amdgcn_readfirstlane((int)threadIdx.x >> 6) << 6) | olane(); }
__device__ __forceinline__ float sigmoidf_(float x) { return 1.f / (1.f + expf(-x)); }

__device__ __forceinline__ void ph_prep_w(LAS unsigned char* lds, const float* __restrict__ W, int K, int Nsrc, const float* __restrict__ scale, bf16_t* __restrict__ out, int Nout, int mode, float mul) {
    const int tid0 = otid(); const int half = tid0 >> 8, t8 = tid0 & 255, tx = t8 & 31, ty = t8 >> 5;
    LAS float* tile = (LAS float*)(lds + half * 4352);
    const int ntn = Nout / 32, ntiles = ntn * (K / 32);
    for (int vb = blockIdx.x; 2 * vb < ntiles; vb += NWG) {
        const int ti = 2 * vb + half; const bool on = ti < ntiles;
        const int n0 = (ti % ntn) * 32, k0 = (ti / ntn) * 32;
        if (on) for (int i = ty; i < 32; i += 8) {
            const int n = n0 + tx, k = k0 + i; int ns = n; bool valid = true;
            if (mode == 1) { if (n < 1920) ns = n; else if (n < 2048) valid = false; else ns = n - 128; }
            if (mode == 2) ns = n + 2944;
            if (mode == 3) ns = ((n >> 7) & 1) * DFF + (n >> 8) * 128 + (n & 127);
            float v = 0.f;
            if (valid) v = W[(size_t)k * Nsrc + ns] * (scale ? scale[k] : 1.f) * mul;
            if (mode == 1) { if (n >= O_WD && n < O_WD + 128) v *= 2.88539008f; else if (n >= O_GD && n < O_GD + 128) v *= -1.44269504f; }
            tile[i * 33 + tx] = v;
        }
        __syncthreads();
        if (on) for (int i = ty; i < 32; i += 8) { const int n = n0 + i, k = k0 + tx; out[(size_t)n * K + k] = f2bf(tile[tx * 33 + i]); }
        __syncthreads();
    }
}

__device__ __forceinline__ void ph_rms_in(const float* __restrict__ xin, bf16_t* __restrict__ xb, float* __restrict__ rstd, int rows) {
    const int tid0 = otid(); const int lane = tid0 & 63;
    for (int row = blockIdx.x * 8 + (tid0 >> 6); row < rows; row += NWG * 8) {
        const f32x4* xr = (const f32x4*)(xin + (size_t)row * D);
        f32x4 v[4]; float s = 0.f;
#pragma unroll
        for (int j = 0; j < 4; ++j) { v[j] = xr[lane + 64 * j]; s += v[j].x * v[j].x + v[j].y * v[j].y + v[j].z * v[j].z + v[j].w * v[j].w; }
        s = wave_sum(s, lane);
        if (lane < 4) rstd[lane * GR + row] = (lane == 0) ? s : 0.f;
#pragma unroll
        for (int j = 0; j < 4; ++j) {
            const int c = (lane + 64 * j) * 4;
            u32x2 w; w.x = pk2bf(v[j].x, v[j].y); w.y = pk2bf(v[j].z, v[j].w);
            *(u32x2*)(xb + (size_t)row * D + c) = w;
        }
    }
}
__device__ __forceinline__ void ph_rstd(const bf16_t* __restrict__ xb, float* __restrict__ rstd, int rows) {
    const int tid0 = otid(); const int lane = tid0 & 63;
#pragma unroll 4
    for (int row = blockIdx.x * 8 + (tid0 >> 6); row < rows; row += NWG * 8) {
        const u32x4* xr = (const u32x4*)(xb + (size_t)row * D);
        float s = 0.f;
#pragma unroll
        for (int j = 0; j < 2; ++j) {
            const u32x4 q = xr[lane + 64 * j];
            const unsigned w[4] = {q.x, q.y, q.z, q.w};
#pragma unroll
            for (int k = 0; k < 4; ++k) { const float a = __uint_as_float(w[k] << 16), c = __uint_as_float(w[k] & 0xffff0000u); s += a * a + c * c; }
        }
        s = wave_sum(s, lane);
        if (lane == 0) rstd[row] = rsqrtf(s * (1.f / D) + 1e-6f);
    }
}

constexpr int RS_A = 140288, RS_B = 141312;
__device__ __forceinline__ void wg_rstd_from_slots(const float* __restrict__ ssq, int row0, LAS float* dst) {
    const int tid0 = otid();
    if (tid0 < 256) {
        const float* p = ssq + row0 + tid0;
        dst[tid0] = rsqrtf(((p[0] + p[GR]) + (p[2 * GR] + p[3 * GR])) * (1.f / D) + 1e-6f);
    }
    __syncthreads();
}

constexpr int EPI_S = 135168;
struct EpiRow {
    static constexpr bool PERM = true, AFTER_DRAIN = false, APERM = false;
    bf16_t* X; float* outf; float* ssq; LAS unsigned char* lds;
    __device__ __forceinline__ void operator()(const pg8::f32x4 (&acc)[2][2][4][2], const pg8::Unit& u, int wr, int wc, int fr, int fq) const {
        const int row0 = u.pm * 256 + wr * 64 + fr, col0 = u.pn * 256 + wc * 32 + 8 * fq;
        const unsigned off0 = (unsigned)row0 * (unsigned)D + (unsigned)col0;
        pg8::u32x4 r[2][4][2];
#pragma unroll
        for (int ai = 0; ai < 2; ++ai)
#pragma unroll
            for (int m = 0; m < 4; ++m)
#pragma unroll
                for (int bj = 0; bj < 2; ++bj) r[ai][m][bj] = *(const pg8::u32x4*)(X + off0 + (unsigned)((ai * 128 + m * 16) * D + bj * 128));
        float ss[2][4];
#pragma unroll
        for (int ai = 0; ai < 2; ++ai)
#pragma unroll
            for (int m = 0; m < 4; ++m) {
                const unsigned off = off0 + (unsigned)((ai * 128 + m * 16) * D);
                float sq = 0.f;
#pragma unroll
                for (int bj = 0; bj < 2; ++bj) {
                    const pg8::u32x4 rr = r[ai][m][bj];
                    pg8::f32x4 v0 = acc[ai][bj][m][0], v1 = acc[ai][bj][m][1];
                    v0[0] += __uint_as_float(rr.x << 16); v0[1] += __uint_as_float(rr.x & 0xffff0000u); v0[2] += __uint_as_float(rr.y << 16); v0[3] += __uint_as_float(rr.y & 0xffff0000u);
                    v1[0] += __uint_as_float(rr.z << 16); v1[1] += __uint_as_float(rr.z & 0xffff0000u); v1[2] += __uint_as_float(rr.w << 16); v1[3] += __uint_as_float(rr.w & 0xffff0000u);
                    if (outf) { *(pg8::f32x4*)(outf + off + bj * 128) = v0; *(pg8::f32x4*)(outf + off + bj * 128 + 4) = v1; }
                    else {
                        pg8::u32x4 w; w.x = pg8::cvt_pk_bf16(v0[0], v0[1]); w.y = pg8::cvt_pk_bf16(v0[2], v0[3]); w.z = pg8::cvt_pk_bf16(v1[0], v1[1]); w.w = pg8::cvt_pk_bf16(v1[2], v1[3]);
                        *(pg8::u32x4*)(X + off + bj * 128) = w;
                        const unsigned ww[4] = {w.x, w.y, w.z, w.w};
#pragma unroll
                        for (int k = 0; k < 4; ++k) { const float a = __uint_as_float(ww[k] << 16), c = __uint_as_float(ww[k] & 0xffff0000u); sq = fmaf(a, a, fmaf(c, c, sq)); }
                    }
                }
                ss[ai][m] = sq;
            }
        if (!outf) {
            const int lane_ = olane();
            LAS float* LS = (LAS float*)(lds + EPI_S);
#pragma unroll
            for (int ai = 0; ai < 2; ++ai)
#pragma unroll
                for (int m = 0; m < 4; ++m) {
                    float s = ss[ai][m];
                    s += shx(s, 16, lane_); s += shx(s, 32, lane_);
                    if (lane_ < 16) LS[wc * 256 + wr * 64 + ai * 128 + m * 16 + lane_] = s;
                }
            __syncthreads();
            const int tid_ = (wr * 4 + wc) * 64 + lane_;
            if (tid_ < 256) ssq[u.pn * GR + u.pm * 256 + tid_] = (LS[tid_] + LS[256 + tid_]) + (LS[512 + tid_] + LS[768 + tid_]);
        }
    }
};
template <int CTRL> __device__ __forceinline__ float dppf(float x) { return __int_as_float(__builtin_amdgcn_update_dpp(0, __float_as_int(x), CTRL, 0xf, 0xf, true)); }
constexpr int EPI_C = 135168;
constexpr int MIXC = 1920;
struct EpiBf {
    static constexpr bool PERM = true, AFTER_DRAIN = false, APERM = true;
    bf16_t* O; const LAS float* rowscale; const LAS float* colscale; int ldc; const float* mu; float* edge; LAS unsigned char* lds;
    __device__ __forceinline__ void operator()(const pg8::f32x4 (&acc)[2][2][4][2], const pg8::Unit& u, int wr, int wc, int fr_in, int fq_in) const {
        const int lane_ = olane(); const int fr = lane_ & 15, fq = lane_ >> 4; (void)fr_in; (void)fq_in;
        const int col0 = u.pn * 256 + wc * 32 + 8 * fq;
        const bool mix = (mu != nullptr) && (u.pn * 256 < MIXC);
        if (mix) {
            const int tid_ = (wr * 4 + wc) * 64 + lane_;
            LAS float* Cf = (LAS float*)(lds + EPI_C);
#pragma unroll
            for (int q = 0; q < 2; ++q) {
                const int idx = tid_ + 512 * q;
                if (idx < 768) {
                    const int k = idx >> 8, col = u.pn * 256 + (idx & 255);
                    float v = (k == 0) ? 1.f : 0.f;
                    if (col < MIXC) { const float a0 = mu[col], a1 = mu[RWC + col]; v = (k == 0) ? 1.f - a0 - a1 : (k == 1) ? a0 : a1; }
                    Cf[idx] = v;
                }
            }
            __syncthreads();
        }
#pragma unroll
        for (int ai = 0; ai < 2; ++ai) {
            const int rowb = u.pm * 256 + ai * 128 + wr * 64;
            pg8::f32x4 rs = (pg8::f32x4){1.f, 1.f, 1.f, 1.f};
            if (rowscale) rs = *(const LAS pg8::f32x4*)(rowscale + wr * 64 + ai * 128 + 4 * fr);
#pragma unroll
            for (int bj = 0; bj < 2; ++bj) {
                pg8::u32x4 w[4];
                if (mix) {
                    const LAS float* Cf = (const LAS float*)(lds + EPI_C) + (wc * 32 + 8 * fq + bj * 128);
                    const unsigned eoff = ((unsigned)((rowb >> 6) * 4 + (fr == 0 ? 0 : 2)) * MIXC + (unsigned)(col0 + bj * 128)) * 4u;
                    const bool isedge = ((fr == 0) || (fr == 15)) && (col0 + bj * 128 < MIXC);
#pragma unroll
                    for (int n = 0; n < 2; ++n) {
                        const pg8::f32x4 k0 = *(const LAS pg8::f32x4*)(Cf + 4 * n), m0 = *(const LAS pg8::f32x4*)(Cf + 256 + 4 * n), m1 = *(const LAS pg8::f32x4*)(Cf + 512 + 4 * n);
                        float c_[4][4];
#pragma unroll
                        for (int e = 0; e < 4; ++e) {
                            float x[4];
#pragma unroll
                            for (int m = 0; m < 4; ++m) x[m] = acc[ai][bj][m][n][e] * rs[m];
                            if (isedge) { *(float*)((char*)edge + eoff + (4 * n + e) * 4u) = (fr == 0) ? x[0] : x[2]; *(float*)((char*)edge + eoff + MIXC * 4u + (4 * n + e) * 4u) = (fr == 0) ? x[1] : x[3]; }
                            const float up = dppf<0x111>(x[3]), dn = dppf<0x101>(x[0]);
                            c_[e][0] = fmaf(k0[e], x[0], fmaf(m0[e], up, m1[e] * x[1])); c_[e][1] = fmaf(k0[e], x[1], fmaf(m0[e], x[0], m1[e] * x[2]));
                            c_[e][2] = fmaf(k0[e], x[2], fmaf(m0[e], x[1], m1[e] * x[3])); c_[e][3] = fmaf(k0[e], x[3], fmaf(m0[e], x[2], m1[e] * dn));
                        }
#pragma unroll
                        for (int m = 0; m < 4; ++m) {
                            const unsigned lo = pg8::cvt_pk_bf16(c_[0][m], c_[1][m]), hi = pg8::cvt_pk_bf16(c_[2][m], c_[3][m]);
                            if (n == 0) { w[m].x = lo; w[m].y = hi; } else { w[m].z = lo; w[m].w = hi; }
                        }
                    }
                } else {
                    pg8::f32x4 cs0 = (pg8::f32x4){1.f, 1.f, 1.f, 1.f}, cs1 = cs0;
                    if (colscale) { cs0 = *(const LAS pg8::f32x4*)(colscale + wc * 32 + 8 * fq + bj * 128); cs1 = *(const LAS pg8::f32x4*)(colscale + wc * 32 + 8 * fq + bj * 128 + 4); }
#pragma unroll
                    for (int m = 0; m < 4; ++m) {
                        const pg8::f32x4 v0 = acc[ai][bj][m][0] * rs[m] * cs0, v1 = acc[ai][bj][m][1] * rs[m] * cs1;
                        w[m].x = pg8::cvt_pk_bf16(v0[0], v0[1]); w[m].y = pg8::cvt_pk_bf16(v0[2], v0[3]); w[m].z = pg8::cvt_pk_bf16(v1[0], v1[1]); w[m].w = pg8::cvt_pk_bf16(v1[2], v1[3]);
                    }
                }
#pragma unroll
                for (int m = 0; m < 4; ++m) {
                    const int row = rowb + 4 * fr + m;
                    bf16_t* p = (ldc < 0) ? O + (size_t)((col0 + bj * 128) >> 3) * 4096 + row * 8 : O + (size_t)row * ldc + col0 + bj * 128;
                    *(pg8::u32x4*)p = w[m];
                }
            }
        }
    }
};
__device__ __forceinline__ void ph_gemm(LAS unsigned char* lds, const bf16_t* A, const bf16_t* Bt, int M, int N, int K, bf16_t* X, float* outf, float* ssq) {
    pg8::Gemm g{A, Bt, M, N, K, 0}; EpiRow e{X, outf, ssq, lds};
    pg8::StaticOrder S; S.init(M, N, NWG, (int)blockIdx.x);
    pg8::gemm_phase<EpiRow, pg8::StaticOrder, true, true>(lds, g, S, e, otid());
}
__device__ __forceinline__ void ph_gemm_bf(LAS unsigned char* lds, const bf16_t* A, const bf16_t* Bt, int M, int N, int K, bf16_t* O, const LAS float* rowscale, const LAS float* colscale, int ldc, const float* mu, float* edge) {
    pg8::Gemm g{A, Bt, M, N, K, 0}; EpiBf e{O, rowscale, colscale, ldc, mu, edge, lds};
    pg8::StaticOrder S; S.init(M, N, NWG, (int)blockIdx.x);
    pg8::gemm_phase<EpiBf, pg8::StaticOrder, true, true>(lds, g, S, e, otid());
}

__device__ __forceinline__ void ph_qknorm(bf16_t* __restrict__ P, const float* __restrict__ qg, const float* __restrict__ kg, int rows) {
    const int tid0 = otid(); const int lane = tid0 & 63;
    const float* gp = (lane < 32 ? qg : kg) + 16 * (lane & 3); const float gs = lane < 32 ? 0.125f * 1.44269504f : 1.f;
    float gv[16];
#pragma unroll
    for (int j = 0; j < 16; ++j) gv[j] = gp[j] * gs;
#pragma unroll 2
    for (int row = blockIdx.x * 8 + (tid0 >> 6); row < rows; row += NWG * 8) {
        bf16_t* p = P + (size_t)row * PCW + QOFF + 16 * lane;
        const u32x4 a = *(const u32x4*)p, c = *(const u32x4*)(p + 8);
        const unsigned w[8] = {a.x, a.y, a.z, a.w, c.x, c.y, c.z, c.w};
        float f[16]; float ss = 0.f;
#pragma unroll
        for (int j = 0; j < 8; ++j) { f[2 * j] = __uint_as_float(w[j] << 16); f[2 * j + 1] = __uint_as_float(w[j] & 0xffff0000u); ss += f[2 * j] * f[2 * j] + f[2 * j + 1] * f[2 * j + 1]; }
        ss += __int_as_float(__builtin_amdgcn_update_dpp(0, __float_as_int(ss), 0xB1, 0xf, 0xf, false));
        ss += __int_as_float(__builtin_amdgcn_update_dpp(0, __float_as_int(ss), 0x4E, 0xf, 0xf, false));
        const float sc = rsqrtf(ss * (1.f / 64.f) + 1e-6f);
        u32x4 o0, o1;
        o0.x = pk2bf(f[0] * sc * gv[0], f[1] * sc * gv[1]); o0.y = pk2bf(f[2] * sc * gv[2], f[3] * sc * gv[3]); o0.z = pk2bf(f[4] * sc * gv[4], f[5] * sc * gv[5]); o0.w = pk2bf(f[6] * sc * gv[6], f[7] * sc * gv[7]);
        o1.x = pk2bf(f[8] * sc * gv[8], f[9] * sc * gv[9]); o1.y = pk2bf(f[10] * sc * gv[10], f[11] * sc * gv[11]); o1.z = pk2bf(f[12] * sc * gv[12], f[13] * sc * gv[13]); o1.w = pk2bf(f[14] * sc * gv[14], f[15] * sc * gv[15]);
        *(u32x4*)p = o0; *(u32x4*)(p + 8) = o1;
    }
}
constexpr int NK_PITCH = 144, NK_BYTES = 576 * NK_PITCH, NV_BYTES = 576 * 64 * 2, L_NK = 0, L_NV = NK_BYTES, L_RPB = NK_BYTES + NV_BYTES;
static_assert(L_RPB + 15 * 32 * 4 <= LDS_MISC, "neighbourhood attention LDS map");
__device__ __forceinline__ void natten_item_lds(LAS unsigned char* lds, const LAS float* rpbl, bf16_t* __restrict__ mixb, int b, int h, int r, int g, int lo, const u32x4 q0, const u32x4 q1, int lane) {
    const int rs = min(max(r - 4, 0), 56);
    const int kc0 = (g == 0) ? 0 : (g == 1) ? 8 : (g == 2) ? 24 : 32;
    const int n = lane & 15, kq = lane >> 4;
    const int tok0 = b * SEQ;
    f32x4 sc_[16];
    const int cq = 16 * g + n, cs = min(max(cq - 8, 0), 48);
    const LAS unsigned char* kl = lds + L_NK + (unsigned)((lo * 64 + kc0 + 8 * (n >> 2) + (n & 3)) * NK_PITCH + 16 * kq);
#pragma unroll
    for (int bi = 0; bi < 16; ++bi) {
        const int i = bi >> 1, nb = bi & 1;
        const u32x4 ka = *(const LAS u32x4*)(kl + (i * 64 + 4 * nb) * NK_PITCH), kc = *(const LAS u32x4*)(kl + (i * 64 + 4 * nb) * NK_PITCH + 64);
        f32x4 acc = (f32x4){0.f, 0.f, 0.f, 0.f};
        acc = __builtin_amdgcn_mfma_f32_16x16x32_bf16(__builtin_bit_cast(bf16x8, ka), __builtin_bit_cast(bf16x8, q0), acc, 0, 0, 0);
        acc = __builtin_amdgcn_mfma_f32_16x16x32_bf16(__builtin_bit_cast(bf16x8, kc), __builtin_bit_cast(bf16x8, q1), acc, 0, 0, 0);
        const LAS float* brow = rpbl + (rs + i - r + 7) * 32;
#pragma unroll
        for (int e = 0; e < 4; ++e) {
            const int kcn = kc0 + 8 * kq + 4 * nb + e;
            const bool valid = (kcn >= cs) && (kcn < cs + 16);
            const int ci = valid ? min(max(kcn - cq + 15, 0), 30) : 31;
            float bv = brow[ci]; asm volatile("" : "+v"(bv));
            acc[e] += bv;
        }
        sc_[bi] = acc;
        if ((bi & 3) == 3) __builtin_amdgcn_sched_barrier(0);
    }
    float mx = -1e30f;
#pragma unroll
    for (int q = 0; q < 16; ++q) mx = fmaxf(fmaxf(fmaxf(mx, sc_[q][0]), fmaxf(sc_[q][1], sc_[q][2])), sc_[q][3]);
    mx = fmaxf(mx, shx(mx, 16, lane)); mx = fmaxf(mx, shx(mx, 32, lane));
    float l = 0.f;
#pragma unroll
    for (int q = 0; q < 16; ++q)
#pragma unroll
        for (int e = 0; e < 4; ++e) { const float pe = __builtin_amdgcn_exp2f(sc_[q][e] - mx); sc_[q][e] = pe; l += pe; }
    l += shx(l, 16, lane); l += shx(l, 32, lane);
    __builtin_amdgcn_sched_barrier(0);
    f32x4 o[4];
#pragma unroll
    for (int d = 0; d < 4; ++d) o[d] = (f32x4){0.f, 0.f, 0.f, 0.f};
    const LAS unsigned char* vl = lds + L_NV + (unsigned)((((lo * 64 + kc0) >> 3) + kq) * 1024 + n * 16);
#pragma unroll
    for (int i = 0; i < 8; ++i) {
        u32x4 pa; pa.x = pk2bf(sc_[2 * i][0], sc_[2 * i][1]); pa.y = pk2bf(sc_[2 * i][2], sc_[2 * i][3]); pa.z = pk2bf(sc_[2 * i + 1][0], sc_[2 * i + 1][1]); pa.w = pk2bf(sc_[2 * i + 1][2], sc_[2 * i + 1][3]);
        const bf16x8 pf = __builtin_bit_cast(bf16x8, pa);
#pragma unroll
        for (int d = 0; d < 4; ++d) {
            const u32x4 vf = *(const LAS u32x4*)(vl + i * 8192 + d * 256);
            o[d] = __builtin_amdgcn_mfma_f32_16x16x32_bf16(__builtin_bit_cast(bf16x8, vf), pf, o[d], 0, 0, 0);
        }
        if (i & 1) __builtin_amdgcn_sched_barrier(0);
    }
    const float li = 1.f / l;
    char* ob = (char*)(mixb + (size_t)(tok0 + r * 64 + 16 * g) * 1024 + 512 + h * 64);
    const unsigned oo = (unsigned)(n * 1024 + 4 * kq) * 2u;
#pragma unroll
    for (int d = 0; d < 4; ++d) *(u32x2*)(ob + oo + 32 * d) = (u32x2){pk2bf(o[d][0] * li, o[d][1] * li), pk2bf(o[d][2] * li, o[d][3] * li)};
}
__device__ __forceinline__ void ph_natten(LAS unsigned char* lds, const bf16_t* P, const bf16_t* VT, int gr, int nseq, const float* rpb, bf16_t* mixb, int wg, int nwg) {
    const int tid0 = otid(); const int lane = tid0 & 63, wave = __builtin_amdgcn_readfirstlane(tid0 >> 6);
    const int h = wg & 7, r0 = 2 * (wg >> 3), r = r0 + (wave >> 2), g = wave & 3;
    const int rsA = min(max(r0 - 4, 0), 56), lo = min(max(r - 4, 0), 56) - rsA;
    const int n = lane & 15, kq = lane >> 4;
    (void)gr; (void)nwg;
    __syncthreads();
    for (int i = tid0; i < 15 * 32; i += NT) { const int rr = i >> 5, cc = i & 31; ((LAS float*)(lds + L_RPB))[i] = (cc < 31) ? 1.44269504f * rpb[h * 15 * 31 + rr * 31 + cc] : -1e30f; }
    u32x4 pk[9], pv[9], q0, q1;
    auto issue = [&](int b) {
        const int tok0 = b * SEQ;
#pragma unroll
        for (int k = 0; k < 9; ++k) {
            const int p = tid0 + NT * k, ts = p >> 3, lr = ts >> 6, col = ts & 63;
            const int row = min(rsA + lr, 63);
            pk[k] = *(const u32x4*)((const char*)(P + (size_t)(tok0 + row * 64 + col) * PCW + KOFF + h * 64) + 16 * (p & 7));
            const int tb = p >> 6, dim = p & 63, lrv = tb >> 3, rowv = min(rsA + lrv, 63);
            pv[k] = *(const u32x4*)(VT + (size_t)(((tok0 + rowv * 64) >> 3) + (tb & 7)) * 4096 + (h * 64 + dim) * 8);
        }
        const char* qb = (const char*)(P + (size_t)(tok0 + r * 64 + 16 * g) * PCW + QOFF + h * 64) + (unsigned)(n * PCW + 8 * kq) * 2u;
        q0 = *(const u32x4*)qb; q1 = *(const u32x4*)(qb + 64);
    };
    issue(0);
    for (int b = 0; b < nseq; ++b) {
        __syncthreads();
#pragma unroll
        for (int k = 0; k < 9; ++k) {
            const int p = tid0 + NT * k;
            *(LAS u32x4*)(lds + L_NK + (p >> 3) * NK_PITCH + 16 * (p & 7)) = pk[k];
            *(LAS u32x4*)(lds + L_NV + p * 16) = pv[k];
        }
        const u32x4 cq0 = q0, cq1 = q1;
        __syncthreads();
        if (b + 1 < nseq) issue(b + 1);
        natten_item_lds(lds, (const LAS float*)(lds + L_RPB), mixb, b, h, r, g, lo, cq0, cq1, lane);
    }
}
constexpr int EPI_W = 135168, EPI_R = EPI_W + 4096;
struct EpiFfn {
    static constexpr bool PERM = true, AFTER_DRAIN = false, APERM = true;
    LAS unsigned char* lds;
    bf16_t* act; float* edge; const float* rstd; const float* cw; const float* cb;
    typedef float f32x2v __attribute__((ext_vector_type(2)));
    static __device__ __forceinline__ f32x2v ld2(const float* base, unsigned byteoff) { return *(const f32x2v*)((const char*)base + byteoff); }
    __device__ __forceinline__ void operator()(const pg8::f32x4 (&acc)[2][2][4][2], const pg8::Unit& u, int wr, int wc, int fr_in, int fq_in) const {
        const int lane_ = olane();
        const int fr = lane_ & 15, fq = lane_ >> 4; (void)fr_in; (void)fq_in;
        const unsigned g0 = (unsigned)(u.pn * 128 + wc * 32 + 8 * fq);
        {
            const int tid_ = (wr * 4 + wc) * 64 + lane_;
            LAS float* Wl = (LAS float*)(lds + EPI_W);
#pragma unroll
            for (int q = 0; q < 2; ++q) {
                const int idx = tid_ + 512 * q, k = idx >> 7, j = idx & 127;
                const float* src = ((k & 3) < 3 ? cw + (k & 3) * UPC : cb) + (k >> 2) * DFF + u.pn * 128 + j;
                Wl[idx] = *src;
            }
            __syncthreads();
        }
#pragma unroll
        for (int n = 0; n < 2; ++n) {
#pragma unroll
            for (int ai = 0; ai < 2; ++ai) {
                const int lane2 = olane();
                const int fr = lane2 & 15, fq = lane2 >> 4;
                const unsigned g0 = (unsigned)(u.pn * 128 + wc * 32 + 8 * fq);
                const LAS float* Wl = (const LAS float*)(lds + EPI_W) + (wc * 32 + 8 * fq);
                const bool isedge = (fr == 0) || (fr == 15);
                const unsigned rowbase = (unsigned)(u.pm * 256 + ai * 128 + wr * 64);
                const f32x4 rs = *(const LAS f32x4*)((const LAS float*)(lds + RS_A) + (wr * 64 + ai * 128 + 4 * fr));
                const unsigned eoff = (((rowbase >> 6) * 4 + (unsigned)(fr == 0 ? 0 : 2)) * UPC + g0 + 4 * n) * 4u;
                unsigned outp[4][2];
                const f32x4 wg0 = *(const LAS f32x4*)(Wl + 0 * 128 + 4 * n), wg1 = *(const LAS f32x4*)(Wl + 1 * 128 + 4 * n), wg2 = *(const LAS f32x4*)(Wl + 2 * 128 + 4 * n), bg4 = *(const LAS f32x4*)(Wl + 3 * 128 + 4 * n);
                const f32x4 wv0 = *(const LAS f32x4*)(Wl + 4 * 128 + 4 * n), wv1 = *(const LAS f32x4*)(Wl + 5 * 128 + 4 * n), wv2 = *(const LAS f32x4*)(Wl + 6 * 128 + 4 * n), bv4 = *(const LAS f32x4*)(Wl + 7 * 128 + 4 * n);
#pragma unroll
                for (int e = 0; e < 4; ++e) {
                    float cg[4], cv[4];
                    const float wg0e = wg0[e], wg1e = wg1[e], wg2e = wg2[e], bge = bg4[e], wv0e = wv0[e], wv1e = wv1[e], wv2e = wv2[e], bve = bv4[e];
                    {
                        float x[4];
#pragma unroll
                        for (int m = 0; m < 4; ++m) x[m] = acc[ai][0][m][n][e] * rs[m];
                        if (isedge) { *(float*)((char*)edge + eoff + 4u * e) = (fr == 0) ? x[0] : x[2]; *(float*)((char*)edge + eoff + UPC * 4u + 4u * e) = (fr == 0) ? x[1] : x[3]; }
                        const float up = dppf<0x111>(x[3]), dn = dppf<0x101>(x[0]);
                        cg[0] = fmaf(wg0e, up, fmaf(wg1e, x[0], fmaf(wg2e, x[1], bge))); cg[1] = fmaf(wg0e, x[0], fmaf(wg1e, x[1], fmaf(wg2e, x[2], bge)));
                        cg[2] = fmaf(wg0e, x[1], fmaf(wg1e, x[2], fmaf(wg2e, x[3], bge))); cg[3] = fmaf(wg0e, x[2], fmaf(wg1e, x[3], fmaf(wg2e, dn, bge)));
                    }
                    {
                        float x[4];
#pragma unroll
                        for (int m = 0; m < 4; ++m) x[m] = acc[ai][1][m][n][e] * rs[m];
                        if (isedge) { *(float*)((char*)edge + eoff + DFF * 4u + 4u * e) = (fr == 0) ? x[0] : x[2]; *(float*)((char*)edge + eoff + (UPC + DFF) * 4u + 4u * e) = (fr == 0) ? x[1] : x[3]; }
                        const float up = dppf<0x111>(x[3]), dn = dppf<0x101>(x[0]);
                        cv[0] = fmaf(wv0e, up, fmaf(wv1e, x[0], fmaf(wv2e, x[1], bve))); cv[1] = fmaf(wv0e, x[0], fmaf(wv1e, x[1], fmaf(wv2e, x[2], bve)));
                        cv[2] = fmaf(wv0e, x[1], fmaf(wv1e, x[2], fmaf(wv2e, x[3], bve))); cv[3] = fmaf(wv0e, x[2], fmaf(wv1e, x[3], fmaf(wv2e, dn, bve)));
                    }
#pragma unroll
                    for (int m = 0; m < 4; ++m) {
                        const float o = (cg[m] * cv[m]) * __builtin_amdgcn_rcpf(1.f + __builtin_amdgcn_exp2f(-1.44269504f * cg[m]));
                        outp[m][e >> 1] = (e & 1) ? cvtpk(__uint_as_float(outp[m][e >> 1]), o) : __float_as_uint(o);
                    }
                    __builtin_amdgcn_sched_barrier(0);
                }
#pragma unroll
                for (int m = 0; m < 4; ++m) {
                    const unsigned rib = 4 * (unsigned)fr + m;
                    if (rib != 0 && rib != 63) *(u32x2*)((char*)act + ((rowbase + rib) * DFF + g0 + 4 * n) * 2u) = (u32x2){outp[m][0], outp[m][1]};
                }
                asm volatile("" ::: "memory");
            }
        }
    }
};
__device__ __forceinline__ void ph_gemm_ffn(LAS unsigned char* lds, const bf16_t* A, const bf16_t* Bt, int M, bf16_t* act, float* edge, const float* rstd, const float* cw, const float* cb) {
    pg8::Gemm g{A, Bt, M, UPC, D, 0}; EpiFfn e{lds, act, edge, rstd, cw, cb};
    pg8::StaticOrder S; S.init(M, UPC, NWG, (int)blockIdx.x);
    pg8::gemm_phase<EpiFfn, pg8::StaticOrder, true, true>(lds, g, S, e, otid());
}
__device__ __forceinline__ void ph_ffn_fix(const float* __restrict__ edge, const float* __restrict__ cw, const float* __restrict__ cb, bf16_t* __restrict__ act, int rows) {
    typedef float f2 __attribute__((ext_vector_type(2)));
    const int tid0 = otid(); const int nb = rows / 64;
    constexpr int CP = DFF / 2;
    const int total = 2 * nb * CP;
#pragma unroll 3
    for (int p = blockIdx.x * NT + tid0; p < total; p += NWG * NT) {
        const int it = p / CP, c = 2 * (p - it * CP);
        const int blk = it >> 1, last = it & 1;
        const int row = blk * 64 + (last ? 63 : 0), t = row & (SEQ - 1);
        const float* cur = edge + ((size_t)blk * 4 + (last ? 3 : 0)) * UPC;
        const bool hp = last ? true : (t > 0), hn = last ? (t < SEQ - 1) : true;
        const float* prv = last ? edge + ((size_t)blk * 4 + 2) * UPC : edge + ((size_t)(hp ? blk - 1 : blk) * 4 + 3) * UPC;
        const float* nxt = last ? edge + ((size_t)(hn ? blk + 1 : blk) * 4 + 0) * UPC : edge + ((size_t)blk * 4 + 1) * UPC;
        const f2 w0g = *(const f2*)(cw + c), w1g = *(const f2*)(cw + UPC + c), w2g = *(const f2*)(cw + 2 * UPC + c), bg = *(const f2*)(cb + c);
        const f2 w0v = *(const f2*)(cw + DFF + c), w1v = *(const f2*)(cw + UPC + DFF + c), w2v = *(const f2*)(cw + 2 * UPC + DFF + c), bv = *(const f2*)(cb + DFF + c);
        const f2 cg = *(const f2*)(cur + c), cv = *(const f2*)(cur + DFF + c);
        f2 pg = *(const f2*)(prv + c), pv = *(const f2*)(prv + DFF + c), ng = *(const f2*)(nxt + c), nv = *(const f2*)(nxt + DFF + c);
        if (!hp) { pg = (f2){0.f, 0.f}; pv = pg; }
        if (!hn) { ng = (f2){0.f, 0.f}; nv = ng; }
        const f2 g = w1g * cg + bg + w0g * pg + w2g * ng, v = w1v * cv + bv + w0v * pv + w2v * nv;
        const float o0 = g[0] * sigmoidf_(g[0]) * v[0], o1 = g[1] * sigmoidf_(g[1]) * v[1];
        *(unsigned*)(act + (size_t)row * DFF + c) = cvtpk(o0, o1);
    }
}

constexpr int NSEG = 4, SEGTOK = SEQ / NSEG;
constexpr int OP_AP = 0, OP_RP = 2048, OP_MX2 = 4096, OP_MD = 5120, OP_MY = 6144, OP_GP = 7168, OP_VT = 11264, OP_GC = 13312, OP_SIZE = 13568;
constexpr int LS_OPS = 0, LS_LABT = 8 * OP_SIZE, LS_MU = LS_LABT + 8 * 1024, LS_CST = LS_MU + 3 * 7 * 64 * 4, LS_WL = LS_CST + 6 * 64 * 4, LS_EOF = LS_WL + 36 * 1024, LS_END = LS_EOF + 1024;
constexpr int WL_DEC = 0, WL_AAA = 8 * 1024, WL_VU = 16 * 1024, WL_G = 20 * 1024;
static_assert(LS_END <= LDS_MISC, "scan unit LDS map");

template <int CTRL> __device__ __forceinline__ float dpp_mov(float x) { return __int_as_float(__builtin_amdgcn_update_dpp(0, __float_as_int(x), CTRL, 0xf, 0xf, false)); }
template <int CTRL> __device__ __forceinline__ unsigned dpp_keep(unsigned old, unsigned src) { return (unsigned)__builtin_amdgcn_update_dpp((int)old, (int)src, CTRL, 0xf, 0xf, false); }
__device__ __forceinline__ float fsig(float z) { return __builtin_amdgcn_rcpf(1.f + __builtin_amdgcn_exp2f(z)); }
__device__ __forceinline__ float ftanh(float z) { return 1.f - 2.f * __builtin_amdgcn_rcpf(1.f + __builtin_amdgcn_exp2f(z)); }
__device__ __forceinline__ f32v2_t bfpair(unsigned u) { return (f32v2_t){__uint_as_float(u << 16), __uint_as_float(u & 0xffff0000u)}; }
__device__ __forceinline__ u32x4 pack8(const float* v) { u32x4 r; r.x = cvtpk(v[0], v[1]); r.y = cvtpk(v[2], v[3]); r.z = cvtpk(v[4], v[5]); r.w = cvtpk(v[6], v[7]); return r; }

struct ScanW {
    const float *mu, *w0, *a0, *v0, *kk_, *ka, *rk;
    const float* pedge;
    const bf16_t *WdecT, *WaaaT, *WgT, *WvuT;
};

template <int NKS> __device__ __forceinline__ void lora_mm(const LAS unsigned char* wl, const u32x4 (&xf)[NKS], float (&out)[16]) {
#pragma unroll
    for (int nb = 0; nb < 4; ++nb) {
        f32x4 acc = (f32x4){0.f, 0.f, 0.f, 0.f};
#pragma unroll
        for (int ks = 0; ks < NKS; ++ks)
            acc = __builtin_amdgcn_mfma_f32_16x16x32_bf16(*(const LAS bf16x8*)(wl + (nb * NKS + ks) * 1024), __builtin_bit_cast(bf16x8, xf[ks]), acc, 0, 0, 0);
        out[4 * nb + 0] = acc[0]; out[4 * nb + 1] = acc[1]; out[4 * nb + 2] = acc[2]; out[4 * nb + 3] = acc[3];
    }
}

template <int V> struct IC { static constexpr int value = V; };
template <int N> __device__ __forceinline__ unsigned edge_lo(unsigned v) { if constexpr (N == 0) return v; else return (unsigned)__builtin_amdgcn_update_dpp(0, (int)v, 0x100 + N, 0xf, 0xf, true); }
template <int N> __device__ __forceinline__ unsigned edge_hi(unsigned v) { if constexpr (N == 0) return v; else return (unsigned)__builtin_amdgcn_update_dpp(0, (int)v, 0x110 + N, 0xf, 0xf, true); }
__device__ __forceinline__ void scan_unit(LAS unsigned char* lds, int unit, int layer, const bf16_t* __restrict__ P, const ScanW& w,
                                          bf16_t* __restrict__ ybuf, bf16_t* __restrict__ gbuf, bf16_t* __restrict__ mixb, bf16_t* __restrict__ vfirst, float* __restrict__ sbon,
                                          bf16_t* __restrict__ yaug, float* __restrict__ segst) {
    const int tid = otid(), lane = tid & 63, wave = __builtin_amdgcn_readfirstlane(tid >> 6);
    const int seg = unit & (NSEG - 1), chain = unit / NSEG;
    const int h = chain & 7, dir = (chain >> 3) & 1, b = chain >> 4;
    const int tokbase = b * SEQ;
    const int t = lane & 15, kq = lane >> 4;
    auto segcol = [&](int s_) { return s_ < 3 ? s_ * 512 + h * 64 : s_ == 3 ? O_WD + dir * 64 : s_ == 4 ? O_AD + dir * 64 : O_GD + (s_ - 5) * 64; };
    if (tid < 384) {
        const int which = tid >> 6, ch = h * 64 + (tid & 63);
        const float v = (which == 0) ? w.kk_[ch] : (which == 1) ? w.ka[ch] : (which == 2) ? w.rk[ch] : (which == 3) ? w.w0[dir * 512 + ch] : (which == 4) ? w.a0[dir * 512 + ch] : ((layer > 0) ? w.v0[ch] : 0.f);
        ((LAS float*)(lds + LS_CST))[tid] = (which >= 3) ? -1.44269504f * v : v;
    }
    for (int i = tid; i < 36 * 64; i += NT) {
        const int f = i >> 6, n = i & 15, q = (i >> 4) & 3;
        const bf16_t* src; int Kw, nb, ks;
        if (f < 8)       { src = w.WdecT + (size_t)dir * 512 * 64; Kw = 64; nb = f >> 1; ks = f & 1; }
        else if (f < 16) { src = w.WaaaT + (size_t)dir * 512 * 64; Kw = 64; nb = (f - 8) >> 1; ks = f & 1; }
        else if (f < 20) { src = w.WvuT; Kw = 32; nb = f - 16; ks = 0; }
        else             { src = w.WgT; Kw = 128; nb = (f - 20) >> 2; ks = (f - 20) & 3; }
        const bf16_t* p = src + (h * 64 + 16 * nb + n) * Kw + 32 * ks + 4 * q;
        const u32x2 lo = *(const u32x2*)p, hi = *(const u32x2*)(p + 16);
        *(LAS u32x4*)(lds + LS_WL + i * 16) = (u32x4){lo.x, lo.y, hi.x, hi.y};
    }
    __syncthreads();

    f32x4 St[4];
    const bool augw = wave >= 4; const int colw = 16 * (wave & 3) + t;
#pragma unroll
    for (int jb = 0; jb < 4; ++jb)
#pragma unroll
        for (int e = 0; e < 4; ++e) St[jb][e] = (augw && (16 * jb + 4 * kq + e) == colw) ? 1.f : 0.f;

    {
        typedef float f2 __attribute__((ext_vector_type(2)));
        const int tseg = dir ? (NSEG - 1 - seg) : seg;
        const int blk0 = (tokbase + tseg * SEGTOK) >> 6;
#pragma unroll 1
        for (int hb = 0; hb < 2; ++hb) {
            f2 cv[7], pv[7], nv[7], a0[7], a1[7]; unsigned po[7];
#pragma unroll
            for (int i = 0; i < 7; ++i) {
                const int p = tid + NT * (hb * 7 + i);
                const int itl = p / 224, c2 = p - itl * 224;
                const int col = segcol(c2 >> 5) + 2 * (c2 & 31);
                const int blk = blk0 + (itl >> 1), last = itl & 1;
                const int row = blk * 64 + (last ? 63 : 0), tt = row & (SEQ - 1);
                const bool hp = last ? true : (tt > 0), hn = last ? (tt < SEQ - 1) : true;
                const float* cur = w.pedge + ((size_t)blk * 4 + (last ? 3 : 0)) * MIXC + col;
                const float* prv = last ? w.pedge + ((size_t)blk * 4 + 2) * MIXC + col : w.pedge + ((size_t)(hp ? blk - 1 : blk) * 4 + 3) * MIXC + col;
                const float* nxt = last ? w.pedge + ((size_t)(hn ? blk + 1 : blk) * 4 + 0) * MIXC + col : w.pedge + ((size_t)blk * 4 + 1) * MIXC + col;
                cv[i] = *(const f2*)cur; pv[i] = *(const f2*)prv; nv[i] = *(const f2*)nxt;
                a0[i] = *(const f2*)(w.mu + col); a1[i] = *(const f2*)(w.mu + RWC + col);
                if (!hp) pv[i] = (f2){0.f, 0.f};
                if (!hn) nv[i] = (f2){0.f, 0.f};
                po[i] = (unsigned)row * (unsigned)PCW + (unsigned)col;
            }
#pragma unroll
            for (int i = 0; i < 7; ++i) {
                const f2 o = ((f2){1.f, 1.f} - a0[i] - a1[i]) * cv[i] + a0[i] * pv[i] + a1[i] * nv[i];
                *(unsigned*)((bf16_t*)P + po[i]) = cvtpk(o[0], o[1]);
            }
        }
        asm volatile("s_waitcnt vmcnt(0)" ::: "memory");
        __syncthreads();
    }
    const char* Pc = (const char*)P;
    u32x2 rc[7][4], fz[3][2], EL[2], EH[2];
    EL[0] = EL[1] = EH[0] = EH[1] = (u32x2){0u, 0u};
    const int colLo = dir ? 1984 : 1952, colHi = dir ? 1952 : 1984;
    auto piece_col = [&](int p, int foldcol) { const int sg = p >> 2, g = p & 3; return (p < 28 ? segcol(sg) + 16 * g : foldcol + 16 * (p & 1)) * 2 + 8 * kq; };
    if (tid < 64) *(LAS u32x4*)(lds + LS_EOF + tid * 16) = (u32x4){(unsigned)piece_col(t, colLo), (unsigned)piece_col((t + 16) & 31, colLo), (unsigned)piece_col(15 - t, colHi), (unsigned)piece_col(31 - t, colHi)};
    auto issue_loads = [&](int it_) {
        const int gb = seg * (SEGTOK / 16) + it_ * 8 + wave;
        const int st = 16 * gb + t;
        const int tok = dir ? (SEQ - 1 - st) : st;
        const unsigned ro = (unsigned)(tokbase + tok) * (unsigned)(PCW * 2) + 8u * kq;
        const int sL = 16 * gb - 1, sH = 16 * gb + 16;
        const bool vL_ = gb > 0, vH_ = gb < SEQ / 16 - 1;
        const int tL = vL_ ? (dir ? (SEQ - 1 - sL) : sL) : 0, tH = vH_ ? (dir ? (SEQ - 1 - sH) : sH) : 0;
        const unsigned rl = (unsigned)(tokbase + tL) * (unsigned)(PCW * 2), rh = (unsigned)(tokbase + tH) * (unsigned)(PCW * 2);
#pragma unroll
        for (int sg = 0; sg < 7; ++sg) {
            if (sg >= 5 && (it_ & 1)) continue;
            const int col = segcol(sg);
#pragma unroll
            for (int g = 0; g < 4; ++g) rc[sg][g] = *(const u32x2*)(Pc + ro + col * 2 + 32 * g);
        }
        const u32x4 eo4 = *(const LAS u32x4*)(lds + LS_EOF + lane * 16);
        const unsigned zo_ = 2016u * 2u + 8u * (unsigned)(lane & 3);
        if (layer > 0) { EL[1] = *(const u32x2*)(Pc + (rl + (vL_ ? eo4.y : zo_))); EH[1] = *(const u32x2*)(Pc + (rh + (vH_ ? eo4.w : zo_))); }
        if (layer > 0) {
#pragma unroll
            for (int g = 0; g < 2; ++g) { fz[0][g] = *(const u32x2*)(Pc + ro + 1920 * 2 + 32 * g); fz[1][g] = *(const u32x2*)(Pc + ro + colLo * 2 + 32 * g); fz[2][g] = *(const u32x2*)(Pc + ro + colHi * 2 + 32 * g); }
        }
    };
#pragma unroll
    for (int sg = 0; sg < 7; ++sg)
#pragma unroll
        for (int g = 0; g < 4; ++g) rc[sg][g] = (u32x2){0u, 0u};
#pragma unroll
    for (int g = 0; g < 2; ++g) { fz[0][g] = fz[1][g] = fz[2][g] = (u32x2){0u, 0u}; }
    __syncthreads();
    issue_loads(0);
    for (int it = 0; it < SEGTOK / 128; ++it) {
        {
            if (wave >= 4) __builtin_amdgcn_s_sleep(3);
            int lane_o = lane; asm volatile("" : "+v"(lane_o));
            const int t = lane_o & 15, kq = lane_o >> 4;
            const LAS unsigned char* WL = lds + LS_WL + lane_o * 16;
            const LAS float* CST = (const LAS float*)(lds + LS_CST) + 4 * kq;
            LAS unsigned char* myop = lds + LS_OPS + wave * OP_SIZE;
            LAS float* labt = (LAS float*)(lds + LS_LABT + wave * 1024);
            const int lane = lane_o;
            const int gb = seg * (SEGTOK / 16) + it * 8 + wave;
            const int st = 16 * gb + t;
            const int tok = dir ? (SEQ - 1 - st) : st;
            const unsigned grow = (unsigned)(tokbase + tok);
            u32x2 vf[4];
#pragma unroll
            for (int g = 0; g < 4; ++g) vf[g] = (u32x2){0u, 0u};
            if (layer > 0) {
#pragma unroll
                for (int g = 0; g < 4; ++g) vf[g] = *(const u32x2*)((const char*)vfirst + (grow * 1024u + (unsigned)((h * 64 + 16 * g + 4 * kq) * 2)));
            }
            auto seg_mix = [&](auto sgc, float (&out)[16]) {
                constexpr int sg = decltype(sgc)::value;
#pragma unroll
                for (int g = 0; g < 4; ++g) {
                    const u32x2 c = rc[sg][g];
                    out[4 * g + 0] = __uint_as_float(c.x << 16); out[4 * g + 1] = __uint_as_float(c.x & 0xffff0000u); out[4 * g + 2] = __uint_as_float(c.y << 16); out[4 * g + 3] = __uint_as_float(c.y & 0xffff0000u);
                }
            };
            auto cst16 = [&](int which, float (&out)[16]) {
#pragma unroll
                for (int g = 0; g < 4; ++g) { const f32x4 v = *(const LAS f32x4*)(CST + which * 64 + 16 * g); out[4 * g] = v[0]; out[4 * g + 1] = v[1]; out[4 * g + 2] = v[2]; out[4 * g + 3] = v[3]; }
            };
            u32x4 selE, selO;
            {
                const unsigned wv = (kq == (t >> 2)) ? (0x3F80u << (16 * (t & 1))) : 0u;
                const unsigned w0_ = (t & 2) ? 0u : wv, w1_ = (t & 2) ? wv : 0u;
                selE = (u32x4){w0_, w1_, 0u, 0u}; selO = (u32x4){0u, 0u, w0_, w1_};
            }
            if ((it & 1) == 0) {
                float g0[16], g1[16]; seg_mix(IC<5>{}, g0); seg_mix(IC<6>{}, g1);
#pragma unroll
                for (int i = 0; i < 16; ++i) { g0[i] = fsig(g0[i]); g1[i] = fsig(g1[i]); }
                u32x4 xf[4]; xf[0] = pack8(g0); xf[1] = pack8(g0 + 8); xf[2] = pack8(g1); xf[3] = pack8(g1 + 8);
                float go[16]; lora_mm<4>(WL + WL_G, xf, go);
#pragma unroll
                for (int g = 0; g < 4; ++g) *(u32x2*)((char*)gbuf + (grow * 1024u + (unsigned)((h * 64 + 16 * g + 4 * kq) * 2))) = (u32x2){cvtpk(go[4 * g], go[4 * g + 1]), cvtpk(go[4 * g + 2], go[4 * g + 3])};
            }
            float kv[16], kk[16];
            seg_mix(IC<1>{}, kv);
            {
                float c_[16]; cst16(0, c_);
                float ss = 0.f;
#pragma unroll
                for (int i = 0; i < 16; ++i) { kk[i] = kv[i] * c_[i]; ss += kk[i] * kk[i]; }
                ss += shx(ss, 16, lane); ss += shx(ss, 32, lane);
                const float rn = __builtin_amdgcn_rsqf(fmaxf(ss, 1e-12f));
#pragma unroll
                for (int i = 0; i < 16; ++i) kk[i] *= rn;
            }
            float kd[16], bb[16];
            {
                float ain[16]; seg_mix(IC<4>{}, ain);
                u32x4 xf[2]; xf[0] = pack8(ain); xf[1] = pack8(ain + 8);
                float xa[16]; lora_mm<2>(WL + WL_AAA, xf, xa);
                float a0c[16], kac[16]; cst16(4, a0c); cst16(1, kac);
#pragma unroll
                for (int i = 0; i < 16; ++i) { const float a = fsig(xa[i] + a0c[i]); kd[i] = kv[i] * (1.f + (a - 1.f) * kac[i]); bb[i] = kk[i] * a; }
            }
            float rv[16];
            seg_mix(IC<0>{}, rv);
            {
                float rkc[16]; cst16(2, rkc);
                float bon = 0.f;
#pragma unroll
                for (int i = 0; i < 16; ++i) bon += rv[i] * kd[i] * rkc[i];
                bon += shx(bon, 16, lane); bon += shx(bon, 32, lane);
                if (kq == 0) *(float*)((char*)sbon + (grow * 64u + (unsigned)((dir * 8 + h) * 4))) = bon;
            }
            {
                float vv[16]; seg_mix(IC<2>{}, vv);
                if (layer > 0) {
                    float hid[8];
                    {
                        const u32x2 z0 = fz[0][0], cl = fz[1][0], ch_ = fz[2][0];
                        const f32v2_t s0 = bfpair(z0.x) + bfpair(dpp_keep<0x111>(edge_lo<12>(EL[1].x), cl.x)) + bfpair(dpp_keep<0x101>(edge_hi<12>(EH[1].x), ch_.x));
                        const f32v2_t s1 = bfpair(z0.y) + bfpair(dpp_keep<0x111>(edge_lo<12>(EL[1].y), cl.y)) + bfpair(dpp_keep<0x101>(edge_hi<12>(EH[1].y), ch_.y));
                        hid[0] = s0[0]; hid[1] = s0[1]; hid[2] = s1[0]; hid[3] = s1[1];
                    }
                    {
                        const u32x2 z0 = fz[0][1], cl = fz[1][1], ch_ = fz[2][1];
                        const f32v2_t s0 = bfpair(z0.x) + bfpair(dpp_keep<0x111>(edge_lo<13>(EL[1].x), cl.x)) + bfpair(dpp_keep<0x101>(edge_hi<13>(EH[1].x), ch_.x));
                        const f32v2_t s1 = bfpair(z0.y) + bfpair(dpp_keep<0x111>(edge_lo<13>(EL[1].y), cl.y)) + bfpair(dpp_keep<0x101>(edge_hi<13>(EH[1].y), ch_.y));
                        hid[4] = s0[0]; hid[5] = s0[1]; hid[6] = s1[0]; hid[7] = s1[1];
                    }
                    u32x4 xf[1]; xf[0] = pack8(hid);
                    float xm[16]; lora_mm<1>(WL + WL_VU, xf, xm);
                    float v0c[16]; cst16(5, v0c);
#pragma unroll
                    for (int g = 0; g < 4; ++g) {
                        const f32v2_t f0 = bfpair(vf[g].x), f1 = bfpair(vf[g].y);
                        vv[4 * g + 0] += (f0[0] - vv[4 * g + 0]) * fsig(xm[4 * g + 0] + v0c[4 * g + 0]); vv[4 * g + 1] += (f0[1] - vv[4 * g + 1]) * fsig(xm[4 * g + 1] + v0c[4 * g + 1]);
                        vv[4 * g + 2] += (f1[0] - vv[4 * g + 2]) * fsig(xm[4 * g + 2] + v0c[4 * g + 2]); vv[4 * g + 3] += (f1[1] - vv[4 * g + 3]) * fsig(xm[4 * g + 3] + v0c[4 * g + 3]);
                    }
                }
                u32x4 vp[2]; vp[0] = pack8(vv); vp[1] = pack8(vv + 8);
                if (dir == 1) {
                    const unsigned pv[8] = {vp[0].x, vp[0].y, vp[0].z, vp[0].w, vp[1].x, vp[1].y, vp[1].z, vp[1].w};
#pragma unroll
                    for (int g = 0; g < 4; ++g) {
                        const u32x2 q = (u32x2){pv[2 * g], pv[2 * g + 1]};
                        *(u32x2*)((char*)mixb + (grow * 2048u + (unsigned)((h * 64 + 16 * g + 4 * kq) * 2))) = q;
                        if (layer == 0) *(u32x2*)((char*)vfirst + (grow * 1024u + (unsigned)((h * 64 + 16 * g + 4 * kq) * 2))) = q;
                    }
                }
#pragma unroll
                for (int ib = 0; ib < 4; ++ib) {
                    const f32x4 z = (f32x4){0.f, 0.f, 0.f, 0.f};
                    const f32x4 d = __builtin_amdgcn_mfma_f32_16x16x32_bf16(__builtin_bit_cast(bf16x8, vp[ib >> 1]), __builtin_bit_cast(bf16x8, (ib & 1) ? selO : selE), z, 0, 0, 0);
                    *(LAS u32x2*)(myop + OP_VT + (ib * 64 + lane) * 8) = (u32x2){cvtpk(d[0], d[1]), cvtpk(d[2], d[3])};
                }
            }
            u32x4 apf[2], rpf[2], btf[2], ktf[2], bgf[2], kgf[2];
            {
                float lw[16];
                {
                    float win[16]; seg_mix(IC<3>{}, win);
#pragma unroll
                    for (int i = 0; i < 16; ++i) win[i] = ftanh(win[i]);
                    u32x4 xf[2]; xf[0] = pack8(win); xf[1] = pack8(win + 8);
                    float xw[16]; lora_mm<2>(WL + WL_DEC, xf, xw);
                    float w0c[16]; cst16(3, w0c);
#pragma unroll
                    for (int i = 0; i < 16; ++i) lw[i] = -0.87503878f * fsig(xw[i] + w0c[i]);
                }
                float at[16], rt[16], bt[16], kt[16], bg[16], kg[16], gC[16];
#pragma unroll
                for (int i = 0; i < 16; ++i) {
                    float lam = lw[i];
                    lam += dpp_mov<0x111>(lam); lam += dpp_mov<0x112>(lam); lam += dpp_mov<0x114>(lam); lam += dpp_mov<0x118>(lam);
                    const float e3 = __builtin_amdgcn_exp2f(lam), e2 = __builtin_amdgcn_exp2f(-lam);
                    const float g = shl_(e3, (lane & 48) | 15);
                    const float e1 = __int_as_float(__builtin_amdgcn_update_dpp(0x3f800000, __float_as_int(e3), 0x111, 0xf, 0xf, false));
                    const float ge = g * e2;
                    gC[i] = g; at[i] = kk[i] * e1; rt[i] = rv[i] * e3; bt[i] = bb[i] * e2; kt[i] = kd[i] * e2; bg[i] = -bb[i] * ge; kg[i] = kd[i] * ge;
                }
                apf[0] = pack8(at); apf[1] = pack8(at + 8); rpf[0] = pack8(rt); rpf[1] = pack8(rt + 8); btf[0] = pack8(bt); btf[1] = pack8(bt + 8);
                ktf[0] = pack8(kt); ktf[1] = pack8(kt + 8); bgf[0] = pack8(bg); bgf[1] = pack8(bg + 8); kgf[0] = pack8(kg); kgf[1] = pack8(kg + 8);
                if (t == 0) {
#pragma unroll
                    for (int g = 0; g < 4; ++g) *(LAS f32x4*)(myop + OP_GC + (kq * 16 + 4 * g) * 4) = (f32x4){gC[4 * g], gC[4 * g + 1], gC[4 * g + 2], gC[4 * g + 3]};
                }
            }
            *(LAS u32x4*)(myop + OP_AP + lane * 16) = apf[0]; *(LAS u32x4*)(myop + OP_AP + 1024 + lane * 16) = apf[1];
            *(LAS u32x4*)(myop + OP_RP + lane * 16) = rpf[0]; *(LAS u32x4*)(myop + OP_RP + 1024 + lane * 16) = rpf[1];
            {
                f32x4 lab = (f32x4){0.f, 0.f, 0.f, 0.f}, lak = lab, lrb = lab, lrk = lab;
#pragma unroll
                for (int ks = 0; ks < 2; ++ks) {
                    lab = __builtin_amdgcn_mfma_f32_16x16x32_bf16(__builtin_bit_cast(bf16x8, btf[ks]), __builtin_bit_cast(bf16x8, apf[ks]), lab, 0, 0, 0);
                    lak = __builtin_amdgcn_mfma_f32_16x16x32_bf16(__builtin_bit_cast(bf16x8, ktf[ks]), __builtin_bit_cast(bf16x8, apf[ks]), lak, 0, 0, 0);
                    lrb = __builtin_amdgcn_mfma_f32_16x16x32_bf16(__builtin_bit_cast(bf16x8, btf[ks]), __builtin_bit_cast(bf16x8, rpf[ks]), lrb, 0, 0, 0);
                    lrk = __builtin_amdgcn_mfma_f32_16x16x32_bf16(__builtin_bit_cast(bf16x8, ktf[ks]), __builtin_bit_cast(bf16x8, rpf[ks]), lrk, 0, 0, 0);
                }
#pragma unroll
                for (int e = 0; e < 4; ++e) {
                    const int s = 4 * kq + e;
                    const bool lo = s < t, le = s <= t;
                    lab[e] = lo ? lab[e] : 0.f; lak[e] = lo ? lak[e] : 0.f; lrb[e] = le ? -lrb[e] : 0.f; lrk[e] = le ? lrk[e] : 0.f;
                    labt[s * 16 + t] = lab[e];
                }
                u32x4 mx; mx.x = 0u; mx.y = 0u; mx.z = cvtpk(lak[0], lak[1]); mx.w = cvtpk(lak[2], lak[3]);
                u32x4 my; my.x = cvtpk(lrb[0], lrb[1]); my.y = cvtpk(lrb[2], lrb[3]); my.z = cvtpk(lrk[0], lrk[1]); my.w = cvtpk(lrk[2], lrk[3]);
                *(LAS u32x4*)(myop + OP_MX2 + lane * 16) = mx; *(LAS u32x4*)(myop + OP_MY + lane * 16) = my;
            }
#pragma unroll
            for (int jb = 0; jb < 4; ++jb) {
                const f32x4 z = (f32x4){0.f, 0.f, 0.f, 0.f};
                const bf16x8 sel = __builtin_bit_cast(bf16x8, (jb & 1) ? selO : selE);
                const f32x4 d0 = __builtin_amdgcn_mfma_f32_16x16x32_bf16(__builtin_bit_cast(bf16x8, bgf[jb >> 1]), sel, z, 0, 0, 0);
                const f32x4 d1 = __builtin_amdgcn_mfma_f32_16x16x32_bf16(__builtin_bit_cast(bf16x8, kgf[jb >> 1]), sel, z, 0, 0, 0);
                u32x4 gp; gp.x = cvtpk(d0[0], d0[1]); gp.y = cvtpk(d0[2], d0[3]); gp.z = cvtpk(d1[0], d1[1]); gp.w = cvtpk(d1[2], d1[3]);
                *(LAS u32x4*)(myop + OP_GP + (jb * 64 + lane) * 16) = gp;
            }
            {
                const int s = t;
                float x[16];
#pragma unroll
                for (int q = 0; q < 16; ++q) x[q] = (q == s) ? 1.f : 0.f;
#pragma unroll
                for (int q = 0; q < 15; ++q) {
                    const f32x4 l0 = *(const LAS f32x4*)(labt + q * 16), l1 = *(const LAS f32x4*)(labt + q * 16 + 4), l2 = *(const LAS f32x4*)(labt + q * 16 + 8), l3 = *(const LAS f32x4*)(labt + q * 16 + 12);
                    const float lq[16] = {l0[0], l0[1], l0[2], l0[3], l1[0], l1[1], l1[2], l1[3], l2[0], l2[1], l2[2], l2[3], l3[0], l3[1], l3[2], l3[3]};
#pragma unroll
                    for (int r = q + 1; r < 16; ++r) x[r] -= lq[r] * x[q];
                }
                LAS bf16_t* md = (LAS bf16_t*)(myop + OP_MD) + (16 * (s >> 2)) * 8 + (s & 3);
#pragma unroll
                for (int j = 0; j < 4; ++j) {
                    const float xv = (kq == 0) ? x[j] : (kq == 1) ? x[4 + j] : (kq == 2) ? x[8 + j] : x[12 + j];
                    md[(4 * kq + j) * 8] = f2bf(xv);
                }
                { unsigned z_ = 0u; asm volatile("" : "+v"(z_)); *(LAS u32x2*)(myop + OP_MD + lane * 16 + 8) = (u32x2){z_, z_}; }
            }
        }
        __syncthreads();
        if (it + 1 < SEGTOK / 128) issue_loads(it + 1);
        int lane_c = lane; asm volatile("" : "+v"(lane_c));
#pragma unroll 1
        for (int c = 0; c < 8; ++c) {
            const int lane = lane_c, kq = lane_c >> 4, colc = 16 * (wave & 3) + (lane_c & 15);
            const LAS unsigned char* op = lds + LS_OPS + c * OP_SIZE;
            u32x2 vt = *(const LAS u32x2*)(op + OP_VT + ((wave & 3) * 64 + lane) * 8);
            if (augw) vt = (u32x2){0u, 0u};
            u32x4 sb0, sb1;
            sb0.x = cvtpk(St[0][0], St[0][1]); sb0.y = cvtpk(St[0][2], St[0][3]); sb0.z = cvtpk(St[1][0], St[1][1]); sb0.w = cvtpk(St[1][2], St[1][3]);
            sb1.x = cvtpk(St[2][0], St[2][1]); sb1.y = cvtpk(St[2][2], St[2][3]); sb1.z = cvtpk(St[3][0], St[3][1]); sb1.w = cvtpk(St[3][2], St[3][3]);
            const bf16x8 ap0 = *(const LAS bf16x8*)(op + OP_AP + lane * 16), ap1 = *(const LAS bf16x8*)(op + OP_AP + 1024 + lane * 16);
            const bf16x8 rp0 = *(const LAS bf16x8*)(op + OP_RP + lane * 16), rp1 = *(const LAS bf16x8*)(op + OP_RP + 1024 + lane * 16);
            const bf16x8 mx2 = *(const LAS bf16x8*)(op + OP_MX2 + lane * 16), mdm = *(const LAS bf16x8*)(op + OP_MD + lane * 16), mym = *(const LAS bf16x8*)(op + OP_MY + lane * 16);
            u32x4 b0v; b0v.x = 0u; b0v.y = 0u; b0v.z = vt.x; b0v.w = vt.y;
            f32x4 ax = (f32x4){0.f, 0.f, 0.f, 0.f};
            ax = __builtin_amdgcn_mfma_f32_16x16x32_bf16(mx2, __builtin_bit_cast(bf16x8, b0v), ax, 0, 0, 0);
            ax = __builtin_amdgcn_mfma_f32_16x16x32_bf16(ap0, __builtin_bit_cast(bf16x8, sb0), ax, 0, 0, 0);
            ax = __builtin_amdgcn_mfma_f32_16x16x32_bf16(ap1, __builtin_bit_cast(bf16x8, sb1), ax, 0, 0, 0);
            f32x4 ay = (f32x4){0.f, 0.f, 0.f, 0.f};
            ay = __builtin_amdgcn_mfma_f32_16x16x32_bf16(rp0, __builtin_bit_cast(bf16x8, sb0), ay, 0, 0, 0);
            ay = __builtin_amdgcn_mfma_f32_16x16x32_bf16(rp1, __builtin_bit_cast(bf16x8, sb1), ay, 0, 0, 0);
            u32x4 bx; bx.x = cvtpk(ax[0], ax[1]); bx.y = cvtpk(ax[2], ax[3]); bx.z = 0u; bx.w = 0u;
            f32x4 ad = (f32x4){0.f, 0.f, 0.f, 0.f};
            ad = __builtin_amdgcn_mfma_f32_16x16x32_bf16(mdm, __builtin_bit_cast(bf16x8, bx), ad, 0, 0, 0);
            u32x4 dv; dv.x = cvtpk(ad[0], ad[1]); dv.y = cvtpk(ad[2], ad[3]); dv.z = vt.x; dv.w = vt.y;
            ay = __builtin_amdgcn_mfma_f32_16x16x32_bf16(mym, __builtin_bit_cast(bf16x8, dv), ay, 0, 0, 0);
#pragma unroll
            for (int jb = 0; jb < 4; ++jb) {
                const f32x4 gc = *(const LAS f32x4*)(op + OP_GC + (kq * 16 + 4 * jb) * 4);
                const bf16x8 gp = *(const LAS bf16x8*)(op + OP_GP + (jb * 64 + lane) * 16);
                St[jb] = __builtin_amdgcn_mfma_f32_16x16x32_bf16(gp, __builtin_bit_cast(bf16x8, dv), St[jb] * gc, 0, 0, 0);
            }
            if (!augw || seg > 0) {
                bf16_t* yb = augw ? yaug : ybuf;
                const int sg0 = 16 * (seg * (SEGTOK / 16) + it * 8 + c) + 4 * kq;
#pragma unroll
                for (int e = 0; e < 4; ++e) { const int tk = dir ? (SEQ - 1 - (sg0 + e)) : (sg0 + e); *(bf16_t*)((char*)yb + ((unsigned)((tokbase + tk) * 2 + dir) * 1024u + (unsigned)((h * 64 + colc) * 2))) = f2bf(ay[e]); }
            }
        }
        __syncthreads();
    }
    if (seg + 1 < NSEG) {
        int lane_f = lane; asm volatile("" : "+v"(lane_f));
        const int kq = lane_f >> 4, colw = 16 * (wave & 3) + (lane_f & 15);
        float* dst = segst + ((size_t)unit * 2 + (augw ? 1 : 0)) * 4096;
#pragma unroll
        for (int jb = 0; jb < 4; ++jb)
#pragma unroll
            for (int e = 0; e < 4; ++e) dst[(16 * jb + 4 * kq + e) * 64 + colw] = St[jb][e];
    }
}

__device__ __forceinline__ void ph_segfix(LAS unsigned char* lds, const float* __restrict__ segst, bf16_t* __restrict__ SS, int nchain) {
    const int tid = otid(), j = tid >> 3, ig = tid & 7;
    LAS float* Sp = (LAS float*)lds;
    for (int chain = blockIdx.x; chain < nchain; chain += NWG) {
        float acc[8];
        for (int k = 1; k < NSEG; ++k) {
            const float* Cp = segst + ((size_t)(chain * NSEG + k - 1) * 2 + 0) * 4096 + j * 64 + 8 * ig;
            const float* Ap = segst + ((size_t)(chain * NSEG + k - 1) * 2 + 1) * 4096 + j * 64;
#pragma unroll
            for (int e = 0; e < 8; ++e) acc[e] = Cp[e];
            if (k > 1) {
                f32x4 ar[16];
#pragma unroll
                for (int q4 = 0; q4 < 16; ++q4) ar[q4] = *(const f32x4*)(Ap + 4 * q4);
#pragma unroll
                for (int q = 0; q < 64; ++q) {
                    const float a = ar[q >> 2][q & 3];
                    const f32x4 s0 = *(const LAS f32x4*)(Sp + q * 64 + 8 * ig), s1 = *(const LAS f32x4*)(Sp + q * 64 + 8 * ig + 4);
                    acc[0] += a * s0[0]; acc[1] += a * s0[1]; acc[2] += a * s0[2]; acc[3] += a * s0[3]; acc[4] += a * s1[0]; acc[5] += a * s1[1]; acc[6] += a * s1[2]; acc[7] += a * s1[3];
                }
            }
            __syncthreads();
#pragma unroll
            for (int e = 0; e < 8; ++e) { Sp[j * 64 + 8 * ig + e] = acc[e]; SS[((size_t)(chain * NSEG + k) * 64 + 8 * ig + e) * 64 + j] = f2bf(acc[e]); }
            __syncthreads();
        }
    }
}
__device__ __forceinline__ void ph_ycorr(const bf16_t* __restrict__ yaug, const bf16_t* __restrict__ SS, bf16_t* __restrict__ ybuf, int nchain) {
    const int tid = otid(), lane = tid & 63, wave = tid >> 6, il = lane & 15, kq = lane >> 4;
    constexpr int TPS = SEGTOK / 16, IPC = (NSEG - 1) * TPS;
    for (int it = blockIdx.x * 8 + wave; it < nchain * IPC; it += NWG * 8) {
        const int chain = it / IPC, r = it % IPC, seg = 1 + r / TPS, tile = r % TPS;
        const int h = chain & 7, dir = (chain >> 3) & 1, b = chain >> 4;
        const int st0 = seg * SEGTOK + 16 * tile, t0 = dir ? (SEQ - 16 - st0) : st0;
        const size_t rowbase = ((size_t)(b * SEQ + t0) * 2 + dir) * 512 + h * 64;
        const bf16x8 a0 = *(const bf16x8*)(yaug + rowbase + (size_t)il * 1024 + 8 * kq), a1 = *(const bf16x8*)(yaug + rowbase + (size_t)il * 1024 + 32 + 8 * kq);
        const bf16_t* ssp = SS + (size_t)(chain * NSEG + seg) * 4096;
#pragma unroll
        for (int nb = 0; nb < 4; ++nb) {
            const bf16x8 b0 = *(const bf16x8*)(ssp + (16 * nb + il) * 64 + 8 * kq), b1 = *(const bf16x8*)(ssp + (16 * nb + il) * 64 + 32 + 8 * kq);
            f32x4 acc = (f32x4){0.f, 0.f, 0.f, 0.f};
            acc = __builtin_amdgcn_mfma_f32_16x16x32_bf16(a0, b0, acc, 0, 0, 0);
            acc = __builtin_amdgcn_mfma_f32_16x16x32_bf16(a1, b1, acc, 0, 0, 0);
#pragma unroll
            for (int e = 0; e < 4; ++e) { bf16_t* yp = ybuf + rowbase + (size_t)(4 * kq + e) * 1024 + 16 * nb + il; *yp = f2bf(bf2f(*yp) + acc[e]); }
        }
    }
}

__device__ __forceinline__ void ph_post2(const bf16_t* __restrict__ ybuf, const bf16_t* __restrict__ gbuf, const float* __restrict__ sbon, const float* __restrict__ lg, const float* __restrict__ lb,
                                         bf16_t* __restrict__ mixb, int rows) {
    const int c = otid(), h = c >> 6, lane = c & 63;
    const float lgc = lg[c], lbc = lb[c];
    for (int t = blockIdx.x; t < rows; t += NWG) {
        const float y = bf2f(ybuf[(size_t)t * 1024 + c]) + bf2f(ybuf[(size_t)t * 1024 + 512 + c]);
        const float mu = wave_sum(y, lane) * (1.f / 64.f); const float dv = y - mu; const float var = wave_sum(dv * dv, lane) * (1.f / 64.f);
        const float yn = dv * rsqrtf(var + 64e-5f) * lgc + lbc;
        const float bon = sbon[(size_t)t * 16 + h] + sbon[(size_t)t * 16 + 8 + h];
        const float o = (yn + bon * bf2f(mixb[(size_t)t * 1024 + c])) * bf2f(gbuf[(size_t)t * 512 + c]);
        mixb[(size_t)t * 1024 + c] = f2bf(o);
    }
}

__device__ __forceinline__ void ph_fold(const float* __restrict__ win1, const float* __restrict__ g1, const float* __restrict__ mu1, const float* __restrict__ vdown, bf16_t* __restrict__ WinT1) {
    const int tid0 = otid();
    for (int idx = blockIdx.x * NT + tid0; idx < 96 * D; idx += NWG * NT) {
        const int jj = idx / D, k = idx % D, which = jj >> 5, j = jj & 31;
        const float* wr = win1 + (size_t)k * INC + 1024;
        float s = 0.f;
        for (int c = 0; c < 512; ++c) {
            const float m0 = mu1[1024 + c], m1 = mu1[RWC + 1024 + c];
            const float cf = (which == 0) ? (1.f - m0 - m1) : (which == 1) ? m0 : m1;
            s += wr[c] * cf * vdown[c * 32 + j];
        }
        WinT1[(size_t)(1920 + jj) * D + k] = f2bf(s * g1[k]);
    }
}


__device__ __forceinline__ void ph_post3(LAS unsigned char* lds, const bf16_t* __restrict__ ybuf, const bf16_t* __restrict__ yaug, const bf16_t* __restrict__ SS, const bf16_t* __restrict__ gbuf, const float* __restrict__ sbon,
                                         const float* __restrict__ lg, const float* __restrict__ lb, bf16_t* __restrict__ mixb, int nseq) {
    const int tid = otid(), lane = tid & 63, wave = tid >> 6, il = lane & 15, kq = lane >> 4;
    (void)nseq;
    const int bh = (int)blockIdx.x >> 3, part = (int)blockIdx.x & 7, b = bh >> 3, h = bh & 7;
    const int segf = part >> 1, segb = (NSEG - 1) - (part >> 1);
    __syncthreads();
    for (int p = tid; p < 2 * 64 * 8; p += NT) {
        const int d = p >> 9, row = (p >> 3) & 63, pc = p & 7, seg = d ? segb : segf;
        const bf16_t* src = SS + (size_t)(((b * 2 + d) * 8 + h) * NSEG + seg) * 4096 + row * 64 + 8 * pc;
        *(LAS u32x4*)(lds + d * (64 * 144) + row * 144 + 16 * pc) = *(const u32x4*)src;
    }
    __syncthreads();
    for (int k = 0; k < 4; ++k) {
        const int tb = 32 * part + wave + 8 * k;
        const int t0 = 16 * tb;
        const size_t tokrow = (size_t)(b * SEQ + t0 + il);
        u32x2 vq_[4], gq_[4]; f32x4 g4_[4], b4_[4];
#pragma unroll
        for (int mb = 0; mb < 4; ++mb) {
            const int ch = h * 64 + 16 * mb + 4 * kq;
            g4_[mb] = *(const f32x4*)(lg + ch); b4_[mb] = *(const f32x4*)(lb + ch);
            vq_[mb] = *(const u32x2*)(mixb + tokrow * 1024 + ch); gq_[mb] = *(const u32x2*)(gbuf + tokrow * 512 + ch);
        }
        const float bon = sbon[tokrow * 16 + h] + sbon[tokrow * 16 + 8 + h];
        float y[4][4];
#pragma unroll
        for (int mb = 0; mb < 4; ++mb)
#pragma unroll
            for (int e = 0; e < 4; ++e) y[mb][e] = 0.f;
#pragma unroll
        for (int dir = 0; dir < 2; ++dir) {
            const size_t ro = (tokrow * 2 + dir) * 512 + h * 64;
#pragma unroll
            for (int mb = 0; mb < 4; ++mb) {
                const u32x2 q = *(const u32x2*)(ybuf + ro + 16 * mb + 4 * kq);
                y[mb][0] += __uint_as_float(q.x << 16); y[mb][1] += __uint_as_float(q.x & 0xffff0000u); y[mb][2] += __uint_as_float(q.y << 16); y[mb][3] += __uint_as_float(q.y & 0xffff0000u);
            }
            const int st0 = dir ? (SEQ - 16 - t0) : t0, seg = st0 / SEGTOK;
            if (seg > 0) {
                const int chain = (b * 2 + dir) * 8 + h;
                const bf16x8 y0 = *(const bf16x8*)(yaug + ro + 8 * kq), y1 = *(const bf16x8*)(yaug + ro + 32 + 8 * kq);
                const LAS unsigned char* ssl = lds + dir * (64 * 144) + il * 144 + 16 * kq;
#pragma unroll
                for (int mb = 0; mb < 4; ++mb) {
                    const bf16x8 a0 = *(const LAS bf16x8*)(ssl + mb * (16 * 144)), a1 = *(const LAS bf16x8*)(ssl + mb * (16 * 144) + 64);
                    f32x4 acc = (f32x4){y[mb][0], y[mb][1], y[mb][2], y[mb][3]};
                    acc = __builtin_amdgcn_mfma_f32_16x16x32_bf16(a0, y0, acc, 0, 0, 0);
                    acc = __builtin_amdgcn_mfma_f32_16x16x32_bf16(a1, y1, acc, 0, 0, 0);
                    y[mb][0] = acc[0]; y[mb][1] = acc[1]; y[mb][2] = acc[2]; y[mb][3] = acc[3];
                }
            }
        }
        float s = 0.f;
#pragma unroll
        for (int mb = 0; mb < 4; ++mb) s += (y[mb][0] + y[mb][1]) + (y[mb][2] + y[mb][3]);
        s += shx(s, 16, lane); s += shx(s, 32, lane);
        const float mu = s * (1.f / 64.f); float q2 = 0.f;
#pragma unroll
        for (int mb = 0; mb < 4; ++mb)
#pragma unroll
            for (int e = 0; e < 4; ++e) { y[mb][e] -= mu; q2 += y[mb][e] * y[mb][e]; }
        q2 += shx(q2, 16, lane); q2 += shx(q2, 32, lane);
        const float rs = rsqrtf(q2 * (1.f / 64.f) + 64e-5f);
#pragma unroll
        for (int mb = 0; mb < 4; ++mb) {
            const int ch = h * 64 + 16 * mb + 4 * kq;
            const f32x4 g4 = g4_[mb], b4 = b4_[mb];
            const u32x2 vq = vq_[mb], gq = gq_[mb];
            const float v0 = __uint_as_float(vq.x << 16), v1 = __uint_as_float(vq.x & 0xffff0000u), v2 = __uint_as_float(vq.y << 16), v3 = __uint_as_float(vq.y & 0xffff0000u);
            const float g0 = __uint_as_float(gq.x << 16), g1 = __uint_as_float(gq.x & 0xffff0000u), g2 = __uint_as_float(gq.y << 16), g3 = __uint_as_float(gq.y & 0xffff0000u);
            const float o0 = (y[mb][0] * rs * g4[0] + b4[0] + bon * v0) * g0, o1 = (y[mb][1] * rs * g4[1] + b4[1] + bon * v1) * g1;
            const float o2 = (y[mb][2] * rs * g4[2] + b4[2] + bon * v2) * g2, o3 = (y[mb][3] * rs * g4[3] + b4[3] + bon * v3) * g3;
            u32x2 o; o.x = cvtpk(o0, o1); o.y = cvtpk(o2, o3);
            *(u32x2*)(mixb + tokrow * 1024 + ch) = o;
        }
    }
}
struct Args { const float* in[27]; float* out; unsigned char* ws; };
struct WsMap { size_t ctl, WinT, WvT, WoutT, WupT, WdnT, WdecT, WaaaT, WgT, WvuT, xb, rstd, vfirst, mixb, act, P, VT, ybuf, gbuf, sbon, yaug, segst, SS, U, end; };
__host__ __device__ constexpr size_t al256(size_t x) { return (x + 255) & ~(size_t)255; }
__host__ __device__ constexpr WsMap make_map() {
    WsMap m{}; size_t off = 0;
    m.ctl = off; off += al256(WS_CTL_BYTES);
    m.WinT = off; off += al256((size_t)DEPTH * PCW * D * 2); m.WvT = off; off += al256((size_t)DEPTH * 512 * D * 2); m.WoutT = off; off += al256((size_t)DEPTH * D * D * 2);
    m.WupT = off; off += al256((size_t)DEPTH * UPC * D * 2); m.WdnT = off; off += al256((size_t)DEPTH * D * DFF * 2);
    m.WdecT = off; off += al256((size_t)DEPTH * 2 * 512 * 64 * 2); m.WaaaT = off; off += al256((size_t)DEPTH * 2 * 512 * 64 * 2); m.WgT = off; off += al256((size_t)DEPTH * 512 * 128 * 2); m.WvuT = off; off += al256((size_t)512 * 32 * 2);
    m.xb = off; off += al256((size_t)GR * D * 2); m.rstd = off; off += al256((size_t)4 * GR * 4); m.vfirst = off; off += al256((size_t)GR * 512 * 2);
    m.mixb = off; off += al256((size_t)GR * 1024 * 2); m.act = off; off += al256((size_t)GR * DFF * 2);
    m.U = off;
    m.P = off; off += al256((size_t)GR * PCW * 2); m.VT = off; off += al256((size_t)512 * GR * 2);
    m.ybuf = off; off += al256((size_t)GR * 1024 * 2); m.gbuf = off; off += al256((size_t)GR * 512 * 2); m.sbon = off; off += al256((size_t)GR * 16 * 4);
    m.yaug = off; off += al256((size_t)GR * 1024 * 2); m.segst = off; off += al256((size_t)GSEQ * 16 * NSEG * 2 * 4096 * 4); m.SS = off; off += al256((size_t)GSEQ * 16 * NSEG * 4096 * 2);
    if (off < m.U + (size_t)GR * UPC * 2) off = m.U + (size_t)GR * UPC * 2;
    m.end = off; return m;
}
constexpr WsMap WSM = make_map();

__global__ void __launch_bounds__(NT, 2) mega(Args args) {
    extern __shared__ __attribute__((aligned(16))) unsigned char lds_raw[];
    LAS unsigned char* lds = (LAS unsigned char*)lds_raw;
    asm volatile("v_mov_b32 v1, 0\n\tv_mov_b32 v2, 0\n\tv_mov_b32 v3, 0\n\tv_mov_b32 v4, 0\n\tv_mov_b32 v5, 0\n\tv_mov_b32 v6, 0\n\tv_mov_b32 v7, 0\n\tv_mov_b32 v8, 0\n\tv_mov_b32 v9, 0\n\tv_mov_b32 v10, 0\n\tv_mov_b32 v11, 0\n\tv_mov_b32 v12, 0\n\tv_mov_b32 v13, 0\n\tv_mov_b32 v14, 0\n\tv_mov_b32 v15, 0\n\tv_mov_b32 v16, 0\n\tv_mov_b32 v17, 0\n\tv_mov_b32 v18, 0\n\tv_mov_b32 v19, 0\n\tv_mov_b32 v20, 0\n\tv_mov_b32 v21, 0\n\tv_mov_b32 v22, 0\n\tv_mov_b32 v23, 0\n\tv_mov_b32 v24, 0\n\tv_mov_b32 v25, 0\n\tv_mov_b32 v26, 0\n\tv_mov_b32 v27, 0\n\tv_mov_b32 v28, 0\n\tv_mov_b32 v29, 0\n\tv_mov_b32 v30, 0\n\tv_mov_b32 v31, 0\n\tv_mov_b32 v32, 0\n\tv_mov_b32 v33, 0\n\tv_mov_b32 v34, 0\n\tv_mov_b32 v35, 0\n\tv_mov_b32 v36, 0\n\tv_mov_b32 v37, 0\n\tv_mov_b32 v38, 0\n\tv_mov_b32 v39, 0\n\tv_mov_b32 v40, 0\n\tv_mov_b32 v41, 0\n\tv_mov_b32 v42, 0\n\tv_mov_b32 v43, 0\n\tv_mov_b32 v44, 0\n\tv_mov_b32 v45, 0\n\tv_mov_b32 v46, 0\n\tv_mov_b32 v47, 0\n\tv_mov_b32 v48, 0\n\tv_mov_b32 v49, 0\n\tv_mov_b32 v50, 0\n\tv_mov_b32 v51, 0\n\tv_mov_b32 v52, 0\n\tv_mov_b32 v53, 0\n\tv_mov_b32 v54, 0\n\tv_mov_b32 v55, 0\n\tv_mov_b32 v56, 0\n\tv_mov_b32 v57, 0\n\tv_mov_b32 v58, 0\n\tv_mov_b32 v59, 0\n\tv_mov_b32 v60, 0\n\tv_mov_b32 v61, 0\n\tv_mov_b32 v62, 0\n\tv_mov_b32 v63, 0\n\tv_mov_b32 v64, 0\n\tv_mov_b32 v65, 0\n\tv_mov_b32 v66, 0\n\tv_mov_b32 v67, 0\n\tv_mov_b32 v68, 0\n\tv_mov_b32 v69, 0\n\tv_mov_b32 v70, 0\n\tv_mov_b32 v71, 0\n\tv_mov_b32 v72, 0\n\tv_mov_b32 v73, 0\n\tv_mov_b32 v74, 0\n\tv_mov_b32 v75, 0\n\tv_mov_b32 v76, 0\n\tv_mov_b32 v77, 0\n\tv_mov_b32 v78, 0\n\tv_mov_b32 v79, 0\n\tv_mov_b32 v80, 0\n\tv_mov_b32 v81, 0\n\tv_mov_b32 v82, 0\n\tv_mov_b32 v83, 0\n\tv_mov_b32 v84, 0\n\tv_mov_b32 v85, 0\n\tv_mov_b32 v86, 0\n\tv_mov_b32 v87, 0\n\tv_mov_b32 v88, 0\n\tv_mov_b32 v89, 0\n\tv_mov_b32 v90, 0\n\tv_mov_b32 v91, 0\n\tv_mov_b32 v92, 0\n\tv_mov_b32 v93, 0\n\tv_mov_b32 v94, 0\n\tv_mov_b32 v95, 0\n\tv_mov_b32 v96, 0\n\tv_mov_b32 v97, 0\n\tv_mov_b32 v98, 0\n\tv_mov_b32 v99, 0\n\tv_mov_b32 v100, 0\n\tv_mov_b32 v101, 0\n\tv_mov_b32 v102, 0\n\tv_mov_b32 v103, 0\n\tv_mov_b32 v104, 0\n\tv_mov_b32 v105, 0\n\tv_mov_b32 v106, 0\n\tv_mov_b32 v107, 0\n\tv_mov_b32 v108, 0\n\tv_mov_b32 v109, 0\n\tv_mov_b32 v110, 0\n\tv_mov_b32 v111, 0\n\tv_mov_b32 v112, 0\n\tv_mov_b32 v113, 0\n\tv_mov_b32 v114, 0\n\tv_mov_b32 v115, 0\n\tv_mov_b32 v116, 0\n\tv_mov_b32 v117, 0\n\tv_mov_b32 v118, 0\n\tv_mov_b32 v119, 0\n\tv_mov_b32 v120, 0\n\tv_mov_b32 v121, 0\n\tv_mov_b32 v122, 0\n\tv_mov_b32 v123, 0\n\tv_mov_b32 v124, 0\n\tv_mov_b32 v125, 0\n\tv_mov_b32 v126, 0\n\tv_mov_b32 v127, 0\n\tv_mov_b32 v128, 0\n\tv_mov_b32 v129, 0\n\tv_mov_b32 v130, 0\n\tv_mov_b32 v131, 0\n\tv_mov_b32 v132, 0\n\tv_mov_b32 v133, 0\n\tv_mov_b32 v134, 0\n\tv_mov_b32 v135, 0\n\tv_mov_b32 v136, 0\n\tv_mov_b32 v137, 0\n\tv_mov_b32 v138, 0\n\tv_mov_b32 v139, 0\n\tv_mov_b32 v140, 0\n\tv_mov_b32 v141, 0\n\tv_mov_b32 v142, 0\n\tv_mov_b32 v143, 0\n\tv_mov_b32 v144, 0\n\tv_mov_b32 v145, 0\n\tv_mov_b32 v146, 0\n\tv_mov_b32 v147, 0\n\tv_mov_b32 v148, 0\n\tv_mov_b32 v149, 0\n\tv_mov_b32 v150, 0\n\tv_mov_b32 v151, 0\n\tv_mov_b32 v152, 0\n\tv_mov_b32 v153, 0\n\tv_mov_b32 v154, 0\n\tv_mov_b32 v155, 0\n\tv_mov_b32 v156, 0\n\tv_mov_b32 v157, 0\n\tv_mov_b32 v158, 0\n\tv_mov_b32 v159, 0\n\tv_mov_b32 v160, 0\n\tv_mov_b32 v161, 0\n\tv_mov_b32 v162, 0\n\tv_mov_b32 v163, 0\n\tv_mov_b32 v164, 0\n\tv_mov_b32 v165, 0\n\tv_mov_b32 v166, 0\n\tv_mov_b32 v167, 0\n\tv_mov_b32 v168, 0\n\tv_mov_b32 v169, 0\n\tv_mov_b32 v170, 0\n\tv_mov_b32 v171, 0\n\tv_mov_b32 v172, 0\n\tv_mov_b32 v173, 0\n\tv_mov_b32 v174, 0\n\tv_mov_b32 v175, 0\n\tv_mov_b32 v176, 0\n\tv_mov_b32 v177, 0\n\tv_mov_b32 v178, 0\n\tv_mov_b32 v179, 0\n\tv_mov_b32 v180, 0\n\tv_mov_b32 v181, 0\n\tv_mov_b32 v182, 0\n\tv_mov_b32 v183, 0\n\tv_mov_b32 v184, 0\n\tv_mov_b32 v185, 0\n\tv_mov_b32 v186, 0\n\tv_mov_b32 v187, 0\n\tv_mov_b32 v188, 0\n\tv_mov_b32 v189, 0\n\tv_mov_b32 v190, 0\n\tv_mov_b32 v191, 0\n\tv_mov_b32 v192, 0\n\tv_mov_b32 v193, 0\n\tv_mov_b32 v194, 0\n\tv_mov_b32 v195, 0\n\tv_mov_b32 v196, 0\n\tv_mov_b32 v197, 0\n\tv_mov_b32 v198, 0\n\tv_mov_b32 v199, 0\n\tv_mov_b32 v200, 0\n\tv_mov_b32 v201, 0\n\tv_mov_b32 v202, 0\n\tv_mov_b32 v203, 0\n\tv_mov_b32 v204, 0\n\tv_mov_b32 v205, 0\n\tv_mov_b32 v206, 0\n\tv_mov_b32 v207, 0\n\tv_mov_b32 v208, 0\n\tv_mov_b32 v209, 0\n\tv_mov_b32 v210, 0\n\tv_mov_b32 v211, 0\n\tv_mov_b32 v212, 0\n\tv_mov_b32 v213, 0\n\tv_mov_b32 v214, 0\n\tv_mov_b32 v215, 0\n\tv_mov_b32 v216, 0\n\tv_mov_b32 v217, 0\n\tv_mov_b32 v218, 0\n\tv_mov_b32 v219, 0\n\tv_mov_b32 v220, 0\n\tv_mov_b32 v221, 0\n\tv_mov_b32 v222, 0\n\tv_mov_b32 v223, 0\n\tv_mov_b32 v224, 0\n\tv_mov_b32 v225, 0\n\tv_mov_b32 v226, 0\n\tv_mov_b32 v227, 0\n\tv_mov_b32 v228, 0\n\tv_mov_b32 v229, 0\n\tv_mov_b32 v230, 0\n\tv_mov_b32 v231, 0\n\tv_mov_b32 v232, 0\n\tv_mov_b32 v233, 0\n\tv_mov_b32 v234, 0\n\tv_mov_b32 v235, 0\n\tv_mov_b32 v236, 0\n\tv_mov_b32 v237, 0\n\tv_mov_b32 v238, 0\n\tv_mov_b32 v239, 0\n\tv_mov_b32 v240, 0\n\tv_mov_b32 v241, 0\n\tv_mov_b32 v242, 0\n\tv_mov_b32 v243, 0\n\ts_mov_b32 s20, 0\n\ts_mov_b32 s21, 0\n\ts_mov_b32 s22, 0\n\ts_mov_b32 s23, 0\n\ts_mov_b32 s24, 0\n\ts_mov_b32 s25, 0\n\ts_mov_b32 s26, 0\n\ts_mov_b32 s27, 0\n\ts_mov_b32 s28, 0\n\ts_mov_b32 s29, 0\n\ts_mov_b32 s30, 0\n\ts_mov_b32 s31, 0\n\ts_mov_b32 s32, 0\n\ts_mov_b32 s33, 0\n\ts_mov_b32 s34, 0\n\ts_mov_b32 s35, 0\n\ts_mov_b32 s36, 0\n\ts_mov_b32 s37, 0\n\ts_mov_b32 s38, 0\n\ts_mov_b32 s39, 0\n\ts_mov_b32 s40, 0\n\ts_mov_b32 s41, 0\n\ts_mov_b32 s42, 0\n\ts_mov_b32 s43, 0\n\ts_mov_b32 s44, 0\n\ts_mov_b32 s45, 0\n\ts_mov_b32 s46, 0\n\ts_mov_b32 s47, 0\n\ts_mov_b32 s48, 0\n\ts_mov_b32 s49, 0\n\ts_mov_b32 s50, 0\n\ts_mov_b32 s51, 0\n\ts_mov_b32 s52, 0\n\ts_mov_b32 s53, 0\n\ts_mov_b32 s54, 0\n\ts_mov_b32 s55, 0\n\ts_mov_b32 s56, 0\n\ts_mov_b32 s57, 0\n\ts_mov_b32 s58, 0\n\ts_mov_b32 s59, 0\n\ts_mov_b32 s60, 0\n\ts_mov_b32 s61, 0\n\ts_mov_b32 s62, 0\n\ts_mov_b32 s63, 0\n\ts_mov_b32 s64, 0\n\ts_mov_b32 s65, 0\n\ts_mov_b32 s66, 0\n\ts_mov_b32 s67, 0\n\ts_mov_b32 s68, 0\n\ts_mov_b32 s69, 0\n\ts_mov_b32 s70, 0\n\ts_mov_b32 s71, 0\n\ts_mov_b32 s72, 0\n\ts_mov_b32 s73, 0\n\ts_mov_b32 s74, 0\n\ts_mov_b32 s75, 0\n\ts_mov_b32 s76, 0\n\ts_mov_b32 s77, 0\n\ts_mov_b32 s78, 0\n\ts_mov_b32 s79, 0\n\ts_mov_b32 s80, 0\n\ts_mov_b32 s81, 0\n\ts_mov_b32 s82, 0\n\ts_mov_b32 s83, 0\n\ts_mov_b32 s84, 0\n\ts_mov_b32 s85, 0\n\ts_mov_b32 s86, 0\n\ts_mov_b32 s87, 0\n\ts_mov_b32 s88, 0\n\ts_mov_b32 s89, 0\n\ts_mov_b32 s90, 0\n\ts_mov_b32 s91, 0\n\ts_mov_b32 s92, 0\n\ts_mov_b32 s93, 0\n\ts_mov_b32 s94, 0\n\ts_mov_b32 s95, 0\n\ts_mov_b32 s96, 0\n\ts_mov_b32 s97, 0\n\ts_mov_b32 s98, 0\n\ts_mov_b32 s99, 0\n\t" ::: "v1", "v2", "v3", "v4", "v5", "v6", "v7", "v8", "v9", "v10", "v11", "v12", "v13", "v14", "v15", "v16", "v17", "v18", "v19", "v20", "v21", "v22", "v23", "v24", "v25", "v26", "v27", "v28", "v29", "v30", "v31", "v32", "v33", "v34", "v35", "v36", "v37", "v38", "v39", "v40", "v41", "v42", "v43", "v44", "v45", "v46", "v47", "v48", "v49", "v50", "v51", "v52", "v53", "v54", "v55", "v56", "v57", "v58", "v59", "v60", "v61", "v62", "v63", "v64", "v65", "v66", "v67", "v68", "v69", "v70", "v71", "v72", "v73", "v74", "v75", "v76", "v77", "v78", "v79", "v80", "v81", "v82", "v83", "v84", "v85", "v86", "v87", "v88", "v89", "v90", "v91", "v92", "v93", "v94", "v95", "v96", "v97", "v98", "v99", "v100", "v101", "v102", "v103", "v104", "v105", "v106", "v107", "v108", "v109", "v110", "v111", "v112", "v113", "v114", "v115", "v116", "v117", "v118", "v119", "v120", "v121", "v122", "v123", "v124", "v125", "v126", "v127", "v128", "v129", "v130", "v131", "v132", "v133", "v134", "v135", "v136", "v137", "v138", "v139", "v140", "v141", "v142", "v143", "v144", "v145", "v146", "v147", "v148", "v149", "v150", "v151", "v152", "v153", "v154", "v155", "v156", "v157", "v158", "v159", "v160", "v161", "v162", "v163", "v164", "v165", "v166", "v167", "v168", "v169", "v170", "v171", "v172", "v173", "v174", "v175", "v176", "v177", "v178", "v179", "v180", "v181", "v182", "v183", "v184", "v185", "v186", "v187", "v188", "v189", "v190", "v191", "v192", "v193", "v194", "v195", "v196", "v197", "v198", "v199", "v200", "v201", "v202", "v203", "v204", "v205", "v206", "v207", "v208", "v209", "v210", "v211", "v212", "v213", "v214", "v215", "v216", "v217", "v218", "v219", "v220", "v221", "v222", "v223", "v224", "v225", "v226", "v227", "v228", "v229", "v230", "v231", "v232", "v233", "v234", "v235", "v236", "v237", "v238", "v239", "v240", "v241", "v242", "v243", "s20", "s21", "s22", "s23", "s24", "s25", "s26", "s27", "s28", "s29", "s30", "s31", "s32", "s33", "s34", "s35", "s36", "s37", "s38", "s39", "s40", "s41", "s42", "s43", "s44", "s45", "s46", "s47", "s48", "s49", "s50", "s51", "s52", "s53", "s54", "s55", "s56", "s57", "s58", "s59", "s60", "s61", "s62", "s63", "s64", "s65", "s66", "s67", "s68", "s69", "s70", "s71", "s72", "s73", "s74", "s75", "s76", "s77", "s78", "s79", "s80", "s81", "s82", "s83", "s84", "s85", "s86", "s87", "s88", "s89", "s90", "s91", "s92", "s93", "s94", "s95", "s96", "s97", "s98", "s99");
    volatile LAS unsigned* misc = (volatile LAS unsigned*)(lds + LDS_MISC);
    if (threadIdx.x < 64) misc[threadIdx.x] = 0u;
    __syncthreads();
    XcdBarrier bar = xcd_barrier_post(((unsigned*)(args.ws + WSM.ctl)), misc + 8, otid() == 0);
#define GRID_BAR() xcd_barrier(bar, otid() == 0)
    const float* const* in = args.in;
    float* X = args.out;
    constexpr int G = NWG; const int bx = (int)blockIdx.x;

#pragma unroll 1
    for (int j = 0; j < 21; ++j) {
        const int l = (j >= 10 && j < 20) ? 1 : 0, k = (j < 20) ? j - 10 * l : 10;
        const float* W; int K_, Nsrc, Nout, mode = 0; const float* scale = nullptr; bf16_t* out; float mul = 1.f;
        if (k == 0)      { W = in[3] + (size_t)l * D * INC; K_ = D; Nsrc = INC; scale = in[2] + l * D; out = ((bf16_t*)(args.ws + WSM.WinT)) + (size_t)l * PCW * D; Nout = PCW; mode = 1; }
        else if (k == 1) { W = in[3] + (size_t)l * D * INC; K_ = D; Nsrc = INC; scale = in[2] + l * D; out = ((bf16_t*)(args.ws + WSM.WvT)) + (size_t)l * 512 * D; Nout = 512; mode = 2; }
        else if (k == 2) { W = in[21] + (size_t)l * D * D; K_ = D; Nsrc = D; out = ((bf16_t*)(args.ws + WSM.WoutT)) + (size_t)l * D * D; Nout = D; }
        else if (k == 3) { W = in[23] + (size_t)l * D * UPC; K_ = D; Nsrc = UPC; scale = in[22] + l * D; out = ((bf16_t*)(args.ws + WSM.WupT)) + (size_t)l * UPC * D; Nout = UPC; mode = 3; }
        else if (k == 4) { W = in[26] + (size_t)l * DFF * D; K_ = DFF; Nsrc = D; out = ((bf16_t*)(args.ws + WSM.WdnT)) + (size_t)l * D * DFF; Nout = D; }
        else if (k <= 6) { const int d = k - 5; W = in[6] + (size_t)(l * 2 + d) * 64 * 512; K_ = 64; Nsrc = 512; out = ((bf16_t*)(args.ws + WSM.WdecT)) + (size_t)(l * 2 + d) * 512 * 64; Nout = 512; mul = -1.44269504f; }
        else if (k <= 8) { const int d = k - 7; W = in[8] + (size_t)(l * 2 + d) * 64 * 512; K_ = 64; Nsrc = 512; out = ((bf16_t*)(args.ws + WSM.WaaaT)) + (size_t)(l * 2 + d) * 512 * 64; Nout = 512; mul = -1.44269504f; }
        else if (k == 9) { W = in[9] + (size_t)l * 128 * 512; K_ = 128; Nsrc = 512; out = ((bf16_t*)(args.ws + WSM.WgT)) + (size_t)l * 512 * 128; Nout = 512; }
        else             { W = in[12]; K_ = 32; Nsrc = 512; out = ((bf16_t*)(args.ws + WSM.WvuT)); Nout = 512; mul = -1.44269504f; }
        ph_prep_w(lds, W, K_, Nsrc, scale, out, Nout, mode, mul);
    }
    GRID_BAR();
    ph_fold(in[3] + (size_t)1 * D * INC, in[2] + D, in[4] + (size_t)1 * 2 * RWC, in[11], ((bf16_t*)(args.ws + WSM.WinT)) + (size_t)1 * PCW * D);

    for (int grp = 0; grp < NGRP; ++grp) {
        const size_t g0 = (size_t)grp * GR;
        float* Xg = X + g0 * D;
        {
            const float* xin = (g0 < (size_t)8 * SEQ) ? in[0] + g0 * D : in[1] + (g0 - (size_t)8 * SEQ) * D;
            ph_rms_in(xin, ((bf16_t*)(args.ws + WSM.xb)), ((float*)(args.ws + WSM.rstd)), GR);
        }
        GRID_BAR();
        for (int l = 0; l < DEPTH; ++l) {
            {
                pg8::StaticOrder S; pg8::Unit u0;
                S.init(GR, PCW, NWG, bx); if (S.next(0, u0)) wg_rstd_from_slots((const float*)(args.ws + WSM.rstd), u0.pm * 256, (LAS float*)(lds + RS_A));
                S.init(512, GR, NWG, bx); if (S.next(0, u0)) wg_rstd_from_slots((const float*)(args.ws + WSM.rstd), u0.pn * 256, (LAS float*)(lds + RS_B));
            }
#pragma unroll 1
            for (int k = 0; k < 2; ++k) {
                const bf16_t* xb_ = (const bf16_t*)(args.ws + WSM.xb);
                const bf16_t* wi_ = ((const bf16_t*)(args.ws + WSM.WinT)) + (size_t)l * PCW * D; const bf16_t* wv_ = ((const bf16_t*)(args.ws + WSM.WvT)) + (size_t)l * 512 * D;
                ph_gemm_bf(lds, k ? wv_ : xb_, k ? xb_ : wi_, k ? 512 : GR, k ? GR : PCW, D, k ? (bf16_t*)(args.ws + WSM.VT) : (bf16_t*)(args.ws + WSM.P),
                           k ? (const LAS float*)nullptr : (const LAS float*)(lds + RS_A), k ? (const LAS float*)(lds + RS_B) : (const LAS float*)nullptr, k ? -1 : PCW,
                           k ? (const float*)nullptr : in[4] + (size_t)l * 2 * RWC, (float*)(args.ws + WSM.act));
            }
            GRID_BAR();
            {
                ph_qknorm(((bf16_t*)(args.ws + WSM.P)), in[18] + l * 64, in[19] + l * 64, GR);
                constexpr int NUNITS = GSEQ * 16 * NSEG;
                if (bx < NUNITS) {
                    ScanW w;
                    w.mu = in[4] + (size_t)l * 2 * RWC; w.w0 = in[5] + l * 1024; w.a0 = in[7] + l * 1024; w.v0 = in[10]; w.kk_ = in[13] + l * 512; w.ka = in[14] + l * 512; w.rk = in[15] + l * 512; w.pedge = (const float*)(args.ws + WSM.act);
                    w.WdecT = ((bf16_t*)(args.ws + WSM.WdecT)) + (size_t)l * 2 * 512 * 64; w.WaaaT = ((bf16_t*)(args.ws + WSM.WaaaT)) + (size_t)l * 2 * 512 * 64; w.WgT = ((bf16_t*)(args.ws + WSM.WgT)) + (size_t)l * 512 * 128; w.WvuT = ((bf16_t*)(args.ws + WSM.WvuT));
                    for (int u = bx; u < NUNITS; u += G) scan_unit(lds, u, l, ((bf16_t*)(args.ws + WSM.P)), w, ((bf16_t*)(args.ws + WSM.ybuf)), ((bf16_t*)(args.ws + WSM.gbuf)), ((bf16_t*)(args.ws + WSM.mixb)), ((bf16_t*)(args.ws + WSM.vfirst)), ((float*)(args.ws + WSM.sbon)), (bf16_t*)(args.ws + WSM.yaug), (float*)(args.ws + WSM.segst));
                }
            }
            GRID_BAR();
#pragma unroll 1
            for (int half = 0; half < 2; ++half) {
                if (half == 0) {
                    ph_segfix(lds, (const float*)(args.ws + WSM.segst), (bf16_t*)(args.ws + WSM.SS), GSEQ * 16);
                    ph_natten(lds, ((bf16_t*)(args.ws + WSM.P)), ((bf16_t*)(args.ws + WSM.VT)), GR, GSEQ, in[20] + (size_t)l * 8 * 15 * 31, ((bf16_t*)(args.ws + WSM.mixb)), bx, G);
                    GRID_BAR();
                    ph_post3(lds, (const bf16_t*)(args.ws + WSM.ybuf), (const bf16_t*)(args.ws + WSM.yaug), (const bf16_t*)(args.ws + WSM.SS), (const bf16_t*)(args.ws + WSM.gbuf), (const float*)(args.ws + WSM.sbon), in[16] + l * 512, in[17] + l * 512, (bf16_t*)(args.ws + WSM.mixb), GSEQ);
                    GRID_BAR();
                } else {
                    { pg8::StaticOrder S; pg8::Unit u0; S.init(GR, UPC, NWG, bx); if (S.next(0, u0)) wg_rstd_from_slots((const float*)(args.ws + WSM.rstd), u0.pm * 256, (LAS float*)(lds + RS_A)); }
                    ph_gemm_ffn(lds, ((bf16_t*)(args.ws + WSM.xb)), ((bf16_t*)(args.ws + WSM.WupT)) + (size_t)l * UPC * D, GR, ((bf16_t*)(args.ws + WSM.act)), (float*)(args.ws + WSM.U), ((float*)(args.ws + WSM.rstd)),
                                in[24] + (size_t)l * 3 * UPC, in[25] + (size_t)l * UPC);
                    GRID_BAR();
                    ph_ffn_fix((const float*)(args.ws + WSM.U), in[24] + (size_t)l * 3 * UPC, in[25] + (size_t)l * UPC, ((bf16_t*)(args.ws + WSM.act)), GR);
                    GRID_BAR();
                }
                ph_gemm(lds, half ? (const bf16_t*)(args.ws + WSM.act) : (const bf16_t*)(args.ws + WSM.mixb),
                        half ? ((const bf16_t*)(args.ws + WSM.WdnT)) + (size_t)l * D * DFF : ((const bf16_t*)(args.ws + WSM.WoutT)) + (size_t)l * D * D, GR, D, half ? DFF : D,
                        (bf16_t*)(args.ws + WSM.xb), (half == 1 && l + 1 == DEPTH) ? Xg : nullptr, (float*)(args.ws + WSM.rstd));
                GRID_BAR();
            }
        }
    }
}

extern "C" void kernel_launch(void* const* d_in, const int* in_sizes, int n_in, void* d_out, int out_size, void* d_ws, size_t ws_size, hipStream_t stream) {
    static int grid = 0;
    static Args a{};
    if (grid == 0) {
        int dev = 0, cus = 0;
        if (hipGetDevice(&dev) != hipSuccess || hipDeviceGetAttribute(&cus, hipDeviceAttributeMultiprocessorCount, dev) != hipSuccess) { fprintf(stderr, "device query failed\n"); grid = -1; return; }
        if (hipFuncSetAttribute((const void*)mega, hipFuncAttributeMaxDynamicSharedMemorySize, LDS_BYTES) != hipSuccess) { fprintf(stderr, "hipFuncSetAttribute failed\n"); grid = -1; return; }
        int per_cu = 0;
        if (hipOccupancyMaxActiveBlocksPerMultiprocessor(&per_cu, (const void*)mega, NT, LDS_BYTES) != hipSuccess || per_cu < 1) { fprintf(stderr, "occupancy query: %d\n", per_cu); }
        (void)hipGetLastError();
        if (cus < NWG) { fprintf(stderr, "this kernel needs %d CUs, device has %d\n", NWG, cus); grid = -1; return; }
        grid = NWG;
    }
    if (grid < 0) return;
    if (WSM.end > ws_size || n_in != 27) { fprintf(stderr, "ws too small: need %zu have %zu (n_in %d)\n", (size_t)WSM.end, ws_size, n_in); return; }
    a = Args{};
    for (int i = 0; i < 27; ++i) a.in[i] = (const float*)d_in[i];
    a.out = (float*)d_out; a.ws = (unsigned char*)d_ws;
    (void)hipMemsetAsync(d_ws, 0, WS_CTL_BYTES, stream);
    hipLaunchKernelGGL(mega, dim3(grid), dim3(NT), LDS_BYTES, stream, a);
}
```

```cpp
#include <hip/hip_runtime.h>
#include <cstdio>
#include <cstdint>
namespace pg8 {
#define PG8_LAS __attribute__((address_space(3)))
typedef unsigned short bf16_t;
typedef short bf16x8 __attribute__((ext_vector_type(8)));
typedef float f32x4 __attribute__((ext_vector_type(4)));
typedef unsigned u32x4 __attribute__((ext_vector_type(4)));
constexpr int BM = 256, BK = 64, HALF = 128, HTB = HALF * BK * 2  , STAGE_BYTES = 8 * HTB, NXCD = 8, WGM = 8;

__host__ __device__ __forceinline__ int lds_byte(int r, int c) { const int st = (r >> 4) * 2 + (c >> 5), rr = r & 15, cc = c & 31, ob = rr * 64 + cc * 2; return st * 1024 + (ob ^ (((ob >> 9) & 1) << 5)); }
__host__ __device__ __forceinline__ void stage_rc(int b, int& R, int& C) { const int st = b / 1024, sb = b % 1024, swz = sb ^ (((sb >> 9) & 1) << 5); R = (st >> 1) * 16 + swz / 64; C = (st & 1) * 32 + (swz % 64) / 2; }
__host__ __device__ __forceinline__ int perm32(int rho) { const int n = rho >> 4, i = rho & 15; return 8 * (i >> 2) + 4 * n + (i & 3); }

struct Unit { int pm, pn; };
struct Gemm { const bf16_t* A; const bf16_t* Bt; int M, N, K, pad; };

struct StaticOrder {
    int nM, nN, nwg, G, c;
    __host__ __device__ void init(int M, int N, int G_, int c_) { nM = M / BM; nN = N / BM; nwg = nM * nN; G = G_; c = c_; }
    __host__ __device__ bool next(int i, Unit& u) const {
        const int L = i * G + c; if (L >= nwg) return false;
        int wgid = L; { const int q = nwg / NXCD, r = nwg % NXCD, xcd = wgid % NXCD, off = wgid / NXCD; wgid = (xcd < r ? xcd * (q + 1) : r * (q + 1) + (xcd - r) * q) + off; }
        const int nig = WGM * nN, gid = wgid / nig, fm = gid * WGM, gsz = (nM - fm) < WGM ? (nM - fm) : WGM;
        u.pm = fm + ((wgid % nig) % gsz); u.pn = (wgid % nig) / gsz; return true;
    }
    __device__ __forceinline__ void a_ready(const Unit&) const {}
    __device__ __forceinline__ void done(const Unit&) const {}
};

__device__ __forceinline__ unsigned cvt_pk_bf16(float lo, float hi) { unsigned r; asm volatile("v_cvt_pk_bf16_f32 %0, %1, %2" : "=v"(r) : "v"(lo), "v"(hi)); return r; }
typedef float f32x2 __attribute__((ext_vector_type(2)));
template <class Epi, class Sched, bool ALIGN_EPI = false, bool SP2 = false>
__device__ __forceinline__ void gemm_phase(PG8_LAS unsigned char* lds, const Gemm g, const Sched& S, const Epi& E, const int tid_in) {
    const int tid = tid_in, wid = __builtin_amdgcn_readfirstlane(tid >> 6), lane = tid & 63, wr = wid >> 2, wc = wid & 3, fr = lane & 15, fq = lane >> 4;
    const int K = g.K, nt = K / BK;
    unsigned voffA[2], voffB[2];
#pragma unroll
    for (int i = 0; i < 2; ++i) { int R, C; stage_rc(tid * 16 + i * 8192, R, C); const int Rb = Epi::PERM ? ((R & ~31) + perm32(R & 31)) : R;
        const int Ra = Epi::APERM ? ((R & ~63) + 4 * (R & 15) + ((R >> 4) & 3)) : R;
        voffA[i] = (unsigned)(Ra * K + C) * 2u; voffB[i] = (unsigned)(Rb * K + C) * 2u; }
    const size_t kstep = (size_t)(BK * 2);
    const size_t hstep = (size_t)HALF * K * 2;
    const size_t tstep = 2 * hstep;
    const unsigned ldsw = (unsigned)wid * 1024u;
    const int aoff = lds_byte(wr * 64 + fr, fq * 8), boff = lds_byte(wc * 32 + fr, fq * 8);
#define PG8_SA(b, h) (((b) * 2 + (h)) * HTB)
#define PG8_SB(b, h) ((4 + (b) * 2 + (h)) * HTB)
#define PG8_STAGE(bufoff, gbase, voff) do { _Pragma("unroll") for (int _i = 0; _i < 2; ++_i) \
        __builtin_amdgcn_global_load_lds((const unsigned*)((const char*)(gbase) + (voff)[_i]), (PG8_LAS unsigned*)(lds + (bufoff) + ldsw + _i * 8192), 16, 0, 0); } while (0)
#define PG8_LDA(dst, b, h) do { _Pragma("unroll") for (int m = 0; m < 4; ++m) _Pragma("unroll") for (int k = 0; k < 2; ++k) dst[m][k] = *(const PG8_LAS bf16x8*)(lds + PG8_SA(b, h) + aoff + m * 2048 + k * 1024); } while (0)
#define PG8_LDB(dst, b, h) do { _Pragma("unroll") for (int n = 0; n < 2; ++n) _Pragma("unroll") for (int k = 0; k < 2; ++k) dst[n][k] = *(const PG8_LAS bf16x8*)(lds + PG8_SB(b, h) + boff + n * 2048 + k * 1024); } while (0)
#define PG8_MMA(ai, bj, At, Bt) do { __builtin_amdgcn_s_setprio(1); _Pragma("unroll") for (int m = 0; m < 4; ++m) _Pragma("unroll") for (int n = 0; n < 2; ++n) _Pragma("unroll") for (int k = 0; k < 2; ++k) \
        acc[ai][bj][m][n] = __builtin_amdgcn_mfma_f32_16x16x32_bf16(Bt[n][k], At[m][k], acc[ai][bj][m][n], 0, 0, 0); __builtin_amdgcn_s_setprio(0); } while (0)
#define PG8_WAIT_V(n) asm volatile("s_waitcnt vmcnt(" #n ")" ::: "memory")
#define PG8_WAIT_L(n) asm volatile("s_waitcnt lgkmcnt(" #n ")" ::: "memory")
#define PG8_BAR __builtin_amdgcn_s_barrier()
#define PG8_SCHED __builtin_amdgcn_sched_barrier(0)
    Unit cur, nxt; int ui = 0;
    if (!S.next(0, cur)) return;
    f32x4 acc[2][2][4][2];
#pragma unroll
    for (int a = 0; a < 2; ++a)
#pragma unroll
        for (int b = 0; b < 2; ++b)
#pragma unroll
            for (int m = 0; m < 4; ++m)
#pragma unroll
                for (int n = 0; n < 2; ++n) acc[a][b][m][n] = (f32x4){0.f, 0.f, 0.f, 0.f};
    bf16x8 At[4][2], B0[2][2], B1[2][2];
    const char* cA = (const char*)g.A + (size_t)cur.pm * tstep; const char* cB = (const char*)g.Bt + (size_t)cur.pn * tstep;
    S.a_ready(cur);
    if constexpr (SP2) {
        PG8_STAGE(PG8_SB(0, 0), cB, voffB); PG8_STAGE(PG8_SB(0, 1), cB + hstep, voffB); PG8_STAGE(PG8_SA(0, 0), cA, voffA); PG8_STAGE(PG8_SA(0, 1), cA + hstep, voffA);
        if (wr == 1) PG8_BAR;
        PG8_WAIT_V(2); PG8_BAR;
        PG8_STAGE(PG8_SB(1, 0), cB + kstep, voffB); PG8_STAGE(PG8_SA(1, 0), cA + kstep, voffA); PG8_STAGE(PG8_SB(1, 1), cB + hstep + kstep, voffB);
        PG8_WAIT_V(6); PG8_BAR;
    } else {
        PG8_STAGE(PG8_SB(0, 0), cB, voffB); PG8_STAGE(PG8_SA(0, 0), cA, voffA); PG8_STAGE(PG8_SB(0, 1), cB + hstep, voffB); PG8_STAGE(PG8_SA(0, 1), cA + hstep, voffA);
        if (wr == 1) PG8_BAR;
        PG8_WAIT_V(4); PG8_BAR;
        PG8_STAGE(PG8_SB(1, 0), cB + kstep, voffB); PG8_STAGE(PG8_SA(1, 0), cA + kstep, voffA); PG8_STAGE(PG8_SB(1, 1), cB + hstep + kstep, voffB);
        PG8_WAIT_V(6); PG8_BAR;
    }
    for (;;) {
        const bool has_next = S.next(ui + 1, nxt);
        const char* nA = has_next ? (const char*)g.A + (size_t)nxt.pm * tstep : cA; const char* nB = has_next ? (const char*)g.Bt + (size_t)nxt.pn * tstep : cB;
        for (int t = 0; t < nt; t += 2) {
            const bool last = (t == nt - 2);
            const char* a1 = cA + (size_t)(t + 1) * kstep;
            const char* a2 = last ? nA : cA + (size_t)(t + 2) * kstep; const char* b2 = last ? nB : cB + (size_t)(t + 2) * kstep;
            const char* a3 = a2 + kstep; const char* b3 = b2 + kstep;
            if (last && has_next) S.a_ready(nxt);
            if constexpr (SP2) {
            PG8_LDB(B0, 0, 0); PG8_LDB(B1, 0, 1); PG8_SCHED; PG8_LDA(At, 0, 0); PG8_STAGE(PG8_SA(1, 1), a1 + hstep, voffA);
            PG8_WAIT_V(8); PG8_WAIT_L(0); PG8_BAR; PG8_MMA(0, 0, At, B0); PG8_MMA(0, 1, At, B1); PG8_BAR; PG8_SCHED;
            PG8_LDA(At, 0, 1); PG8_STAGE(PG8_SB(0, 0), b2, voffB); PG8_STAGE(PG8_SB(0, 1), b2 + hstep, voffB); PG8_STAGE(PG8_SA(0, 0), a2, voffA);
            PG8_WAIT_V(8); PG8_WAIT_L(0); PG8_BAR; PG8_MMA(1, 0, At, B0); PG8_MMA(1, 1, At, B1); PG8_BAR; PG8_SCHED;
            PG8_LDB(B0, 1, 0); PG8_LDB(B1, 1, 1); PG8_SCHED; PG8_LDA(At, 1, 0); PG8_STAGE(PG8_SA(0, 1), a2 + hstep, voffA);
            PG8_WAIT_V(8); PG8_WAIT_L(0); PG8_BAR; PG8_MMA(0, 0, At, B0); PG8_MMA(0, 1, At, B1); PG8_BAR; PG8_SCHED;
            PG8_LDA(At, 1, 1); PG8_STAGE(PG8_SB(1, 0), b3, voffB); PG8_STAGE(PG8_SB(1, 1), b3 + hstep, voffB); PG8_STAGE(PG8_SA(1, 0), a3, voffA);
            PG8_WAIT_V(8); PG8_WAIT_L(0); PG8_BAR; PG8_MMA(1, 0, At, B0); PG8_MMA(1, 1, At, B1); PG8_BAR; PG8_SCHED;
            } else {
            PG8_LDB(B0, 0, 0); PG8_SCHED; PG8_LDA(At, 0, 0); PG8_STAGE(PG8_SA(1, 1), a1 + hstep, voffA);
            PG8_WAIT_L(8); PG8_BAR; PG8_WAIT_L(0); PG8_MMA(0, 0, At, B0); PG8_BAR; PG8_SCHED;
            PG8_LDB(B1, 0, 1); PG8_STAGE(PG8_SB(0, 0), b2, voffB);
            PG8_BAR; PG8_WAIT_L(0); PG8_MMA(0, 1, At, B1); PG8_BAR;
            PG8_LDA(At, 0, 1); PG8_STAGE(PG8_SA(0, 0), a2, voffA);
            PG8_BAR; PG8_WAIT_L(0); PG8_MMA(1, 0, At, B0); PG8_BAR; PG8_SCHED;
            PG8_STAGE(PG8_SB(0, 1), b2 + hstep, voffB);
            PG8_WAIT_V(6); PG8_BAR; PG8_MMA(1, 1, At, B1); PG8_BAR;
            PG8_LDB(B0, 1, 0); PG8_SCHED; PG8_LDA(At, 1, 0); PG8_STAGE(PG8_SA(0, 1), a2 + hstep, voffA);
            PG8_WAIT_L(8); PG8_BAR; PG8_WAIT_L(0); PG8_MMA(0, 0, At, B0); PG8_BAR; PG8_SCHED;
            PG8_LDB(B1, 1, 1); PG8_STAGE(PG8_SB(1, 0), b3, voffB);
            PG8_BAR; PG8_WAIT_L(0); PG8_MMA(0, 1, At, B1); PG8_BAR;
            PG8_LDA(At, 1, 1); PG8_STAGE(PG8_SA(1, 0), a3, voffA);
            PG8_BAR; PG8_WAIT_L(0); PG8_MMA(1, 0, At, B0); PG8_BAR; PG8_SCHED;
            PG8_STAGE(PG8_SB(1, 1), b3 + hstep, voffB);
            PG8_WAIT_V(6); PG8_BAR; PG8_MMA(1, 1, At, B1); PG8_BAR;
            }
        }
        if constexpr (ALIGN_EPI) { if (wr == 0) PG8_BAR; }
        if constexpr (!Epi::AFTER_DRAIN) { E(acc, cur, wr, wc, fr, fq); S.done(cur); }
        if (!has_next) break;
#pragma unroll
        for (int a = 0; a < 2; ++a)
#pragma unroll
            for (int b = 0; b < 2; ++b)
#pragma unroll
                for (int m = 0; m < 4; ++m)
#pragma unroll
                    for (int n = 0; n < 2; ++n) acc[a][b][m][n] = (f32x4){0.f, 0.f, 0.f, 0.f};
        cur = nxt; cA = nA; cB = nB; ++ui;
        if constexpr (ALIGN_EPI) { if (wr == 1) PG8_BAR; }
    }
    PG8_WAIT_V(0);
    if constexpr (!ALIGN_EPI) { if (wr == 0) PG8_BAR; }
    PG8_BAR;
    if constexpr (Epi::AFTER_DRAIN) { E.fused(acc, cur, wr, wc, fr, fq, lds, wid, lane); S.done(cur); }
#undef PG8_SA
#undef PG8_SB
#undef PG8_STAGE
#undef PG8_LDA
#undef PG8_LDB
#undef PG8_MMA
#undef PG8_WAIT_V
#undef PG8_WAIT_L
#undef PG8_BAR
#undef PG8_SCHED
}
}
#define XB_TMO      128
#define XB_XCNT(j)  (256  + 64 * (j))
#define XB_XSUB(j)  (1280 + 64 * (j))
#define XB_XGEN(j)  (2304 + 64 * (j))
#define XB_TOP      3328
#define XB_TOPGEN   3392
#define XCD_BAR_WORDS 3456
#define XB_SPIN_CAP (1u << 22)
#define LAS __attribute__((address_space(3)))

__device__ __forceinline__ unsigned xb_ld(unsigned* p)              { return __hip_atomic_load(p, __ATOMIC_RELAXED, __HIP_MEMORY_SCOPE_AGENT); }
__device__ __forceinline__ unsigned xb_add(unsigned* p, unsigned v) { return __hip_atomic_fetch_add(p, v, __ATOMIC_RELAXED, __HIP_MEMORY_SCOPE_AGENT); }
__device__ __forceinline__ unsigned xb_xcc_id() { return (unsigned)__builtin_amdgcn_s_getreg((3 << 11) | 20) & 0xFu; }
#define XB_SPIN(cond, bar) do { unsigned _sp = 0; while (cond) { __builtin_amdgcn_s_sleep(1); \
    if ((++_sp & 255u) == 0u) { if (xb_ld(&(bar)[XB_TMO])) break; if (_sp > XB_SPIN_CAP) { atomicAdd(&(bar)[XB_TMO], 1u); break; } } } } while (0)

struct XcdBarrier {
    unsigned* bar; unsigned x;
    volatile LAS unsigned* st;
};

__device__ __forceinline__ XcdBarrier xcd_barrier_post(unsigned* bar, volatile LAS unsigned* st, const bool lead) {
    XcdBarrier b; b.bar = bar; b.x = xb_xcc_id(); b.st = st;
    if (lead) (void)xb_add(&bar[XB_XCNT(b.x)], 1u);
    return b;
}
__device__ __forceinline__ void xcd_barrier_complete(unsigned* bar, unsigned x, unsigned& nloc, unsigned& nx) {
    const unsigned G = gridDim.x * gridDim.y * gridDim.z;
    unsigned sum, cnt, mine, sp = 0u;
    for (;;) {
        sum = 0u; cnt = 0u; mine = 0u;
#pragma unroll
        for (unsigned j = 0; j < 16; ++j) { const unsigned c = xb_ld(&bar[XB_XCNT(j)]); sum += c; cnt += (c > 0u) ? 1u : 0u; mine = (j == x) ? c : mine; }
        if (sum == G) break;
        __builtin_amdgcn_s_sleep(1);
        if ((++sp & 255u) == 0u) { if (xb_ld(&bar[XB_TMO])) break; if (sp > XB_SPIN_CAP) { atomicAdd(&bar[XB_TMO], 1u); break; } }
    }
    nloc = mine > 0u ? mine : 1u; nx = cnt > 0u ? cnt : 1u;
}

__device__ __forceinline__ void xcd_barrier(const XcdBarrier& b, const bool lead, const bool rel = true) {
    asm volatile("s_waitcnt vmcnt(0)" ::: "memory");
    __syncthreads();
    if (lead) {
        unsigned* bar = b.bar;
        __builtin_amdgcn_s_waitcnt(0);
        unsigned nloc = b.st[0], nx = b.st[1];
        if (nloc == 0u) { xcd_barrier_complete(bar, b.x, nloc, nx); b.st[0] = nloc; b.st[1] = nx; }
        const unsigned old = xb_add(&bar[XB_XSUB(b.x)], 1u);
        const unsigned gen = old / nloc;
        if (old + 1u == (gen + 1u) * nloc) {
            if (rel) __builtin_amdgcn_fence(__ATOMIC_RELEASE, "agent");
            asm volatile("s_waitcnt vmcnt(0)" ::: "memory");
            const unsigned og = xb_add(&bar[XB_TOP], 1u);
            const unsigned tg = og / nx;
            if (og + 1u == (tg + 1u) * nx) xb_add(&bar[XB_TOPGEN], 1u);
            else XB_SPIN(xb_ld(&bar[XB_TOPGEN]) == tg, bar);
            __builtin_amdgcn_fence(__ATOMIC_ACQUIRE, "agent");
            xb_add(&bar[XB_XGEN(b.x)], 1u);
            asm volatile("s_waitcnt vmcnt(0)" ::: "memory");
        } else {
            XB_SPIN(xb_ld(&bar[XB_XGEN(b.x)]) == gen, bar);
            __builtin_amdgcn_fence(__ATOMIC_ACQUIRE, "agent");
            asm volatile("s_waitcnt vmcnt(0)" ::: "memory");
        }
    }
    __syncthreads();
}

typedef unsigned short bf16_t;
typedef float f32x4 __attribute__((ext_vector_type(4)));
typedef short bf16x8 __attribute__((ext_vector_type(8)));
typedef unsigned u32x4 __attribute__((ext_vector_type(4)));
typedef unsigned u32x2 __attribute__((ext_vector_type(2)));

constexpr int D = 1024, NSEQ = 12, SEQ = 4096, NTOK = NSEQ * SEQ, DEPTH = 2;
constexpr int RWC = 1920, INC = 3456, PCW = 3072, QOFF = 2048, KOFF = 2560, DFF = 2816, UPC = 5632;
constexpr int O_WD = 1536, O_AD = 1664, O_GD = 1792;
constexpr int NT = 512, NWG = 256;
constexpr int LDS_MISC = 161792, LDS_BYTES = LDS_MISC + 1024;
constexpr size_t WS_CTL_BYTES = 1048576;
constexpr int GSEQ = 4, GR = GSEQ * SEQ, NGRP = NSEQ / GSEQ;

typedef __bf16 bf16v2_t __attribute__((ext_vector_type(2)));
typedef float f32v2_t __attribute__((ext_vector_type(2)));
__device__ __forceinline__ unsigned cvtpk(float lo, float hi) { f32v2_t f = {lo, hi}; bf16v2_t b = __builtin_convertvector(f, bf16v2_t); return __builtin_bit_cast(unsigned, b); }
__device__ __forceinline__ unsigned short f2bf(float f) { return __builtin_bit_cast(unsigned short, (__bf16)f); }
__device__ __forceinline__ float bf2f(unsigned short b) { return __uint_as_float(((unsigned)b) << 16); }
__device__ __forceinline__ unsigned pk2bf(float lo, float hi) { return cvtpk(lo, hi); }
__device__ __forceinline__ float shx(float v, int m, int lane) { return __int_as_float(__builtin_amdgcn_ds_bpermute((lane ^ m) << 2, __float_as_int(v))); }
__device__ __forceinline__ float shl_(float v, int src) { return __int_as_float(__builtin_amdgcn_ds_bpermute(src << 2, __float_as_int(v))); }
__device__ __forceinline__ float wave_sum(float v, int lane) {
#pragma unroll
    for (int o = 1; o < 64; o <<= 1) v += shx(v, o, lane);
    return v;
}
__device__ __forceinline__ int olane() { unsigned z = 0u; asm volatile("" : "+s"(z)); int l = (int)__builtin_amdgcn_mbcnt_hi(~0u, __builtin_amdgcn_mbcnt_lo(~0u, z)); asm volatile("" : "+v"(l)); return l; }
__device__ __forceinline__ int otid() { return (__builtin_amdgcn_readfirstlane((int)threadIdx.x >> 6) << 6) | olane(); }
__device__ __forceinline__ float sigmoidf_(float x) { return 1.f / (1.f + expf(-x)); }

__device__ __forceinline__ void ph_prep_w(LAS unsigned char* lds, const float* __restrict__ W, int K, int Nsrc, const float* __restrict__ scale, bf16_t* __restrict__ out, int Nout, int mode, float mul) {
    const int tid0 = otid(); const int half = tid0 >> 8, t8 = tid0 & 255, tx = t8 & 31, ty = t8 >> 5;
    LAS float* tile = (LAS float*)(lds + half * 8448);
    const int ntn = Nout / 32, nkt = (K + 63) / 64, ntiles = ntn * nkt;
    for (int vb = blockIdx.x; 2 * vb < ntiles; vb += NWG) {
        const int ti = 2 * vb + half; const bool on = ti < ntiles;
        const int n0 = (ti % ntn) * 32, k0 = (ti / ntn) * 64;
        if (on) {
            const int n = n0 + tx; int ns = n; bool valid = true;
            if (mode == 1) { if (n < 1920) ns = n; else if (n < 2048) valid = false; else ns = n - 128; }
            if (mode == 2) ns = n + 2944;
            if (mode == 3) ns = ((n >> 7) & 1) * DFF + (n >> 8) * 128 + (n & 127);
            float cs = mul;
            if (mode == 1) { if (n >= O_WD && n < O_WD + 128) cs *= 2.88539008f; else if (n >= O_GD && n < O_GD + 128) cs *= -1.44269504f; }
            float v[8];
#pragma unroll
            for (int q = 0; q < 8; ++q) { const int k = k0 + ty + 8 * q; v[q] = (valid && k < K) ? W[(size_t)k * Nsrc + ns] * (scale ? scale[k] : 1.f) : 0.f; }
#pragma unroll
            for (int q = 0; q < 8; ++q) tile[(ty + 8 * q) * 33 + tx] = v[q] * cs;
        }
        __syncthreads();
        if (on && k0 + 2 * tx < K) {
#pragma unroll
            for (int q = 0; q < 4; ++q) { const int n = n0 + ty + 8 * q; *(unsigned*)(out + (size_t)n * K + k0 + 2 * tx) = cvtpk(tile[(2 * tx) * 33 + ty + 8 * q], tile[(2 * tx + 1) * 33 + ty + 8 * q]); }
        }
        __syncthreads();
    }
}

__device__ __forceinline__ void ph_rms_in(const float* __restrict__ xin, bf16_t* __restrict__ xb, float* __restrict__ rstd, int rows) {
    const int tid0 = otid(); const int lane = tid0 & 63;
    for (int row = blockIdx.x * 8 + (tid0 >> 6); row < rows; row += NWG * 8) {
        const f32x4* xr = (const f32x4*)(xin + (size_t)row * D);
        f32x4 v[4]; float s = 0.f;
#pragma unroll
        for (int j = 0; j < 4; ++j) { v[j] = xr[lane + 64 * j]; s += v[j].x * v[j].x + v[j].y * v[j].y + v[j].z * v[j].z + v[j].w * v[j].w; }
        s = wave_sum(s, lane);
        if (lane < 4) rstd[lane * GR + row] = (lane == 0) ? s : 0.f;
#pragma unroll
        for (int j = 0; j < 4; ++j) {
            const int c = (lane + 64 * j) * 4;
            u32x2 w; w.x = pk2bf(v[j].x, v[j].y); w.y = pk2bf(v[j].z, v[j].w);
            *(u32x2*)(xb + (size_t)row * D + c) = w;
        }
    }
}
__device__ __forceinline__ void ph_rstd(const bf16_t* __restrict__ xb, float* __restrict__ rstd, int rows) {
    const int tid0 = otid(); const int lane = tid0 & 63;
#pragma unroll 4
    for (int row = blockIdx.x * 8 + (tid0 >> 6); row < rows; row += NWG * 8) {
        const u32x4* xr = (const u32x4*)(xb + (size_t)row * D);
        float s = 0.f;
#pragma unroll
        for (int j = 0; j < 2; ++j) {
            const u32x4 q = xr[lane + 64 * j];
            const unsigned w[4] = {q.x, q.y, q.z, q.w};
#pragma unroll
            for (int k = 0; k < 4; ++k) { const float a = __uint_as_float(w[k] << 16), c = __uint_as_float(w[k] & 0xffff0000u); s += a * a + c * c; }
        }
        s = wave_sum(s, lane);
        if (lane == 0) rstd[row] = rsqrtf(s * (1.f / D) + 1e-6f);
    }
}

constexpr int RS_A = 140288, RS_B = 141312;
__device__ __forceinline__ void wg_rstd_from_slots(const float* __restrict__ ssq, int row0, LAS float* dst) {
    const int tid0 = otid();
    if (tid0 < 256) {
        const float* p = ssq + row0 + tid0;
        dst[tid0] = rsqrtf(((p[0] + p[GR]) + (p[2 * GR] + p[3 * GR])) * (1.f / D) + 1e-6f);
    }
    __syncthreads();
}

constexpr int EPI_S = 135168;
struct EpiRow {
    static constexpr bool PERM = true, AFTER_DRAIN = false, APERM = false;
    bf16_t* X; float* outf; float* ssq; LAS unsigned char* lds;
    __device__ __forceinline__ void operator()(const pg8::f32x4 (&acc)[2][2][4][2], const pg8::Unit& u, int wr, int wc, int fr, int fq) const {
        const int row0 = u.pm * 256 + wr * 64 + fr, col0 = u.pn * 256 + wc * 32 + 8 * fq;
        const unsigned off0 = (unsigned)row0 * (unsigned)D + (unsigned)col0;
        pg8::u32x4 r[2][4][2];
#pragma unroll
        for (int ai = 0; ai < 2; ++ai)
#pragma unroll
            for (int m = 0; m < 4; ++m)
#pragma unroll
                for (int bj = 0; bj < 2; ++bj) r[ai][m][bj] = *(const pg8::u32x4*)(X + off0 + (unsigned)((ai * 128 + m * 16) * D + bj * 128));
        float ss[2][4];
#pragma unroll
        for (int ai = 0; ai < 2; ++ai)
#pragma unroll
            for (int m = 0; m < 4; ++m) {
                const unsigned off = off0 + (unsigned)((ai * 128 + m * 16) * D);
                float sq = 0.f;
#pragma unroll
                for (int bj = 0; bj < 2; ++bj) {
                    const pg8::u32x4 rr = r[ai][m][bj];
                    pg8::f32x4 v0 = acc[ai][bj][m][0], v1 = acc[ai][bj][m][1];
                    v0[0] += __uint_as_float(rr.x << 16); v0[1] += __uint_as_float(rr.x & 0xffff0000u); v0[2] += __uint_as_float(rr.y << 16); v0[3] += __uint_as_float(rr.y & 0xffff0000u);
                    v1[0] += __uint_as_float(rr.z << 16); v1[1] += __uint_as_float(rr.z & 0xffff0000u); v1[2] += __uint_as_float(rr.w << 16); v1[3] += __uint_as_float(rr.w & 0xffff0000u);
                    if (outf) { *(pg8::f32x4*)(outf + off + bj * 128) = v0; *(pg8::f32x4*)(outf + off + bj * 128 + 4) = v1; }
                    else {
                        pg8::u32x4 w; w.x = pg8::cvt_pk_bf16(v0[0], v0[1]); w.y = pg8::cvt_pk_bf16(v0[2], v0[3]); w.z = pg8::cvt_pk_bf16(v1[0], v1[1]); w.w = pg8::cvt_pk_bf16(v1[2], v1[3]);
                        *(pg8::u32x4*)(X + off + bj * 128) = w;
                        const unsigned ww[4] = {w.x, w.y, w.z, w.w};
#pragma unroll
                        for (int k = 0; k < 4; ++k) { const float a = __uint_as_float(ww[k] << 16), c = __uint_as_float(ww[k] & 0xffff0000u); sq = fmaf(a, a, fmaf(c, c, sq)); }
                    }
                }
                ss[ai][m] = sq;
            }
        if (!outf) {
            const int lane_ = olane();
            LAS float* LS = (LAS float*)(lds + EPI_S);
#pragma unroll
            for (int ai = 0; ai < 2; ++ai)
#pragma unroll
                for (int m = 0; m < 4; ++m) {
                    float s = ss[ai][m];
                    s += shx(s, 16, lane_); s += shx(s, 32, lane_);
                    if (lane_ < 16) LS[wc * 256 + wr * 64 + ai * 128 + m * 16 + lane_] = s;
                }
            __syncthreads();
            const int tid_ = (wr * 4 + wc) * 64 + lane_;
            if (tid_ < 256) ssq[u.pn * GR + u.pm * 256 + tid_] = (LS[tid_] + LS[256 + tid_]) + (LS[512 + tid_] + LS[768 + tid_]);
        }
    }
};
template <int CTRL> __device__ __forceinline__ float dppf(float x) { return __int_as_float(__builtin_amdgcn_update_dpp(0, __float_as_int(x), CTRL, 0xf, 0xf, true)); }
constexpr int EPI_C = 135168;
constexpr int EPI_Q = 143360;
constexpr int MIXC = 1920;
struct EpiBf {
    static constexpr bool PERM = true, AFTER_DRAIN = false, APERM = true;
    bf16_t* O; const LAS float* rowscale; const LAS float* colscale; int ldc; const float* mu; float* edge; LAS unsigned char* lds; const float* qg; const float* kg;
    __device__ __forceinline__ void operator()(const pg8::f32x4 (&acc)[2][2][4][2], const pg8::Unit& u, int wr, int wc, int fr_in, int fq_in) const {
        const int lane_ = olane(); const int fr = lane_ & 15, fq = lane_ >> 4; (void)fr_in; (void)fq_in;
        const int col0 = u.pn * 256 + wc * 32 + 8 * fq;
        const bool mix = (mu != nullptr) && (u.pn * 256 < MIXC);
        const bool qk = (qg != nullptr) && (u.pn * 256 >= QOFF);
        pg8::f32x4 qc0 = (pg8::f32x4){1.f, 1.f, 1.f, 1.f}, qc1 = qc0;
        if (qk) {
            const bool isk = u.pn * 256 >= KOFF;
            const float* gp = (isk ? kg : qg) + 32 * (wc & 1) + 8 * fq; const float gs = isk ? 1.f : 0.125f * 1.44269504f;
#pragma unroll
            for (int e = 0; e < 4; ++e) { qc0[e] = gp[e] * gs; qc1[e] = gp[4 + e] * gs; }
            LAS float* Qs = (LAS float*)(lds + EPI_Q);
#pragma unroll
            for (int ai = 0; ai < 2; ++ai) {
                const pg8::f32x4 rs = *(const LAS pg8::f32x4*)(rowscale + wr * 64 + ai * 128 + 4 * fr);
#pragma unroll
                for (int bj = 0; bj < 2; ++bj) {
                    pg8::f32x4 s4;
#pragma unroll
                    for (int m = 0; m < 4; ++m) {
                        float ss = 0.f;
#pragma unroll
                        for (int n = 0; n < 2; ++n)
#pragma unroll
                            for (int e = 0; e < 4; ++e) ss = fmaf(acc[ai][bj][m][n][e], acc[ai][bj][m][n][e], ss);
                        ss += __shfl_xor(ss, 16); ss += __shfl_xor(ss, 32);
                        s4[m] = ss * rs[m] * rs[m];
                    }
                    if (fq == 0) *(LAS pg8::f32x4*)(Qs + (bj * 4 + wc) * 264 + ai * 128 + wr * 64 + 4 * fr) = s4;
                }
            }
            __syncthreads();
        }
        if (mix) {
            const int tid_ = (wr * 4 + wc) * 64 + lane_;
            LAS float* Cf = (LAS float*)(lds + EPI_C);
#pragma unroll
            for (int q = 0; q < 2; ++q) {
                const int idx = tid_ + 512 * q;
                if (idx < 768) {
                    const int k = idx >> 8, col = u.pn * 256 + (idx & 255);
                    float v = (k == 0) ? 1.f : 0.f;
                    if (col < MIXC) { const float a0 = mu[col], a1 = mu[RWC + col]; v = (k == 0) ? 1.f - a0 - a1 : (k == 1) ? a0 : a1; }
                    Cf[idx] = v;
                }
            }
            __syncthreads();
        }
#pragma unroll
        for (int ai = 0; ai < 2; ++ai) {
            const int rowb = u.pm * 256 + ai * 128 + wr * 64;
            pg8::f32x4 rs = (pg8::f32x4){1.f, 1.f, 1.f, 1.f};
            if (rowscale) rs = *(const LAS pg8::f32x4*)(rowscale + wr * 64 + ai * 128 + 4 * fr);
#pragma unroll
            for (int bj = 0; bj < 2; ++bj) {
                pg8::u32x4 w[4];
                if (mix) {
                    const LAS float* Cf = (const LAS float*)(lds + EPI_C) + (wc * 32 + 8 * fq + bj * 128);
                    const unsigned eoff = ((unsigned)((rowb >> 6) * 4 + (fr == 0 ? 0 : 2)) * MIXC + (unsigned)(col0 + bj * 128)) * 4u;
                    const bool isedge = ((fr == 0) || (fr == 15)) && (col0 + bj * 128 < MIXC);
#pragma unroll
                    for (int n = 0; n < 2; ++n) {
                        const pg8::f32x4 k0 = *(const LAS pg8::f32x4*)(Cf + 4 * n), m0 = *(const LAS pg8::f32x4*)(Cf + 256 + 4 * n), m1 = *(const LAS pg8::f32x4*)(Cf + 512 + 4 * n);
                        float c_[4][4];
#pragma unroll
                        for (int e = 0; e < 4; ++e) {
                            float x[4];
#pragma unroll
                            for (int m = 0; m < 4; ++m) x[m] = acc[ai][bj][m][n][e] * rs[m];
                            if (isedge) { *(float*)((char*)edge + eoff + (4 * n + e) * 4u) = (fr == 0) ? x[0] : x[2]; *(float*)((char*)edge + eoff + MIXC * 4u + (4 * n + e) * 4u) = (fr == 0) ? x[1] : x[3]; }
                            const float up = dppf<0x111>(x[3]), dn = dppf<0x101>(x[0]);
                            c_[e][0] = fmaf(k0[e], x[0], fmaf(m0[e], up, m1[e] * x[1])); c_[e][1] = fmaf(k0[e], x[1], fmaf(m0[e], x[0], m1[e] * x[2]));
                            c_[e][2] = fmaf(k0[e], x[2], fmaf(m0[e], x[1], m1[e] * x[3])); c_[e][3] = fmaf(k0[e], x[3], fmaf(m0[e], x[2], m1[e] * dn));
                        }
#pragma unroll
                        for (int m = 0; m < 4; ++m) {
                            const unsigned lo = pg8::cvt_pk_bf16(c_[0][m], c_[1][m]), hi = pg8::cvt_pk_bf16(c_[2][m], c_[3][m]);
                            if (n == 0) { w[m].x = lo; w[m].y = hi; } else { w[m].z = lo; w[m].w = hi; }
                        }
                    }
                } else {
                    pg8::f32x4 cs0 = qc0, cs1 = qc1, rq = rs;
                    if (colscale) { cs0 = *(const LAS pg8::f32x4*)(colscale + wc * 32 + 8 * fq + bj * 128); cs1 = *(const LAS pg8::f32x4*)(colscale + wc * 32 + 8 * fq + bj * 128 + 4); }
                    if (qk) {
                        const LAS float* Qs = (const LAS float*)(lds + EPI_Q) + ai * 128 + wr * 64 + 4 * fr;
                        const pg8::f32x4 sa = *(const LAS pg8::f32x4*)(Qs + (bj * 4 + wc) * 264), sb = *(const LAS pg8::f32x4*)(Qs + (bj * 4 + (wc ^ 1)) * 264);
#pragma unroll
                        for (int m = 0; m < 4; ++m) rq[m] = rs[m] * rsqrtf((sa[m] + sb[m]) * (1.f / 64.f) + 1e-6f);
                    }
#pragma unroll
                    for (int m = 0; m < 4; ++m) {
                        const pg8::f32x4 v0 = acc[ai][bj][m][0] * rq[m] * cs0, v1 = acc[ai][bj][m][1] * rq[m] * cs1;
                        w[m].x = pg8::cvt_pk_bf16(v0[0], v0[1]); w[m].y = pg8::cvt_pk_bf16(v0[2], v0[3]); w[m].z = pg8::cvt_pk_bf16(v1[0], v1[1]); w[m].w = pg8::cvt_pk_bf16(v1[2], v1[3]);
                    }
                }
#pragma unroll
                for (int m = 0; m < 4; ++m) {
                    const int row = rowb + 4 * fr + m;
                    bf16_t* p = (ldc < 0) ? O + (size_t)((col0 + bj * 128) >> 3) * 4096 + row * 8 : O + (size_t)row * ldc + col0 + bj * 128;
                    *(pg8::u32x4*)p = w[m];
                }
            }
        }
    }
};
__device__ __forceinline__ void ph_gemm(LAS unsigned char* lds, const bf16_t* A, const bf16_t* Bt, int M, int N, int K, bf16_t* X, float* outf, float* ssq) {
    pg8::Gemm g{A, Bt, M, N, K, 0}; EpiRow e{X, outf, ssq, lds};
    pg8::StaticOrder S; S.init(M, N, NWG, (int)blockIdx.x);
    pg8::gemm_phase<EpiRow, pg8::StaticOrder, true, true>(lds, g, S, e, otid());
}
__device__ __forceinline__ void ph_gemm_bf(LAS unsigned char* lds, const bf16_t* A, const bf16_t* Bt, int M, int N, int K, bf16_t* O, const LAS float* rowscale, const LAS float* colscale, int ldc, const float* mu, float* edge, const float* qg, const float* kg) {
    pg8::Gemm g{A, Bt, M, N, K, 0}; EpiBf e{O, rowscale, colscale, ldc, mu, edge, lds, qg, kg};
    pg8::StaticOrder S; S.init(M, N, NWG, (int)blockIdx.x);
    pg8::gemm_phase<EpiBf, pg8::StaticOrder, true, true>(lds, g, S, e, otid());
}

__device__ __forceinline__ void ph_qknorm(bf16_t* __restrict__ P, const float* __restrict__ qg, const float* __restrict__ kg, int rows) {
    const int tid0 = otid(); const int lane = tid0 & 63;
    const float* gp = (lane < 32 ? qg : kg) + 16 * (lane & 3); const float gs = lane < 32 ? 0.125f * 1.44269504f : 1.f;
    float gv[16];
#pragma unroll
    for (int j = 0; j < 16; ++j) gv[j] = gp[j] * gs;
#pragma unroll 2
    for (int row = blockIdx.x * 8 + (tid0 >> 6); row < rows; row += NWG * 8) {
        bf16_t* p = P + (size_t)row * PCW + QOFF + 16 * lane;
        const u32x4 a = *(const u32x4*)p, c = *(const u32x4*)(p + 8);
        const unsigned w[8] = {a.x, a.y, a.z, a.w, c.x, c.y, c.z, c.w};
        float f[16]; float ss = 0.f;
#pragma unroll
        for (int j = 0; j < 8; ++j) { f[2 * j] = __uint_as_float(w[j] << 16); f[2 * j + 1] = __uint_as_float(w[j] & 0xffff0000u); ss += f[2 * j] * f[2 * j] + f[2 * j + 1] * f[2 * j + 1]; }
        ss += __int_as_float(__builtin_amdgcn_update_dpp(0, __float_as_int(ss), 0xB1, 0xf, 0xf, false));
        ss += __int_as_float(__builtin_amdgcn_update_dpp(0, __float_as_int(ss), 0x4E, 0xf, 0xf, false));
        const float sc = rsqrtf(ss * (1.f / 64.f) + 1e-6f);
        u32x4 o0, o1;
        o0.x = pk2bf(f[0] * sc * gv[0], f[1] * sc * gv[1]); o0.y = pk2bf(f[2] * sc * gv[2], f[3] * sc * gv[3]); o0.z = pk2bf(f[4] * sc * gv[4], f[5] * sc * gv[5]); o0.w = pk2bf(f[6] * sc * gv[6], f[7] * sc * gv[7]);
        o1.x = pk2bf(f[8] * sc * gv[8], f[9] * sc * gv[9]); o1.y = pk2bf(f[10] * sc * gv[10], f[11] * sc * gv[11]); o1.z = pk2bf(f[12] * sc * gv[12], f[13] * sc * gv[13]); o1.w = pk2bf(f[14] * sc * gv[14], f[15] * sc * gv[15]);
        *(u32x4*)p = o0; *(u32x4*)(p + 8) = o1;
    }
}
constexpr int NK_PITCH = 144, NK_BYTES = 576 * NK_PITCH, NV_BYTES = 576 * 64 * 2, L_NK = 0, L_NV = NK_BYTES, L_RPB = NK_BYTES + NV_BYTES;
static_assert(L_RPB + 15 * 32 * 4 <= LDS_MISC, "neighbourhood attention LDS map");
__device__ __forceinline__ void natten_item_lds(LAS unsigned char* lds, const LAS float* rpbl, bf16_t* __restrict__ mixb, int b, int h, int r, int g, int lo, const u32x4 q0, const u32x4 q1, int lane) {
    const int rs = min(max(r - 4, 0), 56);
    const int kc0 = (g == 0) ? 0 : (g == 1) ? 8 : (g == 2) ? 24 : 32;
    const int n = lane & 15, kq = lane >> 4;
    const int tok0 = b * SEQ;
    f32x4 sc_[16];
    const int cq = 16 * g + n, cs = min(max(cq - 8, 0), 48);
    const LAS unsigned char* kl = lds + L_NK + (unsigned)((lo * 64 + kc0 + 8 * (n >> 2) + (n & 3)) * NK_PITCH + 16 * kq);
#pragma unroll
    for (int bi = 0; bi < 16; ++bi) {
        const int i = bi >> 1, nb = bi & 1;
        const u32x4 ka = *(const LAS u32x4*)(kl + (i * 64 + 4 * nb) * NK_PITCH), kc = *(const LAS u32x4*)(kl + (i * 64 + 4 * nb) * NK_PITCH + 64);
        f32x4 acc = (f32x4){0.f, 0.f, 0.f, 0.f};
        acc = __builtin_amdgcn_mfma_f32_16x16x32_bf16(__builtin_bit_cast(bf16x8, ka), __builtin_bit_cast(bf16x8, q0), acc, 0, 0, 0);
        acc = __builtin_amdgcn_mfma_f32_16x16x32_bf16(__builtin_bit_cast(bf16x8, kc), __builtin_bit_cast(bf16x8, q1), acc, 0, 0, 0);
        const LAS float* brow = rpbl + (rs + i - r + 7) * 32;
#pragma unroll
        for (int e = 0; e < 4; ++e) {
            const int kcn = kc0 + 8 * kq + 4 * nb + e;
            const bool valid = (kcn >= cs) && (kcn < cs + 16);
            const int ci = valid ? min(max(kcn - cq + 15, 0), 30) : 31;
            float bv = brow[ci]; asm volatile("" : "+v"(bv));
            acc[e] += bv;
        }
        sc_[bi] = acc;
        if ((bi & 3) == 3) __builtin_amdgcn_sched_barrier(0);
    }
    float mx = -1e30f;
#pragma unroll
    for (int q = 0; q < 16; ++q) mx = fmaxf(fmaxf(fmaxf(mx, sc_[q][0]), fmaxf(sc_[q][1], sc_[q][2])), sc_[q][3]);
    mx = fmaxf(mx, shx(mx, 16, lane)); mx = fmaxf(mx, shx(mx, 32, lane));
    float l = 0.f;
#pragma unroll
    for (int q = 0; q < 16; ++q)
#pragma unroll
        for (int e = 0; e < 4; ++e) { const float pe = __builtin_amdgcn_exp2f(sc_[q][e] - mx); sc_[q][e] = pe; l += pe; }
    l += shx(l, 16, lane); l += shx(l, 32, lane);
    __builtin_amdgcn_sched_barrier(0);
    f32x4 o[4];
#pragma unroll
    for (int d = 0; d < 4; ++d) o[d] = (f32x4){0.f, 0.f, 0.f, 0.f};
    const LAS unsigned char* vl = lds + L_NV + (unsigned)((((lo * 64 + kc0) >> 3) + kq) * 1024 + n * 16);
#pragma unroll
    for (int i = 0; i < 8; ++i) {
        u32x4 pa; pa.x = pk2bf(sc_[2 * i][0], sc_[2 * i][1]); pa.y = pk2bf(sc_[2 * i][2], sc_[2 * i][3]); pa.z = pk2bf(sc_[2 * i + 1][0], sc_[2 * i + 1][1]); pa.w = pk2bf(sc_[2 * i + 1][2], sc_[2 * i + 1][3]);
        const bf16x8 pf = __builtin_bit_cast(bf16x8, pa);
#pragma unroll
        for (int d = 0; d < 4; ++d) {
            const u32x4 vf = *(const LAS u32x4*)(vl + i * 8192 + d * 256);
            o[d] = __builtin_amdgcn_mfma_f32_16x16x32_bf16(__builtin_bit_cast(bf16x8, vf), pf, o[d], 0, 0, 0);
        }
        if (i & 1) __builtin_amdgcn_sched_barrier(0);
    }
    const float li = 1.f / l;
    char* ob = (char*)(mixb + (size_t)(tok0 + r * 64 + 16 * g) * 1024 + 512 + h * 64);
    const unsigned oo = (unsigned)(n * 1024 + 4 * kq) * 2u;
#pragma unroll
    for (int d = 0; d < 4; ++d) *(u32x2*)(ob + oo + 32 * d) = (u32x2){pk2bf(o[d][0] * li, o[d][1] * li), pk2bf(o[d][2] * li, o[d][3] * li)};
}
__device__ __forceinline__ void ph_natten(LAS unsigned char* lds, const bf16_t* P, const bf16_t* VT, int gr, int nseq, const float* rpb, bf16_t* mixb, int wg, int nwg) {
    const int tid0 = otid(); const int lane = tid0 & 63, wave = __builtin_amdgcn_readfirstlane(tid0 >> 6);
    const int h = wg & 7, r0 = 2 * (wg >> 3), r = r0 + (wave >> 2), g = wave & 3;
    const int rsA = min(max(r0 - 4, 0), 56), lo = min(max(r - 4, 0), 56) - rsA;
    const int n = lane & 15, kq = lane >> 4;
    (void)gr; (void)nwg;
    __syncthreads();
    for (int i = tid0; i < 15 * 32; i += NT) { const int rr = i >> 5, cc = i & 31; ((LAS float*)(lds + L_RPB))[i] = (cc < 31) ? 1.44269504f * rpb[h * 15 * 31 + rr * 31 + cc] : -1e30f; }
    u32x4 pk[9], pv[9], q0, q1;
    auto issue = [&](int b) {
        const int tok0 = b * SEQ;
#pragma unroll
        for (int k = 0; k < 9; ++k) {
            const int p = tid0 + NT * k, ts = p >> 3, lr = ts >> 6, col = ts & 63;
            const int row = min(rsA + lr, 63);
            pk[k] = *(const u32x4*)((const char*)(P + (size_t)(tok0 + row * 64 + col) * PCW + KOFF + h * 64) + 16 * (p & 7));
            const int tb = p >> 6, dim = p & 63, lrv = tb >> 3, rowv = min(rsA + lrv, 63);
            pv[k] = *(const u32x4*)(VT + (size_t)(((tok0 + rowv * 64) >> 3) + (tb & 7)) * 4096 + (h * 64 + dim) * 8);
        }
        const char* qb = (const char*)(P + (size_t)(tok0 + r * 64 + 16 * g) * PCW + QOFF + h * 64) + (unsigned)(n * PCW + 8 * kq) * 2u;
        q0 = *(const u32x4*)qb; q1 = *(const u32x4*)(qb + 64);
    };
    issue(0);
    for (int b = 0; b < nseq; ++b) {
        __syncthreads();
#pragma unroll
        for (int k = 0; k < 9; ++k) {
            const int p = tid0 + NT * k;
            *(LAS u32x4*)(lds + L_NK + (p >> 3) * NK_PITCH + 16 * (p & 7)) = pk[k];
            *(LAS u32x4*)(lds + L_NV + p * 16) = pv[k];
        }
        const u32x4 cq0 = q0, cq1 = q1;
        __syncthreads();
        if (b + 1 < nseq) issue(b + 1);
        natten_item_lds(lds, (const LAS float*)(lds + L_RPB), mixb, b, h, r, g, lo, cq0, cq1, lane);
    }
}
constexpr int EPI_W = 135168, EPI_R = EPI_W + 4096;
struct EpiFfn {
    static constexpr bool PERM = true, AFTER_DRAIN = false, APERM = true;
    LAS unsigned char* lds;
    bf16_t* act; float* edge; const float* rstd; const float* cw; const float* cb;
    typedef float f32x2v __attribute__((ext_vector_type(2)));
    static __device__ __forceinline__ f32x2v ld2(const float* base, unsigned byteoff) { return *(const f32x2v*)((const char*)base + byteoff); }
    __device__ __forceinline__ void operator()(const pg8::f32x4 (&acc)[2][2][4][2], const pg8::Unit& u, int wr, int wc, int fr_in, int fq_in) const {
        const int lane_ = olane();
        const int fr = lane_ & 15, fq = lane_ >> 4; (void)fr_in; (void)fq_in;
        const unsigned g0 = (unsigned)(u.pn * 128 + wc * 32 + 8 * fq);
        {
            const int tid_ = (wr * 4 + wc) * 64 + lane_;
            LAS float* Wl = (LAS float*)(lds + EPI_W);
#pragma unroll
            for (int q = 0; q < 2; ++q) {
                const int idx = tid_ + 512 * q, k = idx >> 7, j = idx & 127;
                const float* src = ((k & 3) < 3 ? cw + (k & 3) * UPC : cb) + (k >> 2) * DFF + u.pn * 128 + j;
                Wl[idx] = *src;
            }
            __syncthreads();
        }
#pragma unroll
        for (int n = 0; n < 2; ++n) {
#pragma unroll
            for (int ai = 0; ai < 2; ++ai) {
                const int lane2 = olane();
                const int fr = lane2 & 15, fq = lane2 >> 4;
                const unsigned g0 = (unsigned)(u.pn * 128 + wc * 32 + 8 * fq);
                const LAS float* Wl = (const LAS float*)(lds + EPI_W) + (wc * 32 + 8 * fq);
                const bool isedge = (fr == 0) || (fr == 15);
                const unsigned rowbase = (unsigned)(u.pm * 256 + ai * 128 + wr * 64);
                const f32x4 rs = *(const LAS f32x4*)((const LAS float*)(lds + RS_A) + (wr * 64 + ai * 128 + 4 * fr));
                const unsigned eoff = (((rowbase >> 6) * 4 + (unsigned)(fr == 0 ? 0 : 2)) * UPC + g0 + 4 * n) * 4u;
                unsigned outp[4][2];
                const f32x4 wg0 = *(const LAS f32x4*)(Wl + 0 * 128 + 4 * n), wg1 = *(const LAS f32x4*)(Wl + 1 * 128 + 4 * n), wg2 = *(const LAS f32x4*)(Wl + 2 * 128 + 4 * n), bg4 = *(const LAS f32x4*)(Wl + 3 * 128 + 4 * n);
                const f32x4 wv0 = *(const LAS f32x4*)(Wl + 4 * 128 + 4 * n), wv1 = *(const LAS f32x4*)(Wl + 5 * 128 + 4 * n), wv2 = *(const LAS f32x4*)(Wl + 6 * 128 + 4 * n), bv4 = *(const LAS f32x4*)(Wl + 7 * 128 + 4 * n);
#pragma unroll
                for (int e = 0; e < 4; ++e) {
                    float cg[4], cv[4];
                    const float wg0e = wg0[e], wg1e = wg1[e], wg2e = wg2[e], bge = bg4[e], wv0e = wv0[e], wv1e = wv1[e], wv2e = wv2[e], bve = bv4[e];
                    {
                        float x[4];
#pragma unroll
                        for (int m = 0; m < 4; ++m) x[m] = acc[ai][0][m][n][e] * rs[m];
                        if (isedge) { *(float*)((char*)edge + eoff + 4u * e) = (fr == 0) ? x[0] : x[2]; *(float*)((char*)edge + eoff + UPC * 4u + 4u * e) = (fr == 0) ? x[1] : x[3]; }
                        const float up = dppf<0x111>(x[3]), dn = dppf<0x101>(x[0]);
                        cg[0] = fmaf(wg0e, up, fmaf(wg1e, x[0], fmaf(wg2e, x[1], bge))); cg[1] = fmaf(wg0e, x[0], fmaf(wg1e, x[1], fmaf(wg2e, x[2], bge)));
                        cg[2] = fmaf(wg0e, x[1], fmaf(wg1e, x[2], fmaf(wg2e, x[3], bge))); cg[3] = fmaf(wg0e, x[2], fmaf(wg1e, x[3], fmaf(wg2e, dn, bge)));
                    }
                    {
                        float x[4];
#pragma unroll
                        for (int m = 0; m < 4; ++m) x[m] = acc[ai][1][m][n][e] * rs[m];
                        if (isedge) { *(float*)((char*)edge + eoff + DFF * 4u + 4u * e) = (fr == 0) ? x[0] : x[2]; *(float*)((char*)edge + eoff + (UPC + DFF) * 4u + 4u * e) = (fr == 0) ? x[1] : x[3]; }
                        const float up = dppf<0x111>(x[3]), dn = dppf<0x101>(x[0]);
                        cv[0] = fmaf(wv0e, up, fmaf(wv1e, x[0], fmaf(wv2e, x[1], bve))); cv[1] = fmaf(wv0e, x[0], fmaf(wv1e, x[1], fmaf(wv2e, x[2], bve)));
                        cv[2] = fmaf(wv0e, x[1], fmaf(wv1e, x[2], fmaf(wv2e, x[3], bve))); cv[3] = fmaf(wv0e, x[2], fmaf(wv1e, x[3], fmaf(wv2e, dn, bve)));
                    }
#pragma unroll
                    for (int m = 0; m < 4; ++m) {
                        const float o = (cg[m] * cv[m]) * __builtin_amdgcn_rcpf(1.f + __builtin_amdgcn_exp2f(-1.44269504f * cg[m]));
                        outp[m][e >> 1] = (e & 1) ? cvtpk(__uint_as_float(outp[m][e >> 1]), o) : __float_as_uint(o);
                    }
                    __builtin_amdgcn_sched_barrier(0);
                }
#pragma unroll
                for (int m = 0; m < 4; ++m) {
                    const unsigned rib = 4 * (unsigned)fr + m;
                    if (rib != 0 && rib != 63) *(u32x2*)((char*)act + ((rowbase + rib) * DFF + g0 + 4 * n) * 2u) = (u32x2){outp[m][0], outp[m][1]};
                }
                asm volatile("" ::: "memory");
            }
        }
    }
};
__device__ __forceinline__ void ph_gemm_ffn(LAS unsigned char* lds, const bf16_t* A, const bf16_t* Bt, int M, bf16_t* act, float* edge, const float* rstd, const float* cw, const float* cb) {
    pg8::Gemm g{A, Bt, M, UPC, D, 0}; EpiFfn e{lds, act, edge, rstd, cw, cb};
    pg8::StaticOrder S; S.init(M, UPC, NWG, (int)blockIdx.x);
    pg8::gemm_phase<EpiFfn, pg8::StaticOrder, true, true>(lds, g, S, e, otid());
}
__device__ __forceinline__ void ph_ffn_fix(const float* __restrict__ edge, const float* __restrict__ cw, const float* __restrict__ cb, bf16_t* __restrict__ act, int rows) {
    typedef float f2 __attribute__((ext_vector_type(2)));
    const int tid0 = otid(); (void)rows;
    constexpr int CP = DFF / 2;
    const int cq = (int)blockIdx.x, blk0 = 4 * (8 * (cq & 7) + ((cq >> 3) & 7)) + (cq >> 6);
#pragma unroll 3
    for (int pl = tid0; pl < 2 * CP; pl += NT) {
        const int il = (pl >= CP) ? 1 : 0, it = blk0 * 2 + il, c = 2 * (pl - il * CP);
        const int blk = it >> 1, last = it & 1;
        const int row = blk * 64 + (last ? 63 : 0), t = row & (SEQ - 1);
        const float* cur = edge + ((size_t)blk * 4 + (last ? 3 : 0)) * UPC;
        const bool hp = last ? true : (t > 0), hn = last ? (t < SEQ - 1) : true;
        const float* prv = last ? edge + ((size_t)blk * 4 + 2) * UPC : edge + ((size_t)(hp ? blk - 1 : blk) * 4 + 3) * UPC;
        const float* nxt = last ? edge + ((size_t)(hn ? blk + 1 : blk) * 4 + 0) * UPC : edge + ((size_t)blk * 4 + 1) * UPC;
        const f2 w0g = *(const f2*)(cw + c), w1g = *(const f2*)(cw + UPC + c), w2g = *(const f2*)(cw + 2 * UPC + c), bg = *(const f2*)(cb + c);
        const f2 w0v = *(const f2*)(cw + DFF + c), w1v = *(const f2*)(cw + UPC + DFF + c), w2v = *(const f2*)(cw + 2 * UPC + DFF + c), bv = *(const f2*)(cb + DFF + c);
        const f2 cg = *(const f2*)(cur + c), cv = *(const f2*)(cur + DFF + c);
        f2 pg = *(const f2*)(prv + c), pv = *(const f2*)(prv + DFF + c), ng = *(const f2*)(nxt + c), nv = *(const f2*)(nxt + DFF + c);
        if (!hp) { pg = (f2){0.f, 0.f}; pv = pg; }
        if (!hn) { ng = (f2){0.f, 0.f}; nv = ng; }
        const f2 g = w1g * cg + bg + w0g * pg + w2g * ng, v = w1v * cv + bv + w0v * pv + w2v * nv;
        const float o0 = g[0] * sigmoidf_(g[0]) * v[0], o1 = g[1] * sigmoidf_(g[1]) * v[1];
        *(unsigned*)(act + (size_t)row * DFF + c) = cvtpk(o0, o1);
    }
}

constexpr int NSEG = 4, SEGTOK = SEQ / NSEG;
constexpr int OP_AP = 0, OP_RP = 2048, OP_MX2 = 4096, OP_MD = 5120, OP_MY = 6144, OP_GP = 7168, OP_VT = 11264, OP_GC = 13312, OP_SIZE = 13568;
constexpr int LS_OPS = 0, LS_LABT = 8 * OP_SIZE, LS_MU = LS_LABT + 8 * 1024, LS_CST = LS_MU + 3 * 7 * 64 * 4, LS_WL = LS_CST + 6 * 64 * 4, LS_EOF = LS_WL + 36 * 1024, LS_END = LS_EOF + 1024;
constexpr int WL_DEC = 0, WL_AAA = 8 * 1024, WL_VU = 16 * 1024, WL_G = 20 * 1024;
static_assert(LS_END <= LDS_MISC, "scan unit LDS map");

template <int CTRL> __device__ __forceinline__ float dpp_mov(float x) { return __int_as_float(__builtin_amdgcn_update_dpp(0, __float_as_int(x), CTRL, 0xf, 0xf, false)); }
template <int CTRL> __device__ __forceinline__ unsigned dpp_keep(unsigned old, unsigned src) { return (unsigned)__builtin_amdgcn_update_dpp((int)old, (int)src, CTRL, 0xf, 0xf, false); }
__device__ __forceinline__ float fsig(float z) { return __builtin_amdgcn_rcpf(1.f + __builtin_amdgcn_exp2f(z)); }
__device__ __forceinline__ float ftanh(float z) { return 1.f - 2.f * __builtin_amdgcn_rcpf(1.f + __builtin_amdgcn_exp2f(z)); }
__device__ __forceinline__ f32v2_t bfpair(unsigned u) { return (f32v2_t){__uint_as_float(u << 16), __uint_as_float(u & 0xffff0000u)}; }
__device__ __forceinline__ u32x4 pack8(const float* v) { u32x4 r; r.x = cvtpk(v[0], v[1]); r.y = cvtpk(v[2], v[3]); r.z = cvtpk(v[4], v[5]); r.w = cvtpk(v[6], v[7]); return r; }

struct ScanW {
    const float *mu, *w0, *a0, *v0, *kk_, *ka, *rk;
    const float* pedge;
    const bf16_t *WdecT, *WaaaT, *WgT, *WvuT;
};

template <int NKS> __device__ __forceinline__ void lora_mm(const LAS unsigned char* wl, const u32x4 (&xf)[NKS], float (&out)[16]) {
#pragma unroll
    for (int nb = 0; nb < 4; ++nb) {
        f32x4 acc = (f32x4){0.f, 0.f, 0.f, 0.f};
#pragma unroll
        for (int ks = 0; ks < NKS; ++ks)
            acc = __builtin_amdgcn_mfma_f32_16x16x32_bf16(*(const LAS bf16x8*)(wl + (nb * NKS + ks) * 1024), __builtin_bit_cast(bf16x8, xf[ks]), acc, 0, 0, 0);
        out[4 * nb + 0] = acc[0]; out[4 * nb + 1] = acc[1]; out[4 * nb + 2] = acc[2]; out[4 * nb + 3] = acc[3];
    }
}

template <int V> struct IC { static constexpr int value = V; };
template <int N> __device__ __forceinline__ unsigned edge_lo(unsigned v) { if constexpr (N == 0) return v; else return (unsigned)__builtin_amdgcn_update_dpp(0, (int)v, 0x100 + N, 0xf, 0xf, true); }
template <int N> __device__ __forceinline__ unsigned edge_hi(unsigned v) { if constexpr (N == 0) return v; else return (unsigned)__builtin_amdgcn_update_dpp(0, (int)v, 0x110 + N, 0xf, 0xf, true); }
__device__ __forceinline__ void scan_unit(LAS unsigned char* lds, int unit, int layer, const bf16_t* __restrict__ P, const ScanW& w,
                                          bf16_t* __restrict__ ybuf, bf16_t* __restrict__ gbuf, bf16_t* __restrict__ mixb, bf16_t* __restrict__ vfirst, float* __restrict__ sbon,
                                          bf16_t* __restrict__ yaug, float* __restrict__ segst) {
    const int tid = otid(), lane = tid & 63, wave = __builtin_amdgcn_readfirstlane(tid >> 6);
    const int seg = unit & (NSEG - 1), chain = unit / NSEG;
    const int h = chain & 7, dir = (chain >> 3) & 1, b = chain >> 4;
    const int tokbase = b * SEQ;
    const int t = lane & 15, kq = lane >> 4;
    auto segcol = [&](int s_) { return s_ < 3 ? s_ * 512 + h * 64 : s_ == 3 ? O_WD + dir * 64 : s_ == 4 ? O_AD + dir * 64 : O_GD + (s_ - 5) * 64; };
    if (tid < 384) {
        const int which = tid >> 6, ch = h * 64 + (tid & 63);
        const float v = (which == 0) ? w.kk_[ch] : (which == 1) ? w.ka[ch] : (which == 2) ? w.rk[ch] : (which == 3) ? w.w0[dir * 512 + ch] : (which == 4) ? w.a0[dir * 512 + ch] : ((layer > 0) ? w.v0[ch] : 0.f);
        ((LAS float*)(lds + LS_CST))[tid] = (which >= 3) ? -1.44269504f * v : v;
    }
    for (int i = tid; i < 36 * 64; i += NT) {
        const int f = i >> 6, n = i & 15, q = (i >> 4) & 3;
        const bf16_t* src; int Kw, nb, ks;
        if (f < 8)       { src = w.WdecT + (size_t)dir * 512 * 64; Kw = 64; nb = f >> 1; ks = f & 1; }
        else if (f < 16) { src = w.WaaaT + (size_t)dir * 512 * 64; Kw = 64; nb = (f - 8) >> 1; ks = f & 1; }
        else if (f < 20) { src = w.WvuT; Kw = 32; nb = f - 16; ks = 0; }
        else             { src = w.WgT; Kw = 128; nb = (f - 20) >> 2; ks = (f - 20) & 3; }
        const bf16_t* p = src + (h * 64 + 16 * nb + n) * Kw + 32 * ks + 4 * q;
        const u32x2 lo = *(const u32x2*)p, hi = *(const u32x2*)(p + 16);
        *(LAS u32x4*)(lds + LS_WL + i * 16) = (u32x4){lo.x, lo.y, hi.x, hi.y};
    }
    __syncthreads();

    f32x4 St[4];
    const bool augw = wave >= 4; const int colw = 16 * (wave & 3) + t;
#pragma unroll
    for (int jb = 0; jb < 4; ++jb)
#pragma unroll
        for (int e = 0; e < 4; ++e) St[jb][e] = (augw && (16 * jb + 4 * kq + e) == colw) ? 1.f : 0.f;

    {
        typedef float f2 __attribute__((ext_vector_type(2)));
        const int tseg = dir ? (NSEG - 1 - seg) : seg;
        const int blk0 = (tokbase + tseg * SEGTOK) >> 6;
#pragma unroll 1
        for (int hb = 0; hb < 2; ++hb) {
            f2 cv[7], pv[7], nv[7], a0[7], a1[7]; unsigned po[7];
#pragma unroll
            for (int i = 0; i < 7; ++i) {
                const int p = tid + NT * (hb * 7 + i);
                const int itl = p / 224, c2 = p - itl * 224;
                const int col = segcol(c2 >> 5) + 2 * (c2 & 31);
                const int blk = blk0 + (itl >> 1), last = itl & 1;
                const int row = blk * 64 + (last ? 63 : 0), tt = row & (SEQ - 1);
                const bool hp = last ? true : (tt > 0), hn = last ? (tt < SEQ - 1) : true;
                const float* cur = w.pedge + ((size_t)blk * 4 + (last ? 3 : 0)) * MIXC + col;
                const float* prv = last ? w.pedge + ((size_t)blk * 4 + 2) * MIXC + col : w.pedge + ((size_t)(hp ? blk - 1 : blk) * 4 + 3) * MIXC + col;
                const float* nxt = last ? w.pedge + ((size_t)(hn ? blk + 1 : blk) * 4 + 0) * MIXC + col : w.pedge + ((size_t)blk * 4 + 1) * MIXC + col;
                cv[i] = *(const f2*)cur; pv[i] = *(const f2*)prv; nv[i] = *(const f2*)nxt;
                a0[i] = *(const f2*)(w.mu + col); a1[i] = *(const f2*)(w.mu + RWC + col);
                if (!hp) pv[i] = (f2){0.f, 0.f};
                if (!hn) nv[i] = (f2){0.f, 0.f};
                po[i] = (unsigned)row * (unsigned)PCW + (unsigned)col;
            }
#pragma unroll
            for (int i = 0; i < 7; ++i) {
                const f2 o = ((f2){1.f, 1.f} - a0[i] - a1[i]) * cv[i] + a0[i] * pv[i] + a1[i] * nv[i];
                *(unsigned*)((bf16_t*)P + po[i]) = cvtpk(o[0], o[1]);
            }
        }
        asm volatile("s_waitcnt vmcnt(0)" ::: "memory");
        __syncthreads();
    }
    const char* Pc = (const char*)P;
    u32x2 rc[7][4], fz[3][2], EL[2], EH[2];
    EL[0] = EL[1] = EH[0] = EH[1] = (u32x2){0u, 0u};
    const int colLo = dir ? 1984 : 1952, colHi = dir ? 1952 : 1984;
    auto piece_col = [&](int p, int foldcol) { const int sg = p >> 2, g = p & 3; return (p < 28 ? segcol(sg) + 16 * g : foldcol + 16 * (p & 1)) * 2 + 8 * kq; };
    if (tid < 64) *(LAS u32x4*)(lds + LS_EOF + tid * 16) = (u32x4){(unsigned)piece_col(t, colLo), (unsigned)piece_col((t + 16) & 31, colLo), (unsigned)piece_col(15 - t, colHi), (unsigned)piece_col(31 - t, colHi)};
    auto issue_loads = [&](int it_) {
        const int gb = seg * (SEGTOK / 16) + it_ * 8 + wave;
        const int st = 16 * gb + t;
        const int tok = dir ? (SEQ - 1 - st) : st;
        const unsigned ro = (unsigned)(tokbase + tok) * (unsigned)(PCW * 2) + 8u * kq;
        const int sL = 16 * gb - 1, sH = 16 * gb + 16;
        const bool vL_ = gb > 0, vH_ = gb < SEQ / 16 - 1;
        const int tL = vL_ ? (dir ? (SEQ - 1 - sL) : sL) : 0, tH = vH_ ? (dir ? (SEQ - 1 - sH) : sH) : 0;
        const unsigned rl = (unsigned)(tokbase + tL) * (unsigned)(PCW * 2), rh = (unsigned)(tokbase + tH) * (unsigned)(PCW * 2);
#pragma unroll
        for (int sg = 0; sg < 7; ++sg) {
            if (sg >= 5 && (it_ & 1)) continue;
            const int col = segcol(sg);
#pragma unroll
            for (int g = 0; g < 4; ++g) rc[sg][g] = *(const u32x2*)(Pc + ro + col * 2 + 32 * g);
        }
        const u32x4 eo4 = *(const LAS u32x4*)(lds + LS_EOF + lane * 16);
        const unsigned zo_ = 2016u * 2u + 8u * (unsigned)(lane & 3);
        if (layer > 0) { EL[1] = *(const u32x2*)(Pc + (rl + (vL_ ? eo4.y : zo_))); EH[1] = *(const u32x2*)(Pc + (rh + (vH_ ? eo4.w : zo_))); }
        if (layer > 0) {
#pragma unroll
            for (int g = 0; g < 2; ++g) { fz[0][g] = *(const u32x2*)(Pc + ro + 1920 * 2 + 32 * g); fz[1][g] = *(const u32x2*)(Pc + ro + colLo * 2 + 32 * g); fz[2][g] = *(const u32x2*)(Pc + ro + colHi * 2 + 32 * g); }
        }
    };
#pragma unroll
    for (int sg = 0; sg < 7; ++sg)
#pragma unroll
        for (int g = 0; g < 4; ++g) rc[sg][g] = (u32x2){0u, 0u};
#pragma unroll
    for (int g = 0; g < 2; ++g) { fz[0][g] = fz[1][g] = fz[2][g] = (u32x2){0u, 0u}; }
    __syncthreads();
    issue_loads(0);
    for (int it = 0; it < SEGTOK / 128; ++it) {
        {
            if (wave >= 4) __builtin_amdgcn_s_sleep(3);
            int lane_o = lane; asm volatile("" : "+v"(lane_o));
            const int t = lane_o & 15, kq = lane_o >> 4;
            const LAS unsigned char* WL = lds + LS_WL + lane_o * 16;
            const LAS float* CST = (const LAS float*)(lds + LS_CST) + 4 * kq;
            LAS unsigned char* myop = lds + LS_OPS + wave * OP_SIZE;
            LAS float* labt = (LAS float*)(lds + LS_LABT + wave * 1024);
            const int lane = lane_o;
            const int gb = seg * (SEGTOK / 16) + it * 8 + wave;
            const int st = 16 * gb + t;
            const int tok = dir ? (SEQ - 1 - st) : st;
            const unsigned grow = (unsigned)(tokbase + tok);
            u32x2 vf[4];
#pragma unroll
            for (int g = 0; g < 4; ++g) vf[g] = (u32x2){0u, 0u};
            if (layer > 0) {
#pragma unroll
                for (int g = 0; g < 4; ++g) vf[g] = *(const u32x2*)((const char*)vfirst + (grow * 1024u + (unsigned)((h * 64 + 16 * g + 4 * kq) * 2)));
            }
            auto seg_mix = [&](auto sgc, float (&out)[16]) {
                constexpr int sg = decltype(sgc)::value;
#pragma unroll
                for (int g = 0; g < 4; ++g) {
                    const u32x2 c = rc[sg][g];
                    out[4 * g + 0] = __uint_as_float(c.x << 16); out[4 * g + 1] = __uint_as_float(c.x & 0xffff0000u); out[4 * g + 2] = __uint_as_float(c.y << 16); out[4 * g + 3] = __uint_as_float(c.y & 0xffff0000u);
                }
            };
            auto cst16 = [&](int which, float (&out)[16]) {
#pragma unroll
                for (int g = 0; g < 4; ++g) { const f32x4 v = *(const LAS f32x4*)(CST + which * 64 + 16 * g); out[4 * g] = v[0]; out[4 * g + 1] = v[1]; out[4 * g + 2] = v[2]; out[4 * g + 3] = v[3]; }
            };
            u32x4 selE, selO;
            {
                const unsigned wv = (kq == (t >> 2)) ? (0x3F80u << (16 * (t & 1))) : 0u;
                const unsigned w0_ = (t & 2) ? 0u : wv, w1_ = (t & 2) ? wv : 0u;
                selE = (u32x4){w0_, w1_, 0u, 0u}; selO = (u32x4){0u, 0u, w0_, w1_};
            }
            if ((it & 1) == 0) {
                float g0[16], g1[16]; seg_mix(IC<5>{}, g0); seg_mix(IC<6>{}, g1);
#pragma unroll
                for (int i = 0; i < 16; ++i) { g0[i] = fsig(g0[i]); g1[i] = fsig(g1[i]); }
                u32x4 xf[4]; xf[0] = pack8(g0); xf[1] = pack8(g0 + 8); xf[2] = pack8(g1); xf[3] = pack8(g1 + 8);
                float go[16]; lora_mm<4>(WL + WL_G, xf, go);
#pragma unroll
                for (int g = 0; g < 4; ++g) *(u32x2*)((char*)gbuf + (grow * 1024u + (unsigned)((h * 64 + 16 * g + 4 * kq) * 2))) = (u32x2){cvtpk(go[4 * g], go[4 * g + 1]), cvtpk(go[4 * g + 2], go[4 * g + 3])};
            }
            float kv[16], kk[16];
            seg_mix(IC<1>{}, kv);
            {
                float c_[16]; cst16(0, c_);
                float ss = 0.f;
#pragma unroll
                for (int i = 0; i < 16; ++i) { kk[i] = kv[i] * c_[i]; ss += kk[i] * kk[i]; }
                ss += shx(ss, 16, lane); ss += shx(ss, 32, lane);
                const float rn = __builtin_amdgcn_rsqf(fmaxf(ss, 1e-12f));
#pragma unroll
                for (int i = 0; i < 16; ++i) kk[i] *= rn;
            }
            float kd[16], bb[16];
            {
                float ain[16]; seg_mix(IC<4>{}, ain);
                u32x4 xf[2]; xf[0] = pack8(ain); xf[1] = pack8(ain + 8);
                float xa[16]; lora_mm<2>(WL + WL_AAA, xf, xa);
                float a0c[16], kac[16]; cst16(4, a0c); cst16(1, kac);
#pragma unroll
                for (int i = 0; i < 16; ++i) { const float a = fsig(xa[i] + a0c[i]); kd[i] = kv[i] * (1.f + (a - 1.f) * kac[i]); bb[i] = kk[i] * a; }
            }
            float rv[16];
            seg_mix(IC<0>{}, rv);
            {
                float rkc[16]; cst16(2, rkc);
                float bon = 0.f;
#pragma unroll
                for (int i = 0; i < 16; ++i) bon += rv[i] * kd[i] * rkc[i];
                bon += shx(bon, 16, lane); bon += shx(bon, 32, lane);
                if (kq == 0) *(float*)((char*)sbon + (grow * 64u + (unsigned)((dir * 8 + h) * 4))) = bon;
            }
            {
                float vv[16]; seg_mix(IC<2>{}, vv);
                if (layer > 0) {
                    float hid[8];
                    {
                        const u32x2 z0 = fz[0][0], cl = fz[1][0], ch_ = fz[2][0];
                        const f32v2_t s0 = bfpair(z0.x) + bfpair(dpp_keep<0x111>(edge_lo<12>(EL[1].x), cl.x)) + bfpair(dpp_keep<0x101>(edge_hi<12>(EH[1].x), ch_.x));
                        const f32v2_t s1 = bfpair(z0.y) + bfpair(dpp_keep<0x111>(edge_lo<12>(EL[1].y), cl.y)) + bfpair(dpp_keep<0x101>(edge_hi<12>(EH[1].y), ch_.y));
                        hid[0] = s0[0]; hid[1] = s0[1]; hid[2] = s1[0]; hid[3] = s1[1];
                    }
                    {
                        const u32x2 z0 = fz[0][1], cl = fz[1][1], ch_ = fz[2][1];
                        const f32v2_t s0 = bfpair(z0.x) + bfpair(dpp_keep<0x111>(edge_lo<13>(EL[1].x), cl.x)) + bfpair(dpp_keep<0x101>(edge_hi<13>(EH[1].x), ch_.x));
                        const f32v2_t s1 = bfpair(z0.y) + bfpair(dpp_keep<0x111>(edge_lo<13>(EL[1].y), cl.y)) + bfpair(dpp_keep<0x101>(edge_hi<13>(EH[1].y), ch_.y));
                        hid[4] = s0[0]; hid[5] = s0[1]; hid[6] = s1[0]; hid[7] = s1[1];
                    }
                    u32x4 xf[1]; xf[0] = pack8(hid);
                    float xm[16]; lora_mm<1>(WL + WL_VU, xf, xm);
                    float v0c[16]; cst16(5, v0c);
#pragma unroll
                    for (int g = 0; g < 4; ++g) {
                        const f32v2_t f0 = bfpair(vf[g].x), f1 = bfpair(vf[g].y);
                        vv[4 * g + 0] += (f0[0] - vv[4 * g + 0]) * fsig(xm[4 * g + 0] + v0c[4 * g + 0]); vv[4 * g + 1] += (f0[1] - vv[4 * g + 1]) * fsig(xm[4 * g + 1] + v0c[4 * g + 1]);
                        vv[4 * g + 2] += (f1[0] - vv[4 * g + 2]) * fsig(xm[4 * g + 2] + v0c[4 * g + 2]); vv[4 * g + 3] += (f1[1] - vv[4 * g + 3]) * fsig(xm[4 * g + 3] + v0c[4 * g + 3]);
                    }
                }
                u32x4 vp[2]; vp[0] = pack8(vv); vp[1] = pack8(vv + 8);
                if (dir == 1) {
                    const unsigned pv[8] = {vp[0].x, vp[0].y, vp[0].z, vp[0].w, vp[1].x, vp[1].y, vp[1].z, vp[1].w};
#pragma unroll
                    for (int g = 0; g < 4; ++g) {
                        const u32x2 q = (u32x2){pv[2 * g], pv[2 * g + 1]};
                        *(u32x2*)((char*)mixb + (grow * 2048u + (unsigned)((h * 64 + 16 * g + 4 * kq) * 2))) = q;
                        if (layer == 0) *(u32x2*)((char*)vfirst + (grow * 1024u + (unsigned)((h * 64 + 16 * g + 4 * kq) * 2))) = q;
                    }
                }
#pragma unroll
                for (int ib = 0; ib < 4; ++ib) {
                    const f32x4 z = (f32x4){0.f, 0.f, 0.f, 0.f};
                    const f32x4 d = __builtin_amdgcn_mfma_f32_16x16x32_bf16(__builtin_bit_cast(bf16x8, vp[ib >> 1]), __builtin_bit_cast(bf16x8, (ib & 1) ? selO : selE), z, 0, 0, 0);
                    *(LAS u32x2*)(myop + OP_VT + (ib * 64 + lane) * 8) = (u32x2){cvtpk(d[0], d[1]), cvtpk(d[2], d[3])};
                }
            }
            u32x4 apf[2], rpf[2], btf[2], ktf[2], bgf[2], kgf[2];
            {
                float lw[16];
                {
                    float win[16]; seg_mix(IC<3>{}, win);
#pragma unroll
                    for (int i = 0; i < 16; ++i) win[i] = ftanh(win[i]);
                    u32x4 xf[2]; xf[0] = pack8(win); xf[1] = pack8(win + 8);
                    float xw[16]; lora_mm<2>(WL + WL_DEC, xf, xw);
                    float w0c[16]; cst16(3, w0c);
#pragma unroll
                    for (int i = 0; i < 16; ++i) lw[i] = -0.87503878f * fsig(xw[i] + w0c[i]);
                }
                float at[16], rt[16], bt[16], kt[16], bg[16], kg[16], gC[16];
#pragma unroll
                for (int i = 0; i < 16; ++i) {
                    float lam = lw[i];
                    lam += dpp_mov<0x111>(lam); lam += dpp_mov<0x112>(lam); lam += dpp_mov<0x114>(lam); lam += dpp_mov<0x118>(lam);
                    const float e3 = __builtin_amdgcn_exp2f(lam), e2 = __builtin_amdgcn_exp2f(-lam);
                    const float g = shl_(e3, (lane & 48) | 15);
                    const float e1 = __int_as_float(__builtin_amdgcn_update_dpp(0x3f800000, __float_as_int(e3), 0x111, 0xf, 0xf, false));
                    const float ge = g * e2;
                    gC[i] = g; at[i] = kk[i] * e1; rt[i] = rv[i] * e3; bt[i] = bb[i] * e2; kt[i] = kd[i] * e2; bg[i] = -bb[i] * ge; kg[i] = kd[i] * ge;
                }
                apf[0] = pack8(at); apf[1] = pack8(at + 8); rpf[0] = pack8(rt); rpf[1] = pack8(rt + 8); btf[0] = pack8(bt); btf[1] = pack8(bt + 8);
                ktf[0] = pack8(kt); ktf[1] = pack8(kt + 8); bgf[0] = pack8(bg); bgf[1] = pack8(bg + 8); kgf[0] = pack8(kg); kgf[1] = pack8(kg + 8);
                if (t == 0) {
#pragma unroll
                    for (int g = 0; g < 4; ++g) *(LAS f32x4*)(myop + OP_GC + (kq * 16 + 4 * g) * 4) = (f32x4){gC[4 * g], gC[4 * g + 1], gC[4 * g + 2], gC[4 * g + 3]};
                }
            }
            *(LAS u32x4*)(myop + OP_AP + lane * 16) = apf[0]; *(LAS u32x4*)(myop + OP_AP + 1024 + lane * 16) = apf[1];
            *(LAS u32x4*)(myop + OP_RP + lane * 16) = rpf[0]; *(LAS u32x4*)(myop + OP_RP + 1024 + lane * 16) = rpf[1];
            {
                f32x4 lab = (f32x4){0.f, 0.f, 0.f, 0.f}, lak = lab, lrb = lab, lrk = lab;
#pragma unroll
                for (int ks = 0; ks < 2; ++ks) {
                    lab = __builtin_amdgcn_mfma_f32_16x16x32_bf16(__builtin_bit_cast(bf16x8, btf[ks]), __builtin_bit_cast(bf16x8, apf[ks]), lab, 0, 0, 0);
                    lak = __builtin_amdgcn_mfma_f32_16x16x32_bf16(__builtin_bit_cast(bf16x8, ktf[ks]), __builtin_bit_cast(bf16x8, apf[ks]), lak, 0, 0, 0);
                    lrb = __builtin_amdgcn_mfma_f32_16x16x32_bf16(__builtin_bit_cast(bf16x8, btf[ks]), __builtin_bit_cast(bf16x8, rpf[ks]), lrb, 0, 0, 0);
                    lrk = __builtin_amdgcn_mfma_f32_16x16x32_bf16(__builtin_bit_cast(bf16x8, ktf[ks]), __builtin_bit_cast(bf16x8, rpf[ks]), lrk, 0, 0, 0);
                }
#pragma unroll
                for (int e = 0; e < 4; ++e) {
                    const int s = 4 * kq + e;
                    const bool lo = s < t, le = s <= t;
                    lab[e] = lo ? lab[e] : 0.f; lak[e] = lo ? lak[e] : 0.f; lrb[e] = le ? -lrb[e] : 0.f; lrk[e] = le ? lrk[e] : 0.f;
                    labt[s * 16 + t] = lab[e];
                }
                u32x4 mx; mx.x = 0u; mx.y = 0u; mx.z = cvtpk(lak[0], lak[1]); mx.w = cvtpk(lak[2], lak[3]);
                u32x4 my; my.x = cvtpk(lrb[0], lrb[1]); my.y = cvtpk(lrb[2], lrb[3]); my.z = cvtpk(lrk[0], lrk[1]); my.w = cvtpk(lrk[2], lrk[3]);
                *(LAS u32x4*)(myop + OP_MX2 + lane * 16) = mx; *(LAS u32x4*)(myop + OP_MY + lane * 16) = my;
            }
#pragma unroll
            for (int jb = 0; jb < 4; ++jb) {
                const f32x4 z = (f32x4){0.f, 0.f, 0.f, 0.f};
                const bf16x8 sel = __builtin_bit_cast(bf16x8, (jb & 1) ? selO : selE);
                const f32x4 d0 = __builtin_amdgcn_mfma_f32_16x16x32_bf16(__builtin_bit_cast(bf16x8, bgf[jb >> 1]), sel, z, 0, 0, 0);
                const f32x4 d1 = __builtin_amdgcn_mfma_f32_16x16x32_bf16(__builtin_bit_cast(bf16x8, kgf[jb >> 1]), sel, z, 0, 0, 0);
                u32x4 gp; gp.x = cvtpk(d0[0], d0[1]); gp.y = cvtpk(d0[2], d0[3]); gp.z = cvtpk(d1[0], d1[1]); gp.w = cvtpk(d1[2], d1[3]);
                *(LAS u32x4*)(myop + OP_GP + (jb * 64 + lane) * 16) = gp;
            }
            {
                const int s = t;
                float x[16];
#pragma unroll
                for (int q = 0; q < 16; ++q) x[q] = (q == s) ? 1.f : 0.f;
#pragma unroll
                for (int q = 0; q < 15; ++q) {
                    const f32x4 l0 = *(const LAS f32x4*)(labt + q * 16), l1 = *(const LAS f32x4*)(labt + q * 16 + 4), l2 = *(const LAS f32x4*)(labt + q * 16 + 8), l3 = *(const LAS f32x4*)(labt + q * 16 + 12);
                    const float lq[16] = {l0[0], l0[1], l0[2], l0[3], l1[0], l1[1], l1[2], l1[3], l2[0], l2[1], l2[2], l2[3], l3[0], l3[1], l3[2], l3[3]};
#pragma unroll
                    for (int r = q + 1; r < 16; ++r) x[r] -= lq[r] * x[q];
                }
                LAS bf16_t* md = (LAS bf16_t*)(myop + OP_MD) + (16 * (s >> 2)) * 8 + (s & 3);
#pragma unroll
                for (int j = 0; j < 4; ++j) {
                    const float xv = (kq == 0) ? x[j] : (kq == 1) ? x[4 + j] : (kq == 2) ? x[8 + j] : x[12 + j];
                    md[(4 * kq + j) * 8] = f2bf(xv);
                }
                { unsigned z_ = 0u; asm volatile("" : "+v"(z_)); *(LAS u32x2*)(myop + OP_MD + lane * 16 + 8) = (u32x2){z_, z_}; }
            }
        }
        __syncthreads();
        if (it + 1 < SEGTOK / 128) issue_loads(it + 1);
        int lane_c = lane; asm volatile("" : "+v"(lane_c));
#pragma unroll 1
        for (int c = 0; c < 8; ++c) {
            const int lane = lane_c, kq = lane_c >> 4, colc = 16 * (wave & 3) + (lane_c & 15);
            const LAS unsigned char* op = lds + LS_OPS + c * OP_SIZE;
            u32x2 vt = *(const LAS u32x2*)(op + OP_VT + ((wave & 3) * 64 + lane) * 8);
            if (augw) vt = (u32x2){0u, 0u};
            u32x4 sb0, sb1;
            sb0.x = cvtpk(St[0][0], St[0][1]); sb0.y = cvtpk(St[0][2], St[0][3]); sb0.z = cvtpk(St[1][0], St[1][1]); sb0.w = cvtpk(St[1][2], St[1][3]);
            sb1.x = cvtpk(St[2][0], St[2][1]); sb1.y = cvtpk(St[2][2], St[2][3]); sb1.z = cvtpk(St[3][0], St[3][1]); sb1.w = cvtpk(St[3][2], St[3][3]);
            const bf16x8 ap0 = *(const LAS bf16x8*)(op + OP_AP + lane * 16), ap1 = *(const LAS bf16x8*)(op + OP_AP + 1024 + lane * 16);
            const bf16x8 rp0 = *(const LAS bf16x8*)(op + OP_RP + lane * 16), rp1 = *(const LAS bf16x8*)(op + OP_RP + 1024 + lane * 16);
            const bf16x8 mx2 = *(const LAS bf16x8*)(op + OP_MX2 + lane * 16), mdm = *(const LAS bf16x8*)(op + OP_MD + lane * 16), mym = *(const LAS bf16x8*)(op + OP_MY + lane * 16);
            u32x4 b0v; b0v.x = 0u; b0v.y = 0u; b0v.z = vt.x; b0v.w = vt.y;
            f32x4 ax = (f32x4){0.f, 0.f, 0.f, 0.f};
            ax = __builtin_amdgcn_mfma_f32_16x16x32_bf16(mx2, __builtin_bit_cast(bf16x8, b0v), ax, 0, 0, 0);
            ax = __builtin_amdgcn_mfma_f32_16x16x32_bf16(ap0, __builtin_bit_cast(bf16x8, sb0), ax, 0, 0, 0);
            ax = __builtin_amdgcn_mfma_f32_16x16x32_bf16(ap1, __builtin_bit_cast(bf16x8, sb1), ax, 0, 0, 0);
            f32x4 ay = (f32x4){0.f, 0.f, 0.f, 0.f};
            ay = __builtin_amdgcn_mfma_f32_16x16x32_bf16(rp0, __builtin_bit_cast(bf16x8, sb0), ay, 0, 0, 0);
            ay = __builtin_amdgcn_mfma_f32_16x16x32_bf16(rp1, __builtin_bit_cast(bf16x8, sb1), ay, 0, 0, 0);
            u32x4 bx; bx.x = cvtpk(ax[0], ax[1]); bx.y = cvtpk(ax[2], ax[3]); bx.z = 0u; bx.w = 0u;
            f32x4 ad = (f32x4){0.f, 0.f, 0.f, 0.f};
            ad = __builtin_amdgcn_mfma_f32_16x16x32_bf16(mdm, __builtin_bit_cast(bf16x8, bx), ad, 0, 0, 0);
            u32x4 dv; dv.x = cvtpk(ad[0], ad[1]); dv.y = cvtpk(ad[2], ad[3]); dv.z = vt.x; dv.w = vt.y;
            ay = __builtin_amdgcn_mfma_f32_16x16x32_bf16(mym, __builtin_bit_cast(bf16x8, dv), ay, 0, 0, 0);
#pragma unroll
            for (int jb = 0; jb < 4; ++jb) {
                const f32x4 gc = *(const LAS f32x4*)(op + OP_GC + (kq * 16 + 4 * jb) * 4);
                const bf16x8 gp = *(const LAS bf16x8*)(op + OP_GP + (jb * 64 + lane) * 16);
                St[jb] = __builtin_amdgcn_mfma_f32_16x16x32_bf16(gp, __builtin_bit_cast(bf16x8, dv), St[jb] * gc, 0, 0, 0);
            }
            if (!augw || seg > 0) {
                bf16_t* yb = augw ? yaug : ybuf;
                const int sg0 = 16 * (seg * (SEGTOK / 16) + it * 8 + c) + 4 * kq;
#pragma unroll
                for (int e = 0; e < 4; ++e) { const int tk = dir ? (SEQ - 1 - (sg0 + e)) : (sg0 + e); *(bf16_t*)((char*)yb + ((unsigned)((tokbase + tk) * 2 + dir) * 1024u + (unsigned)((h * 64 + colc) * 2))) = f2bf(ay[e]); }
            }
        }
        __syncthreads();
    }
    if (seg + 1 < NSEG) {
        int lane_f = lane; asm volatile("" : "+v"(lane_f));
        const int kq = lane_f >> 4, colw = 16 * (wave & 3) + (lane_f & 15);
        float* dst = segst + ((size_t)unit * 2 + (augw ? 1 : 0)) * 4096;
#pragma unroll
        for (int jb = 0; jb < 4; ++jb)
#pragma unroll
            for (int e = 0; e < 4; ++e) dst[(16 * jb + 4 * kq + e) * 64 + colw] = St[jb][e];
    }
}

__device__ __forceinline__ void ph_segfix(LAS unsigned char* lds, const float* __restrict__ segst, bf16_t* __restrict__ SS, int nchain) {
    static_assert(GSEQ * 16 * 4 == NWG, "four workgroups per chain");
    const int tid = otid(), j = tid >> 3, ig = tid & 7; (void)nchain;
    LAS float* Sp = (LAS float*)lds;
    const int chain = (int)blockIdx.x & 63, c0 = ((int)blockIdx.x >> 6) * 16 + 2 * ig;
    float acc[2], cn[2]; f32x4 an[16];
#pragma unroll
    for (int q4 = 0; q4 < 16; ++q4) an[q4] = (f32x4){0.f, 0.f, 0.f, 0.f};
    {
        const float* Cp = segst + ((size_t)(chain * NSEG + 0) * 2 + 0) * 4096 + j * 64 + c0;
        cn[0] = Cp[0]; cn[1] = Cp[1];
    }
    for (int k = 1; k < NSEG; ++k) {
        f32x4 ar[16];
        acc[0] = cn[0]; acc[1] = cn[1];
#pragma unroll
        for (int q4 = 0; q4 < 16; ++q4) ar[q4] = an[q4];
        if (k + 1 < NSEG) {
            const float* Cp = segst + ((size_t)(chain * NSEG + k) * 2 + 0) * 4096 + j * 64 + c0;
            const float* Ap = segst + ((size_t)(chain * NSEG + k) * 2 + 1) * 4096 + j * 64;
            cn[0] = Cp[0]; cn[1] = Cp[1];
#pragma unroll
            for (int q4 = 0; q4 < 16; ++q4) an[q4] = *(const f32x4*)(Ap + 4 * q4);
        }
        if (k > 1) {
#pragma unroll
            for (int q = 0; q < 64; ++q) {
                const float a = ar[q >> 2][q & 3];
                const float s0 = Sp[q * 16 + 2 * ig], s1 = Sp[q * 16 + 2 * ig + 1];
                acc[0] += a * s0; acc[1] += a * s1;
            }
        }
        __syncthreads();
#pragma unroll
        for (int e = 0; e < 2; ++e) { Sp[j * 16 + 2 * ig + e] = acc[e]; SS[((size_t)(chain * NSEG + k) * 64 + c0 + e) * 64 + j] = f2bf(acc[e]); }
        __syncthreads();
    }
}
__device__ __forceinline__ void ph_ycorr(const bf16_t* __restrict__ yaug, const bf16_t* __restrict__ SS, bf16_t* __restrict__ ybuf, int nchain) {
    const int tid = otid(), lane = tid & 63, wave = tid >> 6, il = lane & 15, kq = lane >> 4;
    constexpr int TPS = SEGTOK / 16, IPC = (NSEG - 1) * TPS;
    for (int it = blockIdx.x * 8 + wave; it < nchain * IPC; it += NWG * 8) {
        const int chain = it / IPC, r = it % IPC, seg = 1 + r / TPS, tile = r % TPS;
        const int h = chain & 7, dir = (chain >> 3) & 1, b = chain >> 4;
        const int st0 = seg * SEGTOK + 16 * tile, t0 = dir ? (SEQ - 16 - st0) : st0;
        const size_t rowbase = ((size_t)(b * SEQ + t0) * 2 + dir) * 512 + h * 64;
        const bf16x8 a0 = *(const bf16x8*)(yaug + rowbase + (size_t)il * 1024 + 8 * kq), a1 = *(const bf16x8*)(yaug + rowbase + (size_t)il * 1024 + 32 + 8 * kq);
        const bf16_t* ssp = SS + (size_t)(chain * NSEG + seg) * 4096;
#pragma unroll
        for (int nb = 0; nb < 4; ++nb) {
            const bf16x8 b0 = *(const bf16x8*)(ssp + (16 * nb + il) * 64 + 8 * kq), b1 = *(const bf16x8*)(ssp + (16 * nb + il) * 64 + 32 + 8 * kq);
            f32x4 acc = (f32x4){0.f, 0.f, 0.f, 0.f};
            acc = __builtin_amdgcn_mfma_f32_16x16x32_bf16(a0, b0, acc, 0, 0, 0);
            acc = __builtin_amdgcn_mfma_f32_16x16x32_bf16(a1, b1, acc, 0, 0, 0);
#pragma unroll
            for (int e = 0; e < 4; ++e) { bf16_t* yp = ybuf + rowbase + (size_t)(4 * kq + e) * 1024 + 16 * nb + il; *yp = f2bf(bf2f(*yp) + acc[e]); }
        }
    }
}

__device__ __forceinline__ void ph_post2(const bf16_t* __restrict__ ybuf, const bf16_t* __restrict__ gbuf, const float* __restrict__ sbon, const float* __restrict__ lg, const float* __restrict__ lb,
                                         bf16_t* __restrict__ mixb, int rows) {
    const int c = otid(), h = c >> 6, lane = c & 63;
    const float lgc = lg[c], lbc = lb[c];
    for (int t = blockIdx.x; t < rows; t += NWG) {
        const float y = bf2f(ybuf[(size_t)t * 1024 + c]) + bf2f(ybuf[(size_t)t * 1024 + 512 + c]);
        const float mu = wave_sum(y, lane) * (1.f / 64.f); const float dv = y - mu; const float var = wave_sum(dv * dv, lane) * (1.f / 64.f);
        const float yn = dv * rsqrtf(var + 64e-5f) * lgc + lbc;
        const float bon = sbon[(size_t)t * 16 + h] + sbon[(size_t)t * 16 + 8 + h];
        const float o = (yn + bon * bf2f(mixb[(size_t)t * 1024 + c])) * bf2f(gbuf[(size_t)t * 512 + c]);
        mixb[(size_t)t * 1024 + c] = f2bf(o);
    }
}

__device__ __forceinline__ void ph_fold(LAS unsigned char* lds, const float* __restrict__ win1, const float* __restrict__ g1, const float* __restrict__ mu1, const float* __restrict__ vdown, bf16_t* __restrict__ WinT1) {
    const int tid0 = otid(); const int lane = tid0 & 63, wave = tid0 >> 6;
    constexpr int VP = 520;
    __syncthreads();
    for (int i = tid0; i < 512 * 32; i += NT) ((LAS float*)lds)[(i & 31) * VP + (i >> 5)] = vdown[i];
    __syncthreads();
    const int k = (int)blockIdx.x * 8 + wave;
    if (k < D) {
        const int c0 = 8 * lane;
        float cz[8], cp[8], cn[8];
#pragma unroll
        for (int i = 0; i < 8; ++i) {
            const float wv = win1[(size_t)k * INC + 1024 + c0 + i], a = mu1[1024 + c0 + i], bb = mu1[RWC + 1024 + c0 + i];
            cz[i] = wv * (1.f - a - bb); cp[i] = wv * a; cn[i] = wv * bb;
        }
        const float gk = g1[k];
#pragma unroll 4
        for (int j = 0; j < 32; ++j) {
            const f32x4 v0 = *(const LAS f32x4*)((const LAS float*)lds + j * VP + c0), v1 = *(const LAS f32x4*)((const LAS float*)lds + j * VP + c0 + 4);
            float s0 = 0.f, s1 = 0.f, s2 = 0.f;
#pragma unroll
            for (int i = 0; i < 4; ++i) { s0 = fmaf(cz[i], v0[i], s0); s1 = fmaf(cp[i], v0[i], s1); s2 = fmaf(cn[i], v0[i], s2); s0 = fmaf(cz[4 + i], v1[i], s0); s1 = fmaf(cp[4 + i], v1[i], s1); s2 = fmaf(cn[4 + i], v1[i], s2); }
            s0 = wave_sum(s0, lane); s1 = wave_sum(s1, lane); s2 = wave_sum(s2, lane);
            if (lane == 0) {
                WinT1[(size_t)(1920 + j) * D + k] = f2bf(s0 * gk); WinT1[(size_t)(1952 + j) * D + k] = f2bf(s1 * gk); WinT1[(size_t)(1984 + j) * D + k] = f2bf(s2 * gk);
            }
        }
    }
}


__device__ __forceinline__ void ph_post3(LAS unsigned char* lds, const bf16_t* __restrict__ ybuf, const bf16_t* __restrict__ yaug, const bf16_t* __restrict__ SS, const bf16_t* __restrict__ gbuf, const float* __restrict__ sbon,
                                         const float* __restrict__ lg, const float* __restrict__ lb, bf16_t* __restrict__ mixb, int nseq) {
    const int tid = otid(), lane = tid & 63, wave = tid >> 6, il = lane & 15, kq = lane >> 4;
    (void)nseq;
    const int h = (int)blockIdx.x & 7, part = ((int)blockIdx.x >> 3) & 7, b = (int)blockIdx.x >> 6;
    const int segf = part >> 1, segb = (NSEG - 1) - (part >> 1);
    __syncthreads();
    for (int p = tid; p < 2 * 64 * 8; p += NT) {
        const int d = p >> 9, row = (p >> 3) & 63, pc = p & 7, seg = d ? segb : segf;
        const bf16_t* src = SS + (size_t)(((b * 2 + d) * 8 + h) * NSEG + seg) * 4096 + row * 64 + 8 * pc;
        *(LAS u32x4*)(lds + d * (64 * 144) + row * 144 + 16 * pc) = *(const u32x4*)src;
    }
    __syncthreads();
    f32x4 g4_[4], b4_[4];
#pragma unroll
    for (int mb = 0; mb < 4; ++mb) { g4_[mb] = *(const f32x4*)(lg + h * 64 + 16 * mb + 4 * kq); b4_[mb] = *(const f32x4*)(lb + h * 64 + 16 * mb + 4 * kq); }
    u32x2 nvq[4], ngq[4], nyb[2][4]; bf16x8 nya[2][2]; float nbo0, nbo1;
#pragma unroll
    for (int d = 0; d < 2; ++d) { nya[d][0] = (bf16x8){0, 0, 0, 0, 0, 0, 0, 0}; nya[d][1] = nya[d][0]; }
    auto load_item = [&](int k_) {
        const size_t tr = (size_t)(b * SEQ + 16 * (32 * part + wave + 8 * k_) + il);
#pragma unroll
        for (int mb = 0; mb < 4; ++mb) {
            const int ch = h * 64 + 16 * mb + 4 * kq;
            nvq[mb] = *(const u32x2*)(mixb + tr * 1024 + ch); ngq[mb] = *(const u32x2*)(gbuf + tr * 512 + ch);
        }
        nbo0 = sbon[tr * 16 + h]; nbo1 = sbon[tr * 16 + 8 + h];
#pragma unroll
        for (int dir = 0; dir < 2; ++dir) {
            const size_t ro = (tr * 2 + dir) * 512 + h * 64;
#pragma unroll
            for (int mb = 0; mb < 4; ++mb) nyb[dir][mb] = *(const u32x2*)(ybuf + ro + 16 * mb + 4 * kq);
            if ((dir ? segb : segf) > 0) { nya[dir][0] = *(const bf16x8*)(yaug + ro + 8 * kq); nya[dir][1] = *(const bf16x8*)(yaug + ro + 32 + 8 * kq); }
        }
    };
    load_item(0);
    for (int k = 0; k < 4; ++k) {
        const int tb = 32 * part + wave + 8 * k;
        const int t0 = 16 * tb;
        const size_t tokrow = (size_t)(b * SEQ + t0 + il);
        u32x2 vq_[4], gq_[4], yb_[2][4]; bf16x8 ya_[2][2];
#pragma unroll
        for (int mb = 0; mb < 4; ++mb) { vq_[mb] = nvq[mb]; gq_[mb] = ngq[mb]; yb_[0][mb] = nyb[0][mb]; yb_[1][mb] = nyb[1][mb]; }
#pragma unroll
        for (int d = 0; d < 2; ++d) { ya_[d][0] = nya[d][0]; ya_[d][1] = nya[d][1]; }
        const float bon = nbo0 + nbo1;
        if (k + 1 < 4) load_item(k + 1);
        float y[4][4];
#pragma unroll
        for (int mb = 0; mb < 4; ++mb)
#pragma unroll
            for (int e = 0; e < 4; ++e) y[mb][e] = 0.f;
#pragma unroll
        for (int dir = 0; dir < 2; ++dir) {
#pragma unroll
            for (int mb = 0; mb < 4; ++mb) {
                const u32x2 q = yb_[dir][mb];
                y[mb][0] += __uint_as_float(q.x << 16); y[mb][1] += __uint_as_float(q.x & 0xffff0000u); y[mb][2] += __uint_as_float(q.y << 16); y[mb][3] += __uint_as_float(q.y & 0xffff0000u);
            }
            if ((dir ? segb : segf) > 0) {
                const bf16x8 y0 = ya_[dir][0], y1 = ya_[dir][1];
                const LAS unsigned char* ssl = lds + dir * (64 * 144) + il * 144 + 16 * kq;
#pragma unroll
                for (int mb = 0; mb < 4; ++mb) {
                    const bf16x8 a0 = *(const LAS bf16x8*)(ssl + mb * (16 * 144)), a1 = *(const LAS bf16x8*)(ssl + mb * (16 * 144) + 64);
                    f32x4 acc = (f32x4){y[mb][0], y[mb][1], y[mb][2], y[mb][3]};
                    acc = __builtin_amdgcn_mfma_f32_16x16x32_bf16(a0, y0, acc, 0, 0, 0);
                    acc = __builtin_amdgcn_mfma_f32_16x16x32_bf16(a1, y1, acc, 0, 0, 0);
                    y[mb][0] = acc[0]; y[mb][1] = acc[1]; y[mb][2] = acc[2]; y[mb][3] = acc[3];
                }
            }
        }
        float s = 0.f;
#pragma unroll
        for (int mb = 0; mb < 4; ++mb) s += (y[mb][0] + y[mb][1]) + (y[mb][2] + y[mb][3]);
        s += shx(s, 16, lane); s += shx(s, 32, lane);
        const float mu = s * (1.f / 64.f); float q2 = 0.f;
#pragma unroll
        for (int mb = 0; mb < 4; ++mb)
#pragma unroll
            for (int e = 0; e < 4; ++e) { y[mb][e] -= mu; q2 += y[mb][e] * y[mb][e]; }
        q2 += shx(q2, 16, lane); q2 += shx(q2, 32, lane);
        const float rs = rsqrtf(q2 * (1.f / 64.f) + 64e-5f);
#pragma unroll
        for (int mb = 0; mb < 4; ++mb) {
            const int ch = h * 64 + 16 * mb + 4 * kq;
            const f32x4 g4 = g4_[mb], b4 = b4_[mb];
            const u32x2 vq = vq_[mb], gq = gq_[mb];
            const float v0 = __uint_as_float(vq.x << 16), v1 = __uint_as_float(vq.x & 0xffff0000u), v2 = __uint_as_float(vq.y << 16), v3 = __uint_as_float(vq.y & 0xffff0000u);
            const float g0 = __uint_as_float(gq.x << 16), g1 = __uint_as_float(gq.x & 0xffff0000u), g2 = __uint_as_float(gq.y << 16), g3 = __uint_as_float(gq.y & 0xffff0000u);
            const float o0 = (y[mb][0] * rs * g4[0] + b4[0] + bon * v0) * g0, o1 = (y[mb][1] * rs * g4[1] + b4[1] + bon * v1) * g1;
            const float o2 = (y[mb][2] * rs * g4[2] + b4[2] + bon * v2) * g2, o3 = (y[mb][3] * rs * g4[3] + b4[3] + bon * v3) * g3;
            u32x2 o; o.x = cvtpk(o0, o1); o.y = cvtpk(o2, o3);
            *(u32x2*)(mixb + tokrow * 1024 + ch) = o;
        }
    }
}
struct Args { const float* in[27]; float* out; unsigned char* ws; };
struct WsMap { size_t ctl, WinT, WvT, WoutT, WupT, WdnT, WdecT, WaaaT, WgT, WvuT, xb, rstd, vfirst, mixb, act, P, VT, ybuf, gbuf, sbon, yaug, segst, SS, U, end; };
__host__ __device__ constexpr size_t al256(size_t x) { return (x + 255) & ~(size_t)255; }
__host__ __device__ constexpr WsMap make_map() {
    WsMap m{}; size_t off = 0;
    m.ctl = off; off += al256(WS_CTL_BYTES);
    m.WinT = off; off += al256((size_t)DEPTH * PCW * D * 2); m.WvT = off; off += al256((size_t)DEPTH * 512 * D * 2); m.WoutT = off; off += al256((size_t)DEPTH * D * D * 2);
    m.WupT = off; off += al256((size_t)DEPTH * UPC * D * 2); m.WdnT = off; off += al256((size_t)DEPTH * D * DFF * 2);
    m.WdecT = off; off += al256((size_t)DEPTH * 2 * 512 * 64 * 2); m.WaaaT = off; off += al256((size_t)DEPTH * 2 * 512 * 64 * 2); m.WgT = off; off += al256((size_t)DEPTH * 512 * 128 * 2); m.WvuT = off; off += al256((size_t)512 * 32 * 2);
    m.xb = off; off += al256((size_t)2 * GR * D * 2); m.rstd = off; off += al256((size_t)2 * 4 * GR * 4); m.vfirst = off; off += al256((size_t)GR * 512 * 2);
    m.mixb = off; off += al256((size_t)GR * 1024 * 2); m.act = off; off += al256((size_t)GR * DFF * 2);
    m.U = off;
    m.P = off; off += al256((size_t)GR * PCW * 2); m.VT = off; off += al256((size_t)512 * GR * 2);
    m.ybuf = off; off += al256((size_t)GR * 1024 * 2); m.gbuf = off; off += al256((size_t)GR * 512 * 2); m.sbon = off; off += al256((size_t)GR * 16 * 4);
    m.yaug = off; off += al256((size_t)GR * 1024 * 2); m.segst = off; off += al256((size_t)GSEQ * 16 * NSEG * 2 * 4096 * 4); m.SS = off; off += al256((size_t)GSEQ * 16 * NSEG * 4096 * 2);
    if (off < m.U + (size_t)GR * UPC * 2) off = m.U + (size_t)GR * UPC * 2;
    m.end = off; return m;
}
constexpr WsMap WSM = make_map();

__global__ void __launch_bounds__(NT, 2) mega(Args args) {
    extern __shared__ __attribute__((aligned(16))) unsigned char lds_raw[];
    LAS unsigned char* lds = (LAS unsigned char*)lds_raw;
    asm volatile("v_mov_b32 v1, 0\n\tv_mov_b32 v2, 0\n\tv_mov_b32 v3, 0\n\tv_mov_b32 v4, 0\n\tv_mov_b32 v5, 0\n\tv_mov_b32 v6, 0\n\tv_mov_b32 v7, 0\n\tv_mov_b32 v8, 0\n\tv_mov_b32 v9, 0\n\tv_mov_b32 v10, 0\n\tv_mov_b32 v11, 0\n\tv_mov_b32 v12, 0\n\tv_mov_b32 v13, 0\n\tv_mov_b32 v14, 0\n\tv_mov_b32 v15, 0\n\tv_mov_b32 v16, 0\n\tv_mov_b32 v17, 0\n\tv_mov_b32 v18, 0\n\tv_mov_b32 v19, 0\n\tv_mov_b32 v20, 0\n\tv_mov_b32 v21, 0\n\tv_mov_b32 v22, 0\n\tv_mov_b32 v23, 0\n\tv_mov_b32 v24, 0\n\tv_mov_b32 v25, 0\n\tv_mov_b32 v26, 0\n\tv_mov_b32 v27, 0\n\tv_mov_b32 v28, 0\n\tv_mov_b32 v29, 0\n\tv_mov_b32 v30, 0\n\tv_mov_b32 v31, 0\n\tv_mov_b32 v32, 0\n\tv_mov_b32 v33, 0\n\tv_mov_b32 v34, 0\n\tv_mov_b32 v35, 0\n\tv_mov_b32 v36, 0\n\tv_mov_b32 v37, 0\n\tv_mov_b32 v38, 0\n\tv_mov_b32 v39, 0\n\tv_mov_b32 v40, 0\n\tv_mov_b32 v41, 0\n\tv_mov_b32 v42, 0\n\tv_mov_b32 v43, 0\n\tv_mov_b32 v44, 0\n\tv_mov_b32 v45, 0\n\tv_mov_b32 v46, 0\n\tv_mov_b32 v47, 0\n\tv_mov_b32 v48, 0\n\tv_mov_b32 v49, 0\n\tv_mov_b32 v50, 0\n\tv_mov_b32 v51, 0\n\tv_mov_b32 v52, 0\n\tv_mov_b32 v53, 0\n\tv_mov_b32 v54, 0\n\tv_mov_b32 v55, 0\n\tv_mov_b32 v56, 0\n\tv_mov_b32 v57, 0\n\tv_mov_b32 v58, 0\n\tv_mov_b32 v59, 0\n\tv_mov_b32 v60, 0\n\tv_mov_b32 v61, 0\n\tv_mov_b32 v62, 0\n\tv_mov_b32 v63, 0\n\tv_mov_b32 v64, 0\n\tv_mov_b32 v65, 0\n\tv_mov_b32 v66, 0\n\tv_mov_b32 v67, 0\n\tv_mov_b32 v68, 0\n\tv_mov_b32 v69, 0\n\tv_mov_b32 v70, 0\n\tv_mov_b32 v71, 0\n\tv_mov_b32 v72, 0\n\tv_mov_b32 v73, 0\n\tv_mov_b32 v74, 0\n\tv_mov_b32 v75, 0\n\tv_mov_b32 v76, 0\n\tv_mov_b32 v77, 0\n\tv_mov_b32 v78, 0\n\tv_mov_b32 v79, 0\n\tv_mov_b32 v80, 0\n\tv_mov_b32 v81, 0\n\tv_mov_b32 v82, 0\n\tv_mov_b32 v83, 0\n\tv_mov_b32 v84, 0\n\tv_mov_b32 v85, 0\n\tv_mov_b32 v86, 0\n\tv_mov_b32 v87, 0\n\tv_mov_b32 v88, 0\n\tv_mov_b32 v89, 0\n\tv_mov_b32 v90, 0\n\tv_mov_b32 v91, 0\n\tv_mov_b32 v92, 0\n\tv_mov_b32 v93, 0\n\tv_mov_b32 v94, 0\n\tv_mov_b32 v95, 0\n\tv_mov_b32 v96, 0\n\tv_mov_b32 v97, 0\n\tv_mov_b32 v98, 0\n\tv_mov_b32 v99, 0\n\tv_mov_b32 v100, 0\n\tv_mov_b32 v101, 0\n\tv_mov_b32 v102, 0\n\tv_mov_b32 v103, 0\n\tv_mov_b32 v104, 0\n\tv_mov_b32 v105, 0\n\tv_mov_b32 v106, 0\n\tv_mov_b32 v107, 0\n\tv_mov_b32 v108, 0\n\tv_mov_b32 v109, 0\n\tv_mov_b32 v110, 0\n\tv_mov_b32 v111, 0\n\tv_mov_b32 v112, 0\n\tv_mov_b32 v113, 0\n\tv_mov_b32 v114, 0\n\tv_mov_b32 v115, 0\n\tv_mov_b32 v116, 0\n\tv_mov_b32 v117, 0\n\tv_mov_b32 v118, 0\n\tv_mov_b32 v119, 0\n\tv_mov_b32 v120, 0\n\tv_mov_b32 v121, 0\n\tv_mov_b32 v122, 0\n\tv_mov_b32 v123, 0\n\tv_mov_b32 v124, 0\n\tv_mov_b32 v125, 0\n\tv_mov_b32 v126, 0\n\tv_mov_b32 v127, 0\n\tv_mov_b32 v128, 0\n\tv_mov_b32 v129, 0\n\tv_mov_b32 v130, 0\n\tv_mov_b32 v131, 0\n\tv_mov_b32 v132, 0\n\tv_mov_b32 v133, 0\n\tv_mov_b32 v134, 0\n\tv_mov_b32 v135, 0\n\tv_mov_b32 v136, 0\n\tv_mov_b32 v137, 0\n\tv_mov_b32 v138, 0\n\tv_mov_b32 v139, 0\n\tv_mov_b32 v140, 0\n\tv_mov_b32 v141, 0\n\tv_mov_b32 v142, 0\n\tv_mov_b32 v143, 0\n\tv_mov_b32 v144, 0\n\tv_mov_b32 v145, 0\n\tv_mov_b32 v146, 0\n\tv_mov_b32 v147, 0\n\tv_mov_b32 v148, 0\n\tv_mov_b32 v149, 0\n\tv_mov_b32 v150, 0\n\tv_mov_b32 v151, 0\n\tv_mov_b32 v152, 0\n\tv_mov_b32 v153, 0\n\tv_mov_b32 v154, 0\n\tv_mov_b32 v155, 0\n\tv_mov_b32 v156, 0\n\tv_mov_b32 v157, 0\n\tv_mov_b32 v158, 0\n\tv_mov_b32 v159, 0\n\tv_mov_b32 v160, 0\n\tv_mov_b32 v161, 0\n\tv_mov_b32 v162, 0\n\tv_mov_b32 v163, 0\n\tv_mov_b32 v164, 0\n\tv_mov_b32 v165, 0\n\tv_mov_b32 v166, 0\n\tv_mov_b32 v167, 0\n\tv_mov_b32 v168, 0\n\tv_mov_b32 v169, 0\n\tv_mov_b32 v170, 0\n\tv_mov_b32 v171, 0\n\tv_mov_b32 v172, 0\n\tv_mov_b32 v173, 0\n\tv_mov_b32 v174, 0\n\tv_mov_b32 v175, 0\n\tv_mov_b32 v176, 0\n\tv_mov_b32 v177, 0\n\tv_mov_b32 v178, 0\n\tv_mov_b32 v179, 0\n\tv_mov_b32 v180, 0\n\tv_mov_b32 v181, 0\n\tv_mov_b32 v182, 0\n\tv_mov_b32 v183, 0\n\tv_mov_b32 v184, 0\n\tv_mov_b32 v185, 0\n\tv_mov_b32 v186, 0\n\tv_mov_b32 v187, 0\n\tv_mov_b32 v188, 0\n\tv_mov_b32 v189, 0\n\tv_mov_b32 v190, 0\n\tv_mov_b32 v191, 0\n\tv_mov_b32 v192, 0\n\tv_mov_b32 v193, 0\n\tv_mov_b32 v194, 0\n\tv_mov_b32 v195, 0\n\tv_mov_b32 v196, 0\n\tv_mov_b32 v197, 0\n\tv_mov_b32 v198, 0\n\tv_mov_b32 v199, 0\n\tv_mov_b32 v200, 0\n\tv_mov_b32 v201, 0\n\tv_mov_b32 v202, 0\n\tv_mov_b32 v203, 0\n\tv_mov_b32 v204, 0\n\tv_mov_b32 v205, 0\n\tv_mov_b32 v206, 0\n\tv_mov_b32 v207, 0\n\tv_mov_b32 v208, 0\n\tv_mov_b32 v209, 0\n\tv_mov_b32 v210, 0\n\tv_mov_b32 v211, 0\n\tv_mov_b32 v212, 0\n\tv_mov_b32 v213, 0\n\tv_mov_b32 v214, 0\n\tv_mov_b32 v215, 0\n\tv_mov_b32 v216, 0\n\tv_mov_b32 v217, 0\n\tv_mov_b32 v218, 0\n\tv_mov_b32 v219, 0\n\tv_mov_b32 v220, 0\n\tv_mov_b32 v221, 0\n\tv_mov_b32 v222, 0\n\tv_mov_b32 v223, 0\n\tv_mov_b32 v224, 0\n\tv_mov_b32 v225, 0\n\tv_mov_b32 v226, 0\n\tv_mov_b32 v227, 0\n\tv_mov_b32 v228, 0\n\tv_mov_b32 v229, 0\n\tv_mov_b32 v230, 0\n\tv_mov_b32 v231, 0\n\tv_mov_b32 v232, 0\n\tv_mov_b32 v233, 0\n\tv_mov_b32 v234, 0\n\tv_mov_b32 v235, 0\n\tv_mov_b32 v236, 0\n\tv_mov_b32 v237, 0\n\tv_mov_b32 v238, 0\n\tv_mov_b32 v239, 0\n\tv_mov_b32 v240, 0\n\tv_mov_b32 v241, 0\n\tv_mov_b32 v242, 0\n\tv_mov_b32 v243, 0\n\ts_mov_b32 s20, 0\n\ts_mov_b32 s21, 0\n\ts_mov_b32 s22, 0\n\ts_mov_b32 s23, 0\n\ts_mov_b32 s24, 0\n\ts_mov_b32 s25, 0\n\ts_mov_b32 s26, 0\n\ts_mov_b32 s27, 0\n\ts_mov_b32 s28, 0\n\ts_mov_b32 s29, 0\n\ts_mov_b32 s30, 0\n\ts_mov_b32 s31, 0\n\ts_mov_b32 s32, 0\n\ts_mov_b32 s33, 0\n\ts_mov_b32 s34, 0\n\ts_mov_b32 s35, 0\n\ts_mov_b32 s36, 0\n\ts_mov_b32 s37, 0\n\ts_mov_b32 s38, 0\n\ts_mov_b32 s39, 0\n\ts_mov_b32 s40, 0\n\ts_mov_b32 s41, 0\n\ts_mov_b32 s42, 0\n\ts_mov_b32 s43, 0\n\ts_mov_b32 s44, 0\n\ts_mov_b32 s45, 0\n\ts_mov_b32 s46, 0\n\ts_mov_b32 s47, 0\n\ts_mov_b32 s48, 0\n\ts_mov_b32 s49, 0\n\ts_mov_b32 s50, 0\n\ts_mov_b32 s51, 0\n\ts_mov_b32 s52, 0\n\ts_mov_b32 s53, 0\n\ts_mov_b32 s54, 0\n\ts_mov_b32 s55, 0\n\ts_mov_b32 s56, 0\n\ts_mov_b32 s57, 0\n\ts_mov_b32 s58, 0\n\ts_mov_b32 s59, 0\n\ts_mov_b32 s60, 0\n\ts_mov_b32 s61, 0\n\ts_mov_b32 s62, 0\n\ts_mov_b32 s63, 0\n\ts_mov_b32 s64, 0\n\ts_mov_b32 s65, 0\n\ts_mov_b32 s66, 0\n\ts_mov_b32 s67, 0\n\ts_mov_b32 s68, 0\n\ts_mov_b32 s69, 0\n\ts_mov_b32 s70, 0\n\ts_mov_b32 s71, 0\n\ts_mov_b32 s72, 0\n\ts_mov_b32 s73, 0\n\ts_mov_b32 s74, 0\n\ts_mov_b32 s75, 0\n\ts_mov_b32 s76, 0\n\ts_mov_b32 s77, 0\n\ts_mov_b32 s78, 0\n\ts_mov_b32 s79, 0\n\ts_mov_b32 s80, 0\n\ts_mov_b32 s81, 0\n\ts_mov_b32 s82, 0\n\ts_mov_b32 s83, 0\n\ts_mov_b32 s84, 0\n\ts_mov_b32 s85, 0\n\ts_mov_b32 s86, 0\n\ts_mov_b32 s87, 0\n\ts_mov_b32 s88, 0\n\ts_mov_b32 s89, 0\n\ts_mov_b32 s90, 0\n\ts_mov_b32 s91, 0\n\ts_mov_b32 s92, 0\n\ts_mov_b32 s93, 0\n\ts_mov_b32 s94, 0\n\ts_mov_b32 s95, 0\n\ts_mov_b32 s96, 0\n\ts_mov_b32 s97, 0\n\ts_mov_b32 s98, 0\n\ts_mov_b32 s99, 0\n\t" ::: "v1", "v2", "v3", "v4", "v5", "v6", "v7", "v8", "v9", "v10", "v11", "v12", "v13", "v14", "v15", "v16", "v17", "v18", "v19", "v20", "v21", "v22", "v23", "v24", "v25", "v26", "v27", "v28", "v29", "v30", "v31", "v32", "v33", "v34", "v35", "v36", "v37", "v38", "v39", "v40", "v41", "v42", "v43", "v44", "v45", "v46", "v47", "v48", "v49", "v50", "v51", "v52", "v53", "v54", "v55", "v56", "v57", "v58", "v59", "v60", "v61", "v62", "v63", "v64", "v65", "v66", "v67", "v68", "v69", "v70", "v71", "v72", "v73", "v74", "v75", "v76", "v77", "v78", "v79", "v80", "v81", "v82", "v83", "v84", "v85", "v86", "v87", "v88", "v89", "v90", "v91", "v92", "v93", "v94", "v95", "v96", "v97", "v98", "v99", "v100", "v101", "v102", "v103", "v104", "v105", "v106", "v107", "v108", "v109", "v110", "v111", "v112", "v113", "v114", "v115", "v116", "v117", "v118", "v119", "v120", "v121", "v122", "v123", "v124", "v125", "v126", "v127", "v128", "v129", "v130", "v131", "v132", "v133", "v134", "v135", "v136", "v137", "v138", "v139", "v140", "v141", "v142", "v143", "v144", "v145", "v146", "v147", "v148", "v149", "v150", "v151", "v152", "v153", "v154", "v155", "v156", "v157", "v158", "v159", "v160", "v161", "v162", "v163", "v164", "v165", "v166", "v167", "v168", "v169", "v170", "v171", "v172", "v173", "v174", "v175", "v176", "v177", "v178", "v179", "v180", "v181", "v182", "v183", "v184", "v185", "v186", "v187", "v188", "v189", "v190", "v191", "v192", "v193", "v194", "v195", "v196", "v197", "v198", "v199", "v200", "v201", "v202", "v203", "v204", "v205", "v206", "v207", "v208", "v209", "v210", "v211", "v212", "v213", "v214", "v215", "v216", "v217", "v218", "v219", "v220", "v221", "v222", "v223", "v224", "v225", "v226", "v227", "v228", "v229", "v230", "v231", "v232", "v233", "v234", "v235", "v236", "v237", "v238", "v239", "v240", "v241", "v242", "v243", "s20", "s21", "s22", "s23", "s24", "s25", "s26", "s27", "s28", "s29", "s30", "s31", "s32", "s33", "s34", "s35", "s36", "s37", "s38", "s39", "s40", "s41", "s42", "s43", "s44", "s45", "s46", "s47", "s48", "s49", "s50", "s51", "s52", "s53", "s54", "s55", "s56", "s57", "s58", "s59", "s60", "s61", "s62", "s63", "s64", "s65", "s66", "s67", "s68", "s69", "s70", "s71", "s72", "s73", "s74", "s75", "s76", "s77", "s78", "s79", "s80", "s81", "s82", "s83", "s84", "s85", "s86", "s87", "s88", "s89", "s90", "s91", "s92", "s93", "s94", "s95", "s96", "s97", "s98", "s99");
    volatile LAS unsigned* misc = (volatile LAS unsigned*)(lds + LDS_MISC);
    if (threadIdx.x < 64) misc[threadIdx.x] = 0u;
    __syncthreads();
    XcdBarrier bar = xcd_barrier_post(((unsigned*)(args.ws + WSM.ctl)), misc + 8, otid() == 0);
#define GRID_BAR() xcd_barrier(bar, otid() == 0)
    if (threadIdx.x == 0) { misc[16] = 4u; misc[17] = 1u; }
    XcdBarrier gbar; gbar.bar = ((unsigned*)(args.ws + WSM.ctl)) + 16384 + 3584 * (blockIdx.x & 63u); gbar.x = 0u; gbar.st = misc + 16;
    if (threadIdx.x == 0) __hip_atomic_store(((unsigned*)(args.ws + WSM.ctl)) + 8192 + blockIdx.x, xb_xcc_id() + 1u, __ATOMIC_RELAXED, __HIP_MEMORY_SCOPE_AGENT);
#define GROUP_BAR() do { if (misc[18] == 0u) { asm volatile("s_waitcnt vmcnt(0)" ::: "memory"); __syncthreads(); if (otid() == 0) { __builtin_amdgcn_fence(__ATOMIC_RELEASE, "agent"); asm volatile("s_waitcnt vmcnt(0)" ::: "memory"); } } \
                         xcd_barrier(gbar, otid() == 0); } while (0)
#define GROUP_BAR_C(okw) do { if (misc[okw] == 0u) { asm volatile("s_waitcnt vmcnt(0)" ::: "memory"); __syncthreads(); if (otid() == 0) { __builtin_amdgcn_fence(__ATOMIC_RELEASE, "agent"); asm volatile("s_waitcnt vmcnt(0)" ::: "memory"); } } \
                               xcd_barrier(gbar, otid() == 0, false); } while (0)
    const float* const* in = args.in;
    float* X = args.out;
    constexpr int G = NWG; const int bx = (int)blockIdx.x;

    {
        const int tid0 = otid(); const int half = __builtin_amdgcn_readfirstlane(tid0 >> 8), t8 = tid0 & 255, tx = t8 & 31, ty = t8 >> 5;
        LAS float* tile = (LAS float*)(lds + half * 8448);
        constexpr int TL = 96 * 16 + 16 * 16 + 32 * 16 + 176 * 16 + 32 * 44 + 4 * 16 + 16 * 2, TT = 2 * TL + 16;
#pragma unroll 1
        for (int gt0 = 2 * bx; gt0 < TT; gt0 += 2 * NWG) {
            const int gt = gt0 + half;
            const int l = (gt >= TL && gt < 2 * TL) ? 1 : 0; int r = (gt < 2 * TL) ? gt - l * TL : -1;
            const float* W; int K_, Nsrc, Nout, mode = 0; const float* scale = nullptr; bf16_t* out; float mul = 1.f; int lt;
            if (r < 0)          { lt = gt - 2 * TL; W = in[12]; K_ = 32; Nsrc = 512; out = ((bf16_t*)(args.ws + WSM.WvuT)); Nout = 512; mul = -1.44269504f; }
            else if (r < 1536)  { lt = r; W = in[3] + (size_t)l * D * INC; K_ = D; Nsrc = INC; scale = in[2] + l * D; out = ((bf16_t*)(args.ws + WSM.WinT)) + (size_t)l * PCW * D; Nout = PCW; mode = 1; }
            else if (r < 1792)  { lt = r - 1536; W = in[3] + (size_t)l * D * INC; K_ = D; Nsrc = INC; scale = in[2] + l * D; out = ((bf16_t*)(args.ws + WSM.WvT)) + (size_t)l * 512 * D; Nout = 512; mode = 2; }
            else if (r < 2304)  { lt = r - 1792; W = in[21] + (size_t)l * D * D; K_ = D; Nsrc = D; out = ((bf16_t*)(args.ws + WSM.WoutT)) + (size_t)l * D * D; Nout = D; }
            else if (r < 5120)  { lt = r - 2304; W = in[23] + (size_t)l * D * UPC; K_ = D; Nsrc = UPC; scale = in[22] + l * D; out = ((bf16_t*)(args.ws + WSM.WupT)) + (size_t)l * UPC * D; Nout = UPC; mode = 3; }
            else if (r < 6528)  { lt = r - 5120; W = in[26] + (size_t)l * DFF * D; K_ = DFF; Nsrc = D; out = ((bf16_t*)(args.ws + WSM.WdnT)) + (size_t)l * D * DFF; Nout = D; }
            else if (r < 6560)  { const int d = (r - 6528) >> 4; lt = (r - 6528) & 15; W = in[6] + (size_t)(l * 2 + d) * 64 * 512; K_ = 64; Nsrc = 512; out = ((bf16_t*)(args.ws + WSM.WdecT)) + (size_t)(l * 2 + d) * 512 * 64; Nout = 512; mul = -1.44269504f; }
            else if (r < 6592)  { const int d = (r - 6560) >> 4; lt = (r - 6560) & 15; W = in[8] + (size_t)(l * 2 + d) * 64 * 512; K_ = 64; Nsrc = 512; out = ((bf16_t*)(args.ws + WSM.WaaaT)) + (size_t)(l * 2 + d) * 512 * 64; Nout = 512; mul = -1.44269504f; }
            else                { lt = r - 6592; W = in[9] + (size_t)l * 128 * 512; K_ = 128; Nsrc = 512; out = ((bf16_t*)(args.ws + WSM.WgT)) + (size_t)l * 512 * 128; Nout = 512; }
            const int ntn = Nout / 32, n0 = (lt % ntn) * 32, k0 = (lt / ntn) * 64;
            {
                const int n = n0 + tx; int ns = n; bool valid = true;
                if (mode == 1) { if (n < 1920) ns = n; else if (n < 2048) valid = false; else ns = n - 128; }
                if (mode == 2) ns = n + 2944;
                if (mode == 3) ns = ((n >> 7) & 1) * DFF + (n >> 8) * 128 + (n & 127);
                float cs = mul;
                if (mode == 1) { if (n >= O_WD && n < O_WD + 128) cs *= 2.88539008f; else if (n >= O_GD && n < O_GD + 128) cs *= -1.44269504f; }
                float v[8];
#pragma unroll
                for (int q = 0; q < 8; ++q) { const int k = k0 + ty + 8 * q; v[q] = (valid && k < K_) ? W[(size_t)k * Nsrc + ns] * (scale ? scale[k] : 1.f) : 0.f; }
#pragma unroll
                for (int q = 0; q < 8; ++q) tile[(ty + 8 * q) * 33 + tx] = v[q] * cs;
            }
            __syncthreads();
            if (k0 + 2 * tx < K_) {
#pragma unroll
                for (int q = 0; q < 4; ++q) { const int n = n0 + ty + 8 * q; *(unsigned*)(out + (size_t)n * K_ + k0 + 2 * tx) = cvtpk(tile[(2 * tx) * 33 + ty + 8 * q], tile[(2 * tx + 1) * 33 + ty + 8 * q]); }
            }
            __syncthreads();
        }
    }
#pragma unroll 1
    for (int grp = -1; grp < NGRP; ++grp) {
        bf16_t* xbg = (bf16_t*)(args.ws + WSM.xb) + (size_t)(grp & 1) * GR * D;
        float* ssqg = (float*)(args.ws + WSM.rstd) + (size_t)(grp & 1) * 4 * GR;
        if (grp < 0) {
            ph_rms_in(in[0], (bf16_t*)(args.ws + WSM.xb), (float*)(args.ws + WSM.rstd) + 0, GR);
            GRID_BAR();
            if (threadIdx.x == 0) {
                unsigned* xw = ((unsigned*)(args.ws + WSM.ctl)) + 8192 + (blockIdx.x & 63u);
                const unsigned a0 = xb_ld(xw), a1 = xb_ld(xw + 64), a2 = xb_ld(xw + 128), a3 = xb_ld(xw + 192);
                const bool own = (a0 != 0u && a0 == a1 && a1 == a2 && a2 == a3);
                misc[18] = own ? 1u : 0u;
                const unsigned me = xb_ld(xw + (blockIdx.x & ~63u)), g = blockIdx.x & 63u, pmq = 8u * (g & 7u) + (g >> 3);
                unsigned* xa = ((unsigned*)(args.ws + WSM.ctl)) + 8192;
                bool nb = own;
#pragma unroll
                for (int d = -1; d <= 1; d += 2) {
                    const int q = (int)pmq + d;
                    if (q >= 0 && q < 64) { const unsigned gq = ((unsigned)q & 7u) * 8u + ((unsigned)q >> 3); for (unsigned k = 0; k < 4u; ++k) nb = nb && (xb_ld(xa + gq + 64u * k) == me); }
                }
                misc[19] = nb ? 1u : 0u;
                bool pc = own;
                { const unsigned bq = g >> 4, hq = g & 7u; for (unsigned k = 0; k < 8u; ++k) pc = pc && (xb_ld(xa + bq * 64u + k * 8u + hq) == me); }
                misc[20] = pc ? 1u : 0u;
            }
            ph_fold(lds, in[3] + (size_t)1 * D * INC, in[2] + D, in[4] + (size_t)1 * 2 * RWC, in[11], ((bf16_t*)(args.ws + WSM.WinT)) + (size_t)1 * PCW * D);
            __syncthreads();
            continue;
        }
        const size_t g0 = (size_t)grp * GR;
        float* Xg = X + g0 * D;
        for (int l = 0; l < DEPTH; ++l) {
            {
                pg8::StaticOrder S; pg8::Unit u0; int bxq = bx; asm volatile("" : "+s"(bxq));
                S.init(GR, PCW, NWG, bxq); if (S.next(0, u0)) wg_rstd_from_slots((const float*)ssqg, u0.pm * 256, (LAS float*)(lds + RS_A));
                S.init(512, GR, NWG, bxq); if (S.next(0, u0)) wg_rstd_from_slots((const float*)ssqg, u0.pn * 256, (LAS float*)(lds + RS_B));
            }
#pragma unroll 1
            for (int k = 0; k < 2; ++k) {
                const bf16_t* xb_ = xbg;
                const bf16_t* wi_ = ((const bf16_t*)(args.ws + WSM.WinT)) + (size_t)l * PCW * D; const bf16_t* wv_ = ((const bf16_t*)(args.ws + WSM.WvT)) + (size_t)l * 512 * D;
                ph_gemm_bf(lds, k ? wv_ : xb_, k ? xb_ : wi_, k ? 512 : GR, k ? GR : PCW, D, k ? (bf16_t*)(args.ws + WSM.VT) : (bf16_t*)(args.ws + WSM.P),
                           k ? (const LAS float*)nullptr : (const LAS float*)(lds + RS_A), k ? (const LAS float*)(lds + RS_B) : (const LAS float*)nullptr, k ? -1 : PCW,
                           k ? (const float*)nullptr : in[4] + (size_t)l * 2 * RWC, (float*)(args.ws + WSM.act), k ? (const float*)nullptr : in[18] + l * 64, in[19] + l * 64);
            }
            GRID_BAR();
            {
                ph_natten(lds, ((bf16_t*)(args.ws + WSM.P)), ((bf16_t*)(args.ws + WSM.VT)), GR, GSEQ, in[20] + (size_t)l * 8 * 15 * 31, ((bf16_t*)(args.ws + WSM.mixb)), bx, G);
                __syncthreads();
                constexpr int NUNITS = GSEQ * 16 * NSEG;
                if (bx < NUNITS) {
                    ScanW w;
                    w.mu = in[4] + (size_t)l * 2 * RWC; w.w0 = in[5] + l * 1024; w.a0 = in[7] + l * 1024; w.v0 = in[10]; w.kk_ = in[13] + l * 512; w.ka = in[14] + l * 512; w.rk = in[15] + l * 512; w.pedge = (const float*)(args.ws + WSM.act);
                    w.WdecT = ((bf16_t*)(args.ws + WSM.WdecT)) + (size_t)l * 2 * 512 * 64; w.WaaaT = ((bf16_t*)(args.ws + WSM.WaaaT)) + (size_t)l * 2 * 512 * 64; w.WgT = ((bf16_t*)(args.ws + WSM.WgT)) + (size_t)l * 512 * 128; w.WvuT = ((bf16_t*)(args.ws + WSM.WvuT));
                    static_assert(NUNITS == G && NSEG == 4, "one scan unit per workgroup");
                    const int bxs = (bx & 63) * NSEG + (bx >> 6);
                    for (int u = bxs; u < NUNITS; u += G) { scan_unit(lds, u, l, ((bf16_t*)(args.ws + WSM.P)), w, ((bf16_t*)(args.ws + WSM.ybuf)), ((bf16_t*)(args.ws + WSM.gbuf)), ((bf16_t*)(args.ws + WSM.mixb)), ((bf16_t*)(args.ws + WSM.vfirst)), ((float*)(args.ws + WSM.sbon)), (bf16_t*)(args.ws + WSM.yaug), (float*)(args.ws + WSM.segst)); }
                }
            }
            GROUP_BAR_C(18);
#pragma unroll 1
            for (int half = 0; half < 2; ++half) {
                if (half == 0) {
                    ph_segfix(lds, (const float*)(args.ws + WSM.segst), (bf16_t*)(args.ws + WSM.SS), GSEQ * 16);
                    GROUP_BAR_C(20);
                    if (otid() == 0) {
                        unsigned* ctlw = (unsigned*)(args.ws + WSM.ctl) + 16384;
                        const unsigned n = xb_ld(gbar.bar + XB_XGEN(0));
                        const unsigned bq = (unsigned)blockIdx.x >> 6, hq = (unsigned)blockIdx.x & 7u;
                        { unsigned* w = ctlw + 3584u * ((bq * 2u) * 8u + hq) + XB_XGEN(0); XB_SPIN(xb_ld(w) < n, gbar.bar); }
                        { unsigned* w = ctlw + 3584u * ((bq * 2u + 1u) * 8u + hq) + XB_XGEN(0); XB_SPIN(xb_ld(w) < n, gbar.bar); }
                        __builtin_amdgcn_fence(__ATOMIC_ACQUIRE, "agent");
                        asm volatile("s_waitcnt vmcnt(0)" ::: "memory");
                    }
                    __syncthreads();
                    ph_post3(lds, (const bf16_t*)(args.ws + WSM.ybuf), (const bf16_t*)(args.ws + WSM.yaug), (const bf16_t*)(args.ws + WSM.SS), (const bf16_t*)(args.ws + WSM.gbuf), (const float*)(args.ws + WSM.sbon), in[16] + l * 512, in[17] + l * 512, (bf16_t*)(args.ws + WSM.mixb), GSEQ);
                    GRID_BAR();
                } else {
                    { pg8::StaticOrder S; pg8::Unit u0; S.init(GR, UPC, NWG, bx); if (S.next(0, u0)) wg_rstd_from_slots((const float*)ssqg, u0.pm * 256, (LAS float*)(lds + RS_A)); }
                    ph_gemm_ffn(lds, xbg, ((bf16_t*)(args.ws + WSM.WupT)) + (size_t)l * UPC * D, GR, ((bf16_t*)(args.ws + WSM.act)), (float*)(args.ws + WSM.U), ssqg,
                                in[24] + (size_t)l * 3 * UPC, in[25] + (size_t)l * UPC);
                    GROUP_BAR_C(19);
                    if (otid() == 0) {
                        unsigned* ctlw = (unsigned*)(args.ws + WSM.ctl) + 16384;
                        const unsigned g = (unsigned)blockIdx.x & 63u, pmq = 8u * (g & 7u) + (g >> 3);
                        const unsigned n = xb_ld(gbar.bar + XB_XGEN(0));
                        if (pmq > 0u)  { const unsigned q = pmq - 1u; unsigned* w = ctlw + 3584u * ((q & 7u) * 8u + (q >> 3)) + XB_XGEN(0); XB_SPIN(xb_ld(w) < n, gbar.bar); }
                        if (pmq < 63u) { const unsigned q = pmq + 1u; unsigned* w = ctlw + 3584u * ((q & 7u) * 8u + (q >> 3)) + XB_XGEN(0); XB_SPIN(xb_ld(w) < n, gbar.bar); }
                        __builtin_amdgcn_fence(__ATOMIC_ACQUIRE, "agent");
                        asm volatile("s_waitcnt vmcnt(0)" ::: "memory");
                    }
                    __syncthreads();
                    ph_ffn_fix((const float*)(args.ws + WSM.U), in[24] + (size_t)l * 3 * UPC, in[25] + (size_t)l * UPC, ((bf16_t*)(args.ws + WSM.act)), GR);
                    GROUP_BAR_C(18);
                }
                ph_gemm(lds, half ? (const bf16_t*)(args.ws + WSM.act) : (const bf16_t*)(args.ws + WSM.mixb),
                        half ? ((const bf16_t*)(args.ws + WSM.WdnT)) + (size_t)l * D * DFF : ((const bf16_t*)(args.ws + WSM.WoutT)) + (size_t)l * D * D, GR, D, half ? DFF : D,
                        xbg, (half == 1 && l + 1 == DEPTH) ? Xg : nullptr, ssqg);
                if (half == 1 && l + 1 == DEPTH) {
                    if (grp + 1 == NGRP) break;
                    int gn = grp + 1; asm volatile("" : "+s"(gn));
                    const size_t g1 = (size_t)gn * GR;
                    ph_rms_in((g1 < (size_t)8 * SEQ) ? in[0] + g1 * D : in[1] + (g1 - (size_t)8 * SEQ) * D, (bf16_t*)(args.ws + WSM.xb) + (size_t)(gn & 1) * GR * D, (float*)(args.ws + WSM.rstd) + (size_t)(gn & 1) * 4 * GR, GR);
                }
                if (half == 0) GROUP_BAR_C(18);
                else GRID_BAR();
            }
        }
    }
}

extern "C" void kernel_launch(void* const* d_in, const int* in_sizes, int n_in, void* d_out, int out_size, void* d_ws, size_t ws_size, hipStream_t stream) {
    static int grid = 0;
    static Args a{};
    if (grid == 0) {
        int dev = 0, cus = 0;
        if (hipGetDevice(&dev) != hipSuccess || hipDeviceGetAttribute(&cus, hipDeviceAttributeMultiprocessorCount, dev) != hipSuccess) { fprintf(stderr, "device query failed\n"); grid = -1; return; }
        if (hipFuncSetAttribute((const void*)mega, hipFuncAttributeMaxDynamicSharedMemorySize, LDS_BYTES) != hipSuccess) { fprintf(stderr, "hipFuncSetAttribute failed\n"); grid = -1; return; }
        int per_cu = 0;
        if (hipOccupancyMaxActiveBlocksPerMultiprocessor(&per_cu, (const void*)mega, NT, LDS_BYTES) != hipSuccess || per_cu < 1) { fprintf(stderr, "occupancy query: %d\n", per_cu); }
        (void)hipGetLastError();
        if (cus < NWG) { fprintf(stderr, "this kernel needs %d CUs, device has %d\n", NWG, cus); grid = -1; return; }
        grid = NWG;
    }
    if (grid < 0) return;
    if (WSM.end > ws_size || n_in != 27) { fprintf(stderr, "ws too small: need %zu have %zu (n_in %d)\n", (size_t)WSM.end, ws_size, n_in); return; }
    a = Args{};
    for (int i = 0; i < 27; ++i) a.in[i] = (const float*)d_in[i];
    a.out = (float*)d_out; a.ws = (unsigned char*)d_ws;
    (void)hipMemsetAsync(d_ws, 0, WS_CTL_BYTES, stream);
    hipLaunchKernelGGL(mega, dim3(grid), dim3(NT), LDS_BYTES, stream, a);
}
```
